# Optimizing an MI355X kernel written in HIP

```python
import math
import jax, jax.numpy as jnp
from jax import lax
import numpy as np

D_MODEL = 2048
BATCH = 1
SEQ = 16384
DEPTH = 1

CHUNK = 64
EPS = 1e-6
H_A = 8
HD_A = 128
H_IDX = 16
D_IDX = 64
TOPK_MAX = 256
QBLOCK = 128
N_T5_BUCKETS = 32
T5_MAX_DIST = 1024
H_B = 8
HD_B = 128
N_LEFT_CHUNKS = 8
N_BAND = N_LEFT_CHUNKS + 1
REL_CLIP = 128
W_A = H_A * HD_A
W_B = H_B * HD_B
W_IDX_Q = H_IDX * D_IDX
SPLITS = [W_A, W_A, W_A, W_IDX_Q, D_IDX, H_IDX, W_B, W_B, W_B, D_MODEL, D_MODEL]
IN_COLS = sum(SPLITS)
N_GROUPS = 8
EXP_PER_GROUP = 8
N_EXPERTS = N_GROUPS * EXP_PER_GROUP
TOPK_IN_GROUP = 2
D_FF_E = D_MODEL // 4
MOE_BLOCK = 128

kernel_name = "hybrid_dsa_chunkband_hmoe_block"


def rmsnorm(x, g):
    xf = x.astype(jnp.float32)
    y = xf * lax.rsqrt(jnp.mean(xf * xf, axis=-1, keepdims=True) + EPS)
    return y.astype(x.dtype) * g


def t5_bucket(rel):
    nb = N_T5_BUCKETS // 2
    ret = (rel > 0).astype(jnp.int32) * nb
    n = jnp.abs(rel)
    max_exact = nb // 2
    nf = jnp.maximum(n, 1).astype(jnp.float32)
    large = max_exact + (jnp.log(nf / max_exact) / math.log(T5_MAX_DIST / max_exact)
                         * (nb - max_exact)).astype(jnp.int32)
    large = jnp.minimum(large, nb - 1)
    return ret + jnp.where(n < max_exact, n, large)


def dsa_branch(q, k, v, qi, ki, wi, t5_table):
    Bn, S = q.shape[0], q.shape[1]
    n_sel = min(TOPK_MAX, S // 4)
    nqb = S // QBLOCK
    key_pos = jnp.arange(S, dtype=jnp.int32)
    scale = 1.0 / math.sqrt(HD_A)
    w_scale = (H_IDX ** -0.5) * (D_IDX ** -0.5)

    def block(b):
        start = b * QBLOCK
        q_b = lax.dynamic_slice_in_dim(q, start, QBLOCK, axis=1)
        qi_b = lax.dynamic_slice_in_dim(qi, start, QBLOCK, axis=1)
        wi_b = lax.dynamic_slice_in_dim(wi, start, QBLOCK, axis=1)
        t = start + jnp.arange(QBLOCK, dtype=jnp.int32)
        limit = (t // CHUNK + 1) * CHUNK
        act = jax.nn.relu(jnp.einsum('bqhd,bsd->bqhs', qi_b, ki).astype(jnp.float32))
        score = jnp.einsum('bqhs,bqh->bqs', act, wi_b.astype(jnp.float32) * w_scale)
        vis = key_pos[None, :] < limit[:, None]
        score = jnp.where(vis[None], score, -jnp.inf)
        _, idx = lax.top_k(score, n_sel)
        valid = idx < limit[None, :, None]
        k_g = jax.vmap(lambda kk, ii: kk[ii])(k, idx)
        v_g = jax.vmap(lambda vv, ii: vv[ii])(v, idx)
        logits = jnp.einsum('bqhd,bqkhd->bhqk', q_b, k_g).astype(jnp.float32) * scale
        bias = t5_table[t5_bucket(idx - t[None, :, None])]
        logits = logits + jnp.transpose(bias, (0, 3, 1, 2)).astype(jnp.float32)
        logits = jnp.where(valid[:, None], logits, -jnp.inf)
        p = jax.nn.softmax(logits, axis=-1).astype(v.dtype)
        return jnp.einsum('bhqk,bqkhd->bqhd', p, v_g)

    out = lax.map(block, jnp.arange(nqb, dtype=jnp.int32))
    return jnp.transpose(out, (1, 0, 2, 3, 4)).reshape(Bn, S, W_A)


def chunk_band_branch(q, k, v, rel_table):
    Bn, S = q.shape[0], q.shape[1]
    nc = S // CHUNK
    pad = N_LEFT_CHUNKS * CHUNK
    kp = jnp.pad(k, ((0, 0), (pad, 0), (0, 0), (0, 0))).reshape(Bn, nc + N_LEFT_CHUNKS, CHUNK, H_B, HD_B)
    vp = jnp.pad(v, ((0, 0), (pad, 0), (0, 0), (0, 0))).reshape(Bn, nc + N_LEFT_CHUNKS, CHUNK, H_B, HD_B)
    k_band = jnp.concatenate([kp[:, j:j + nc] for j in range(N_BAND)], axis=2)
    v_band = jnp.concatenate([vp[:, j:j + nc] for j in range(N_BAND)], axis=2)
    qc = q.reshape(Bn, nc, CHUNK, H_B, HD_B)
    logits = jnp.einsum('bcqhd,bckhd->bchqk', qc, k_band).astype(jnp.float32) / math.sqrt(HD_B)
    qi = jnp.arange(CHUNK, dtype=jnp.int32)
    kj = jnp.arange(N_BAND * CHUNK, dtype=jnp.int32)
    rel = qi[:, None] - (kj[None, :] - pad)
    bias = rel_table[:, jnp.clip(rel, -REL_CLIP, REL_CLIP) + REL_CLIP]
    key_chunk = jnp.arange(nc, dtype=jnp.int32)[:, None] - N_LEFT_CHUNKS + kj[None, :] // CHUNK
    valid = key_chunk >= 0
    logits = jnp.where(valid[None, :, None, None, :],
                       logits + bias[None, None].astype(jnp.float32), -jnp.inf)
    p = jax.nn.softmax(logits, axis=-1).astype(v.dtype)
    out = jnp.einsum('bchqk,bckhd->bcqhd', p, v_band)
    return out.reshape(Bn, S, W_B)


def hierarchical_moe(h, w_rg, b_rg, w_re, b_re, w1, w3, w2):
    Bn, S, D = h.shape
    T = Bn * S
    xt = h.reshape(T, D)
    g_logits = (xt @ w_rg).astype(jnp.float32) + b_rg.astype(jnp.float32)
    g_prob = jax.nn.softmax(g_logits, axis=-1)
    grp = jnp.argmax(g_logits, axis=-1).astype(jnp.int32)
    p_grp = jnp.take_along_axis(g_prob, grp[:, None], axis=-1)[:, 0]
    e_logits = ((xt @ w_re).astype(jnp.float32) + b_re.astype(jnp.float32)).reshape(T, N_GROUPS, EXP_PER_GROUP)
    e_in = jnp.take_along_axis(e_logits, grp[:, None, None], axis=1)[:, 0]
    top_v, top_i = lax.top_k(e_in, TOPK_IN_GROUP)
    p_in = jax.nn.softmax(top_v, axis=-1)
    expert = grp[:, None] * EXP_PER_GROUP + top_i.astype(jnp.int32)
    weight = p_grp[:, None] * p_in

    M = T * TOPK_IN_GROUP
    e_flat = expert.reshape(M)
    tok_flat = jnp.repeat(jnp.arange(T, dtype=jnp.int32), TOPK_IN_GROUP)
    w_flat = weight.reshape(M)
    order = jnp.argsort(e_flat, stable=True)
    e_s, tok_s, w_s = e_flat[order], tok_flat[order], w_flat[order]
    counts = jnp.bincount(e_flat, length=N_EXPERTS).astype(jnp.int32)
    start = jnp.cumsum(counts) - counts
    padded = ((counts + MOE_BLOCK - 1) // MOE_BLOCK) * MOE_BLOCK
    pend = jnp.cumsum(padded)
    pstart = pend - padded
    dest = pstart[e_s] + (jnp.arange(M, dtype=jnp.int32) - start[e_s])
    nb = (M + MOE_BLOCK - 1) // MOE_BLOCK + N_EXPERTS
    P = nb * MOE_BLOCK
    tok_buf = jnp.zeros((P,), jnp.int32).at[dest].set(tok_s)
    w_buf = jnp.zeros((P,), h.dtype).at[dest].set(w_s.astype(h.dtype))
    blk_e = jnp.minimum(jnp.searchsorted(pend, jnp.arange(nb, dtype=jnp.int32) * MOE_BLOCK, side='right'),
                        N_EXPERTS - 1).astype(jnp.int32)

    def run(args):
        tok, wt, e = args
        xb = xt[tok]
        a = jax.nn.silu(xb @ w1[e]) * (xb @ w3[e])
        return (a @ w2[e]) * wt[:, None]

    y = lax.map(run, (tok_buf.reshape(nb, MOE_BLOCK), w_buf.reshape(nb, MOE_BLOCK), blk_e))
    out = jnp.zeros((T, D), h.dtype).at[tok_buf].add(y.reshape(P, D))
    return out.reshape(Bn, S, D)


def setup_inputs(seed: int = 0) -> dict:
    key = jax.random.key(seed)
    ks = jax.random.split(key, 24)
    f32 = jnp.float32
    D = D_MODEL

    def nrm(k, shape, scale):
        return jax.random.normal(k, shape, f32) * scale

    return {
        "x": nrm(ks[0], (BATCH, SEQ, D), 1.0),
        "c": nrm(ks[1], (BATCH, D), 1.0),
        "w_ada": nrm(ks[2], (DEPTH, D, 6 * D), D ** -0.5 * 0.5),
        "b_ada": nrm(ks[3], (DEPTH, 6 * D), 0.02),
        "norm_mix": 1.0 + nrm(ks[4], (DEPTH, D), 0.02),
        "w_in": nrm(ks[5], (DEPTH, D, IN_COLS), D ** -0.5),
        "t5_table": nrm(ks[6], (N_T5_BUCKETS, H_A), 0.3),
        "rel_table": nrm(ks[7], (DEPTH, H_B, 2 * REL_CLIP + 1), 0.3),
        "w_up_a": nrm(ks[8], (DEPTH, W_A, D), W_A ** -0.5),
        "w_up_b": nrm(ks[9], (DEPTH, W_B, D), W_B ** -0.5),
        "w_o": nrm(ks[10], (DEPTH, D, D), D ** -0.5),
        "norm_ffn": 1.0 + nrm(ks[11], (DEPTH, D), 0.02),
        "w_rg": nrm(ks[12], (DEPTH, D, N_GROUPS), D ** -0.5),
        "b_rg": nrm(ks[13], (DEPTH, N_GROUPS), 0.01),
        "w_re": nrm(ks[14], (DEPTH, D, N_EXPERTS), D ** -0.5),
        "b_re": nrm(ks[15], (DEPTH, N_EXPERTS), 0.01),
        "w1": nrm(ks[16], (DEPTH, N_EXPERTS, D, D_FF_E), D ** -0.5),
        "w3": nrm(ks[17], (DEPTH, N_EXPERTS, D, D_FF_E), D ** -0.5),
        "w2": nrm(ks[18], (DEPTH, N_EXPERTS, D_FF_E, D), D_FF_E ** -0.5),
        "norm_final": 1.0 + nrm(ks[19], (D,), 0.02),
    }


def reference(x, c, w_ada, b_ada, norm_mix, w_in, t5_table, rel_table, w_up_a, w_up_b,
              w_o, norm_ffn, w_rg, b_rg, w_re, b_re, w1, w3, w2, norm_final):
    Bn, S, D = x.shape
    split_pts = list(np.cumsum(SPLITS)[:-1])
    c_act = jax.nn.silu(c)
    for l in range(DEPTH):
        mod = c_act @ w_ada[l] + b_ada[l]
        sh1, sc1, g1, sh2, sc2, g2 = [m[:, None, :] for m in jnp.split(mod, 6, axis=-1)]

        h = rmsnorm(x, norm_mix[l]) * (1.0 + sc1) + sh1
        proj = h @ w_in[l]
        qa, ka, va, qi, ki, wi, qb, kb, vb, gate_a, gate_b = jnp.split(proj, split_pts, axis=-1)
        y_a = dsa_branch(qa.reshape(Bn, S, H_A, HD_A), ka.reshape(Bn, S, H_A, HD_A),
                         va.reshape(Bn, S, H_A, HD_A), qi.reshape(Bn, S, H_IDX, D_IDX),
                         ki, wi, t5_table)
        y_b = chunk_band_branch(qb.reshape(Bn, S, H_B, HD_B), kb.reshape(Bn, S, H_B, HD_B),
                                vb.reshape(Bn, S, H_B, HD_B), rel_table[l])
        merged = jax.nn.sigmoid(gate_a) * (y_a @ w_up_a[l]) + jax.nn.sigmoid(gate_b) * (y_b @ w_up_b[l])
        x = x + g1 * (merged @ w_o[l])

        h2 = rmsnorm(x, norm_ffn[l]) * (1.0 + sc2) + sh2
        x = x + g2 * hierarchical_moe(h2, w_rg[l], b_rg[l], w_re[l], b_re[l], w1[l], w3[l], w2[l])
    return rmsnorm(x, norm_final)
```

```cpp
#include <hip/hip_runtime.h>
#include <cstdio>
#include <cstdint>

#define LAS __attribute__((address_space(3)))
typedef unsigned short bf16_t;
typedef short bf16x8 __attribute__((ext_vector_type(8)));
typedef short s16x4 __attribute__((ext_vector_type(4)));
typedef float f32x2 __attribute__((ext_vector_type(2)));
typedef float f32x4 __attribute__((ext_vector_type(4)));
typedef float f32x16 __attribute__((ext_vector_type(16)));
typedef unsigned u32x2 __attribute__((ext_vector_type(2)));
typedef unsigned u32x4 __attribute__((ext_vector_type(4)));
typedef int i32x4_ __attribute__((ext_vector_type(4)));
typedef int i32x8 __attribute__((ext_vector_type(8)));

constexpr int SEQ = 16384, DM = 2048, NPROJ = 11520  , NPROJ_REAL = 11344;
constexpr int COL_QA = 0, COL_KA = 1024, COL_VA = 2048, COL_QI = 3072, COL_KI = 4096, COL_WI = 4160, COL_QB = 4176, COL_KB = 5200, COL_VB = 6224, COL_GA = 7248, COL_GB = 9296;
constexpr int NEXP = 64, DFF = 512, LIST_CAP = 16384;
constexpr int NPB = 5376  , NPB_REAL = 5200, NP8 = 6144  ;
constexpr int H8_SCALE_LOG2 = 4, W8_SCALE_LOG2 = 9, W2_SCALE_LOG2 = 8, A8_SCALE_LOG2 = 4, Y8_SCALE_LOG2 = 6, M8_SCALE_LOG2 = 5;
constexpr float EPS = 1e-6f;
constexpr float LOG2E = 1.4426950408889634f;

constexpr size_t A256(size_t x) { return (x + 255) / 256 * 256; }
constexpr size_t WS_CTL = 0;
constexpr size_t CTL_BAR = 0;
constexpr size_t CTL_MOD = 16384;
constexpr size_t CTL_ECNT = 16384 + 49152;
constexpr size_t CTL_BYTES = 16384 + 49152 + 4096 + 256;
constexpr size_t WS_WINT = 131072;
constexpr size_t WS_WUPA = WS_WINT + (size_t)NPROJ * DM * 2;
constexpr size_t WS_WUPB = WS_WUPA + (size_t)DM * 1024 * 2;
constexpr size_t WS_WO   = WS_WUPB + (size_t)DM * 1024 * 2;
constexpr size_t WS_W13  = WS_WO + (size_t)DM * DM * 2;
constexpr size_t WS_W2   = WS_W13 + (size_t)NEXP * 1024 * DM;
constexpr size_t WS_H    = WS_W2 + (size_t)NEXP * DM * DFF;
constexpr size_t WS_PROJ = WS_H + (size_t)SEQ * DM * 2;
constexpr size_t WS_MASK = WS_PROJ + (size_t)SEQ * NPROJ * 2;
constexpr size_t WS_YA   = WS_MASK + (size_t)256 * SEQ * 8;
constexpr size_t WS_YB   = WS_YA + (size_t)SEQ * 1024 * 2;
constexpr size_t WS_MRG  = WS_YB + (size_t)SEQ * 1024 * 2;
constexpr size_t WS_LIST = WS_MRG + (size_t)SEQ * DM * 2;
constexpr size_t WS_TSLOT = WS_LIST + (size_t)NEXP * LIST_CAP * 4;
constexpr size_t WS_TW   = WS_TSLOT + (size_t)SEQ * 2 * 4;
constexpr size_t WS_H8   = WS_TW + (size_t)SEQ * 2 * 4;
constexpr size_t WS_END  = WS_H8 + (size_t)SEQ * DM;
constexpr int MAX_PAD_ROWS = 2 * SEQ + NEXP * 255 + 1;
static_assert((size_t)MAX_PAD_ROWS * DM * 2 <= (size_t)SEQ * NPROJ * 2, "y fits in proj region");
static_assert((size_t)MAX_PAD_ROWS * DFF * 2 <= (size_t)SEQ * DM * 2, "a fits in merged region");

constexpr int LDS_BYTES = 147456;

__device__ __forceinline__ unsigned cvt_pk_bf16(float lo, float hi) { unsigned r; asm volatile("v_cvt_pk_bf16_f32 %0, %1, %2" : "=v"(r) : "v"(lo), "v"(hi)); return r; }
__device__ __forceinline__ float bf_lo(unsigned w) { return __uint_as_float(w << 16); }
__device__ __forceinline__ float bf_hi(unsigned w) { return __uint_as_float(w & 0xffff0000u); }
__device__ __forceinline__ float sigmoidf_(float x) { return __builtin_amdgcn_rcpf(1.0f + __builtin_amdgcn_exp2f(-x * LOG2E)); }
__device__ __forceinline__ unsigned cvt_fp8x4_(float a, float b, float c, float d) {
    int w = 0; w = __builtin_amdgcn_cvt_pk_fp8_f32(a, b, w, false); w = __builtin_amdgcn_cvt_pk_fp8_f32(c, d, w, true); return (unsigned)w;
}
__device__ __forceinline__ float wave_sum(float v) {
#pragma unroll
    for (int o = 32; o >= 1; o >>= 1) v += __shfl_xor(v, o);
    return v;
}

#define XB_TMO      128
#define XB_XCNT(j)  (256  + 64 * (j))
#define XB_XSUB(j)  (1280 + 64 * (j))
#define XB_XGEN(j)  (2304 + 64 * (j))
#define XB_TOP      3328
#define XB_TOPGEN   3392
#define XCD_BAR_WORDS 3456
#define XB_SPIN_CAP (1u << 22)
__device__ __forceinline__ unsigned xb_ld(unsigned* p)              { return __hip_atomic_load(p, __ATOMIC_RELAXED, __HIP_MEMORY_SCOPE_AGENT); }
__device__ __forceinline__ unsigned xb_add(unsigned* p, unsigned v) { return __hip_atomic_fetch_add(p, v, __ATOMIC_RELAXED, __HIP_MEMORY_SCOPE_AGENT); }
__device__ __forceinline__ unsigned xb_xcc_id() { return (unsigned)__builtin_amdgcn_s_getreg((3 << 11) | 20) & 0xFu; }
#define XB_SPIN(cond, bar) do { unsigned _sp = 0; while (cond) { __builtin_amdgcn_s_sleep(1); \
    if ((++_sp & 255u) == 0u) { if (xb_ld(&(bar)[XB_TMO])) break; if (_sp > XB_SPIN_CAP) { atomicAdd(&(bar)[XB_TMO], 1u); break; } } } } while (0)
struct XcdBarrier { unsigned* bar; unsigned x; volatile LAS unsigned* st; };
__device__ __forceinline__ XcdBarrier xcd_barrier_post(unsigned* bar, volatile LAS unsigned* st) {
    XcdBarrier b; b.bar = bar; b.x = xb_xcc_id(); b.st = st;
    if (threadIdx.x == 0) (void)xb_add(&bar[XB_XCNT(b.x)], 1u);
    return b;
}
__device__ __forceinline__ void xcd_barrier_complete(unsigned* bar, unsigned x, unsigned& nloc, unsigned& nx) {
    const unsigned G = gridDim.x * gridDim.y * gridDim.z;
    unsigned sum, cnt, mine, sp = 0u;
    for (;;) {
        sum = 0u; cnt = 0u; mine = 0u;
#pragma unroll
        for (unsigned j = 0; j < 16; ++j) { const unsigned c = xb_ld(&bar[XB_XCNT(j)]); sum += c; cnt += (c > 0u) ? 1u : 0u; mine = (j == x) ? c : mine; }
        if (sum == G) break;
        __builtin_amdgcn_s_sleep(1);
        if ((++sp & 255u) == 0u) { if (xb_ld(&bar[XB_TMO])) break; if (sp > XB_SPIN_CAP) { atomicAdd(&bar[XB_TMO], 1u); break; } }
    }
    nloc = mine > 0u ? mine : 1u; nx = cnt > 0u ? cnt : 1u;
}
__device__ __forceinline__ void xcd_barrier(const XcdBarrier& b) {
    asm volatile("s_waitcnt vmcnt(0)" ::: "memory");
    __syncthreads();
    if (threadIdx.x == 0) {
        unsigned* bar = b.bar;
        __builtin_amdgcn_s_waitcnt(0);
        unsigned nloc = b.st[0], nx = b.st[1];
        if (nloc == 0u) { xcd_barrier_complete(bar, b.x, nloc, nx); b.st[0] = nloc; b.st[1] = nx; }
        const unsigned old = xb_add(&bar[XB_XSUB(b.x)], 1u);
        const unsigned gen = old / nloc;
        if (old + 1u == (gen + 1u) * nloc) {
            __builtin_amdgcn_fence(__ATOMIC_RELEASE, "agent");
            asm volatile("s_waitcnt vmcnt(0)" ::: "memory");
            const unsigned og = xb_add(&bar[XB_TOP], 1u);
            const unsigned tg = og / nx;
            if (og + 1u == (tg + 1u) * nx) xb_add(&bar[XB_TOPGEN], 1u);
            else XB_SPIN(xb_ld(&bar[XB_TOPGEN]) == tg, bar);
            __builtin_amdgcn_fence(__ATOMIC_ACQUIRE, "agent");
            xb_add(&bar[XB_XGEN(b.x)], 1u);
            asm volatile("s_waitcnt vmcnt(0)" ::: "memory");
        } else {
            XB_SPIN(xb_ld(&bar[XB_XGEN(b.x)]) == gen, bar);
            __builtin_amdgcn_fence(__ATOMIC_ACQUIRE, "agent");
            asm volatile("s_waitcnt vmcnt(0)" ::: "memory");
        }
    }
    __syncthreads();
}

namespace pg8 {
constexpr int BM = 256, BK = 64, HALF = 128, HTB = HALF * BK * 2, STAGE_BYTES = 8 * HTB, NXCD = 8, WGM = 8;
__host__ __device__ __forceinline__ int lds_byte(int r, int c) { const int st = (r >> 4) * 2 + (c >> 5), rr = r & 15, cc = c & 31, ob = rr * 64 + cc * 2; return st * 1024 + (ob ^ (((ob >> 9) & 1) << 5)); }
__host__ __device__ __forceinline__ void stage_rc(int b, int& R, int& C) { const int st = b / 1024, sb = b % 1024, swz = sb ^ (((sb >> 9) & 1) << 5); R = (st >> 1) * 16 + swz / 64; C = (st & 1) * 32 + (swz % 64) / 2; }
__host__ __device__ __forceinline__ int perm32(int rho) { const int n = rho >> 4, i = rho & 15; return 8 * (i >> 2) + 4 * n + (i & 3); }

struct Unit { int pm, pn; const char* A; const char* B; int x0, x1; };

template <int K> struct StaticOrder {
    int nM, nN, nwg, G, c; const char* A; const char* Bt;
    __device__ void init(const void* A_, const void* Bt_, int M, int N, int G_, int c_) { A = (const char*)A_; Bt = (const char*)Bt_; nM = M / BM; nN = N / BM; nwg = nM * nN; G = G_; c = c_; }
    __device__ __forceinline__ bool next(int i, Unit& u) const {
        const long L = (long)i * G + c; if (L >= nwg) return false;
        int wgid = (int)L; { const int q = nwg / NXCD, r = nwg % NXCD, xcd = wgid % NXCD, off = wgid / NXCD; wgid = (xcd < r ? xcd * (q + 1) : r * (q + 1) + (xcd - r) * q) + off; }
        const int nig = WGM * nN, gid = wgid / nig, fm = gid * WGM, gsz = (nM - fm) < WGM ? (nM - fm) : WGM;
        u.pm = fm + ((wgid % nig) % gsz); u.pn = (wgid % nig) / gsz;
        u.A = A + (size_t)u.pm * BM * K * 2; u.B = Bt + (size_t)u.pn * BM * K * 2; u.x0 = 0; u.x1 = 0; return true;
    }
    __device__ __forceinline__ int arow(const Unit&, int r) const { return r; }
};

template <bool FP8> struct FragT { typedef bf16x8 A[4][2]; typedef bf16x8 B[2][2]; };
template <> struct FragT<true> { typedef i32x8 A[4]; typedef i32x8 B[2]; };
struct ProjOrder8 : StaticOrder<1024> {
    int bid;
    __device__ __forceinline__ bool next(int i, Unit& u) const {
        if (G != 256) return StaticOrder<1024>::next(i, u);
        long L;
        if (i < 4) L = (long)i * 256 + bid; else { if (bid < 64) return false; L = 1024 + (long)(i - 4) * 192 + (bid - 64); }
        if (L >= nwg) return false;
        int wgid = (int)L; { const int q = nwg / NXCD, r = nwg % NXCD, xcd = wgid % NXCD, off = wgid / NXCD; wgid = (xcd < r ? xcd * (q + 1) : r * (q + 1) + (xcd - r) * q) + off; }
        const int nig = WGM * nN, gid = wgid / nig, fm = gid * WGM, gsz = (nM - fm) < WGM ? (nM - fm) : WGM;
        u.pm = fm + ((wgid % nig) % gsz); u.pn = (wgid % nig) / gsz;
        u.A = A + (size_t)u.pm * BM * 1024 * 2; u.B = Bt + (size_t)u.pn * BM * 1024 * 2; u.x0 = 0; u.x1 = 0; return true;
    }
};
template <int K, bool GATHER, bool FP8, class Epi, class Sched>
__device__ __forceinline__ void gemm_phase(LAS unsigned char* lds, const Sched& S, const Epi& E, int sclW_log2 = 0, int sclH_log2 = 0) {
    const int tid = threadIdx.x, wid = __builtin_amdgcn_readfirstlane(tid >> 6), lane = tid & 63, wr = wid >> 2, wc = wid & 3, fr = lane & 15, fq = lane >> 4;
    constexpr int nt = K / BK;
    int R0, C0, R1, C1; stage_rc(tid * 16, R0, C0); stage_rc(tid * 16 + 8192, R1, C1);
    unsigned voffB[2];
    { const int Rb0 = Epi::PERM ? ((R0 & ~31) + perm32(R0 & 31)) : R0, Rb1 = Epi::PERM ? ((R1 & ~31) + perm32(R1 & 31)) : R1;
      voffB[0] = (unsigned)(Rb0 * K + C0) * 2u; voffB[1] = (unsigned)(Rb1 * K + C1) * 2u; }
    constexpr size_t kstep = (size_t)(BK * 2), hstep = (size_t)HALF * K * 2;
    const unsigned ldsw = (unsigned)wid * 1024u;
    const int aoff = lds_byte(wr * 64 + fr, fq * 8), boff = lds_byte(wc * 32 + fr, fq * 8);
#define PG8_SA(b, h) (((b) * 2 + (h)) * HTB)
#define PG8_SB(b, h) ((4 + (b) * 2 + (h)) * HTB)
#define PG8_GLDS(bufoff, gp0, gp1) do { \
        __builtin_amdgcn_global_load_lds((const unsigned*)(gp0), (LAS unsigned*)(lds + (bufoff) + ldsw), 16, 0, 0); \
        __builtin_amdgcn_global_load_lds((const unsigned*)(gp1), (LAS unsigned*)(lds + (bufoff) + ldsw + 8192), 16, 0, 0); } while (0)
#define PG8_STAGE_B(bufoff, gbase) PG8_GLDS(bufoff, (const char*)(gbase) + voffB[0], (const char*)(gbase) + voffB[1])
#define PG8_STAGE_A(bufoff, gbase, v0, v1) PG8_GLDS(bufoff, (const char*)(gbase) + (v0), (const char*)(gbase) + (v1))
#define PG8_LDA(dst, b, h) do { if constexpr (FP8) { _Pragma("unroll") for (int m = 0; m < 4; ++m) { \
            const i32x4_ lo_ = *(const LAS i32x4_*)(lds + PG8_SA(b, h) + aoff + m * 2048), hi_ = *(const LAS i32x4_*)(lds + PG8_SA(b, h) + aoff + m * 2048 + 1024); \
            *(i32x8*)&dst[m] = __builtin_shufflevector(lo_, hi_, 0, 1, 2, 3, 4, 5, 6, 7); } } \
        else { _Pragma("unroll") for (int m = 0; m < 4; ++m) _Pragma("unroll") for (int k = 0; k < 2; ++k) ((bf16x8*)&dst[m])[k] = *(const LAS bf16x8*)(lds + PG8_SA(b, h) + aoff + m * 2048 + k * 1024); } } while (0)
#define PG8_LDB(dst, b, h) do { if constexpr (FP8) { _Pragma("unroll") for (int n = 0; n < 2; ++n) { \
            const i32x4_ lo_ = *(const LAS i32x4_*)(lds + PG8_SB(b, h) + boff + n * 2048), hi_ = *(const LAS i32x4_*)(lds + PG8_SB(b, h) + boff + n * 2048 + 1024); \
            *(i32x8*)&dst[n] = __builtin_shufflevector(lo_, hi_, 0, 1, 2, 3, 4, 5, 6, 7); } } \
        else { _Pragma("unroll") for (int n = 0; n < 2; ++n) _Pragma("unroll") for (int k = 0; k < 2; ++k) ((bf16x8*)&dst[n])[k] = *(const LAS bf16x8*)(lds + PG8_SB(b, h) + boff + n * 2048 + k * 1024); } } while (0)
#define PG8_MMA(ai, bj, At, Bt) do { __builtin_amdgcn_s_setprio(1); \
        if constexpr (FP8) { _Pragma("unroll") for (int m = 0; m < 4; ++m) _Pragma("unroll") for (int n = 0; n < 2; ++n) \
            asm volatile("v_mfma_scale_f32_16x16x128_f8f6f4 %0, %1, %2, %0, %3, %4 op_sel_hi:[0,0,0]" : "+v"(acc[ai][bj][m][n]) : "v"(*(const i32x8*)&Bt[n]), "v"(*(const i32x8*)&At[m]), "v"(sclW), "v"(sclH)); } \
        else { _Pragma("unroll") for (int m = 0; m < 4; ++m) _Pragma("unroll") for (int n = 0; n < 2; ++n) _Pragma("unroll") for (int k = 0; k < 2; ++k) \
            acc[ai][bj][m][n] = __builtin_amdgcn_mfma_f32_16x16x32_bf16(((const bf16x8*)&Bt[n])[k], ((const bf16x8*)&At[m])[k], acc[ai][bj][m][n], 0, 0, 0); } \
        __builtin_amdgcn_s_setprio(0); } while (0)
#define PG8_WAIT_V(n) asm volatile("s_waitcnt vmcnt(" #n ")" ::: "memory")
#define PG8_WAIT_L(n) asm volatile("s_waitcnt lgkmcnt(" #n ")" ::: "memory")
#define PG8_BAR __builtin_amdgcn_s_barrier()
#define PG8_SCHED __builtin_amdgcn_sched_barrier(0)
#define PG8_SETA(u, v) do { if (GATHER) { \
        v[0][0] = (unsigned)(S.arow(u, R0) * K + C0) * 2u; v[0][1] = (unsigned)(S.arow(u, R1) * K + C1) * 2u; \
        v[1][0] = (unsigned)(S.arow(u, HALF + R0) * K + C0) * 2u; v[1][1] = (unsigned)(S.arow(u, HALF + R1) * K + C1) * 2u; \
      } else { v[0][0] = (unsigned)(R0 * K + C0) * 2u; v[0][1] = (unsigned)(R1 * K + C1) * 2u; v[1][0] = v[0][0] + (unsigned)hstep; v[1][1] = v[0][1] + (unsigned)hstep; } } while (0)
    Unit cur, nxt; int ui = 0;
    if (!S.next(0, cur)) return;
    f32x4 acc[2][2][4][2];
#pragma unroll
    for (int a = 0; a < 2; ++a)
#pragma unroll
        for (int b = 0; b < 2; ++b)
#pragma unroll
            for (int m = 0; m < 4; ++m)
#pragma unroll
                for (int n = 0; n < 2; ++n) acc[a][b][m][n] = (f32x4){0.f, 0.f, 0.f, 0.f};
    typename FragT<FP8>::A At; typename FragT<FP8>::B B0, B1;
    const int sclW = 127 - sclW_log2, sclH = 127 - sclH_log2;
    unsigned vA[2][2], vN[2][2];
    PG8_SETA(cur, vA);
    const char* cA = cur.A; const char* cB = cur.B;
    PG8_STAGE_B(PG8_SB(0, 0), cB); PG8_STAGE_A(PG8_SA(0, 0), cA, vA[0][0], vA[0][1]); PG8_STAGE_B(PG8_SB(0, 1), cB + hstep); PG8_STAGE_A(PG8_SA(0, 1), cA, vA[1][0], vA[1][1]);
    if (wr == 1) PG8_BAR;
    PG8_WAIT_V(4); PG8_BAR;
    PG8_STAGE_B(PG8_SB(1, 0), cB + kstep); PG8_STAGE_A(PG8_SA(1, 0), cA + kstep, vA[0][0], vA[0][1]); PG8_STAGE_B(PG8_SB(1, 1), cB + hstep + kstep);
    PG8_WAIT_V(6); PG8_BAR;
    for (;;) {
        const bool has_next = S.next(ui + 1, nxt);
        const char* nA = has_next ? nxt.A : cA; const char* nB = has_next ? nxt.B : cB;
        if (has_next) { PG8_SETA(nxt, vN); } else { vN[0][0] = vA[0][0]; vN[0][1] = vA[0][1]; vN[1][0] = vA[1][0]; vN[1][1] = vA[1][1]; }
        for (int t = 0; t < nt; t += 2) {
            const bool last = (t == nt - 2);
            const char* a1 = cA + (size_t)(t + 1) * kstep;
            const char* a2 = last ? nA : cA + (size_t)(t + 2) * kstep; const char* b2 = last ? nB : cB + (size_t)(t + 2) * kstep;
            const char* a3 = a2 + kstep; const char* b3 = b2 + kstep;
            const unsigned w00 = last ? vN[0][0] : vA[0][0], w01 = last ? vN[0][1] : vA[0][1], w10 = last ? vN[1][0] : vA[1][0], w11 = last ? vN[1][1] : vA[1][1];
            PG8_LDB(B0, 0, 0); PG8_SCHED; PG8_LDA(At, 0, 0); PG8_STAGE_A(PG8_SA(1, 1), a1, vA[1][0], vA[1][1]);
            PG8_WAIT_L(8); PG8_BAR; PG8_WAIT_L(0); PG8_MMA(0, 0, At, B0); PG8_BAR; PG8_SCHED;
            PG8_LDB(B1, 0, 1); PG8_STAGE_B(PG8_SB(0, 0), b2);
            PG8_BAR; PG8_WAIT_L(0); PG8_MMA(0, 1, At, B1); PG8_BAR;
            PG8_LDA(At, 0, 1); PG8_STAGE_A(PG8_SA(0, 0), a2, w00, w01);
            PG8_BAR; PG8_WAIT_L(0); PG8_MMA(1, 0, At, B0); PG8_BAR; PG8_SCHED;
            PG8_STAGE_B(PG8_SB(0, 1), b2 + hstep);
            PG8_WAIT_V(6); PG8_BAR; PG8_MMA(1, 1, At, B1); PG8_BAR;
            PG8_LDB(B0, 1, 0); PG8_SCHED; PG8_LDA(At, 1, 0); PG8_STAGE_A(PG8_SA(0, 1), a2, w10, w11);
            PG8_WAIT_L(8); PG8_BAR; PG8_WAIT_L(0); PG8_MMA(0, 0, At, B0); PG8_BAR; PG8_SCHED;
            PG8_LDB(B1, 1, 1); PG8_STAGE_B(PG8_SB(1, 0), b3);
            PG8_BAR; PG8_WAIT_L(0); PG8_MMA(0, 1, At, B1); PG8_BAR;
            PG8_LDA(At, 1, 1); PG8_STAGE_A(PG8_SA(1, 0), a3, w00, w01);
            PG8_BAR; PG8_WAIT_L(0); PG8_MMA(1, 0, At, B0); PG8_BAR; PG8_SCHED;
            PG8_STAGE_B(PG8_SB(1, 1), b3 + hstep);
            PG8_WAIT_V(6); PG8_BAR; PG8_MMA(1, 1, At, B1); PG8_BAR;
        }
        if constexpr (FP8) asm volatile("s_nop 15\n\ts_nop 15\n\ts_nop 15" ::: "memory");
        E(acc, cur, wr, wc, fr, fq);
        if (!has_next) break;
#pragma unroll
        for (int a = 0; a < 2; ++a)
#pragma unroll
            for (int b = 0; b < 2; ++b)
#pragma unroll
                for (int m = 0; m < 4; ++m)
#pragma unroll
                    for (int n = 0; n < 2; ++n) acc[a][b][m][n] = (f32x4){0.f, 0.f, 0.f, 0.f};
        cur = nxt; cA = nA; cB = nB; ++ui;
        vA[0][0] = vN[0][0]; vA[0][1] = vN[0][1]; vA[1][0] = vN[1][0]; vA[1][1] = vN[1][1];
    }
    PG8_WAIT_V(0);
    if (wr == 0) PG8_BAR;
    PG8_BAR;
#undef PG8_SA
#undef PG8_SB
#undef PG8_GLDS
#undef PG8_STAGE_A
#undef PG8_STAGE_B
#undef PG8_LDA
#undef PG8_LDB
#undef PG8_MMA
#undef PG8_WAIT_V
#undef PG8_WAIT_L
#undef PG8_BAR
#undef PG8_SCHED
#undef PG8_SETA
}

struct EpiProj {
    static constexpr bool PERM = true;
    bf16_t* O;
    __device__ __forceinline__ void operator()(const f32x4 (&acc)[2][2][4][2], const Unit& u, int wr, int wc, int fr, int fq) const {
        const int row0 = u.pm * BM + wr * 64 + fr, col0 = u.pn * BM + wc * 32 + 8 * fq;
#pragma unroll
        for (int ai = 0; ai < 2; ++ai)
#pragma unroll
            for (int m = 0; m < 4; ++m) { bf16_t* rowp = O + (size_t)(row0 + ai * HALF + m * 16) * NPROJ;
#pragma unroll
                for (int bj = 0; bj < 2; ++bj) { const f32x4 v0 = acc[ai][bj][m][0], v1 = acc[ai][bj][m][1];
                    const int c = col0 + bj * HALF;
                    u32x4 w; w.x = cvt_pk_bf16(v0[0], v0[1]); w.y = cvt_pk_bf16(v0[2], v0[3]); w.z = cvt_pk_bf16(v1[0], v1[1]); w.w = cvt_pk_bf16(v1[2], v1[3]);
                    if (c < NPB_REAL) *(u32x4*)(rowp + (c < 2048 ? c : c + 1024)) = w; } }
    }
};
struct EpiProj8 {
    static constexpr bool PERM = true;
    bf16_t* O;
    __device__ __forceinline__ void operator()(const f32x4 (&acc)[2][2][4][2], const Unit& u, int wr, int wc, int fr, int fq) const {
        const int row0 = u.pm * BM + wr * 64 + fr;
        const int tc = u.pn * BM;
        const int dc = (tc < 1024 ? COL_VA + tc : (tc < 2048 ? COL_VB + (tc - 1024) : COL_GA + (tc - 2048))) + wc * 32 + 8 * fq;
#pragma unroll
        for (int ai = 0; ai < 2; ++ai)
#pragma unroll
            for (int m = 0; m < 4; ++m) { bf16_t* rowp = O + (size_t)(row0 + ai * HALF + m * 16) * NPROJ + dc;
#pragma unroll
                for (int bj = 0; bj < 2; ++bj) { const f32x4 v0 = acc[ai][bj][m][0], v1 = acc[ai][bj][m][1];
                    u32x4 w; w.x = cvt_pk_bf16(v0[0], v0[1]); w.y = cvt_pk_bf16(v0[2], v0[3]); w.z = cvt_pk_bf16(v1[0], v1[1]); w.w = cvt_pk_bf16(v1[2], v1[3]);
                    *(u32x4*)(rowp + bj * HALF) = w; } }
    }
};
template <bool ADD> struct EpiGate {
    static constexpr bool PERM = true;
    const bf16_t* proj; int gcol; const bf16_t* Tin; void* Tout;
    __device__ __forceinline__ void operator()(const f32x4 (&acc)[2][2][4][2], const Unit& u, int wr, int wc, int fr, int fq) const {
        const int row0 = u.pm * BM + wr * 64 + fr, col0 = u.pn * BM + wc * 32 + 8 * fq;
#pragma unroll
        for (int ai = 0; ai < 2; ++ai) {
            u32x4 gb[4][2], tb[4][2];
#pragma unroll
            for (int m = 0; m < 4; ++m)
#pragma unroll
                for (int bj = 0; bj < 2; ++bj) { const size_t row = (size_t)(row0 + ai * HALF + m * 16);
                    gb[m][bj] = *(const u32x4*)(proj + row * NPROJ + gcol + col0 + bj * HALF);
                    if (ADD) tb[m][bj] = *(const u32x4*)(Tin + row * DM + col0 + bj * HALF); }
#pragma unroll
            for (int m = 0; m < 4; ++m) { const size_t row = (size_t)(row0 + ai * HALF + m * 16);
#pragma unroll
                for (int bj = 0; bj < 2; ++bj) { const f32x4 v0 = acc[ai][bj][m][0], v1 = acc[ai][bj][m][1];
                    const u32x4 g = gb[m][bj];
                    float o[8];
                    o[0] = sigmoidf_(bf_lo(g.x)) * v0[0]; o[1] = sigmoidf_(bf_hi(g.x)) * v0[1]; o[2] = sigmoidf_(bf_lo(g.y)) * v0[2]; o[3] = sigmoidf_(bf_hi(g.y)) * v0[3];
                    o[4] = sigmoidf_(bf_lo(g.z)) * v1[0]; o[5] = sigmoidf_(bf_hi(g.z)) * v1[1]; o[6] = sigmoidf_(bf_lo(g.w)) * v1[2]; o[7] = sigmoidf_(bf_hi(g.w)) * v1[3];
#if defined(DBG_NOA)
                    if (!ADD) { for (int q_ = 0; q_ < 8; ++q_) o[q_] = 0.f; }
#endif
#if defined(DBG_NOB)
                    if (ADD) { for (int q_ = 0; q_ < 8; ++q_) o[q_] = 0.f; }
#endif
                    if (ADD) { const u32x4 t = tb[m][bj];
                        o[0] += bf_lo(t.x); o[1] += bf_hi(t.x); o[2] += bf_lo(t.y); o[3] += bf_hi(t.y); o[4] += bf_lo(t.z); o[5] += bf_hi(t.z); o[6] += bf_lo(t.w); o[7] += bf_hi(t.w);
                        const float s8 = (float)(1 << M8_SCALE_LOG2);
#pragma unroll
                        for (int q_ = 0; q_ < 8; ++q_) o[q_] = fminf(fmaxf(o[q_] * s8, -440.f), 440.f);
                        u32x2 w; w.x = cvt_fp8x4_(o[0], o[1], o[2], o[3]); w.y = cvt_fp8x4_(o[4], o[5], o[6], o[7]);
                        *(u32x2*)((unsigned char*)Tout + row * DM + col0 + bj * HALF) = w;
                    } else {
                        u32x4 w; w.x = cvt_pk_bf16(o[0], o[1]); w.y = cvt_pk_bf16(o[2], o[3]); w.z = cvt_pk_bf16(o[4], o[5]); w.w = cvt_pk_bf16(o[6], o[7]);
                        *(u32x4*)((bf16_t*)Tout + row * DM + col0 + bj * HALF) = w; } } }
        }
    }
};
struct EpiRes {
    static constexpr bool PERM = true;
    const float* X; const float* g1; bf16_t* O;
    __device__ __forceinline__ void operator()(const f32x4 (&acc)[2][2][4][2], const Unit& u, int wr, int wc, int fr, int fq) const {
        const int row0 = u.pm * BM + wr * 64 + fr, col0 = u.pn * BM + wc * 32 + 8 * fq;
        f32x4 gv[2][2];
#pragma unroll
        for (int bj = 0; bj < 2; ++bj)
#pragma unroll
            for (int n = 0; n < 2; ++n) gv[bj][n] = *(const f32x4*)(g1 + col0 + bj * HALF + n * 4);
#pragma unroll
        for (int ai = 0; ai < 2; ++ai) {
            f32x4 xb[4][2][2];
#pragma unroll
            for (int m = 0; m < 4; ++m)
#pragma unroll
                for (int bj = 0; bj < 2; ++bj) { const size_t ro = (size_t)(row0 + ai * HALF + m * 16) * DM + col0;
                    xb[m][bj][0] = *(const f32x4*)(X + ro + bj * HALF); xb[m][bj][1] = *(const f32x4*)(X + ro + bj * HALF + 4); }
#pragma unroll
            for (int m = 0; m < 4; ++m) { const size_t ro = (size_t)(row0 + ai * HALF + m * 16) * DM + col0;
#pragma unroll
                for (int bj = 0; bj < 2; ++bj) {
                    const f32x4 o0 = xb[m][bj][0] + gv[bj][0] * acc[ai][bj][m][0], o1 = xb[m][bj][1] + gv[bj][1] * acc[ai][bj][m][1];
                    u32x4 w; w.x = cvt_pk_bf16(o0[0], o0[1]); w.y = cvt_pk_bf16(o0[2], o0[3]); w.z = cvt_pk_bf16(o1[0], o1[1]); w.w = cvt_pk_bf16(o1[2], o1[3]);
                    *(u32x4*)(O + ro + bj * HALF) = w; } }
        }
    }
};
struct EpiMoe1 {
    static constexpr bool PERM = false;
    unsigned char* Aout;
    __device__ __forceinline__ void operator()(const f32x4 (&acc)[2][2][4][2], const Unit& u, int wr, int wc, int fr, int fq) const {
        const int row0 = u.x0 + wr * 64 + fr; const float s8 = (float)(1 << A8_SCALE_LOG2);
#pragma unroll
        for (int ai = 0; ai < 2; ++ai)
#pragma unroll
            for (int m = 0; m < 4; ++m) { unsigned char* rowp = Aout + (size_t)(row0 + ai * HALF + m * 16) * DFF;
#pragma unroll
                for (int bj = 0; bj < 2; ++bj) { const f32x4 a1 = acc[ai][bj][m][0], a3 = acc[ai][bj][m][1]; float o[4];
#pragma unroll
                    for (int j = 0; j < 4; ++j) o[j] = fminf(fmaxf(a1[j] * sigmoidf_(a1[j]) * a3[j] * s8, -440.f), 440.f);
                    *(unsigned*)(rowp + (8 * u.pn + 4 * bj + wc) * 16 + 4 * fq) = cvt_fp8x4_(o[0], o[1], o[2], o[3]); } }
    }
};
struct EpiMoe2 {
    static constexpr bool PERM = true;
    bf16_t* Y;
    __device__ __forceinline__ void operator()(const f32x4 (&acc)[2][2][4][2], const Unit& u, int wr, int wc, int fr, int fq) const {
        const int row0 = u.x0 + wr * 64 + fr, col0 = u.pn * BM + wc * 32 + 8 * fq;
#pragma unroll
        for (int ai = 0; ai < 2; ++ai)
#pragma unroll
            for (int m = 0; m < 4; ++m) { bf16_t* rowp = Y + (size_t)(row0 + ai * HALF + m * 16) * DM + col0;
#pragma unroll
                for (int bj = 0; bj < 2; ++bj) { const f32x4 v0 = acc[ai][bj][m][0], v1 = acc[ai][bj][m][1];
                    u32x4 w; w.x = cvt_pk_bf16(v0[0], v0[1]); w.y = cvt_pk_bf16(v0[2], v0[3]); w.z = cvt_pk_bf16(v1[0], v1[1]); w.w = cvt_pk_bf16(v1[2], v1[3]);
                    *(u32x4*)(rowp + bj * HALF) = w; } }
    }
};
}
struct Args {
    const float* in[20]; float* out; unsigned char* ws; int ph_lo, ph_hi;
};
struct Frame {
    LAS unsigned char* lds; int tid, lane, wave, G, bid, vcu;
    const float *x, *c, *w_ada, *b_ada, *norm_mix, *w_in, *t5, *rel, *w_up_a, *w_up_b, *w_o, *norm_ffn, *w_rg, *b_rg, *w_re, *b_re, *w1, *w3, *w2, *norm_final;
    float* out; unsigned char* ws;
    float* mod; unsigned* ecnt;
    bf16_t *WinT, *WupaT, *WupbT, *WoT, *W13T, *W2T, *H, *PROJ, *YA, *YB, *MRG;
    unsigned char *WinT8, *H8, *W13T8, *W2T8, *Wupa8, *Wupb8, *Wo8;
    unsigned long long* MASK; int* LIST; int* TSLOT; float* TW;
};

__device__ __forceinline__ void p0_mod(const Frame& F) {
    LAS float* red = (LAS float*)F.lds;
    for (int b = F.bid; b < 256; b += F.G) {
        const int t = F.tid;
        f32x4 acc = {0.f, 0.f, 0.f, 0.f};
        const int c4 = t % 12, kg = t / 12;
        if (t < 480) {
            const float* wp = F.w_ada + b * 48 + c4 * 4;
            int k = kg;
            for (; k + 7 * 40 < DM; k += 8 * 40) {
                f32x4 w[8]; float sv[8];
#pragma unroll
                for (int u = 0; u < 8; ++u) { w[u] = *(const f32x4*)(wp + (size_t)(k + 40 * u) * 12288); const float cv = F.c[k + 40 * u]; sv[u] = cv * sigmoidf_(cv); }
#pragma unroll
                for (int u = 0; u < 8; ++u) acc += w[u] * sv[u];
            }
            for (; k < DM; k += 40) { const float cv = F.c[k]; const float s = cv * sigmoidf_(cv); const f32x4 w = *(const f32x4*)(wp + (size_t)k * 12288); acc += w * s; }
            *(LAS f32x4*)(red + (kg * 12 + c4) * 4) = acc;
        }
        __syncthreads();
        if (t < 12) { f32x4 sum = *(const f32x4*)(F.b_ada + b * 48 + t * 4);
            for (int g = 0; g < 40; ++g) sum += *(LAS f32x4*)(red + (g * 12 + t) * 4);
            *(f32x4*)(F.mod + b * 48 + t * 4) = sum; }
        __syncthreads();
    }
}
__device__ __forceinline__ int rowmap(int n, int mode) { return mode == 0 ? n : (32 * (n >> 4) + (n & 15) + (mode == 2 ? 16 : 0)); }
__device__ __forceinline__ unsigned cvt_fp8x4(float a, float b, float c, float d) {
    int w = 0;
    w = __builtin_amdgcn_cvt_pk_fp8_f32(a, b, w, false);
    w = __builtin_amdgcn_cvt_pk_fp8_f32(c, d, w, true);
    return (unsigned)w;
}
constexpr int TC_WIN = 32 * 178, TC_UP = 16 * 32, TC_WO = 32 * 32, TC_W1 = NEXP * 32 * 8, TC_W2 = NEXP * 8 * 32;
constexpr int TC_TOTAL = TC_WIN + 2 * TC_UP + TC_WO + 2 * TC_W1 + TC_W2;
constexpr int TC_EARLY = TC_WIN + 2 * TC_UP + TC_WO;
#ifndef TC_LATE_START
#define TC_LATE_START TC_EARLY
#endif
struct TDesc { const float* src; int N, k0, n0, ldd, mode; unsigned char* dst; };
__device__ __forceinline__ bool tconv_desc(const Frame& F, int tl, TDesc& d, int limit = TC_TOTAL) {
    if (tl >= limit) return false;
    int r = tl;
    if (r < TC_WIN) { d.src = F.w_in; d.N = NPROJ_REAL; d.k0 = (r % 32) * 64; d.n0 = (r / 32) * 64; d.dst = (unsigned char*)F.WinT; d.ldd = DM; d.mode = 3; return true; }
    r -= TC_WIN;
    if (r < TC_UP) { d.src = F.w_up_a; d.N = DM; d.k0 = (r % 16) * 64; d.n0 = (r / 16) * 64; d.dst = F.Wupa8; d.ldd = 1024; d.mode = 7; return true; }
    r -= TC_UP;
    if (r < TC_UP) { d.src = F.w_up_b; d.N = DM; d.k0 = (r % 16) * 64; d.n0 = (r / 16) * 64; d.dst = F.Wupb8; d.ldd = 1024; d.mode = 7; return true; }
    r -= TC_UP;
    if (r < TC_WO) { d.src = F.w_o; d.N = DM; d.k0 = (r % 32) * 64; d.n0 = (r / 32) * 64; d.dst = F.Wo8; d.ldd = DM; d.mode = 7; return true; }
    r -= TC_WO;
    if (r < TC_W1) { const int e = r / 256, q = r % 256; d.src = F.w1 + (size_t)e * DM * DFF; d.N = DFF; d.k0 = (q % 32) * 64; d.n0 = (q / 32) * 64; d.dst = F.W13T8 + (size_t)e * 1024 * DM; d.ldd = DM; d.mode = 4; return true; }
    r -= TC_W1;
    if (r < TC_W1) { const int e = r / 256, q = r % 256; d.src = F.w3 + (size_t)e * DM * DFF; d.N = DFF; d.k0 = (q % 32) * 64; d.n0 = (q / 32) * 64; d.dst = F.W13T8 + (size_t)e * 1024 * DM; d.ldd = DM; d.mode = 5; return true; }
    r -= TC_W1;
    { const int e = r / 256, q = r % 256; d.src = F.w2 + (size_t)e * DFF * DM; d.N = DM; d.k0 = (q % 8) * 64; d.n0 = (q / 8) * 64; d.dst = F.W2T8 + (size_t)e * DM * DFF; d.ldd = DFF; d.mode = 6; return true; }
}
__device__ __forceinline__ void tconv_load(const Frame& F, const TDesc& d, f32x4 (&v)[2]) {
    const int kk = F.tid >> 4, n4 = (F.tid & 15) * 4;
    const int nn = min(d.n0 + n4, d.N - 4);
    const float* p0 = d.src + (size_t)(d.k0 + kk) * d.N + nn; const float* p1 = p0 + (size_t)32 * d.N;
    asm volatile("global_load_dwordx4 %0, %1, off" : "=v"(v[0]) : "v"(p0) : "memory");
    asm volatile("global_load_dwordx4 %0, %1, off" : "=v"(v[1]) : "v"(p1) : "memory");
}
__device__ __forceinline__ void tconv_to_lds(const Frame& F, const f32x4 (&vin)[2], LAS float* tile  ) {
    const int t = F.tid, kk = t >> 4, n4 = (t & 15) * 4;
#pragma unroll
    for (int h = 0; h < 2; ++h) { const int k = kk + 32 * h; tile[k * 65 + n4 + 0] = vin[h][0]; tile[k * 65 + n4 + 1] = vin[h][1]; tile[k * 65 + n4 + 2] = vin[h][2]; tile[k * 65 + n4 + 3] = vin[h][3]; }
}
__device__ __forceinline__ void tconv_from_lds(const Frame& F, const TDesc& d, const LAS float* tile) {
    const int t = F.tid;
    { const int n = t >> 3, kq = (t & 7) * 8; const int k0 = d.k0, n0 = d.n0, mode = d.mode;
      if (n0 + n < d.N) {
        float v[8];
#pragma unroll
        for (int i = 0; i < 8; ++i) v[i] = tile[(kq + i) * 65 + n];
        if (mode == 3) {
            const int c = n0 + n; int rb = -1, r8 = -1;
            if (c < 2048) rb = c; else if (c < 3072) r8 = c - 2048; else if (c < 6224) rb = c - 1024; else if (c < 7248) r8 = 1024 + (c - 6224); else r8 = 2048 + (c - 7248);
            if (rb >= 0) { u32x4 w; w.x = cvt_pk_bf16(v[0], v[1]); w.y = cvt_pk_bf16(v[2], v[3]); w.z = cvt_pk_bf16(v[4], v[5]); w.w = cvt_pk_bf16(v[6], v[7]);
                *(u32x4*)(F.WinT + (size_t)rb * DM + k0 + kq) = w; }
            else { const float sc = (float)(1 << W8_SCALE_LOG2); u32x2 w; w.x = cvt_fp8x4_(v[0] * sc, v[1] * sc, v[2] * sc, v[3] * sc); w.y = cvt_fp8x4_(v[4] * sc, v[5] * sc, v[6] * sc, v[7] * sc);
                *(u32x2*)(F.WinT8 + (size_t)r8 * DM + k0 + kq) = w; }
        } else {
            const float sc = (float)(1 << (mode == 6 ? W2_SCALE_LOG2 : W8_SCALE_LOG2)); const int r = rowmap(n0 + n, mode == 4 ? 1 : (mode == 5 ? 2 : 0));
            u32x2 w; w.x = cvt_fp8x4_(v[0] * sc, v[1] * sc, v[2] * sc, v[3] * sc); w.y = cvt_fp8x4_(v[4] * sc, v[5] * sc, v[6] * sc, v[7] * sc);
            *(u32x2*)(d.dst + (size_t)r * d.ldd + k0 + kq) = w; } } }
}
__device__ __forceinline__ void tconv_store(const Frame& F, const TDesc& d, const f32x4 (&vin)[2], int ahead  ) {
    LAS float* tile = (LAS float*)F.lds;
    if (ahead >= 4) asm volatile("s_waitcnt vmcnt(8)" ::: "memory"); else if (ahead == 3) asm volatile("s_waitcnt vmcnt(6)" ::: "memory"); else if (ahead == 2) asm volatile("s_waitcnt vmcnt(4)" ::: "memory");
    else if (ahead == 1) asm volatile("s_waitcnt vmcnt(2)" ::: "memory"); else asm volatile("s_waitcnt vmcnt(0)" ::: "memory");
#ifdef DIAG_ZERO_P0_WUP
    if (d.mode == 7 && d.ldd == 1024) { const f32x4 z[2] = {(f32x4){0.f,0.f,0.f,0.f}, (f32x4){0.f,0.f,0.f,0.f}}; tconv_to_lds(F, z, tile); } else
#endif
    tconv_to_lds(F, vin, tile);
    __syncthreads();
    tconv_from_lds(F, d, tile);
    __syncthreads();
}
constexpr int CONV_LDS_OFF = 16384, CONV_LDS_BYTES = 64 * 64 * 4;
struct ConvSt { int base, cs; };
__device__ __forceinline__ LAS unsigned char* conv_buf(const Frame& F, int i) { return F.lds + CONV_LDS_OFF + (((i % 3) + 3) % 3) * CONV_LDS_BYTES; }
__device__ __forceinline__ bool conv_issue(const Frame& F, int tl, int bufi) {
    TDesc d; if (!tconv_desc(F, tl, d)) return false;
    LAS unsigned char* buf = conv_buf(F, bufi);
#pragma unroll
    for (int p = 0; p < 2; ++p) {
        const int k = p * 32 + (F.tid >> 4), c = F.tid & 15, cs = c ^ ((k >> 3) & 7);
        const float* g = d.src + (size_t)(d.k0 + k) * d.N + d.n0 + 4 * cs;
        __builtin_amdgcn_global_load_lds((const unsigned*)g, (LAS unsigned*)(buf + p * 8192 + F.wave * 1024), 16, 0, 0);
    }
    return true;
}
__device__ __forceinline__ void conv_drain(const Frame& F, int tl, int bufi) {
    TDesc d; if (tl < 0 || !tconv_desc(F, tl, d)) return;
    const LAS float* tile = (const LAS float*)conv_buf(F, bufi);
    const int t = F.tid, n = t >> 3, kq = (t & 7) * 8, f = t & 7;
    float v[8];
#pragma unroll
    for (int i = 0; i < 8; ++i) v[i] = tile[(kq + i) * 64 + (((n >> 2) ^ f) << 2) + (n & 3)];
    const int mode = d.mode;
    const float sc = (float)(1 << (mode == 6 ? W2_SCALE_LOG2 : W8_SCALE_LOG2)); const int r = rowmap(d.n0 + n, mode == 4 ? 1 : (mode == 5 ? 2 : 0));
    u32x2 w; w.x = cvt_fp8x4_(v[0] * sc, v[1] * sc, v[2] * sc, v[3] * sc); w.y = cvt_fp8x4_(v[4] * sc, v[5] * sc, v[6] * sc, v[7] * sc);
    *(u32x2*)(d.dst + (size_t)r * d.ldd + d.k0 + kq) = w;
}
__device__ __forceinline__ void p0_convert(const Frame& F) {
    TDesc d0, d1, d2, d3, d4; f32x4 v0[2], v1[2], v2[2], v3[2], v4[2];
    int tl = F.bid; const int G = F.G;
    bool h0 = tconv_desc(F, tl, d0, TC_EARLY); if (h0) tconv_load(F, d0, v0);
    bool h1 = tconv_desc(F, tl + G, d1, TC_EARLY); if (h1) tconv_load(F, d1, v1);
    bool h2 = tconv_desc(F, tl + 2 * G, d2, TC_EARLY); if (h2) tconv_load(F, d2, v2);
    bool h3 = tconv_desc(F, tl + 3 * G, d3, TC_EARLY); if (h3) tconv_load(F, d3, v3);
    bool h4 = false;
#define TC_STEP(HX, DX, VX, HN, DN, VN, K, A1, A2, A3) \
        if (!HX) break; \
        HN = tconv_desc(F, tl + (K) * G, DN, TC_EARLY); if (HN) tconv_load(F, DN, VN); \
        tconv_store(F, DX, VX, (A1 ? 1 : 0) + (A2 ? 1 : 0) + (A3 ? 1 : 0) + (HN ? 1 : 0));
    for (;;) {
        TC_STEP(h0, d0, v0, h4, d4, v4, 4, h1, h2, h3)
        TC_STEP(h1, d1, v1, h0, d0, v0, 5, h2, h3, h4)
        TC_STEP(h2, d2, v2, h1, d1, v1, 6, h3, h4, h0)
        TC_STEP(h3, d3, v3, h2, d2, v2, 7, h4, h0, h1)
        TC_STEP(h4, d4, v4, h3, d3, v3, 8, h0, h1, h2)
        tl += 5 * G;
    }
#undef TC_STEP
    asm volatile("s_waitcnt vmcnt(0)" ::: "memory");
    { u32x4* z = (u32x4*)(F.WinT + (size_t)NPB_REAL * DM); const int n16 = (NPB - NPB_REAL) * DM * 2 / 16;
      for (int i = F.bid * 512 + F.tid; i < n16; i += F.G * 512) z[i] = (u32x4){0u, 0u, 0u, 0u}; }
}

__device__ __forceinline__ void p1_norm(const Frame& F) {
    const float* sh1 = F.mod; const float* sc1 = F.mod + DM;
    f32x4 ga[8], gb[8];
#pragma unroll
    for (int j = 0; j < 8; ++j) { const int c = 4 * F.lane + 256 * j; const f32x4 nm = *(const f32x4*)(F.norm_mix + c), sc = *(const f32x4*)(sc1 + c); ga[j] = nm * (sc + 1.0f); gb[j] = *(const f32x4*)(sh1 + c); }
    const int rstep = F.G * 8; int row = F.bid * 8 + F.wave;
    f32x4 v[8], vn[8];
    if (row < SEQ) {
#pragma unroll
        for (int j = 0; j < 8; ++j) v[j] = *(const f32x4*)(F.x + (size_t)row * DM + 4 * F.lane + 256 * j);
    }
    for (; row < SEQ; row += rstep) {
        const int nrow = row + rstep;
        if (nrow < SEQ) {
#pragma unroll
            for (int j = 0; j < 8; ++j) vn[j] = *(const f32x4*)(F.x + (size_t)nrow * DM + 4 * F.lane + 256 * j);
        }
        float ss = 0.f;
#pragma unroll
        for (int j = 0; j < 8; ++j) ss += v[j][0] * v[j][0] + v[j][1] * v[j][1] + v[j][2] * v[j][2] + v[j][3] * v[j][3];
        ss = wave_sum(ss);
        const float rstd = __builtin_amdgcn_rsqf(ss * (1.0f / DM) + EPS);
        bf16_t* hp = F.H + (size_t)row * DM + 4 * F.lane; unsigned char* h8 = F.H8 + (size_t)row * DM + 4 * F.lane;
        const float s8 = (float)(1 << H8_SCALE_LOG2);
#pragma unroll
        for (int j = 0; j < 8; ++j) { const f32x4 o = v[j] * rstd * ga[j] + gb[j]; u32x2 w; w.x = cvt_pk_bf16(o[0], o[1]); w.y = cvt_pk_bf16(o[2], o[3]); *(u32x2*)(hp + 256 * j) = w;
            const f32x4 c8 = __builtin_elementwise_min(__builtin_elementwise_max(o * s8, (f32x4){-440.f, -440.f, -440.f, -440.f}), (f32x4){440.f, 440.f, 440.f, 440.f});
            *(unsigned*)(h8 + 256 * j) = cvt_fp8x4_(c8[0], c8[1], c8[2], c8[3]); }
#pragma unroll
        for (int j = 0; j < 8; ++j) v[j] = vn[j];
    }
}

constexpr int P8_RSTD = 0, P8_LOG = 1024, P8_AS = 32768, P8_AS_STRIDE = 32 * 65 * 4 + 128;
__device__ __forceinline__ void p8_router(const Frame& F) {
    const float* sh2 = F.mod + 3 * DM; const float* sc2 = F.mod + 4 * DM;
    const bf16_t* X1 = F.H;
    LAS float* rs = (LAS float*)(F.lds + P8_RSTD);
    LAS float* lg = (LAS float*)(F.lds + P8_LOG);
    LAS float* As = (LAS float*)(F.lds + P8_AS + F.wave * P8_AS_STRIDE);
    for (int blk = F.bid; blk < SEQ / 64; blk += F.G) {
        const int T0 = blk * 64;
        {
            f32x4 ga[8], gb[8];
#pragma unroll
            for (int j = 0; j < 8; ++j) { const int c = 4 * F.lane + 256 * j; const f32x4 nm = *(const f32x4*)(F.norm_ffn + c), sc = *(const f32x4*)(sc2 + c); ga[j] = nm * (sc + 1.0f); gb[j] = *(const f32x4*)(sh2 + c); }
            for (int r = F.wave; r < 64; r += 8) {
                const bf16_t* xp = X1 + (size_t)(T0 + r) * DM + 4 * F.lane;
                f32x4 v[8]; float ss = 0.f;
#pragma unroll
                for (int j = 0; j < 8; ++j) { const u32x2 w = *(const u32x2*)(xp + 256 * j); v[j] = (f32x4){bf_lo(w.x), bf_hi(w.x), bf_lo(w.y), bf_hi(w.y)}; }
#pragma unroll
                for (int j = 0; j < 8; ++j) ss += v[j][0] * v[j][0] + v[j][1] * v[j][1] + v[j][2] * v[j][2] + v[j][3] * v[j][3];
                ss = wave_sum(ss);
                const float rstd = __builtin_amdgcn_rsqf(ss * (1.0f / DM) + EPS);
                if (F.lane == 0) rs[r] = rstd;
                unsigned char* hp = F.H8 + (size_t)(T0 + r) * DM + 4 * F.lane; const float s8 = (float)(1 << H8_SCALE_LOG2);
#pragma unroll
                for (int j = 0; j < 8; ++j) { const f32x4 o = v[j] * rstd * ga[j] + gb[j];
                    const f32x4 c8 = __builtin_elementwise_min(__builtin_elementwise_max(o * s8, (f32x4){-440.f, -440.f, -440.f, -440.f}), (f32x4){440.f, 440.f, 440.f, 440.f});
                    *(unsigned*)(hp + 256 * j) = cvt_fp8x4_(c8[0], c8[1], c8[2], c8[3]); }
            }
        }
        __syncthreads();
        f32x16 acc[2][3];
#pragma unroll
        for (int a = 0; a < 2; ++a)
#pragma unroll
            for (int b = 0; b < 3; ++b)
#pragma unroll
                for (int i = 0; i < 16; ++i) acc[a][b][i] = 0.f;
        {
            const int kbase = F.wave * 256;
            const int ltok = F.lane >> 3, lk4 = (F.lane & 7) * 4;
            const int mi = F.lane & 31, mk = F.lane >> 5;
            const float* bp[3]; int bst[3];
#pragma unroll
            for (int nt = 0; nt < 3; ++nt) { const int col = 32 * nt + mi;
                if (col < 8) { bp[nt] = F.w_rg + col; bst[nt] = 8; } else if (col < 72) { bp[nt] = F.w_re + (col - 8); bst[nt] = 64; } else { bp[nt] = nullptr; bst[nt] = 0; } }
            float rsv[8];
#pragma unroll
            for (int i = 0; i < 8; ++i) rsv[i] = rs[8 * i + ltok];
            for (int ch = 0; ch < 8; ++ch) {
                const int k0 = kbase + ch * 32;
                const f32x4 gav = *(const f32x4*)(F.norm_ffn + k0 + lk4) * (*(const f32x4*)(sc2 + k0 + lk4) + 1.0f), gbv = *(const f32x4*)(sh2 + k0 + lk4);
#pragma unroll
                for (int i = 0; i < 8; ++i) { const int tok = 8 * i + ltok;
                    const u32x2 xw = *(const u32x2*)(X1 + (size_t)(T0 + tok) * DM + k0 + lk4); const f32x4 xv = {bf_lo(xw.x), bf_hi(xw.x), bf_lo(xw.y), bf_hi(xw.y)};
                    const f32x4 hv = xv * rsv[i] * gav + gbv;
                    As[(lk4 + 0) * 65 + tok] = hv[0]; As[(lk4 + 1) * 65 + tok] = hv[1]; As[(lk4 + 2) * 65 + tok] = hv[2]; As[(lk4 + 3) * 65 + tok] = hv[3]; }
                asm volatile("s_waitcnt lgkmcnt(0)" ::: "memory");
#pragma unroll
                for (int hs = 0; hs < 2; ++hs) {
                    float bw[8][3];
#pragma unroll
                    for (int s = 0; s < 8; ++s)
#pragma unroll
                        for (int nt = 0; nt < 3; ++nt) bw[s][nt] = bp[nt] ? bp[nt][(size_t)(k0 + 2 * (8 * hs + s) + mk) * bst[nt]] : 0.f;
#pragma unroll
                    for (int s = 0; s < 8; ++s) {
                        const float a0 = As[(2 * (8 * hs + s) + mk) * 65 + mi], a1 = As[(2 * (8 * hs + s) + mk) * 65 + 32 + mi];
#pragma unroll
                        for (int nt = 0; nt < 3; ++nt) { acc[0][nt] = __builtin_amdgcn_mfma_f32_32x32x2f32(a0, bw[s][nt], acc[0][nt], 0, 0, 0); acc[1][nt] = __builtin_amdgcn_mfma_f32_32x32x2f32(a1, bw[s][nt], acc[1][nt], 0, 0, 0); }
                    }
                }
                asm volatile("s_waitcnt lgkmcnt(0)" ::: "memory");
            }
        }
        for (int w = 0; w < 8; ++w) {
            if (F.wave == w) {
                const int col = F.lane & 31, hi = F.lane >> 5;
#pragma unroll
                for (int mt = 0; mt < 2; ++mt)
#pragma unroll
                    for (int nt = 0; nt < 3; ++nt)
#pragma unroll
                        for (int r = 0; r < 16; ++r) { const int tok = 32 * mt + (r & 3) + 8 * (r >> 2) + 4 * hi; LAS float* p = lg + tok * 96 + 32 * nt + col;
                            if (w == 0) *p = acc[mt][nt][r]; else *p += acc[mt][nt][r]; }
            }
            __syncthreads();
        }
        if (F.tid < 64) {
            const int tok = F.tid, T = T0 + tok; const LAS float* L = lg + tok * 96;
            float g[8]; float gmax = -3.4e38f; int grp = 0;
#pragma unroll
            for (int i = 0; i < 8; ++i) { g[i] = L[i] + F.b_rg[i]; if (g[i] > gmax) { gmax = g[i]; grp = i; } }
            float den = 0.f;
#pragma unroll
            for (int i = 0; i < 8; ++i) den += __expf(g[i] - gmax);
            const float pgrp = 1.0f / den;
            float v0 = -3.4e38f, v1 = -3.4e38f; int i0 = 0, i1 = 0;
#pragma unroll
            for (int i = 0; i < 8; ++i) { float e = 0.f;
#pragma unroll
                for (int gsel = 0; gsel < 8; ++gsel) { const float cand = L[8 + gsel * 8 + i] + F.b_re[gsel * 8 + i]; e = (grp == gsel) ? cand : e; }
                if (e > v0) { v1 = v0; i1 = i0; v0 = e; i0 = i; } else if (e > v1) { v1 = e; i1 = i; } }
            const float ex = __expf(v1 - v0); const float p0 = 1.0f / (1.0f + ex), p1 = ex / (1.0f + ex);
            const int e0 = grp * 8 + i0, e1 = grp * 8 + i1;
            const unsigned pos0 = atomicAdd(F.ecnt + 16 * e0, 1u), pos1 = atomicAdd(F.ecnt + 16 * e1, 1u);
            F.LIST[(size_t)e0 * LIST_CAP + pos0] = T; F.LIST[(size_t)e1 * LIST_CAP + pos1] = T;
            F.TSLOT[2 * T + 0] = (e0 << 16) | (int)pos0; F.TSLOT[2 * T + 1] = (e1 << 16) | (int)pos1;
            F.TW[2 * T + 0] = pgrp * p0; F.TW[2 * T + 1] = pgrp * p1;
        }
        __syncthreads();
    }
}

constexpr int MOE_TS = 131072, MOE_CNT = 131072 + 512, MOE_TOK = 131072 + 1024;
__device__ __forceinline__ void moe_tables(const Frame& F) {
    LAS int* ts = (LAS int*)(F.lds + MOE_TS); LAS int* cn = (LAS int*)(F.lds + MOE_CNT);
    if (F.tid < 64) cn[F.tid] = (int)__hip_atomic_load(F.ecnt + 16 * F.tid, __ATOMIC_RELAXED, __HIP_MEMORY_SCOPE_AGENT);
    __syncthreads();
    if (F.tid == 0) { int s = 0; for (int e = 0; e < 64; ++e) { ts[e] = s; s += (cn[e] + 255) >> 8; } ts[64] = s; }
    __syncthreads();
}
__device__ __forceinline__ int moe_find(const LAS int* ts, int T) {
    int lo = 0, hi = 64;
    while (hi - lo > 1) { const int mid = (lo + hi) >> 1; if (ts[mid] <= T) lo = mid; else hi = mid; }
    return lo;
}
struct MoeOrder1 {
    const Frame* F; const LAS int* ts; const LAS int* tokl;
    __device__ __forceinline__ bool next(int i, pg8::Unit& u) const {
        const int uu = i * F->G + F->vcu, T = uu >> 2; if (T >= ts[64]) return false;
        const int e = moe_find(ts, T);
        u.pm = T; u.pn = uu & 3; u.A = (const char*)F->H8; u.B = (const char*)(F->W13T8 + (size_t)e * 1024 * DM + (size_t)u.pn * 256 * DM); u.x0 = T * 256; u.x1 = i; return true;
    }
    __device__ __forceinline__ int arow(const pg8::Unit& u, int r) const { return tokl[u.x1 * 256 + r]; }
};
struct MoeOrder2 {
    const Frame* F; const LAS int* ts;
    __device__ __forceinline__ bool next(int i, pg8::Unit& u) const {
        const int uu = i * F->G + F->vcu, T = uu >> 3; if (T >= ts[64]) return false;
        const int e = moe_find(ts, T);
        u.pm = T; u.pn = uu & 7; u.A = (const char*)F->MRG + (size_t)T * 256 * DFF; u.B = (const char*)(F->W2T8 + (size_t)e * DM * DFF + (size_t)u.pn * 256 * DFF); u.x0 = T * 256; u.x1 = 0; return true;
    }
    __device__ __forceinline__ int arow(const pg8::Unit&, int r) const { return r; }
};
__device__ __forceinline__ void moe1_fill_lists(const Frame& F) {
    const LAS int* ts = (const LAS int*)(F.lds + MOE_TS); const LAS int* cn = (const LAS int*)(F.lds + MOE_CNT); LAS int* tokl = (LAS int*)(F.lds + MOE_TOK);
    for (int i = 0; i < 8; ++i) {
        const int uu = i * F.G + F.vcu, T = uu >> 2; if (T >= ts[64]) break;
        const int e = moe_find(ts, T), mt = T - ts[e];
        if (F.tid < 256) { const int pos = mt * 256 + F.tid; tokl[i * 256 + F.tid] = pos < cn[e] ? F.LIST[(size_t)e * LIST_CAP + pos] : 0; }
    }
    __syncthreads();
}

__device__ __forceinline__ void p11_final(const Frame& F) {
    const LAS int* ts = (const LAS int*)(F.lds + MOE_TS);
    const float* g2 = F.mod + 5 * DM; const bf16_t* Y = F.PROJ;
    f32x4 gg[8], nf[8];
#pragma unroll
    for (int j = 0; j < 8; ++j) { const int c = 4 * F.lane + 256 * j; gg[j] = *(const f32x4*)(g2 + c); nf[j] = *(const f32x4*)(F.norm_final + c); }
    const int rstep = F.G * 8; int row = F.bid * 8 + F.wave;
    u32x2 xw[8], ya[8], yb[8], xwn[8], yan[8], ybn[8]; float w0 = 0.f, w1 = 0.f, w0n = 0.f, w1n = 0.f;
#define P11_LOAD(R, XW, YA, YB, W0, W1) do { const int s0_ = F.TSLOT[2 * (R)], s1_ = F.TSLOT[2 * (R) + 1]; W0 = F.TW[2 * (R)]; W1 = F.TW[2 * (R) + 1]; \
        const size_t r0_ = (size_t)ts[s0_ >> 16] * 256 + (s0_ & 0xffff), r1_ = (size_t)ts[s1_ >> 16] * 256 + (s1_ & 0xffff); \
        const bf16_t* x1p_ = F.H + (size_t)(R) * DM + 4 * F.lane; const bf16_t* y0_ = Y + r0_ * DM + 4 * F.lane; const bf16_t* y1_ = Y + r1_ * DM + 4 * F.lane; \
        _Pragma("unroll") for (int j = 0; j < 8; ++j) { XW[j] = *(const u32x2*)(x1p_ + 256 * j); YA[j] = *(const u32x2*)(y0_ + 256 * j); YB[j] = *(const u32x2*)(y1_ + 256 * j); } } while (0)
    if (row < SEQ) P11_LOAD(row, xw, ya, yb, w0, w1);
    for (; row < SEQ; row += rstep) {
        const int nrow = row + rstep;
        if (nrow < SEQ) P11_LOAD(nrow, xwn, yan, ybn, w0n, w1n);
        float* xp = F.out + (size_t)row * DM + 4 * F.lane;
        f32x4 v[8]; float ss = 0.f;
#pragma unroll
        for (int j = 0; j < 8; ++j) { const f32x4 xv = {bf_lo(xw[j].x), bf_hi(xw[j].x), bf_lo(xw[j].y), bf_hi(xw[j].y)}; const u32x2 a = ya[j], b = yb[j];
            f32x4 m; m[0] = w0 * bf_lo(a.x) + w1 * bf_lo(b.x); m[1] = w0 * bf_hi(a.x) + w1 * bf_hi(b.x); m[2] = w0 * bf_lo(a.y) + w1 * bf_lo(b.y); m[3] = w0 * bf_hi(a.y) + w1 * bf_hi(b.y);
#if defined(DBG_NOMOE)
            m = (f32x4){0.f, 0.f, 0.f, 0.f};
#endif
            v[j] = xv + gg[j] * m; }
#pragma unroll
        for (int j = 0; j < 8; ++j) ss += v[j][0] * v[j][0] + v[j][1] * v[j][1] + v[j][2] * v[j][2] + v[j][3] * v[j][3];
        ss = wave_sum(ss);
        const float rstd = __builtin_amdgcn_rsqf(ss * (1.0f / DM) + EPS);
#pragma unroll
        for (int j = 0; j < 8; ++j) *(f32x4*)(xp + 256 * j) = v[j] * rstd * nf[j];
#pragma unroll
        for (int j = 0; j < 8; ++j) { xw[j] = xwn[j]; ya[j] = yan[j]; yb[j] = ybn[j]; }
        w0 = w0n; w1 = w1n;
    }
#undef P11_LOAD
}
namespace att {
constexpr int D = 128, NW = 8, QBLK = 32, KVBLK = 64;
constexpr float SCALE = 0.088388347648318440f;
constexpr float THR = 8.f;
constexpr int LDP = NPROJ;
constexpr int LDO = 1024;
constexpr int SHM_V = KVBLK * D * 2, SHM_K = KVBLK * D * 2;
constexpr int OFF_WS = 2 * SHM_V + 2 * SHM_K, OFF_TAB = OFF_WS + NW * 64 * 4;
constexpr int DLO = -63;
#define KSWZ(row, colB) ((row) * 256 + ((colB) ^ (((row) & 7) << 4)))
#define SBAR() __builtin_amdgcn_sched_barrier(0)
__device__ __forceinline__ int crow(int r, int hi) { return (r & 3) + 8 * (r >> 2) + 4 * hi; }

__device__ __forceinline__ void partialSM(f32x16& p0, f32x16& p1, float& m_reg, float& mn, float& alpha) {
  constexpr float C = SCALE * 1.4426950408889634f;
  float pmax = p0[0];
#pragma unroll
  for (int r = 1; r < 16; ++r) pmax = fmaxf(pmax, p0[r]);
#pragma unroll
  for (int r = 0; r < 16; ++r) pmax = fmaxf(pmax, p1[r]);
  { auto rr = __builtin_amdgcn_permlane32_swap(__float_as_uint(pmax), __float_as_uint(pmax), false, false);
    pmax = fmaxf(__uint_as_float(rr[0]), __uint_as_float(rr[1])); }
  if (__builtin_expect(__all(pmax - m_reg <= THR / SCALE), 1)) { mn = m_reg; alpha = 1.f; }
  else { mn = fmaxf(m_reg, pmax); alpha = __builtin_amdgcn_exp2f((m_reg - mn) * C); m_reg = mn; }
  float mnC = -mn * C;
#pragma unroll
  for (int r = 0; r < 16; ++r) p0[r] = fmaf(p0[r], C, mnC);
#pragma unroll
  for (int r = 0; r < 16; ++r) p1[r] = fmaf(p1[r], C, mnC);
#pragma unroll
  for (int r = 0; r < 16; ++r) p0[r] = __builtin_amdgcn_exp2f(p0[r]);
}
template <int MODE>
__device__ __forceinline__ void finishSM(f32x16& p0, f32x16& p1, float alpha, float& l_reg, bf16x8& pa0, bf16x8& pa1, bf16x8& pa2, bf16x8& pa3) {
#pragma unroll
  for (int r = 0; r < 16; ++r) p1[r] = __builtin_amdgcn_exp2f(p1[r]);
  float ps = 0;
#pragma unroll
  for (int r = 0; r < 16; ++r) ps += p0[r];
#pragma unroll
  for (int r = 0; r < 16; ++r) ps += p1[r];
  { auto rr = __builtin_amdgcn_permlane32_swap(__float_as_uint(ps), __float_as_uint(ps), false, false);
    ps = __uint_as_float(rr[0]) + __uint_as_float(rr[1]); }
  l_reg = l_reg * alpha + ps;
#define PK4(P, BASE, OUT) do { unsigned a0 = cvt_pk_bf16(P[BASE + 0], P[BASE + 1]), a1 = cvt_pk_bf16(P[BASE + 2], P[BASE + 3]);   \
    unsigned b0 = cvt_pk_bf16(P[BASE + 4], P[BASE + 5]), b1 = cvt_pk_bf16(P[BASE + 6], P[BASE + 7]);                              \
    auto r0 = __builtin_amdgcn_permlane32_swap(a0, b0, false, false); auto r1 = __builtin_amdgcn_permlane32_swap(a1, b1, false, false); \
    u32x4 w = {r0[0], r1[0], r0[1], r1[1]}; OUT = *reinterpret_cast<bf16x8*>(&w); } while (0)
  PK4(p0, 0, pa0); PK4(p0, 8, pa1); PK4(p1, 0, pa2); PK4(p1, 8, pa3);
#undef PK4
}
__device__ __forceinline__ void qkt(f32x16& p0, f32x16& p1, const LAS char* Ks, const bf16x8* qr, int r32, int hi) {
#pragma unroll
  for (int i = 0; i < 16; ++i) { p0[i] = 0.f; p1[i] = 0.f; }
#pragma unroll
  for (int d0 = 0; d0 < 8; ++d0) { int cb = (d0 * 16 + hi * 8) * 2;
    bf16x8 b0 = *reinterpret_cast<const LAS bf16x8*>(Ks + KSWZ(r32, cb));
    bf16x8 b1 = *reinterpret_cast<const LAS bf16x8*>(Ks + KSWZ(32 + r32, cb));
    p0 = __builtin_amdgcn_mfma_f32_32x32x16_bf16(b0, qr[d0], p0, 0, 0, 0);
    p1 = __builtin_amdgcn_mfma_f32_32x32x16_bf16(b1, qr[d0], p1, 0, 0, 0); }
}
__device__ __forceinline__ int v_st(int k, int c) { const int kk = (k & ~0xC) | ((k & 4) << 1) | ((k & 8) >> 1); return ((kk >> 3) * 4 + (c >> 5)) * 512 + ((kk & 7) * 32 + (c & 31)) * 2; }
__device__ __forceinline__ int v_rd_base(int lane) { return ((lane & 3) << 3) | (((lane >> 2) & 3) << 6) | (((lane >> 4) & 1) << 5) | (((lane >> 5) & 1) << 8); }
constexpr int v_rd_off(int d0, int ks, int half) { return d0 * 512 + ks * 4096 + half * 2048; }
template <int OFF> __device__ __forceinline__ s16x4 tr_read(int vb) {
  s16x4 r; asm volatile("ds_read_b64_tr_b16 %0, %1 offset:%2" : "=&v"(r) : "v"(vb), "i"(OFF) : "memory"); return r;
}
template <int D0> __device__ __forceinline__ void pv_one(f32x16& od, int vb, bf16x8 pa0, bf16x8 pa1, bf16x8 pa2, bf16x8 pa3) {
  const s16x4 l0 = tr_read<v_rd_off(D0, 0, 0)>(vb), h0 = tr_read<v_rd_off(D0, 0, 1)>(vb), l1 = tr_read<v_rd_off(D0, 1, 0)>(vb), h1 = tr_read<v_rd_off(D0, 1, 1)>(vb);
  const s16x4 l2 = tr_read<v_rd_off(D0, 2, 0)>(vb), h2 = tr_read<v_rd_off(D0, 2, 1)>(vb), l3 = tr_read<v_rd_off(D0, 3, 0)>(vb), h3 = tr_read<v_rd_off(D0, 3, 1)>(vb);
  asm volatile("s_waitcnt lgkmcnt(0)" ::: "memory"); SBAR();
#define PK(L, H) (bf16x8){L[0], L[1], L[2], L[3], H[0], H[1], H[2], H[3]}
  od = __builtin_amdgcn_mfma_f32_32x32x16_bf16(pa0, PK(l0, h0), od, 0, 0, 0);
  od = __builtin_amdgcn_mfma_f32_32x32x16_bf16(pa1, PK(l1, h1), od, 0, 0, 0);
  od = __builtin_amdgcn_mfma_f32_32x32x16_bf16(pa2, PK(l2, h2), od, 0, 0, 0);
  od = __builtin_amdgcn_mfma_f32_32x32x16_bf16(pa3, PK(l3, h3), od, 0, 0, 0);
#undef PK
}
__device__ __forceinline__ void pv_d0(f32x16* o, int vb, bf16x8 pa0, bf16x8 pa1, bf16x8 pa2, bf16x8 pa3) {
  pv_one<0>(o[0], vb, pa0, pa1, pa2, pa3); pv_one<1>(o[1], vb, pa0, pa1, pa2, pa3); pv_one<2>(o[2], vb, pa0, pa1, pa2, pa3); pv_one<3>(o[3], vb, pa0, pa1, pa2, pa3);
}

template <int MODE, int DMAX>
__device__ __forceinline__ void score_hook(f32x16& p0, f32x16& p1, int kt, int tq  , int tq_wave0  , int hi, const LAS float* tab, unsigned long long msk) {
  if (MODE == 1) {
    const int cw = tq_wave0 >> 6;
    if (kt > cw || kt < cw - 8) {
#pragma unroll
      for (int r = 0; r < 16; ++r) { p0[r] = -3.0e38f; p1[r] = -3.0e38f; }
      return;
    }
  }
#ifndef ATT_NOHOOK
  if (tq_wave0 - (kt * 64 + 63) < DMAX) {
    const int base = tq - kt * 64 - 4 * hi - DLO;
#pragma unroll
    for (int r = 0; r < 16; ++r) {
      const int c = (r & 3) + 8 * (r >> 2);
      int i0 = base - c, i1 = base - c - 32;
      i0 = min(max(i0, 0), DMAX - DLO); i1 = min(max(i1, 0), DMAX - DLO);
      p0[r] += tab[i0]; p1[r] += tab[i1];
      SBAR();
    }
  }
#endif
  if (MODE == 0) {
    const unsigned mk0 = (unsigned)msk >> (16 * hi), mk1 = (unsigned)(msk >> 32) >> (16 * hi);
#pragma unroll
    for (int r = 0; r < 16; ++r) {
      { const unsigned m_ = (unsigned)__builtin_amdgcn_sbfe(mk0, r, 1); p0[r] = __uint_as_float((m_ & __float_as_uint(p0[r])) | (~m_ & 0xFF61B1E6u)); }
      { const unsigned m_ = (unsigned)__builtin_amdgcn_sbfe(mk1, r, 1); p1[r] = __uint_as_float((m_ & __float_as_uint(p1[r])) | (~m_ & 0xFF61B1E6u)); }
    }
  }
}

__device__ __forceinline__ unsigned long long mload_(const char* base, unsigned off) { asm volatile("" : "+v"(off)); return *(const unsigned long long*)(base + off); }
template <int MODE, int DMAX>
__device__ __forceinline__ void attn_unit(const bf16_t* __restrict__ Qb  , const bf16_t* __restrict__ Kh  , const bf16_t* __restrict__ Vh,
                                          unsigned char* __restrict__ Ob  , const unsigned long long* __restrict__ maskq  , int q0, int kt0, int kt1, LAS char* lds) {
  const int tid = threadIdx.x, wid = tid >> 6, lane = tid & 63, r32 = lane & 31, hi = lane >> 5;
  LAS char* V_lds = lds; LAS char* K_lds = lds + 2 * SHM_V;
  LAS float* ws = (LAS float*)(lds + OFF_WS) + wid * 64; LAS float* li_l = ws; LAS float* al_l = ws + 32;
  const LAS float* tab = (const LAS float*)(lds + OFF_TAB);
  float m_reg = -1e30f, l_reg = 0; f32x16 o[4]; bf16x8 qr[8];
#pragma unroll
  for (int d = 0; d < 4; ++d)
#pragma unroll
    for (int r = 0; r < 16; ++r) o[d][r] = 0.f;
  const bf16_t* Qw = Qb + (long)(wid * QBLK + r32) * LDP + hi * 8;
#pragma unroll
  for (int d0 = 0; d0 < 8; ++d0) qr[d0] = *reinterpret_cast<const bf16x8*>(Qw + d0 * 16);
  const int tq0w = q0 + wid * QBLK, tq = tq0w + r32;
  const int sr = tid >> 4, sc = (tid & 15) * 8, vst0 = v_st(sr, sc), vst1 = v_st(32 + sr, sc);
  const int vb0 = (int)(uintptr_t)V_lds + v_rd_base(lane);
  const char* Kc = (const char*)Kh; const char* Vc = (const char*)Vh; const unsigned soff = (unsigned)(sr * LDP + sc) * 2u;
  const unsigned moff = (unsigned)(__builtin_amdgcn_readfirstlane(wid) * QBLK + r32) * 8u;
  struct { bf16x8 vs0, vs1, ks0, ks1; } sr_[1];
#define SLOAD(i, k0) do { unsigned _so = soff; asm volatile("" : "+v"(_so)); unsigned _so2 = soff; asm volatile("" : "+v"(_so2)); \
    const char* _kp = Kc + (size_t)(unsigned)(k0) * (size_t)(LDP * 2); const char* _vp = Vc + (size_t)(unsigned)(k0) * (size_t)(LDP * 2); \
    const char* _kp2 = _kp + (32 * LDP * 2); const char* _vp2 = _vp + (32 * LDP * 2); \
    sr_[i].vs0 = *reinterpret_cast<const bf16x8*>(_vp + _so); sr_[i].vs1 = *reinterpret_cast<const bf16x8*>(_vp2 + _so2); \
    sr_[i].ks0 = *reinterpret_cast<const bf16x8*>(_kp + _so); sr_[i].ks1 = *reinterpret_cast<const bf16x8*>(_kp2 + _so2); } while (0)
#define SWRITE(b, i) do { *(LAS bf16x8*)(V_lds + (b) * SHM_V + vst0) = sr_[i].vs0;          \
    *(LAS bf16x8*)(V_lds + (b) * SHM_V + vst1) = sr_[i].vs1; int kc = sc * 2;               \
    *(LAS bf16x8*)(K_lds + (b) * SHM_K + KSWZ(sr, kc)) = sr_[i].ks0;                       \
    *(LAS bf16x8*)(K_lds + (b) * SHM_K + KSWZ(32 + sr, kc)) = sr_[i].ks1; } while (0)
#define SWAIT() asm volatile("s_waitcnt vmcnt(0)" ::: "memory")
#define RESC(a) do { if (__any((a) < 1.f)) { if (hi == 0) al_l[r32] = (a); asm volatile("s_waitcnt lgkmcnt(0)" ::: "memory"); \
    _Pragma("unroll") for (int d = 0; d < 4; ++d) _Pragma("unroll") for (int r = 0; r < 16; ++r) o[d][r] *= al_l[crow(r, hi)]; } } while (0)
#define MLOAD(kt) (MODE == 0 ? mload_((const char*)maskq + (size_t)(unsigned)(kt) * (size_t)(SEQ * 8), moff) : 0ull)
  f32x16 pA0, pA1, pB0, pB1; float mnA, mnB, alA, alB; bf16x8 pa0, pa1, pa2, pa3; const int NT = kt1 - kt0;
  unsigned long long mA = 0, mB = 0;
  constexpr int SE = 0, SO = 0;
  SLOAD(SE, kt0 * KVBLK); mA = MLOAD(kt0); asm volatile("s_waitcnt vmcnt(0)" ::: "memory"); SWRITE(0, SE); __syncthreads();
  qkt(pA0, pA1, K_lds, qr, r32, hi); score_hook<MODE, DMAX>(pA0, pA1, kt0, tq, tq0w, hi, tab, mA); partialSM(pA0, pA1, m_reg, mnA, alA);
  SLOAD(SO, (kt0 + 1) * KVBLK);
  SWAIT(); SWRITE(1, SO); __syncthreads();
  for (int j = 1; j + 1 < NT; j += 2) {
    SBAR(); mB = MLOAD(kt0 + j); qkt(pB0, pB1, K_lds + SHM_K, qr, r32, hi); score_hook<MODE, DMAX>(pB0, pB1, kt0 + j, tq, tq0w, hi, tab, mB);
    finishSM<MODE>(pA0, pA1, alA, l_reg, pa0, pa1, pa2, pa3); SBAR();
    SLOAD(SO, (kt0 + j + 1) * KVBLK); SBAR();
    pv_d0(o, vb0, pa0, pa1, pa2, pa3); partialSM(pB0, pB1, m_reg, mnB, alB);
    __syncthreads(); SWAIT(); SWRITE(0, SE);
    RESC(alB); __syncthreads();
    SBAR(); mA = MLOAD(kt0 + j + 1); qkt(pA0, pA1, K_lds, qr, r32, hi); score_hook<MODE, DMAX>(pA0, pA1, kt0 + j + 1, tq, tq0w, hi, tab, mA);
    finishSM<MODE>(pB0, pB1, alB, l_reg, pa0, pa1, pa2, pa3); SBAR();
    SLOAD(SE, (kt0 + j + 2) * KVBLK); SBAR();
    pv_d0(o, vb0 + SHM_V, pa0, pa1, pa2, pa3); partialSM(pA0, pA1, m_reg, mnA, alA);
    __syncthreads(); SWAIT(); SWRITE(1, SO);
    RESC(alA); __syncthreads();
  }
  SBAR(); mB = MLOAD(kt1 - 1); qkt(pB0, pB1, K_lds + SHM_K, qr, r32, hi); score_hook<MODE, DMAX>(pB0, pB1, kt1 - 1, tq, tq0w, hi, tab, mB);
  finishSM<MODE>(pA0, pA1, alA, l_reg, pa0, pa1, pa2, pa3); SBAR();
  pv_d0(o, vb0, pa0, pa1, pa2, pa3); partialSM(pB0, pB1, m_reg, mnB, alB);
  __syncthreads(); RESC(alB);
  finishSM<MODE>(pB0, pB1, alB, l_reg, pa0, pa1, pa2, pa3); SBAR();
  pv_d0(o, vb0 + SHM_V, pa0, pa1, pa2, pa3);
  if (hi == 0) li_l[r32] = l_reg; asm volatile("s_waitcnt lgkmcnt(0)" ::: "memory");
  float rli[16];
#pragma unroll
  for (int r = 0; r < 16; ++r) rli[r] = __builtin_amdgcn_rcpf(li_l[crow(r, hi)]);
  unsigned char* Ow = Ob + (long)(wid * QBLK) * LDO; const float s8 = (float)(1 << Y8_SCALE_LOG2);
#pragma unroll
  for (int r = 0; r < 16; ++r) { int orow = crow(r, hi);
#pragma unroll
    for (int d0 = 0; d0 < 4; ++d0) { const float v = fminf(fmaxf(o[d0][r] * rli[r] * s8, -440.f), 440.f); const int w = __builtin_amdgcn_cvt_pk_fp8_f32(v, 0.f, 0, false); Ow[(long)orow * LDO + d0 * 32 + r32] = (unsigned char)(w & 0xff); } }
  __syncthreads();
#undef SLOAD
#undef SWRITE
#undef SWAIT
#undef RESC
#undef MLOAD
}
#undef KSWZ
}

__device__ __forceinline__ int t5_bucket_dev(int rel) {
    const int n = rel < 0 ? -rel : rel; int b;
    if (n < 8) b = n; else b = 8 + (n >= 15) + (n >= 27) + (n >= 50) + (n >= 91) + (n >= 166) + (n >= 305) + (n >= 559);
    return b + (rel > 0 ? 16 : 0);
}
constexpr int DMAX_A = 559, DMAX_B = 128;
__device__ __forceinline__ void fill_tab_A(const Frame& F, int h, LAS char* lds) {
    LAS float* tab = (LAS float*)(lds + att::OFF_TAB);
    const float far = F.t5[15 * 8 + h];
    for (int i = F.tid; i <= DMAX_A - att::DLO; i += 512) { const int d = i + att::DLO; tab[i] = (F.t5[t5_bucket_dev(-d) * 8 + h] - far) * (1.0f / att::SCALE); }
    __syncthreads();
}
__device__ __forceinline__ void fill_tab_B(const Frame& F, int h, LAS char* lds) {
    LAS float* tab = (LAS float*)(lds + att::OFF_TAB);
    const float far = F.rel[h * 257 + 256];
    for (int i = F.tid; i <= DMAX_B - att::DLO; i += 512) { const int d = i + att::DLO; tab[i] = (F.rel[h * 257 + min(max(d, -128), 128) + 128] - far) * (1.0f / att::SCALE); }
    __syncthreads();
}
namespace idx {
constexpr int KT_OFF = 0, KT_BYTES = 8192, CAND_OFF = CONV_LDS_OFF + 3 * CONV_LDS_BYTES + 256, CAND_STRIDE = 2440, CAP = 608, EMERG = CAP - 64, NREG = (CAP + 63) / 64;
static_assert(CAND_OFF % 8 == 0 && CAND_OFF + 32 * CAND_STRIDE <= LDS_BYTES - 16, "indexer LDS map");
constexpr float W_SCALE = 0.03125f;

__device__ __forceinline__ unsigned ordered_u32(float f) { const unsigned u = __float_as_uint(f); return u ^ ((unsigned)((int)u >> 31) | 0x80000000u); }
__device__ __forceinline__ float unordered_f32(unsigned o) { const unsigned u = (o & 0x80000000u) ? (o ^ 0x80000000u) : ~o; return __uint_as_float(u); }

__device__ __forceinline__ unsigned select_thr(const unsigned (&P)[NREG], unsigned maxP, unsigned lob, int lowbit, unsigned vin, int bin, int& bout) {
    int b; unsigned v;
    if (bin < 0) { const unsigned X = maxP ^ lob; if (X == 0u) { bout = -1; return maxP; } b = 31 - __builtin_clz(X); v = maxP & ~((2u << b) - 1u); }
    else { b = bin; v = vin; }
    if (lowbit > b) { bout = b; return v; }
    for (int bit = b; bit >= lowbit; --bit) {
        const unsigned tr = v | (1u << bit);
        int c = 0;
#pragma unroll
        for (int j = 0; j < NREG; ++j) c += __builtin_popcountll(__ballot(P[j] >= tr));
        if (c >= 256) v = tr;
    }
    bout = lowbit - 1;
    return v;
}

template <int VAR> __device__ __forceinline__ void indexer_unit(const Frame& F, int u, ConvSt& cv) {
    LAS unsigned char* lds = F.lds;
    const int tid = F.tid, wid = F.wave, lane = F.lane, r32 = lane & 31, hi = lane >> 5;
    const int t0 = u * 32, chunk = t0 >> 6, ntile = chunk + 1, ntile_q = 4 * ((chunk >> 2) + 1);
    const bf16_t* proj = F.PROJ;
    bf16x8 Af[2][4]; float wv[2][16];
    {
        const int head = (r32 & 3) | ((r32 >> 3) << 2), qsel = (r32 >> 2) & 1;
#pragma unroll
        for (int mt = 0; mt < 2; ++mt) {
            const int q = t0 + 4 * wid + 2 * mt + qsel;
            const bf16_t* qp = proj + (size_t)q * NPROJ + COL_QI + head * 64 + 8 * hi;
#pragma unroll
            for (int s = 0; s < 4; ++s) Af[mt][s] = *(const bf16x8*)(qp + 16 * s);
            const int qh = t0 + 4 * wid + 2 * mt + hi;
            const u32x4 w0 = *(const u32x4*)(proj + (size_t)qh * NPROJ + COL_WI), w1 = *(const u32x4*)(proj + (size_t)qh * NPROJ + COL_WI + 8);
            wv[mt][0] = bf_lo(w0.x) * W_SCALE; wv[mt][1] = bf_hi(w0.x) * W_SCALE; wv[mt][2] = bf_lo(w0.y) * W_SCALE; wv[mt][3] = bf_hi(w0.y) * W_SCALE;
            wv[mt][4] = bf_lo(w0.z) * W_SCALE; wv[mt][5] = bf_hi(w0.z) * W_SCALE; wv[mt][6] = bf_lo(w0.w) * W_SCALE; wv[mt][7] = bf_hi(w0.w) * W_SCALE;
            wv[mt][8] = bf_lo(w1.x) * W_SCALE; wv[mt][9] = bf_hi(w1.x) * W_SCALE; wv[mt][10] = bf_lo(w1.y) * W_SCALE; wv[mt][11] = bf_hi(w1.y) * W_SCALE;
            wv[mt][12] = bf_lo(w1.z) * W_SCALE; wv[mt][13] = bf_hi(w1.z) * W_SCALE; wv[mt][14] = bf_lo(w1.w) * W_SCALE; wv[mt][15] = bf_hi(w1.w) * W_SCALE;
        }
    }
    int cnt[2][2] = {{0, 0}, {0, 0}};
    float tau[2] = {-3.4e38f, -3.4e38f};
    unsigned lob[2][2] = {{0u, 0u}, {0u, 0u}};
    const int cbase[2] = {CAND_OFF + (4 * wid + 0 + hi) * CAND_STRIDE, CAND_OFF + (4 * wid + 2 + hi) * CAND_STRIDE};
    const int skey = tid >> 3, sslot = tid & 7;
    const int sdst = skey * 128 + ((sslot ^ ((skey >> 1) & 7)) * 16);
    const bf16_t* ksrc = proj + (size_t)skey * NPROJ + COL_KI + sslot * 8;
    u32x4 stg = *(const u32x4*)ksrc;
    *(LAS u32x4*)(lds + KT_OFF + sdst) = stg;
    __syncthreads();
#define IDX_MFMA(ACC, MT, BF) do { _Pragma("unroll") for (int i_ = 0; i_ < 16; ++i_) ACC[i_] = 0.f; \
        _Pragma("unroll") for (int s_ = 0; s_ < 4; ++s_) ACC = __builtin_amdgcn_mfma_f32_32x32x16_bf16(Af[MT][s_], BF[s_], ACC, 0, 0, 0); } while (0)
#define IDX_SCORE(SC, ACC, MT) do { \
        float sa_ = 0.f; \
        _Pragma("unroll") for (int r_ = 0; r_ < 16; ++r_) { const float ta_ = __int_as_float(max(__float_as_int(ACC[r_]), 0)); sa_ = fmaf(wv[MT][r_], ta_, sa_); } \
        SC = sa_; } while (0)
#define IDX_PIPE() do { _Pragma("unroll") for (int g_ = 0; g_ < 4; ++g_) { __builtin_amdgcn_sched_group_barrier(0x008, 1, 0); __builtin_amdgcn_sched_group_barrier(0x002, 9, 0); } } while (0)
#define IDX_APPEND(SC, MT, HF) do { \
        const bool pass = (VAR == 1) ? false : (SC >= tau[MT]); if (VAR == 1) { asm volatile("" :: "v"(SC)); } \
        const unsigned long long bm = __ballot(pass); \
        if (bm != 0ull) { \
            const unsigned blo = (unsigned)bm, bhi = (unsigned)(bm >> 32); \
            const int nlo = __builtin_popcount(blo), nhi = __builtin_popcount(bhi); \
            const int pre = __builtin_amdgcn_mbcnt_hi(bhi, __builtin_amdgcn_mbcnt_lo(blo, 0)); \
            const int pos = hi ? (cnt[MT][1] + pre - nlo) : (cnt[MT][0] + pre); \
            if (pass) { \
                const unsigned gk = (unsigned)(jt * 64 + 32 * (HF) + r32); \
                const unsigned P = (ordered_u32(SC) & 0xFFFFC000u) | (16383u - gk); \
                *(LAS unsigned*)(lds + cbase[MT] + pos * 4) = P; \
            } \
            cnt[MT][0] += nlo; cnt[MT][1] += nhi; \
        } } while (0)
    for (int jt = 0; jt < ntile; ++jt) {
        {
            bool cnext = false;
            if (VAR == 0) conv_drain(F, cv.cs >= 1 ? cv.base + (cv.cs - 1) * F.G : -1, cv.cs - 1);
            if (VAR != 5 && jt + 1 < ntile) {
                const bf16_t* g = proj + (size_t)((jt + 1) * 64 + skey) * NPROJ + COL_KI + ((sslot ^ ((skey >> 1) & 7)) * 8);
                __builtin_amdgcn_global_load_lds((const unsigned*)g, (LAS unsigned*)(lds + KT_OFF + ((jt + 1) & 1) * KT_BYTES + wid * 1024), 16, 0, 0);
            }
            if (VAR == 0) cnext = conv_issue(F, cv.base + (cv.cs + 1) * F.G, cv.cs + 1);
            const LAS unsigned char* kb = lds + KT_OFF + (jt & 1) * KT_BYTES;
            bf16x8 Bf0[4], Bf1[4];
#pragma unroll
            for (int s = 0; s < 4; ++s) Bf0[s] = *(const LAS bf16x8*)(kb + r32 * 128 + (((2 * s + hi) ^ ((r32 >> 1) & 7)) * 16));
#pragma unroll
            for (int s = 0; s < 4; ++s) Bf1[s] = *(const LAS bf16x8*)(kb + (32 + r32) * 128 + (((2 * s + hi) ^ ((r32 >> 1) & 7)) * 16));
            f32x16 accA, accB; float scA, scB;
            IDX_MFMA(accA, 0, Bf0);
            __builtin_amdgcn_sched_barrier(0);
            IDX_MFMA(accB, 1, Bf0); IDX_SCORE(scA, accA, 0); IDX_PIPE();
            IDX_APPEND(scA, 0, 0);
            IDX_MFMA(accA, 0, Bf1); IDX_SCORE(scB, accB, 1); IDX_PIPE();
            IDX_APPEND(scB, 1, 0);
            IDX_MFMA(accB, 1, Bf1); IDX_SCORE(scA, accA, 0); IDX_PIPE();
            IDX_APPEND(scA, 0, 1);
            IDX_SCORE(scB, accB, 1);
            IDX_APPEND(scB, 1, 1);
            const int seen = 64 * (jt + 1);
            const int mx = max(max(cnt[0][0], cnt[0][1]), max(cnt[1][0], cnt[1][1]));
            const int q448 = seen / 448;
            const bool sched = (q448 * 448 == seen) && ((q448 & (q448 - 1)) == 0) && (jt + 1 < ntile);
            if (sched || mx >= EMERG) {
#pragma unroll
                for (int mt = 0; mt < 2; ++mt)
#pragma unroll
                    for (int hh = 0; hh < 2; ++hh) {
                        const int n = cnt[mt][hh];
                        if (n > 256) {
                            const int base = CAND_OFF + (4 * wid + 2 * mt + hh) * CAND_STRIDE;
                            unsigned P[NREG]; unsigned mxp = 0;
#pragma unroll
                            for (int j = 0; j < NREG; ++j) { const int i = j * 64 + lane; P[j] = i < n ? *(const LAS unsigned*)(lds + base + i * 4) : 0u; mxp = max(mxp, P[j]); }
#pragma unroll
                            for (int o = 32; o >= 1; o >>= 1) mxp = max(mxp, (unsigned)__shfl_xor((int)mxp, o));
                            mxp = __builtin_amdgcn_readfirstlane(mxp);
                            int bo; unsigned v = select_thr(P, mxp, lob[mt][hh], 14, 0u, -1, bo);
                            int kept = 0;
#pragma unroll
                            for (int j = 0; j < NREG; ++j) kept += __builtin_popcountll(__ballot(P[j] >= v));
                            if (kept > 400) { v = select_thr(P, mxp, lob[mt][hh], 0, v, bo, bo); }
                            int np = 0;
#pragma unroll
                            for (int j = 0; j < NREG; ++j) {
                                const bool k = P[j] >= v; const unsigned long long bm = __ballot(k);
                                const int pre = __builtin_amdgcn_mbcnt_hi((unsigned)(bm >> 32), __builtin_amdgcn_mbcnt_lo((unsigned)bm, 0));
                                if (k) *(LAS unsigned*)(lds + base + (np + pre) * 4) = P[j];
                                np += __builtin_popcountll(bm);
                            }
                            cnt[mt][hh] = np; lob[mt][hh] = v & 0xFFFFC000u;
                            const float tf = unordered_f32(v & 0xFFFFC000u);
                            if (hi == hh) tau[mt] = tf;
                        }
                    }
            }
            if (cnext) asm volatile("s_waitcnt vmcnt(2)" ::: "memory"); else asm volatile("s_waitcnt vmcnt(0)" ::: "memory");
            if (VAR == 0) cv.cs += 1;
        }
        if (VAR != 5) { asm volatile("s_waitcnt lgkmcnt(0)" ::: "memory"); __builtin_amdgcn_s_barrier(); asm volatile("" ::: "memory"); }
    }
#undef IDX_MFMA
#undef IDX_SCORE
#undef IDX_PIPE
#undef IDX_APPEND
#pragma unroll
    for (int mt = 0; mt < 2; ++mt)
#pragma unroll
        for (int hh = 0; hh < 2; ++hh) {
            const int n = cnt[mt][hh];
            const int base = CAND_OFF + (4 * wid + 2 * mt + hh) * CAND_STRIDE;
            unsigned P[NREG]; unsigned mxp = 0;
#pragma unroll
            for (int j = 0; j < NREG; ++j) { const int i = j * 64 + lane; P[j] = i < n ? *(const LAS unsigned*)(lds + base + i * 4) : 0u; mxp = max(mxp, P[j]); }
            unsigned v = 1u;
            if (n > 256) {
#pragma unroll
                for (int o = 32; o >= 1; o >>= 1) mxp = max(mxp, (unsigned)__shfl_xor((int)mxp, o));
                mxp = __builtin_amdgcn_readfirstlane(mxp);
                int bo_; v = select_thr(P, mxp, lob[mt][hh], 0, 0u, -1, bo_);
            }
            asm volatile("s_waitcnt lgkmcnt(0)" ::: "memory");
            for (int i = lane; i < 2 * ntile_q; i += 64) *(LAS unsigned*)(lds + base + i * 4) = 0u;
            asm volatile("s_waitcnt lgkmcnt(0)" ::: "memory");
#pragma unroll
            for (int j = 0; j < NREG; ++j) {
                if (P[j] >= v && P[j] != 0u) {
                    const unsigned gk = 16383u - (P[j] & 0x3FFFu);
                    const unsigned kt = gk >> 6, kk = gk & 63u, t = kk >> 5, jj = kk & 31u, hb = (jj >> 2) & 1u, r = (jj & 3u) + 4u * (jj >> 3);
                    __hip_atomic_fetch_or((LAS unsigned*)(lds + base + (kt * 2 + t) * 4), 1u << (16u * hb + r), __ATOMIC_RELAXED, __HIP_MEMORY_SCOPE_WORKGROUP);
                }
            }
        }
    __syncthreads();
    for (int k2 = wid; 2 * k2 < ntile_q; k2 += 8) {
        const int kt = 2 * k2 + hi;
        if (kt < ntile_q) {
            const u32x2 m = *(const LAS u32x2*)(lds + CAND_OFF + r32 * CAND_STRIDE + kt * 8);
            *(u32x2*)((VAR ? (unsigned long long*)(F.ws + WS_END) : F.MASK) + (size_t)kt * SEQ + t0 + r32) = m;
        }
    }
    __syncthreads();
}
}
#ifndef MK_N_LAUNCHES
#define MK_N_LAUNCHES 1
#endif
constexpr int N_PHASES = 12;
constexpr int BAR_LDS_OFF = LDS_BYTES - 16;

__global__ __launch_bounds__(512, 2) void fwd(Args args) {
    extern __shared__ __attribute__((aligned(16))) unsigned char shm[];
    Frame F;
    F.lds = (LAS unsigned char*)shm;
    F.tid = threadIdx.x; F.lane = F.tid & 63; F.wave = __builtin_amdgcn_readfirstlane(F.tid >> 6);
    F.G = gridDim.x; F.bid = blockIdx.x; F.vcu = (F.G % 8 == 0) ? (F.bid % 8) * (F.G / 8) + F.bid / 8 : F.bid;
    F.x = args.in[0]; F.c = args.in[1]; F.w_ada = args.in[2]; F.b_ada = args.in[3]; F.norm_mix = args.in[4]; F.w_in = args.in[5]; F.t5 = args.in[6]; F.rel = args.in[7];
    F.w_up_a = args.in[8]; F.w_up_b = args.in[9]; F.w_o = args.in[10]; F.norm_ffn = args.in[11]; F.w_rg = args.in[12]; F.b_rg = args.in[13]; F.w_re = args.in[14]; F.b_re = args.in[15];
    F.w1 = args.in[16]; F.w3 = args.in[17]; F.w2 = args.in[18]; F.norm_final = args.in[19];
    F.out = args.out; F.ws = args.ws;
    unsigned char* ws = args.ws;
    F.mod = (float*)(ws + CTL_MOD); F.ecnt = (unsigned*)(ws + CTL_ECNT);
    F.WinT = (bf16_t*)(ws + WS_WINT); F.WupaT = (bf16_t*)(ws + WS_WUPA); F.WupbT = (bf16_t*)(ws + WS_WUPB); F.WoT = (bf16_t*)(ws + WS_WO); F.W13T = (bf16_t*)(ws + WS_W13); F.W2T = (bf16_t*)(ws + WS_W2);
    F.H = (bf16_t*)(ws + WS_H); F.PROJ = (bf16_t*)(ws + WS_PROJ); F.YA = (bf16_t*)(ws + WS_YA); F.YB = (bf16_t*)(ws + WS_YB); F.MRG = (bf16_t*)(ws + WS_MRG);
    F.WinT8 = ws + WS_WINT + (size_t)NPB * DM * 2; F.H8 = ws + WS_H8; F.W13T8 = ws + WS_W13; F.W2T8 = ws + WS_W2; F.Wupa8 = ws + WS_WUPA; F.Wupb8 = ws + WS_WUPB; F.Wo8 = ws + WS_WO;
    F.MASK = (unsigned long long*)(ws + WS_MASK); F.LIST = (int*)(ws + WS_LIST); F.TSLOT = (int*)(ws + WS_TSLOT); F.TW = (float*)(ws + WS_TW);

    const int lo = args.ph_lo, hi = args.ph_hi;
    XcdBarrier bar; bar.bar = (unsigned*)(ws + CTL_BAR); bar.x = 0; bar.st = nullptr;
    if (hi - lo > 1) {
        if (F.tid == 0) *(LAS u32x4*)(F.lds + BAR_LDS_OFF) = (u32x4){0u, 0u, 0u, 0u};
        __syncthreads();
        bar = xcd_barrier_post((unsigned*)(ws + CTL_BAR), (volatile LAS unsigned*)(F.lds + BAR_LDS_OFF));
    }
#ifndef PHASE_MASK
#define PHASE_MASK 0xFFF
#endif
#define IN(k) (((PHASE_MASK >> (k)) & 1) && lo <= (k) && (k) < hi)
#ifndef DUP_PHASE
#define DUP_PHASE -1
#endif
#define REP(k) for (int rep_ = 0; rep_ < ((DUP_PHASE) == (k) ? 2 : 1); ++rep_)
#define SEAM(k) do { if (IN(k) && IN((k) + 1)) xcd_barrier(bar); } while (0)

    if (IN(0)) { p0_mod(F); REP(0) p0_convert(F); }
    SEAM(0);
    if (IN(1)) REP(1) { p1_norm(F); }
    SEAM(1);
    if (IN(2)) {
        { pg8::StaticOrder<2048> S; S.init(F.H, F.WinT, SEQ, NPB, F.G, F.bid);
          pg8::EpiProj E{F.PROJ};
          pg8::gemm_phase<2048, false, false>(F.lds, S, E);
#if DUP_PHASE == 20
          pg8::gemm_phase<2048, false, false>(F.lds, S, E);
#endif
        }
        { pg8::ProjOrder8 S; S.init(F.H8, F.WinT8, SEQ, NP8, F.G, F.bid); S.bid = F.bid;
          pg8::EpiProj8 E{F.PROJ};
          pg8::gemm_phase<1024, false, true>(F.lds, S, E, W8_SCALE_LOG2, H8_SCALE_LOG2);
#if DUP_PHASE == 21
          pg8::gemm_phase<1024, false, true>(F.lds, S, E, W8_SCALE_LOG2, H8_SCALE_LOG2);
#endif
        }
    }
    SEAM(2);
    if (IN(3)) {
#ifndef NO_IDX
        {
            ConvSt cv; cv.base = TC_LATE_START + F.bid; cv.cs = 0;
            __syncthreads();
            (void)conv_issue(F, cv.base, 0);
            for (int p = F.bid; p < 256; p += F.G) { idx::indexer_unit<0>(F, p, cv); idx::indexer_unit<0>(F, 511 - p, cv); }
#ifdef IDX_PROBE
            for (int p = F.bid; p < 256; p += F.G) { idx::indexer_unit<IDX_PROBE>(F, p, cv); idx::indexer_unit<IDX_PROBE>(F, 511 - p, cv); }
#endif
            conv_drain(F, cv.cs >= 1 ? cv.base + (cv.cs - 1) * F.G : -1, cv.cs - 1);
            asm volatile("s_waitcnt vmcnt(0)" ::: "memory"); __syncthreads();
            conv_drain(F, cv.base + cv.cs * F.G, cv.cs);
            __syncthreads();
            for (int tl = cv.base + (cv.cs + 1) * F.G;; tl += F.G) { TDesc d; f32x4 v[2]; if (!tconv_desc(F, tl, d)) break; tconv_load(F, d, v); tconv_store(F, d, v, 0); }
        }
#endif
#ifndef NO_BAND
        REP(31) for (int p = F.bid; p < 256; p += F.G) {
            const int h = p & 7, j = p >> 3;
            fill_tab_B(F, h, (LAS char*)F.lds);
#pragma unroll 1
            for (int s = 0; s < 2; ++s) {
                const int qt = s ? 63 - j : j, q0 = qt * 256;
                const int kt0 = (4 * qt - 8) > 0 ? (4 * qt - 8) : 0, kt1 = 4 * qt + 4;
                att::attn_unit<1, DMAX_B>(F.PROJ + (size_t)q0 * NPROJ + COL_QB + h * 128, F.PROJ + COL_KB + h * 128, F.PROJ + COL_VB + h * 128, (unsigned char*)F.YB + (size_t)q0 * 1024 + h * 128, nullptr, q0, kt0, kt1, (LAS char*)F.lds);
            }
        }
#endif
    }
    SEAM(3);
    if (IN(4)) REP(4) {
        for (int p = F.bid; p < 256; p += F.G) {
            const int h = p & 7, j = p >> 3;
            fill_tab_A(F, h, (LAS char*)F.lds);
#pragma unroll 1
            for (int s = 0; s < 2; ++s) {
                const int qt = s ? 63 - j : j, q0 = qt * 256;
                att::attn_unit<0, DMAX_A>(F.PROJ + (size_t)q0 * NPROJ + COL_QA + h * 128, F.PROJ + COL_KA + h * 128, F.PROJ + COL_VA + h * 128, (unsigned char*)F.YA + (size_t)q0 * 1024 + h * 128, F.MASK + q0, q0, 0, 4 * qt + 4, (LAS char*)F.lds);
            }
        }
    }
    SEAM(4);
    if (IN(5)) {
        pg8::StaticOrder<512> S; S.init(F.YA, F.Wupa8, SEQ, DM, F.G, F.bid);
        pg8::EpiGate<false> E{F.PROJ, COL_GA, nullptr, F.H};
        pg8::gemm_phase<512, false, true>(F.lds, S, E, W8_SCALE_LOG2, Y8_SCALE_LOG2);
#if DUP_PHASE == 5
        pg8::gemm_phase<512, false, true>(F.lds, S, E, W8_SCALE_LOG2, Y8_SCALE_LOG2);
#endif
    }
    if (IN(5) && IN(6)) { asm volatile("s_waitcnt vmcnt(0)" ::: "memory"); __syncthreads(); if (F.tid == 0) { __builtin_amdgcn_fence(__ATOMIC_ACQUIRE, "agent"); asm volatile("s_waitcnt vmcnt(0)" ::: "memory"); } __syncthreads(); }
    if (IN(6)) {
        pg8::StaticOrder<512> S; S.init(F.YB, F.Wupb8, SEQ, DM, F.G, F.bid);
        pg8::EpiGate<true> E{F.PROJ, COL_GB, F.H, F.MRG};
        pg8::gemm_phase<512, false, true>(F.lds, S, E, W8_SCALE_LOG2, Y8_SCALE_LOG2);
#if DUP_PHASE == 6
        pg8::gemm_phase<512, false, true>(F.lds, S, E, W8_SCALE_LOG2, Y8_SCALE_LOG2);
#endif
    }
    SEAM(6);
    if (IN(7)) {
        pg8::StaticOrder<1024> S; S.init(F.MRG, F.Wo8, SEQ, DM, F.G, F.bid);
        pg8::EpiRes E{F.x, F.mod + 2 * DM, F.H};
        pg8::gemm_phase<1024, false, true>(F.lds, S, E, W8_SCALE_LOG2, M8_SCALE_LOG2);
#if DUP_PHASE == 7
        pg8::gemm_phase<1024, false, true>(F.lds, S, E, W8_SCALE_LOG2, M8_SCALE_LOG2);
#endif
    }
    SEAM(7);
    if (IN(8)) { p8_router(F); }
    SEAM(8);
    if (IN(9)) {
        moe_tables(F); moe1_fill_lists(F);
        MoeOrder1 S{&F, (const LAS int*)(F.lds + MOE_TS), (const LAS int*)(F.lds + MOE_TOK)};
        pg8::EpiMoe1 E{(unsigned char*)F.MRG};
        pg8::gemm_phase<1024, true, true>(F.lds, S, E, W8_SCALE_LOG2, H8_SCALE_LOG2);
#if DUP_PHASE == 9
        pg8::gemm_phase<1024, true, true>(F.lds, S, E, W8_SCALE_LOG2, H8_SCALE_LOG2);
#endif
    }
    SEAM(9);
    if (IN(10)) {
        moe_tables(F);
        MoeOrder2 S{&F, (const LAS int*)(F.lds + MOE_TS)};
        pg8::EpiMoe2 E{F.PROJ};
        pg8::gemm_phase<256, false, true>(F.lds, S, E, W2_SCALE_LOG2, A8_SCALE_LOG2);
#if DUP_PHASE == 10
        pg8::gemm_phase<256, false, true>(F.lds, S, E, W2_SCALE_LOG2, A8_SCALE_LOG2);
#endif
    }
    SEAM(10);
    if (IN(11)) { moe_tables(F); p11_final(F); }
#undef IN
#undef SEAM
}

extern "C" void kernel_launch(void* const* d_in, const int* in_sizes, int n_in, void* d_out, int out_size, void* d_ws, size_t ws_size, hipStream_t stream) {
    static int grid = 0;
    if (grid == 0) {
        if (n_in != 20 || out_size != SEQ * DM || ws_size < WS_END) { fprintf(stderr, "kernel_launch: shape/workspace mismatch: n_in %d out %d ws %zu (need %zu)\n", n_in, out_size, ws_size, (size_t)WS_END); grid = -1; return; }
        int dev = 0, cus = 0, per_cu = 0;
        if (hipGetDevice(&dev) != hipSuccess || hipDeviceGetAttribute(&cus, hipDeviceAttributeMultiprocessorCount, dev) != hipSuccess) { grid = -1; return; }
        if (hipFuncSetAttribute((const void*)fwd, hipFuncAttributeMaxDynamicSharedMemorySize, LDS_BYTES) != hipSuccess) { fprintf(stderr, "kernel_launch: hipFuncSetAttribute failed\n"); grid = -1; return; }
        if (hipOccupancyMaxActiveBlocksPerMultiprocessor(&per_cu, (const void*)fwd, 512, LDS_BYTES) != hipSuccess || per_cu < 1) fprintf(stderr, "kernel_launch: occupancy query says %d\n", per_cu);
        (void)hipGetLastError();
        grid = cus;
    }
    if (grid < 0) return;
    (void)hipMemsetAsync((char*)d_ws + WS_CTL, 0, CTL_BYTES, stream);
    Args a{};
    for (int i = 0; i < 20; ++i) a.in[i] = (const float*)d_in[i];
    a.out = (float*)d_out; a.ws = (unsigned char*)d_ws;
#if MK_N_LAUNCHES == 1
    a.ph_lo = 0; a.ph_hi = N_PHASES;
    hipLaunchKernelGGL(fwd, dim3(grid), dim3(512), LDS_BYTES, stream, a);
#else
    for (int ph = 0; ph < N_PHASES; ++ph) { a.ph_lo = ph; a.ph_hi = ph + 1; hipLaunchKernelGGL(fwd, dim3(grid), dim3(512), LDS_BYTES, stream, a); }
#endif
    const hipError_t le = hipPeekAtLastError();
    if (le != hipSuccess) fprintf(stderr, "kernel_launch: launch failed: %s\n", hipGetErrorName(le));
}
```

```cpp
#include <hip/hip_runtime.h>
#include <cstdio>
#include <cstdint>

#define LAS __attribute__((address_space(3)))
typedef unsigned short bf16_t;
typedef short bf16x8 __attribute__((ext_vector_type(8)));
typedef short s16x4 __attribute__((ext_vector_type(4)));
typedef float f32x2 __attribute__((ext_vector_type(2)));
typedef float f32x4 __attribute__((ext_vector_type(4)));
typedef float f32x16 __attribute__((ext_vector_type(16)));
typedef unsigned u32x2 __attribute__((ext_vector_type(2)));
typedef unsigned u32x4 __attribute__((ext_vector_type(4)));
typedef int i32x4_ __attribute__((ext_vector_type(4)));
typedef int i32x8 __attribute__((ext_vector_type(8)));

constexpr int SEQ = 16384, DM = 2048, NPROJ = 11520  , NPROJ_REAL = 11344;
constexpr int COL_QA = 0, COL_KA = 1024, COL_VA = 2048, COL_QI = 3072, COL_KI = 4096, COL_WI = 4160, COL_QB = 4176, COL_KB = 5200, COL_VB = 6224, COL_GA = 7248, COL_GB = 9296;
constexpr int NEXP = 64, DFF = 512, LIST_CAP = 16384;
constexpr int NPB = 5376  , NPB_REAL = 5200, NP8 = 6144  ;
constexpr int H8_SCALE_LOG2 = 4, W8_SCALE_LOG2 = 9, W2_SCALE_LOG2 = 8, A8_SCALE_LOG2 = 4, Y8_SCALE_LOG2 = 6, M8_SCALE_LOG2 = 5;
constexpr float EPS = 1e-6f;
constexpr float LOG2E = 1.4426950408889634f;

constexpr size_t A256(size_t x) { return (x + 255) / 256 * 256; }
constexpr size_t WS_CTL = 0;
constexpr size_t CTL_BAR = 0;
constexpr size_t CTL_MOD = 16384;
constexpr size_t CTL_ECNT = 16384 + 49152;
constexpr size_t CTL_BYTES = 16384 + 49152 + 4096 + 256;
constexpr size_t WS_WINT = 131072;
constexpr size_t WS_WUPA = WS_WINT + (size_t)NPROJ * DM * 2;
constexpr size_t WS_WUPB = WS_WUPA + (size_t)DM * 1024 * 2;
constexpr size_t WS_WO   = WS_WUPB + (size_t)DM * 1024 * 2;
constexpr size_t WS_W13  = WS_WO + (size_t)DM * DM * 2;
constexpr size_t WS_W2   = WS_W13 + (size_t)NEXP * 1024 * DM;
constexpr size_t WS_H    = WS_W2 + (size_t)NEXP * DM * DFF;
constexpr size_t WS_PROJ = WS_H + (size_t)SEQ * DM * 2;
constexpr size_t WS_MASK = WS_PROJ + (size_t)SEQ * NPROJ * 2;
constexpr size_t WS_YA   = WS_MASK + (size_t)256 * SEQ * 8;
constexpr size_t WS_YB   = WS_YA + (size_t)SEQ * 1024 * 2;
constexpr size_t WS_MRG  = WS_YB + (size_t)SEQ * 1024 * 2;
constexpr size_t WS_LIST = WS_MRG + (size_t)SEQ * DM * 2;
constexpr size_t WS_TSLOT = WS_LIST + (size_t)NEXP * LIST_CAP * 4;
constexpr size_t WS_TW   = WS_TSLOT + (size_t)SEQ * 2 * 4;
constexpr size_t WS_H8   = WS_TW + (size_t)SEQ * 2 * 4;
constexpr size_t WS_RB   = WS_H8 + (size_t)SEQ * DM;
constexpr size_t WS_END  = WS_RB + (size_t)(1 << 20);
constexpr int MAX_PAD_ROWS = 2 * SEQ + NEXP * 255 + 1;
static_assert((size_t)MAX_PAD_ROWS * DM * 2 <= (size_t)SEQ * NPROJ * 2, "y fits in proj region");
static_assert((size_t)MAX_PAD_ROWS * DFF * 2 <= (size_t)SEQ * DM * 2, "a fits in merged region");

constexpr int LDS_BYTES = 147456;

__device__ __forceinline__ unsigned cvt_pk_bf16(float lo, float hi) { unsigned r; asm volatile("v_cvt_pk_bf16_f32 %0, %1, %2" : "=v"(r) : "v"(lo), "v"(hi)); return r; }
__device__ __forceinline__ float bf_lo(unsigned w) { return __uint_as_float(w << 16); }
__device__ __forceinline__ float bf_hi(unsigned w) { return __uint_as_float(w & 0xffff0000u); }
__device__ __forceinline__ float sigmoidf_(float x) { return __builtin_amdgcn_rcpf(1.0f + __builtin_amdgcn_exp2f(-x * LOG2E)); }
__device__ __forceinline__ unsigned cvt_fp8x4_(float a, float b, float c, float d) {
    int w = 0; w = __builtin_amdgcn_cvt_pk_fp8_f32(a, b, w, false); w = __builtin_amdgcn_cvt_pk_fp8_f32(c, d, w, true); return (unsigned)w;
}
__device__ __forceinline__ float wave_sum(float v) {
#pragma unroll
    for (int o = 32; o >= 1; o >>= 1) v += __shfl_xor(v, o);
    return v;
}

#define XB_TMO      128
#define XB_XCNT(j)  (256  + 64 * (j))
#define XB_XSUB(j)  (1280 + 64 * (j))
#define XB_XGEN(j)  (2304 + 64 * (j))
#define XB_TOP      3328
#define XB_TOPGEN   3392
#define XCD_BAR_WORDS 3456
#define XB_SPIN_CAP (1u << 22)
__device__ __forceinline__ unsigned xb_ld(unsigned* p)              { return __hip_atomic_load(p, __ATOMIC_RELAXED, __HIP_MEMORY_SCOPE_AGENT); }
__device__ __forceinline__ unsigned xb_add(unsigned* p, unsigned v) { return __hip_atomic_fetch_add(p, v, __ATOMIC_RELAXED, __HIP_MEMORY_SCOPE_AGENT); }
__device__ __forceinline__ unsigned xb_xcc_id() { return (unsigned)__builtin_amdgcn_s_getreg((3 << 11) | 20) & 0xFu; }
#define XB_SPIN(cond, bar) do { unsigned _sp = 0; while (cond) { __builtin_amdgcn_s_sleep(1); \
    if ((++_sp & 255u) == 0u) { if (xb_ld(&(bar)[XB_TMO])) break; if (_sp > XB_SPIN_CAP) { atomicAdd(&(bar)[XB_TMO], 1u); break; } } } } while (0)
struct XcdBarrier { unsigned* bar; unsigned x; volatile LAS unsigned* st; };
__device__ __forceinline__ XcdBarrier xcd_barrier_post(unsigned* bar, volatile LAS unsigned* st) {
    XcdBarrier b; b.bar = bar; b.x = xb_xcc_id(); b.st = st;
    if (threadIdx.x == 0) (void)xb_add(&bar[XB_XCNT(b.x)], 1u);
    return b;
}
__device__ __forceinline__ void xcd_barrier_complete(unsigned* bar, unsigned x, unsigned& nloc, unsigned& nx) {
    const unsigned G = gridDim.x * gridDim.y * gridDim.z;
    unsigned sum, cnt, mine, sp = 0u;
    for (;;) {
        sum = 0u; cnt = 0u; mine = 0u;
#pragma unroll
        for (unsigned j = 0; j < 16; ++j) { const unsigned c = xb_ld(&bar[XB_XCNT(j)]); sum += c; cnt += (c > 0u) ? 1u : 0u; mine = (j == x) ? c : mine; }
        if (sum == G) break;
        __builtin_amdgcn_s_sleep(1);
        if ((++sp & 255u) == 0u) { if (xb_ld(&bar[XB_TMO])) break; if (sp > XB_SPIN_CAP) { atomicAdd(&bar[XB_TMO], 1u); break; } }
    }
    nloc = mine > 0u ? mine : 1u; nx = cnt > 0u ? cnt : 1u;
}
__device__ __forceinline__ void xcd_barrier(const XcdBarrier& b) {
    asm volatile("s_waitcnt vmcnt(0)" ::: "memory");
    __syncthreads();
    if (threadIdx.x == 0) {
        unsigned* bar = b.bar;
        __builtin_amdgcn_s_waitcnt(0);
        unsigned nloc = b.st[0], nx = b.st[1];
        if (nloc == 0u) { xcd_barrier_complete(bar, b.x, nloc, nx); b.st[0] = nloc; b.st[1] = nx; }
        const unsigned old = xb_add(&bar[XB_XSUB(b.x)], 1u);
        const unsigned gen = old / nloc;
        if (old + 1u == (gen + 1u) * nloc) {
            __builtin_amdgcn_fence(__ATOMIC_RELEASE, "agent");
            asm volatile("s_waitcnt vmcnt(0)" ::: "memory");
            const unsigned og = xb_add(&bar[XB_TOP], 1u);
            const unsigned tg = og / nx;
            if (og + 1u == (tg + 1u) * nx) xb_add(&bar[XB_TOPGEN], 1u);
            else XB_SPIN(xb_ld(&bar[XB_TOPGEN]) == tg, bar);
            __builtin_amdgcn_fence(__ATOMIC_ACQUIRE, "agent");
            xb_add(&bar[XB_XGEN(b.x)], 1u);
            asm volatile("s_waitcnt vmcnt(0)" ::: "memory");
        } else {
            XB_SPIN(xb_ld(&bar[XB_XGEN(b.x)]) == gen, bar);
            __builtin_amdgcn_fence(__ATOMIC_ACQUIRE, "agent");
            asm volatile("s_waitcnt vmcnt(0)" ::: "memory");
        }
    }
    __syncthreads();
}

namespace pg8 {
constexpr int BM = 256, BK = 64, HALF = 128, HTB = HALF * BK * 2, STAGE_BYTES = 8 * HTB, NXCD = 8, WGM = 8;
__host__ __device__ __forceinline__ int lds_byte(int r, int c) { const int st = (r >> 4) * 2 + (c >> 5), rr = r & 15, cc = c & 31, ob = rr * 64 + cc * 2; return st * 1024 + (ob ^ (((ob >> 9) & 1) << 5)); }
__host__ __device__ __forceinline__ void stage_rc(int b, int& R, int& C) { const int st = b / 1024, sb = b % 1024, swz = sb ^ (((sb >> 9) & 1) << 5); R = (st >> 1) * 16 + swz / 64; C = (st & 1) * 32 + (swz % 64) / 2; }
__host__ __device__ __forceinline__ int perm32(int rho) { const int n = rho >> 4, i = rho & 15; return 8 * (i >> 2) + 4 * n + (i & 3); }

struct Unit { int pm, pn; const char* A; const char* B; int x0, x1; };

template <int K> struct StaticOrder {
    int nM, nN, nwg, G, c; const char* A; const char* Bt;
    __device__ void init(const void* A_, const void* Bt_, int M, int N, int G_, int c_) { A = (const char*)A_; Bt = (const char*)Bt_; nM = M / BM; nN = N / BM; nwg = nM * nN; G = G_; c = c_; }
    __device__ __forceinline__ bool next(int i, Unit& u) const {
        const long L = (long)i * G + c; if (L >= nwg) return false;
        int wgid = (int)L; { const int q = nwg / NXCD, r = nwg % NXCD, xcd = wgid % NXCD, off = wgid / NXCD; wgid = (xcd < r ? xcd * (q + 1) : r * (q + 1) + (xcd - r) * q) + off; }
        const int nig = WGM * nN, gid = wgid / nig, fm = gid * WGM, gsz = (nM - fm) < WGM ? (nM - fm) : WGM;
        u.pm = fm + ((wgid % nig) % gsz); u.pn = (wgid % nig) / gsz;
        u.A = A + (size_t)u.pm * BM * K * 2; u.B = Bt + (size_t)u.pn * BM * K * 2; u.x0 = 0; u.x1 = 0; return true;
    }
    __device__ __forceinline__ int arow(const Unit&, int r) const { return r; }
};

template <bool FP8> struct FragT { typedef bf16x8 A[4][2]; typedef bf16x8 B[2][2]; };
template <> struct FragT<true> { typedef i32x8 A[4]; typedef i32x8 B[2]; };
struct ProjOrder8 : StaticOrder<1024> {
    int bid;
    __device__ __forceinline__ bool next(int i, Unit& u) const {
        if (G != 256) return StaticOrder<1024>::next(i, u);
        long L;
        if (i < 4) L = (long)i * 256 + bid; else { if (bid < 64) return false; L = 1024 + (long)(i - 4) * 192 + (bid - 64); }
        if (L >= nwg) return false;
        int wgid = (int)L; { const int q = nwg / NXCD, r = nwg % NXCD, xcd = wgid % NXCD, off = wgid / NXCD; wgid = (xcd < r ? xcd * (q + 1) : r * (q + 1) + (xcd - r) * q) + off; }
        const int nig = WGM * nN, gid = wgid / nig, fm = gid * WGM, gsz = (nM - fm) < WGM ? (nM - fm) : WGM;
        u.pm = fm + ((wgid % nig) % gsz); u.pn = (wgid % nig) / gsz;
        u.A = A + (size_t)u.pm * BM * 1024 * 2; u.B = Bt + (size_t)u.pn * BM * 1024 * 2; u.x0 = 0; u.x1 = 0; return true;
    }
};
template <int K, bool GATHER, bool FP8, class Epi, class Sched>
__device__ __forceinline__ void gemm_phase(LAS unsigned char* lds, const Sched& S, const Epi& E, int sclW_log2 = 0, int sclH_log2 = 0) {
    const int tid = threadIdx.x, wid = __builtin_amdgcn_readfirstlane(tid >> 6), lane = tid & 63, wr = wid >> 2, wc = wid & 3, fr = lane & 15, fq = lane >> 4;
    constexpr int nt = K / BK;
    int R0, C0, R1, C1; stage_rc(tid * 16, R0, C0); stage_rc(tid * 16 + 8192, R1, C1);
    unsigned voffB[2];
    { const int Rb0 = Epi::PERM ? ((R0 & ~31) + perm32(R0 & 31)) : R0, Rb1 = Epi::PERM ? ((R1 & ~31) + perm32(R1 & 31)) : R1;
      voffB[0] = (unsigned)(Rb0 * K + C0) * 2u; voffB[1] = (unsigned)(Rb1 * K + C1) * 2u; }
    constexpr size_t kstep = (size_t)(BK * 2), hstep = (size_t)HALF * K * 2;
    const unsigned ldsw = (unsigned)wid * 1024u;
    const int aoff = lds_byte(wr * 64 + fr, fq * 8), boff = lds_byte(wc * 32 + fr, fq * 8);
#define PG8_SA(b, h) (((b) * 2 + (h)) * HTB)
#define PG8_SB(b, h) ((4 + (b) * 2 + (h)) * HTB)
#define PG8_GLDS(bufoff, gp0, gp1) do { \
        __builtin_amdgcn_global_load_lds((const unsigned*)(gp0), (LAS unsigned*)(lds + (bufoff) + ldsw), 16, 0, 0); \
        __builtin_amdgcn_global_load_lds((const unsigned*)(gp1), (LAS unsigned*)(lds + (bufoff) + ldsw + 8192), 16, 0, 0); } while (0)
#define PG8_STAGE_B(bufoff, gbase) PG8_GLDS(bufoff, (const char*)(gbase) + voffB[0], (const char*)(gbase) + voffB[1])
#define PG8_STAGE_A(bufoff, gbase, v0, v1) PG8_GLDS(bufoff, (const char*)(gbase) + (v0), (const char*)(gbase) + (v1))
#define PG8_LDA(dst, b, h) do { if constexpr (FP8) { _Pragma("unroll") for (int m = 0; m < 4; ++m) { \
            const i32x4_ lo_ = *(const LAS i32x4_*)(lds + PG8_SA(b, h) + aoff + m * 2048), hi_ = *(const LAS i32x4_*)(lds + PG8_SA(b, h) + aoff + m * 2048 + 1024); \
            *(i32x8*)&dst[m] = __builtin_shufflevector(lo_, hi_, 0, 1, 2, 3, 4, 5, 6, 7); } } \
        else { _Pragma("unroll") for (int m = 0; m < 4; ++m) _Pragma("unroll") for (int k = 0; k < 2; ++k) ((bf16x8*)&dst[m])[k] = *(const LAS bf16x8*)(lds + PG8_SA(b, h) + aoff + m * 2048 + k * 1024); } } while (0)
#define PG8_LDB(dst, b, h) do { if constexpr (FP8) { _Pragma("unroll") for (int n = 0; n < 2; ++n) { \
            const i32x4_ lo_ = *(const LAS i32x4_*)(lds + PG8_SB(b, h) + boff + n * 2048), hi_ = *(const LAS i32x4_*)(lds + PG8_SB(b, h) + boff + n * 2048 + 1024); \
            *(i32x8*)&dst[n] = __builtin_shufflevector(lo_, hi_, 0, 1, 2, 3, 4, 5, 6, 7); } } \
        else { _Pragma("unroll") for (int n = 0; n < 2; ++n) _Pragma("unroll") for (int k = 0; k < 2; ++k) ((bf16x8*)&dst[n])[k] = *(const LAS bf16x8*)(lds + PG8_SB(b, h) + boff + n * 2048 + k * 1024); } } while (0)
#define PG8_MMA(ai, bj, At, Bt) do { __builtin_amdgcn_s_setprio(1); \
        if constexpr (FP8) { _Pragma("unroll") for (int m = 0; m < 4; ++m) _Pragma("unroll") for (int n = 0; n < 2; ++n) \
            asm volatile("v_mfma_scale_f32_16x16x128_f8f6f4 %0, %1, %2, %0, %3, %4 op_sel_hi:[0,0,0]" : "+v"(acc[ai][bj][m][n]) : "v"(*(const i32x8*)&Bt[n]), "v"(*(const i32x8*)&At[m]), "v"(sclW), "v"(sclH)); } \
        else { _Pragma("unroll") for (int m = 0; m < 4; ++m) _Pragma("unroll") for (int n = 0; n < 2; ++n) _Pragma("unroll") for (int k = 0; k < 2; ++k) \
            acc[ai][bj][m][n] = __builtin_amdgcn_mfma_f32_16x16x32_bf16(((const bf16x8*)&Bt[n])[k], ((const bf16x8*)&At[m])[k], acc[ai][bj][m][n], 0, 0, 0); } \
        __builtin_amdgcn_s_setprio(0); } while (0)
#define PG8_WAIT_V(n) asm volatile("s_waitcnt vmcnt(" #n ")" ::: "memory")
#define PG8_WAIT_L(n) asm volatile("s_waitcnt lgkmcnt(" #n ")" ::: "memory")
#define PG8_BAR __builtin_amdgcn_s_barrier()
#define PG8_SCHED __builtin_amdgcn_sched_barrier(0)
#define PG8_SETA(u, v) do { if (GATHER) { \
        v[0][0] = (unsigned)(S.arow(u, R0) * K + C0) * 2u; v[0][1] = (unsigned)(S.arow(u, R1) * K + C1) * 2u; \
        v[1][0] = (unsigned)(S.arow(u, HALF + R0) * K + C0) * 2u; v[1][1] = (unsigned)(S.arow(u, HALF + R1) * K + C1) * 2u; \
      } else { v[0][0] = (unsigned)(R0 * K + C0) * 2u; v[0][1] = (unsigned)(R1 * K + C1) * 2u; v[1][0] = v[0][0] + (unsigned)hstep; v[1][1] = v[0][1] + (unsigned)hstep; } } while (0)
    Unit cur, nxt; int ui = 0;
    if (!S.next(0, cur)) return;
    f32x4 acc[2][2][4][2];
#pragma unroll
    for (int a = 0; a < 2; ++a)
#pragma unroll
        for (int b = 0; b < 2; ++b)
#pragma unroll
            for (int m = 0; m < 4; ++m)
#pragma unroll
                for (int n = 0; n < 2; ++n) acc[a][b][m][n] = (f32x4){0.f, 0.f, 0.f, 0.f};
    typename FragT<FP8>::A At; typename FragT<FP8>::B B0, B1;
    const int sclW = 127 - sclW_log2, sclH = 127 - sclH_log2;
    unsigned vA[2][2], vN[2][2];
    PG8_SETA(cur, vA);
    const char* cA = cur.A; const char* cB = cur.B;
    PG8_STAGE_B(PG8_SB(0, 0), cB); PG8_STAGE_A(PG8_SA(0, 0), cA, vA[0][0], vA[0][1]); PG8_STAGE_B(PG8_SB(0, 1), cB + hstep); PG8_STAGE_A(PG8_SA(0, 1), cA, vA[1][0], vA[1][1]);
    if (wr == 1) PG8_BAR;
    PG8_WAIT_V(4); PG8_BAR;
    PG8_STAGE_B(PG8_SB(1, 0), cB + kstep); PG8_STAGE_A(PG8_SA(1, 0), cA + kstep, vA[0][0], vA[0][1]); PG8_STAGE_B(PG8_SB(1, 1), cB + hstep + kstep);
    PG8_WAIT_V(6); PG8_BAR;
    for (;;) {
        const bool has_next = S.next(ui + 1, nxt);
        const char* nA = has_next ? nxt.A : cA; const char* nB = has_next ? nxt.B : cB;
        if (has_next) { PG8_SETA(nxt, vN); } else { vN[0][0] = vA[0][0]; vN[0][1] = vA[0][1]; vN[1][0] = vA[1][0]; vN[1][1] = vA[1][1]; }
        for (int t = 0; t < nt; t += 2) {
            const bool last = (t == nt - 2);
            const char* a1 = cA + (size_t)(t + 1) * kstep;
            const char* a2 = last ? nA : cA + (size_t)(t + 2) * kstep; const char* b2 = last ? nB : cB + (size_t)(t + 2) * kstep;
            const char* a3 = a2 + kstep; const char* b3 = b2 + kstep;
            const unsigned w00 = last ? vN[0][0] : vA[0][0], w01 = last ? vN[0][1] : vA[0][1], w10 = last ? vN[1][0] : vA[1][0], w11 = last ? vN[1][1] : vA[1][1];
            PG8_LDB(B0, 0, 0); PG8_SCHED; PG8_LDA(At, 0, 0); PG8_STAGE_A(PG8_SA(1, 1), a1, vA[1][0], vA[1][1]);
            PG8_WAIT_L(8); PG8_BAR; PG8_WAIT_L(0); PG8_MMA(0, 0, At, B0); PG8_BAR; PG8_SCHED;
            PG8_LDB(B1, 0, 1); PG8_STAGE_B(PG8_SB(0, 0), b2);
            PG8_BAR; PG8_WAIT_L(0); PG8_MMA(0, 1, At, B1); PG8_BAR;
            PG8_LDA(At, 0, 1); PG8_STAGE_A(PG8_SA(0, 0), a2, w00, w01);
            PG8_BAR; PG8_WAIT_L(0); PG8_MMA(1, 0, At, B0); PG8_BAR; PG8_SCHED;
            PG8_STAGE_B(PG8_SB(0, 1), b2 + hstep);
            PG8_WAIT_V(6); PG8_BAR; PG8_MMA(1, 1, At, B1); PG8_BAR;
            PG8_LDB(B0, 1, 0); PG8_SCHED; PG8_LDA(At, 1, 0); PG8_STAGE_A(PG8_SA(0, 1), a2, w10, w11);
            PG8_WAIT_L(8); PG8_BAR; PG8_WAIT_L(0); PG8_MMA(0, 0, At, B0); PG8_BAR; PG8_SCHED;
            PG8_LDB(B1, 1, 1); PG8_STAGE_B(PG8_SB(1, 0), b3);
            PG8_BAR; PG8_WAIT_L(0); PG8_MMA(0, 1, At, B1); PG8_BAR;
            PG8_LDA(At, 1, 1); PG8_STAGE_A(PG8_SA(1, 0), a3, w00, w01);
            PG8_BAR; PG8_WAIT_L(0); PG8_MMA(1, 0, At, B0); PG8_BAR; PG8_SCHED;
            PG8_STAGE_B(PG8_SB(1, 1), b3 + hstep);
            PG8_WAIT_V(6); PG8_BAR; PG8_MMA(1, 1, At, B1); PG8_BAR;
        }
        if constexpr (FP8) asm volatile("s_nop 15\n\ts_nop 15\n\ts_nop 15" ::: "memory");
        E(acc, cur, wr, wc, fr, fq);
        if (!has_next) break;
#pragma unroll
        for (int a = 0; a < 2; ++a)
#pragma unroll
            for (int b = 0; b < 2; ++b)
#pragma unroll
                for (int m = 0; m < 4; ++m)
#pragma unroll
                    for (int n = 0; n < 2; ++n) acc[a][b][m][n] = (f32x4){0.f, 0.f, 0.f, 0.f};
        cur = nxt; cA = nA; cB = nB; ++ui;
        vA[0][0] = vN[0][0]; vA[0][1] = vN[0][1]; vA[1][0] = vN[1][0]; vA[1][1] = vN[1][1];
    }
    PG8_WAIT_V(0);
    if (wr == 0) PG8_BAR;
    PG8_BAR;
#undef PG8_SA
#undef PG8_SB
#undef PG8_GLDS
#undef PG8_STAGE_A
#undef PG8_STAGE_B
#undef PG8_LDA
#undef PG8_LDB
#undef PG8_MMA
#undef PG8_WAIT_V
#undef PG8_WAIT_L
#undef PG8_BAR
#undef PG8_SCHED
#undef PG8_SETA
}

struct EpiProj {
    static constexpr bool PERM = true;
    bf16_t* O;
    __device__ __forceinline__ void operator()(const f32x4 (&acc)[2][2][4][2], const Unit& u, int wr, int wc, int fr, int fq) const {
        const int row0 = u.pm * BM + wr * 64 + fr, col0 = u.pn * BM + wc * 32 + 8 * fq;
#pragma unroll
        for (int ai = 0; ai < 2; ++ai)
#pragma unroll
            for (int m = 0; m < 4; ++m) { bf16_t* rowp = O + (size_t)(row0 + ai * HALF + m * 16) * NPROJ;
#pragma unroll
                for (int bj = 0; bj < 2; ++bj) { const f32x4 v0 = acc[ai][bj][m][0], v1 = acc[ai][bj][m][1];
                    const int c = col0 + bj * HALF;
                    u32x4 w; w.x = cvt_pk_bf16(v0[0], v0[1]); w.y = cvt_pk_bf16(v0[2], v0[3]); w.z = cvt_pk_bf16(v1[0], v1[1]); w.w = cvt_pk_bf16(v1[2], v1[3]);
                    if (c < NPB_REAL) *(u32x4*)(rowp + (c < 2048 ? c : c + 1024)) = w; } }
    }
};
struct EpiProj8 {
    static constexpr bool PERM = true;
    bf16_t* O;
    __device__ __forceinline__ void operator()(const f32x4 (&acc)[2][2][4][2], const Unit& u, int wr, int wc, int fr, int fq) const {
        const int row0 = u.pm * BM + wr * 64 + fr;
        const int tc = u.pn * BM;
        const int dc = (tc < 1024 ? COL_VA + tc : (tc < 2048 ? COL_VB + (tc - 1024) : COL_GA + (tc - 2048))) + wc * 32 + 8 * fq;
#pragma unroll
        for (int ai = 0; ai < 2; ++ai)
#pragma unroll
            for (int m = 0; m < 4; ++m) { bf16_t* rowp = O + (size_t)(row0 + ai * HALF + m * 16) * NPROJ + dc;
#pragma unroll
                for (int bj = 0; bj < 2; ++bj) { const f32x4 v0 = acc[ai][bj][m][0], v1 = acc[ai][bj][m][1];
                    u32x4 w; w.x = cvt_pk_bf16(v0[0], v0[1]); w.y = cvt_pk_bf16(v0[2], v0[3]); w.z = cvt_pk_bf16(v1[0], v1[1]); w.w = cvt_pk_bf16(v1[2], v1[3]);
                    *(u32x4*)(rowp + bj * HALF) = w; } }
    }
};
template <bool ADD> struct EpiGate {
    static constexpr bool PERM = true;
    const bf16_t* proj; int gcol; const bf16_t* Tin; void* Tout;
    __device__ __forceinline__ void operator()(const f32x4 (&acc)[2][2][4][2], const Unit& u, int wr, int wc, int fr, int fq) const {
        const int row0 = u.pm * BM + wr * 64 + fr, col0 = u.pn * BM + wc * 32 + 8 * fq;
#pragma unroll
        for (int ai = 0; ai < 2; ++ai) {
            u32x4 gb[4][2], tb[4][2];
#pragma unroll
            for (int m = 0; m < 4; ++m)
#pragma unroll
                for (int bj = 0; bj < 2; ++bj) { const size_t row = (size_t)(row0 + ai * HALF + m * 16);
                    gb[m][bj] = *(const u32x4*)(proj + row * NPROJ + gcol + col0 + bj * HALF);
                    if (ADD) tb[m][bj] = *(const u32x4*)(Tin + row * DM + col0 + bj * HALF); }
#pragma unroll
            for (int m = 0; m < 4; ++m) { const size_t row = (size_t)(row0 + ai * HALF + m * 16);
#pragma unroll
                for (int bj = 0; bj < 2; ++bj) { const f32x4 v0 = acc[ai][bj][m][0], v1 = acc[ai][bj][m][1];
                    const u32x4 g = gb[m][bj];
                    float o[8];
                    o[0] = sigmoidf_(bf_lo(g.x)) * v0[0]; o[1] = sigmoidf_(bf_hi(g.x)) * v0[1]; o[2] = sigmoidf_(bf_lo(g.y)) * v0[2]; o[3] = sigmoidf_(bf_hi(g.y)) * v0[3];
                    o[4] = sigmoidf_(bf_lo(g.z)) * v1[0]; o[5] = sigmoidf_(bf_hi(g.z)) * v1[1]; o[6] = sigmoidf_(bf_lo(g.w)) * v1[2]; o[7] = sigmoidf_(bf_hi(g.w)) * v1[3];
#if defined(DBG_NOA)
                    if (!ADD) { for (int q_ = 0; q_ < 8; ++q_) o[q_] = 0.f; }
#endif
#if defined(DBG_NOB)
                    if (ADD) { for (int q_ = 0; q_ < 8; ++q_) o[q_] = 0.f; }
#endif
                    if (ADD) { const u32x4 t = tb[m][bj];
                        o[0] += bf_lo(t.x); o[1] += bf_hi(t.x); o[2] += bf_lo(t.y); o[3] += bf_hi(t.y); o[4] += bf_lo(t.z); o[5] += bf_hi(t.z); o[6] += bf_lo(t.w); o[7] += bf_hi(t.w);
                        const float s8 = (float)(1 << M8_SCALE_LOG2);
#pragma unroll
                        for (int q_ = 0; q_ < 8; ++q_) o[q_] = fminf(fmaxf(o[q_] * s8, -440.f), 440.f);
                        u32x2 w; w.x = cvt_fp8x4_(o[0], o[1], o[2], o[3]); w.y = cvt_fp8x4_(o[4], o[5], o[6], o[7]);
                        *(u32x2*)((unsigned char*)Tout + row * DM + col0 + bj * HALF) = w;
                    } else {
                        u32x4 w; w.x = cvt_pk_bf16(o[0], o[1]); w.y = cvt_pk_bf16(o[2], o[3]); w.z = cvt_pk_bf16(o[4], o[5]); w.w = cvt_pk_bf16(o[6], o[7]);
                        *(u32x4*)((bf16_t*)Tout + row * DM + col0 + bj * HALF) = w; } } }
        }
    }
};
struct EpiRes {
    static constexpr bool PERM = true;
    const float* X; const float* g1; bf16_t* O;
    __device__ __forceinline__ void operator()(const f32x4 (&acc)[2][2][4][2], const Unit& u, int wr, int wc, int fr, int fq) const {
        const int row0 = u.pm * BM + wr * 64 + fr, col0 = u.pn * BM + wc * 32 + 8 * fq;
        f32x4 gv[2][2];
#pragma unroll
        for (int bj = 0; bj < 2; ++bj)
#pragma unroll
            for (int n = 0; n < 2; ++n) gv[bj][n] = *(const f32x4*)(g1 + col0 + bj * HALF + n * 4);
#pragma unroll
        for (int ai = 0; ai < 2; ++ai) {
            f32x4 xb[4][2][2];
#pragma unroll
            for (int m = 0; m < 4; ++m)
#pragma unroll
                for (int bj = 0; bj < 2; ++bj) { const size_t ro = (size_t)(row0 + ai * HALF + m * 16) * DM + col0;
                    xb[m][bj][0] = *(const f32x4*)(X + ro + bj * HALF); xb[m][bj][1] = *(const f32x4*)(X + ro + bj * HALF + 4); }
#pragma unroll
            for (int m = 0; m < 4; ++m) { const size_t ro = (size_t)(row0 + ai * HALF + m * 16) * DM + col0;
#pragma unroll
                for (int bj = 0; bj < 2; ++bj) {
                    const f32x4 o0 = xb[m][bj][0] + gv[bj][0] * acc[ai][bj][m][0], o1 = xb[m][bj][1] + gv[bj][1] * acc[ai][bj][m][1];
                    u32x4 w; w.x = cvt_pk_bf16(o0[0], o0[1]); w.y = cvt_pk_bf16(o0[2], o0[3]); w.z = cvt_pk_bf16(o1[0], o1[1]); w.w = cvt_pk_bf16(o1[2], o1[3]);
                    *(u32x4*)(O + ro + bj * HALF) = w; } }
        }
    }
};
struct EpiMoe1 {
    static constexpr bool PERM = false;
    unsigned char* Aout;
    __device__ __forceinline__ void operator()(const f32x4 (&acc)[2][2][4][2], const Unit& u, int wr, int wc, int fr, int fq) const {
        const int row0 = u.x0 + wr * 64 + fr; const float s8 = (float)(1 << A8_SCALE_LOG2);
#pragma unroll
        for (int ai = 0; ai < 2; ++ai)
#pragma unroll
            for (int m = 0; m < 4; ++m) { unsigned char* rowp = Aout + (size_t)(row0 + ai * HALF + m * 16) * DFF;
#pragma unroll
                for (int bj = 0; bj < 2; ++bj) { const f32x4 a1 = acc[ai][bj][m][0], a3 = acc[ai][bj][m][1]; float o[4];
#pragma unroll
                    for (int j = 0; j < 4; ++j) o[j] = fminf(fmaxf(a1[j] * sigmoidf_(a1[j]) * a3[j] * s8, -440.f), 440.f);
                    *(unsigned*)(rowp + (8 * u.pn + 4 * bj + wc) * 16 + 4 * fq) = cvt_fp8x4_(o[0], o[1], o[2], o[3]); } }
    }
};
struct EpiMoe2 {
    static constexpr bool PERM = true;
    bf16_t* Y;
    __device__ __forceinline__ void operator()(const f32x4 (&acc)[2][2][4][2], const Unit& u, int wr, int wc, int fr, int fq) const {
        const int row0 = u.x0 + wr * 64 + fr, col0 = u.pn * BM + wc * 32 + 8 * fq;
#pragma unroll
        for (int ai = 0; ai < 2; ++ai)
#pragma unroll
            for (int m = 0; m < 4; ++m) { bf16_t* rowp = Y + (size_t)(row0 + ai * HALF + m * 16) * DM + col0;
#pragma unroll
                for (int bj = 0; bj < 2; ++bj) { const f32x4 v0 = acc[ai][bj][m][0], v1 = acc[ai][bj][m][1];
                    u32x4 w; w.x = cvt_pk_bf16(v0[0], v0[1]); w.y = cvt_pk_bf16(v0[2], v0[3]); w.z = cvt_pk_bf16(v1[0], v1[1]); w.w = cvt_pk_bf16(v1[2], v1[3]);
                    *(u32x4*)(rowp + bj * HALF) = w; } }
    }
};
}
struct Args {
    const float* in[20]; float* out; unsigned char* ws; int ph_lo, ph_hi;
};
struct Frame {
    LAS unsigned char* lds; int tid, lane, wave, G, bid, vcu;
    const float *x, *c, *w_ada, *b_ada, *norm_mix, *w_in, *t5, *rel, *w_up_a, *w_up_b, *w_o, *norm_ffn, *w_rg, *b_rg, *w_re, *b_re, *w1, *w3, *w2, *norm_final;
    float* out; unsigned char* ws;
    float* mod; unsigned* ecnt;
    bf16_t *WinT, *WupaT, *WupbT, *WoT, *W13T, *W2T, *H, *PROJ, *YA, *YB, *MRG;
    unsigned char *WinT8, *H8, *W13T8, *W2T8, *Wupa8, *Wupb8, *Wo8;
    unsigned long long* MASK; int* LIST; int* TSLOT; float* TW;
    bf16_t *RBH, *RBL; float* RC;
};

__device__ __forceinline__ void p0_mod(const Frame& F) {
    LAS float* red = (LAS float*)F.lds;
    for (int b = F.bid; b < 256; b += F.G) {
        const int t = F.tid;
        f32x4 acc = {0.f, 0.f, 0.f, 0.f};
        const int c4 = t % 12, kg = t / 12;
        if (t < 480) {
            const float* wp = F.w_ada + b * 48 + c4 * 4;
            int k = kg;
            for (; k + 7 * 40 < DM; k += 8 * 40) {
                f32x4 w[8]; float sv[8];
#pragma unroll
                for (int u = 0; u < 8; ++u) { w[u] = *(const f32x4*)(wp + (size_t)(k + 40 * u) * 12288); const float cv = F.c[k + 40 * u]; sv[u] = cv * sigmoidf_(cv); }
#pragma unroll
                for (int u = 0; u < 8; ++u) acc += w[u] * sv[u];
            }
            for (; k < DM; k += 40) { const float cv = F.c[k]; const float s = cv * sigmoidf_(cv); const f32x4 w = *(const f32x4*)(wp + (size_t)k * 12288); acc += w * s; }
            *(LAS f32x4*)(red + (kg * 12 + c4) * 4) = acc;
        }
        __syncthreads();
        if (t < 12) { f32x4 sum = *(const f32x4*)(F.b_ada + b * 48 + t * 4);
            for (int g = 0; g < 40; ++g) sum += *(LAS f32x4*)(red + (g * 12 + t) * 4);
            *(f32x4*)(F.mod + b * 48 + t * 4) = sum; }
        __syncthreads();
    }
}
__device__ __forceinline__ int rowmap(int n, int mode) { return mode == 0 ? n : (32 * (n >> 4) + (n & 15) + (mode == 2 ? 16 : 0)); }
__device__ __forceinline__ unsigned cvt_fp8x4(float a, float b, float c, float d) {
    int w = 0;
    w = __builtin_amdgcn_cvt_pk_fp8_f32(a, b, w, false);
    w = __builtin_amdgcn_cvt_pk_fp8_f32(c, d, w, true);
    return (unsigned)w;
}
constexpr int TC_WIN = 32 * 178, TC_UP = 16 * 32, TC_WO = 32 * 32, TC_W1 = NEXP * 32 * 8, TC_W2 = NEXP * 8 * 32;
constexpr int TC_TOTAL = TC_WIN + 2 * TC_UP + TC_WO + 2 * TC_W1 + TC_W2;
constexpr int TC_EARLY = TC_WIN + 2 * TC_UP + TC_WO;
#ifndef TC_LATE_START
#define TC_LATE_START TC_EARLY
#endif
struct TDesc { const float* src; int N, k0, n0, ldd, mode; unsigned char* dst; };
__device__ __forceinline__ bool tconv_desc(const Frame& F, int tl, TDesc& d, int limit = TC_TOTAL) {
    if (tl >= limit) return false;
    int r = tl;
    if (r < TC_WIN) { d.src = F.w_in; d.N = NPROJ_REAL; d.k0 = (r % 32) * 64; d.n0 = (r / 32) * 64; d.dst = (unsigned char*)F.WinT; d.ldd = DM; d.mode = 3; return true; }
    r -= TC_WIN;
    if (r < TC_UP) { d.src = F.w_up_a; d.N = DM; d.k0 = (r % 16) * 64; d.n0 = (r / 16) * 64; d.dst = F.Wupa8; d.ldd = 1024; d.mode = 7; return true; }
    r -= TC_UP;
    if (r < TC_UP) { d.src = F.w_up_b; d.N = DM; d.k0 = (r % 16) * 64; d.n0 = (r / 16) * 64; d.dst = F.Wupb8; d.ldd = 1024; d.mode = 7; return true; }
    r -= TC_UP;
    if (r < TC_WO) { d.src = F.w_o; d.N = DM; d.k0 = (r % 32) * 64; d.n0 = (r / 32) * 64; d.dst = F.Wo8; d.ldd = DM; d.mode = 7; return true; }
    r -= TC_WO;
    if (r < TC_W1) { const int e = r / 256, q = r % 256; d.src = F.w1 + (size_t)e * DM * DFF; d.N = DFF; d.k0 = (q % 32) * 64; d.n0 = (q / 32) * 64; d.dst = F.W13T8 + (size_t)e * 1024 * DM; d.ldd = DM; d.mode = 4; return true; }
    r -= TC_W1;
    if (r < TC_W1) { const int e = r / 256, q = r % 256; d.src = F.w3 + (size_t)e * DM * DFF; d.N = DFF; d.k0 = (q % 32) * 64; d.n0 = (q / 32) * 64; d.dst = F.W13T8 + (size_t)e * 1024 * DM; d.ldd = DM; d.mode = 5; return true; }
    r -= TC_W1;
    { const int e = r / 256, q = r % 256; d.src = F.w2 + (size_t)e * DFF * DM; d.N = DM; d.k0 = (q % 8) * 64; d.n0 = (q / 8) * 64; d.dst = F.W2T8 + (size_t)e * DM * DFF; d.ldd = DFF; d.mode = 6; return true; }
}
__device__ __forceinline__ void tconv_load(const Frame& F, const TDesc& d, f32x4 (&v)[2]) {
    const int kk = F.tid >> 4, n4 = (F.tid & 15) * 4;
    const int nn = min(d.n0 + n4, d.N - 4);
    const float* p0 = d.src + (size_t)(d.k0 + kk) * d.N + nn; const float* p1 = p0 + (size_t)32 * d.N;
    asm volatile("global_load_dwordx4 %0, %1, off" : "=v"(v[0]) : "v"(p0) : "memory");
    asm volatile("global_load_dwordx4 %0, %1, off" : "=v"(v[1]) : "v"(p1) : "memory");
}
__device__ __forceinline__ void tconv_to_lds(const Frame& F, const f32x4 (&vin)[2], LAS float* tile  ) {
    const int t = F.tid, kk = t >> 4, n4 = (t & 15) * 4;
#pragma unroll
    for (int h = 0; h < 2; ++h) { const int k = kk + 32 * h; tile[k * 65 + n4 + 0] = vin[h][0]; tile[k * 65 + n4 + 1] = vin[h][1]; tile[k * 65 + n4 + 2] = vin[h][2]; tile[k * 65 + n4 + 3] = vin[h][3]; }
}
__device__ __forceinline__ void tconv_from_lds(const Frame& F, const TDesc& d, const LAS float* tile) {
    const int t = F.tid;
    { const int n = t >> 3, kq = (t & 7) * 8; const int k0 = d.k0, n0 = d.n0, mode = d.mode;
      if (n0 + n < d.N) {
        float v[8];
#pragma unroll
        for (int i = 0; i < 8; ++i) v[i] = tile[(kq + i) * 65 + n];
        if (mode == 3) {
            const int c = n0 + n; int rb = -1, r8 = -1;
            if (c < 2048) rb = c; else if (c < 3072) r8 = c - 2048; else if (c < 6224) rb = c - 1024; else if (c < 7248) r8 = 1024 + (c - 6224); else r8 = 2048 + (c - 7248);
            if (rb >= 0) { u32x4 w; w.x = cvt_pk_bf16(v[0], v[1]); w.y = cvt_pk_bf16(v[2], v[3]); w.z = cvt_pk_bf16(v[4], v[5]); w.w = cvt_pk_bf16(v[6], v[7]);
                *(u32x4*)(F.WinT + (size_t)rb * DM + k0 + kq) = w; }
            else { const float sc = (float)(1 << W8_SCALE_LOG2); u32x2 w; w.x = cvt_fp8x4_(v[0] * sc, v[1] * sc, v[2] * sc, v[3] * sc); w.y = cvt_fp8x4_(v[4] * sc, v[5] * sc, v[6] * sc, v[7] * sc);
                *(u32x2*)(F.WinT8 + (size_t)r8 * DM + k0 + kq) = w; }
        } else {
            const float sc = (float)(1 << (mode == 6 ? W2_SCALE_LOG2 : W8_SCALE_LOG2)); const int r = rowmap(n0 + n, mode == 4 ? 1 : (mode == 5 ? 2 : 0));
            u32x2 w; w.x = cvt_fp8x4_(v[0] * sc, v[1] * sc, v[2] * sc, v[3] * sc); w.y = cvt_fp8x4_(v[4] * sc, v[5] * sc, v[6] * sc, v[7] * sc);
            *(u32x2*)(d.dst + (size_t)r * d.ldd + k0 + kq) = w; } } }
}
__device__ __forceinline__ void tconv_store(const Frame& F, const TDesc& d, const f32x4 (&vin)[2], int ahead  ) {
    LAS float* tile = (LAS float*)F.lds;
    if (ahead >= 4) asm volatile("s_waitcnt vmcnt(8)" ::: "memory"); else if (ahead == 3) asm volatile("s_waitcnt vmcnt(6)" ::: "memory"); else if (ahead == 2) asm volatile("s_waitcnt vmcnt(4)" ::: "memory");
    else if (ahead == 1) asm volatile("s_waitcnt vmcnt(2)" ::: "memory"); else asm volatile("s_waitcnt vmcnt(0)" ::: "memory");
#ifdef DIAG_ZERO_P0_WUP
    if (d.mode == 7 && d.ldd == 1024) { const f32x4 z[2] = {(f32x4){0.f,0.f,0.f,0.f}, (f32x4){0.f,0.f,0.f,0.f}}; tconv_to_lds(F, z, tile); } else
#endif
    tconv_to_lds(F, vin, tile);
    __syncthreads();
    tconv_from_lds(F, d, tile);
    __syncthreads();
}
constexpr int CONV_LDS_OFF = 16384, CONV_LDS_BYTES = 64 * 64 * 4;
struct ConvSt { int base, cs; };
__device__ __forceinline__ LAS unsigned char* conv_buf(const Frame& F, int i) { return F.lds + CONV_LDS_OFF + (((i % 3) + 3) % 3) * CONV_LDS_BYTES; }
__device__ __forceinline__ bool conv_issue(const Frame& F, int tl, int bufi) {
    TDesc d; if (!tconv_desc(F, tl, d)) return false;
    LAS unsigned char* buf = conv_buf(F, bufi);
#pragma unroll
    for (int p = 0; p < 2; ++p) {
        const int k = p * 32 + (F.tid >> 4), c = F.tid & 15, cs = c ^ ((k >> 3) & 7);
        const float* g = d.src + (size_t)(d.k0 + k) * d.N + d.n0 + 4 * cs;
        __builtin_amdgcn_global_load_lds((const unsigned*)g, (LAS unsigned*)(buf + p * 8192 + F.wave * 1024), 16, 0, 0);
    }
    return true;
}
__device__ __forceinline__ void conv_drain(const Frame& F, int tl, int bufi) {
    TDesc d; if (tl < 0 || !tconv_desc(F, tl, d)) return;
    const LAS float* tile = (const LAS float*)conv_buf(F, bufi);
    const int t = F.tid, n = t >> 3, kq = (t & 7) * 8, f = t & 7;
    float v[8];
#pragma unroll
    for (int i = 0; i < 8; ++i) v[i] = tile[(kq + i) * 64 + (((n >> 2) ^ f) << 2) + (n & 3)];
    const int mode = d.mode;
    const float sc = (float)(1 << (mode == 6 ? W2_SCALE_LOG2 : W8_SCALE_LOG2)); const int r = rowmap(d.n0 + n, mode == 4 ? 1 : (mode == 5 ? 2 : 0));
    u32x2 w; w.x = cvt_fp8x4_(v[0] * sc, v[1] * sc, v[2] * sc, v[3] * sc); w.y = cvt_fp8x4_(v[4] * sc, v[5] * sc, v[6] * sc, v[7] * sc);
    *(u32x2*)(d.dst + (size_t)r * d.ldd + d.k0 + kq) = w;
}
__device__ __forceinline__ void p0_convert(const Frame& F) {
    TDesc d0, d1, d2, d3, d4; f32x4 v0[2], v1[2], v2[2], v3[2], v4[2];
    int tl = F.bid; const int G = F.G;
    bool h0 = tconv_desc(F, tl, d0, TC_EARLY); if (h0) tconv_load(F, d0, v0);
    bool h1 = tconv_desc(F, tl + G, d1, TC_EARLY); if (h1) tconv_load(F, d1, v1);
    bool h2 = tconv_desc(F, tl + 2 * G, d2, TC_EARLY); if (h2) tconv_load(F, d2, v2);
    bool h3 = tconv_desc(F, tl + 3 * G, d3, TC_EARLY); if (h3) tconv_load(F, d3, v3);
    bool h4 = false;
#define TC_STEP(HX, DX, VX, HN, DN, VN, K, A1, A2, A3) \
        if (!HX) break; \
        HN = tconv_desc(F, tl + (K) * G, DN, TC_EARLY); if (HN) tconv_load(F, DN, VN); \
        tconv_store(F, DX, VX, (A1 ? 1 : 0) + (A2 ? 1 : 0) + (A3 ? 1 : 0) + (HN ? 1 : 0));
    for (;;) {
        TC_STEP(h0, d0, v0, h4, d4, v4, 4, h1, h2, h3)
        TC_STEP(h1, d1, v1, h0, d0, v0, 5, h2, h3, h4)
        TC_STEP(h2, d2, v2, h1, d1, v1, 6, h3, h4, h0)
        TC_STEP(h3, d3, v3, h2, d2, v2, 7, h4, h0, h1)
        TC_STEP(h4, d4, v4, h3, d3, v3, 8, h0, h1, h2)
        tl += 5 * G;
    }
#undef TC_STEP
    asm volatile("s_waitcnt vmcnt(0)" ::: "memory");
    { u32x4* z = (u32x4*)(F.WinT + (size_t)NPB_REAL * DM); const int n16 = (NPB - NPB_REAL) * DM * 2 / 16;
      for (int i = F.bid * 512 + F.tid; i < n16; i += F.G * 512) z[i] = (u32x4){0u, 0u, 0u, 0u}; }
}

__device__ __forceinline__ void p1_router_prep(const Frame& F) {
    const float* sh2 = F.mod + 3 * DM; const float* sc2 = F.mod + 4 * DM;
    LAS float* red = (LAS float*)F.lds;
    for (int col = F.bid; col < 96; col += F.G) {
        const int k = F.tid * 4;
        const f32x4 ga = *(const f32x4*)(F.norm_ffn + k) * (*(const f32x4*)(sc2 + k) + 1.0f), gb = *(const f32x4*)(sh2 + k);
        float w[4], gbw = 0.f;
#pragma unroll
        for (int j = 0; j < 4; ++j) { const float wv = col < 8 ? F.w_rg[(size_t)(k + j) * 8 + col] : (col < 72 ? F.w_re[(size_t)(k + j) * 64 + (col - 8)] : 0.f); gbw += gb[j] * wv; w[j] = wv * ga[j]; }
        u32x2 h, l;
        h.x = cvt_pk_bf16(w[0], w[1]); h.y = cvt_pk_bf16(w[2], w[3]);
        l.x = cvt_pk_bf16(w[0] - bf_lo(h.x), w[1] - bf_hi(h.x)); l.y = cvt_pk_bf16(w[2] - bf_lo(h.y), w[3] - bf_hi(h.y));
        *(u32x2*)(F.RBH + (size_t)col * DM + k) = h; *(u32x2*)(F.RBL + (size_t)col * DM + k) = l;
        gbw = wave_sum(gbw);
        if (F.lane == 0) red[F.wave] = gbw;
        __syncthreads();
        if (F.tid == 0) { float s = 0.f; for (int i = 0; i < 8; ++i) s += red[i]; F.RC[col] = s; }
        __syncthreads();
    }
}

__device__ __forceinline__ void p1_norm(const Frame& F) {
    const float* sh1 = F.mod; const float* sc1 = F.mod + DM;
    f32x4 ga[8], gb[8];
#pragma unroll
    for (int j = 0; j < 8; ++j) { const int c = 4 * F.lane + 256 * j; const f32x4 nm = *(const f32x4*)(F.norm_mix + c), sc = *(const f32x4*)(sc1 + c); ga[j] = nm * (sc + 1.0f); gb[j] = *(const f32x4*)(sh1 + c); }
    const int rstep = F.G * 8; int row = F.bid * 8 + F.wave;
    f32x4 v[8], vn[8];
    if (row < SEQ) {
#pragma unroll
        for (int j = 0; j < 8; ++j) v[j] = *(const f32x4*)(F.x + (size_t)row * DM + 4 * F.lane + 256 * j);
    }
    for (; row < SEQ; row += rstep) {
        const int nrow = row + rstep;
        if (nrow < SEQ) {
#pragma unroll
            for (int j = 0; j < 8; ++j) vn[j] = *(const f32x4*)(F.x + (size_t)nrow * DM + 4 * F.lane + 256 * j);
        }
        float ss = 0.f;
#pragma unroll
        for (int j = 0; j < 8; ++j) ss += v[j][0] * v[j][0] + v[j][1] * v[j][1] + v[j][2] * v[j][2] + v[j][3] * v[j][3];
        ss = wave_sum(ss);
        const float rstd = __builtin_amdgcn_rsqf(ss * (1.0f / DM) + EPS);
        bf16_t* hp = F.H + (size_t)row * DM + 4 * F.lane; unsigned char* h8 = F.H8 + (size_t)row * DM + 4 * F.lane;
        const float s8 = (float)(1 << H8_SCALE_LOG2);
#pragma unroll
        for (int j = 0; j < 8; ++j) { const f32x4 o = v[j] * rstd * ga[j] + gb[j]; u32x2 w; w.x = cvt_pk_bf16(o[0], o[1]); w.y = cvt_pk_bf16(o[2], o[3]); *(u32x2*)(hp + 256 * j) = w;
            const f32x4 c8 = __builtin_elementwise_min(__builtin_elementwise_max(o * s8, (f32x4){-440.f, -440.f, -440.f, -440.f}), (f32x4){440.f, 440.f, 440.f, 440.f});
            *(unsigned*)(h8 + 256 * j) = cvt_fp8x4_(c8[0], c8[1], c8[2], c8[3]); }
#pragma unroll
        for (int j = 0; j < 8; ++j) v[j] = vn[j];
    }
}

constexpr int P8_RSTD = 0, P8_LOG = 1024, P8_AS = 32768, P8_AS_STRIDE = 32 * 65 * 4 + 128;
__device__ __forceinline__ void p8_router(const Frame& F) {
    const float* sh2 = F.mod + 3 * DM; const float* sc2 = F.mod + 4 * DM;
    const bf16_t* X1 = F.H;
    LAS float* rs = (LAS float*)(F.lds + P8_RSTD);
    LAS float* lg = (LAS float*)(F.lds + P8_LOG);
    for (int blk = F.bid; blk < SEQ / 64; blk += F.G) {
        const int T0 = blk * 64;
        {
            int l4 = 4 * F.lane; asm volatile("" : "+v"(l4));
            f32x4 ga[8], gb[8];
#pragma unroll
            for (int j = 0; j < 8; ++j) { const int c = l4 + 256 * j; const f32x4 nm = *(const f32x4*)(F.norm_ffn + c), sc = *(const f32x4*)(sc2 + c); ga[j] = nm * (sc + 1.0f); gb[j] = *(const f32x4*)(sh2 + c); }
            for (int r = F.wave; r < 64; r += 8) {
                const bf16_t* xp = X1 + (size_t)(T0 + r) * DM + l4;
                f32x4 v[8]; float ss = 0.f;
#pragma unroll
                for (int j = 0; j < 8; ++j) { const u32x2 w = *(const u32x2*)(xp + 256 * j); v[j] = (f32x4){bf_lo(w.x), bf_hi(w.x), bf_lo(w.y), bf_hi(w.y)}; }
#pragma unroll
                for (int j = 0; j < 8; ++j) ss += v[j][0] * v[j][0] + v[j][1] * v[j][1] + v[j][2] * v[j][2] + v[j][3] * v[j][3];
                ss = wave_sum(ss);
                const float rstd = __builtin_amdgcn_rsqf(ss * (1.0f / DM) + EPS);
                if (F.lane == 0) rs[r] = rstd;
                unsigned char* hp = F.H8 + (size_t)(T0 + r) * DM + l4; const float s8 = (float)(1 << H8_SCALE_LOG2);
#pragma unroll
                for (int j = 0; j < 8; ++j) { const f32x4 o = v[j] * rstd * ga[j] + gb[j];
                    const f32x4 c8 = __builtin_elementwise_min(__builtin_elementwise_max(o * s8, (f32x4){-440.f, -440.f, -440.f, -440.f}), (f32x4){440.f, 440.f, 440.f, 440.f});
                    *(unsigned*)(hp + 256 * j) = cvt_fp8x4_(c8[0], c8[1], c8[2], c8[3]); }
            }
        }
        __syncthreads();
        f32x16 acc[2][3];
#pragma unroll
        for (int a = 0; a < 2; ++a)
#pragma unroll
            for (int b = 0; b < 3; ++b)
#pragma unroll
                for (int i = 0; i < 16; ++i) acc[a][b][i] = 0.f;
        {
            const int mi = F.lane & 31, mk = F.lane >> 5;
            unsigned kl = (unsigned)(F.wave * 256 + 8 * mk + mi * DM) * 2u; asm volatile("" : "+v"(kl));
            const char* xap = (const char*)(X1 + (size_t)T0 * DM); const char* bhp = (const char*)F.RBH; const char* blp = (const char*)F.RBL;
            u32x4 xa, xb, bh[3], bl[3], xan, xbn, bhn[3], bln[3];
#define P8_LOAD(ks, XA, XB, BH, BL) { const unsigned o = kl + (ks) * 32; \
                XA = *(const u32x4*)(xap + o); XB = *(const u32x4*)(xap + o + 32 * DM * 2); \
                _Pragma("unroll") for (int nt = 0; nt < 3; ++nt) { BH[nt] = *(const u32x4*)(bhp + o + nt * 32 * DM * 2); BL[nt] = *(const u32x4*)(blp + o + nt * 32 * DM * 2); } }
            P8_LOAD(0, xa, xb, bh, bl)
#pragma unroll 2
            for (int ks = 0; ks < 16; ++ks) {
                if (ks + 1 < 16) P8_LOAD(ks + 1, xan, xbn, bhn, bln)
                const bf16x8 a0 = __builtin_bit_cast(bf16x8, xa), a1 = __builtin_bit_cast(bf16x8, xb);
#pragma unroll
                for (int nt = 0; nt < 3; ++nt) { const bf16x8 h_ = __builtin_bit_cast(bf16x8, bh[nt]), l_ = __builtin_bit_cast(bf16x8, bl[nt]);
                    acc[0][nt] = __builtin_amdgcn_mfma_f32_32x32x16_bf16(a0, l_, acc[0][nt], 0, 0, 0); acc[1][nt] = __builtin_amdgcn_mfma_f32_32x32x16_bf16(a1, l_, acc[1][nt], 0, 0, 0);
                    acc[0][nt] = __builtin_amdgcn_mfma_f32_32x32x16_bf16(a0, h_, acc[0][nt], 0, 0, 0); acc[1][nt] = __builtin_amdgcn_mfma_f32_32x32x16_bf16(a1, h_, acc[1][nt], 0, 0, 0); }
                xa = xan; xb = xbn;
#pragma unroll
                for (int nt = 0; nt < 3; ++nt) { bh[nt] = bhn[nt]; bl[nt] = bln[nt]; }
            }
#undef P8_LOAD
        }
        for (int w = 0; w < 8; ++w) {
            if (F.wave == w) {
                const int col = F.lane & 31, hi = F.lane >> 5;
#pragma unroll
                for (int mt = 0; mt < 2; ++mt)
#pragma unroll
                    for (int nt = 0; nt < 3; ++nt)
#pragma unroll
                        for (int r = 0; r < 16; ++r) { const int tok = 32 * mt + (r & 3) + 8 * (r >> 2) + 4 * hi; LAS float* p = lg + tok * 96 + 32 * nt + col;
                            if (w == 0) *p = acc[mt][nt][r]; else *p += acc[mt][nt][r]; }
            }
            __syncthreads();
        }
        if (F.tid < 64) {
            const int tok = F.tid, T = T0 + tok; const LAS float* Lr = lg + tok * 96; const float* Lc = F.RC; const float rsv = rs[tok];
#define L(i_) (rsv * Lr[i_] + Lc[i_])
            float g[8]; float gmax = -3.4e38f; int grp = 0;
#pragma unroll
            for (int i = 0; i < 8; ++i) { g[i] = L(i) + F.b_rg[i]; if (g[i] > gmax) { gmax = g[i]; grp = i; } }
            float den = 0.f;
#pragma unroll
            for (int i = 0; i < 8; ++i) den += __expf(g[i] - gmax);
            const float pgrp = 1.0f / den;
            float v0 = -3.4e38f, v1 = -3.4e38f; int i0 = 0, i1 = 0;
#pragma unroll
            for (int i = 0; i < 8; ++i) { float e = 0.f;
#pragma unroll
                for (int gsel = 0; gsel < 8; ++gsel) { const float cand = L(8 + gsel * 8 + i) + F.b_re[gsel * 8 + i]; e = (grp == gsel) ? cand : e; }
                if (e > v0) { v1 = v0; i1 = i0; v0 = e; i0 = i; } else if (e > v1) { v1 = e; i1 = i; } }
            const float ex = __expf(v1 - v0); const float p0 = 1.0f / (1.0f + ex), p1 = ex / (1.0f + ex);
            const int e0 = grp * 8 + i0, e1 = grp * 8 + i1;
            const unsigned pos0 = atomicAdd(F.ecnt + 16 * e0, 1u), pos1 = atomicAdd(F.ecnt + 16 * e1, 1u);
            F.LIST[(size_t)e0 * LIST_CAP + pos0] = T; F.LIST[(size_t)e1 * LIST_CAP + pos1] = T;
            F.TSLOT[2 * T + 0] = (e0 << 16) | (int)pos0; F.TSLOT[2 * T + 1] = (e1 << 16) | (int)pos1;
            F.TW[2 * T + 0] = pgrp * p0; F.TW[2 * T + 1] = pgrp * p1;
#undef L
        }
        __syncthreads();
    }
}

constexpr int MOE_TS = 131072, MOE_CNT = 131072 + 512, MOE_TOK = 131072 + 1024;
__device__ __forceinline__ void moe_tables(const Frame& F) {
    LAS int* ts = (LAS int*)(F.lds + MOE_TS); LAS int* cn = (LAS int*)(F.lds + MOE_CNT);
    if (F.tid < 64) cn[F.tid] = (int)__hip_atomic_load(F.ecnt + 16 * F.tid, __ATOMIC_RELAXED, __HIP_MEMORY_SCOPE_AGENT);
    __syncthreads();
    if (F.tid == 0) { int s = 0; for (int e = 0; e < 64; ++e) { ts[e] = s; s += (cn[e] + 255) >> 8; } ts[64] = s; }
    __syncthreads();
}
__device__ __forceinline__ int moe_find(const LAS int* ts, int T) {
    int lo = 0, hi = 64;
    while (hi - lo > 1) { const int mid = (lo + hi) >> 1; if (ts[mid] <= T) lo = mid; else hi = mid; }
    return lo;
}
struct MoeOrder1 {
    const Frame* F; const LAS int* ts; const LAS int* tokl;
    __device__ __forceinline__ bool next(int i, pg8::Unit& u) const {
        const int uu = i * F->G + F->vcu, T = uu >> 2; if (T >= ts[64]) return false;
        const int e = moe_find(ts, T);
        u.pm = T; u.pn = uu & 3; u.A = (const char*)F->H8; u.B = (const char*)(F->W13T8 + (size_t)e * 1024 * DM + (size_t)u.pn * 256 * DM); u.x0 = T * 256; u.x1 = i; return true;
    }
    __device__ __forceinline__ int arow(const pg8::Unit& u, int r) const { return tokl[u.x1 * 256 + r]; }
};
struct MoeOrder2 {
    const Frame* F; const LAS int* ts;
    __device__ __forceinline__ bool next(int i, pg8::Unit& u) const {
        const int uu = i * F->G + F->vcu, T = uu >> 3; if (T >= ts[64]) return false;
        const int e = moe_find(ts, T);
        u.pm = T; u.pn = uu & 7; u.A = (const char*)F->MRG + (size_t)T * 256 * DFF; u.B = (const char*)(F->W2T8 + (size_t)e * DM * DFF + (size_t)u.pn * 256 * DFF); u.x0 = T * 256; u.x1 = 0; return true;
    }
    __device__ __forceinline__ int arow(const pg8::Unit&, int r) const { return r; }
};
__device__ __forceinline__ void moe1_fill_lists(const Frame& F) {
    const LAS int* ts = (const LAS int*)(F.lds + MOE_TS); const LAS int* cn = (const LAS int*)(F.lds + MOE_CNT); LAS int* tokl = (LAS int*)(F.lds + MOE_TOK);
    for (int i = 0; i < 8; ++i) {
        const int uu = i * F.G + F.vcu, T = uu >> 2; if (T >= ts[64]) break;
        const int e = moe_find(ts, T), mt = T - ts[e];
        if (F.tid < 256) { const int pos = mt * 256 + F.tid; tokl[i * 256 + F.tid] = pos < cn[e] ? F.LIST[(size_t)e * LIST_CAP + pos] : 0; }
    }
    __syncthreads();
}

__device__ __forceinline__ void p11_final(const Frame& F) {
    const LAS int* ts = (const LAS int*)(F.lds + MOE_TS);
    const float* g2 = F.mod + 5 * DM; const bf16_t* Y = F.PROJ;
    f32x4 gg[8], nf[8];
#pragma unroll
    for (int j = 0; j < 8; ++j) { const int c = 4 * F.lane + 256 * j; gg[j] = *(const f32x4*)(g2 + c); nf[j] = *(const f32x4*)(F.norm_final + c); }
    const int rstep = F.G * 8; int row = F.bid * 8 + F.wave;
    u32x2 xw[8], ya[8], yb[8], xwn[8], yan[8], ybn[8]; float w0 = 0.f, w1 = 0.f, w0n = 0.f, w1n = 0.f;
#define P11_LOAD(R, XW, YA, YB, W0, W1) do { const int s0_ = F.TSLOT[2 * (R)], s1_ = F.TSLOT[2 * (R) + 1]; W0 = F.TW[2 * (R)]; W1 = F.TW[2 * (R) + 1]; \
        const size_t r0_ = (size_t)ts[s0_ >> 16] * 256 + (s0_ & 0xffff), r1_ = (size_t)ts[s1_ >> 16] * 256 + (s1_ & 0xffff); \
        const bf16_t* x1p_ = F.H + (size_t)(R) * DM + 4 * F.lane; const bf16_t* y0_ = Y + r0_ * DM + 4 * F.lane; const bf16_t* y1_ = Y + r1_ * DM + 4 * F.lane; \
        _Pragma("unroll") for (int j = 0; j < 8; ++j) { XW[j] = *(const u32x2*)(x1p_ + 256 * j); YA[j] = *(const u32x2*)(y0_ + 256 * j); YB[j] = *(const u32x2*)(y1_ + 256 * j); } } while (0)
    if (row < SEQ) P11_LOAD(row, xw, ya, yb, w0, w1);
    for (; row < SEQ; row += rstep) {
        const int nrow = row + rstep;
        if (nrow < SEQ) P11_LOAD(nrow, xwn, yan, ybn, w0n, w1n);
        float* xp = F.out + (size_t)row * DM + 4 * F.lane;
        f32x4 v[8]; float ss = 0.f;
#pragma unroll
        for (int j = 0; j < 8; ++j) { const f32x4 xv = {bf_lo(xw[j].x), bf_hi(xw[j].x), bf_lo(xw[j].y), bf_hi(xw[j].y)}; const u32x2 a = ya[j], b = yb[j];
            f32x4 m; m[0] = w0 * bf_lo(a.x) + w1 * bf_lo(b.x); m[1] = w0 * bf_hi(a.x) + w1 * bf_hi(b.x); m[2] = w0 * bf_lo(a.y) + w1 * bf_lo(b.y); m[3] = w0 * bf_hi(a.y) + w1 * bf_hi(b.y);
#if defined(DBG_NOMOE)
            m = (f32x4){0.f, 0.f, 0.f, 0.f};
#endif
            v[j] = xv + gg[j] * m; }
#pragma unroll
        for (int j = 0; j < 8; ++j) ss += v[j][0] * v[j][0] + v[j][1] * v[j][1] + v[j][2] * v[j][2] + v[j][3] * v[j][3];
        ss = wave_sum(ss);
        const float rstd = __builtin_amdgcn_rsqf(ss * (1.0f / DM) + EPS);
#pragma unroll
        for (int j = 0; j < 8; ++j) *(f32x4*)(xp + 256 * j) = v[j] * rstd * nf[j];
#pragma unroll
        for (int j = 0; j < 8; ++j) { xw[j] = xwn[j]; ya[j] = yan[j]; yb[j] = ybn[j]; }
        w0 = w0n; w1 = w1n;
    }
#undef P11_LOAD
}
namespace att {
constexpr int D = 128, NW = 8, QBLK = 32, KVBLK = 64;
constexpr float SCALE = 0.088388347648318440f;
constexpr float THR = 8.f;
constexpr int LDP = NPROJ;
constexpr int LDO = 1024;
constexpr int SHM_V = KVBLK * D * 2, SHM_K = KVBLK * D * 2;
constexpr int OFF_WS = 2 * SHM_V + 2 * SHM_K, OFF_TAB = OFF_WS + NW * 64 * 4;
constexpr int DLO = -63;
#define KSWZ(row, colB) ((row) * 256 + ((colB) ^ (((row) & 7) << 4)))
#define SBAR() __builtin_amdgcn_sched_barrier(0)
__device__ __forceinline__ int crow(int r, int hi) { return (r & 3) + 8 * (r >> 2) + 4 * hi; }

__device__ __forceinline__ void partialSM(f32x16& p0, f32x16& p1, float& m_reg, float& mn, float& alpha) {
  constexpr float C = SCALE * 1.4426950408889634f;
  float pmax = p0[0];
#pragma unroll
  for (int r = 1; r < 16; ++r) pmax = fmaxf(pmax, p0[r]);
#pragma unroll
  for (int r = 0; r < 16; ++r) pmax = fmaxf(pmax, p1[r]);
  { auto rr = __builtin_amdgcn_permlane32_swap(__float_as_uint(pmax), __float_as_uint(pmax), false, false);
    pmax = fmaxf(__uint_as_float(rr[0]), __uint_as_float(rr[1])); }
  if (__builtin_expect(__all(pmax - m_reg <= THR / SCALE), 1)) { mn = m_reg; alpha = 1.f; }
  else { mn = fmaxf(m_reg, pmax); alpha = __builtin_amdgcn_exp2f((m_reg - mn) * C); m_reg = mn; }
  float mnC = -mn * C;
#pragma unroll
  for (int r = 0; r < 16; ++r) p0[r] = fmaf(p0[r], C, mnC);
#pragma unroll
  for (int r = 0; r < 16; ++r) p1[r] = fmaf(p1[r], C, mnC);
#pragma unroll
  for (int r = 0; r < 16; ++r) p0[r] = __builtin_amdgcn_exp2f(p0[r]);
}
template <int MODE>
__device__ __forceinline__ void finishSM(f32x16& p0, f32x16& p1, float alpha, float& l_reg, bf16x8& pa0, bf16x8& pa1, bf16x8& pa2, bf16x8& pa3) {
#pragma unroll
  for (int r = 0; r < 16; ++r) p1[r] = __builtin_amdgcn_exp2f(p1[r]);
  float ps = 0;
#pragma unroll
  for (int r = 0; r < 16; ++r) ps += p0[r];
#pragma unroll
  for (int r = 0; r < 16; ++r) ps += p1[r];
  { auto rr = __builtin_amdgcn_permlane32_swap(__float_as_uint(ps), __float_as_uint(ps), false, false);
    ps = __uint_as_float(rr[0]) + __uint_as_float(rr[1]); }
  l_reg = l_reg * alpha + ps;
#define PK4(P, BASE, OUT) do { unsigned a0 = cvt_pk_bf16(P[BASE + 0], P[BASE + 1]), a1 = cvt_pk_bf16(P[BASE + 2], P[BASE + 3]);   \
    unsigned b0 = cvt_pk_bf16(P[BASE + 4], P[BASE + 5]), b1 = cvt_pk_bf16(P[BASE + 6], P[BASE + 7]);                              \
    auto r0 = __builtin_amdgcn_permlane32_swap(a0, b0, false, false); auto r1 = __builtin_amdgcn_permlane32_swap(a1, b1, false, false); \
    u32x4 w = {r0[0], r1[0], r0[1], r1[1]}; OUT = *reinterpret_cast<bf16x8*>(&w); } while (0)
  PK4(p0, 0, pa0); PK4(p0, 8, pa1); PK4(p1, 0, pa2); PK4(p1, 8, pa3);
#undef PK4
}
__device__ __forceinline__ void qkt(f32x16& p0, f32x16& p1, const LAS char* Ks, const bf16x8* qr, int r32, int hi) {
#pragma unroll
  for (int i = 0; i < 16; ++i) { p0[i] = 0.f; p1[i] = 0.f; }
#pragma unroll
  for (int d0 = 0; d0 < 8; ++d0) { int cb = (d0 * 16 + hi * 8) * 2;
    bf16x8 b0 = *reinterpret_cast<const LAS bf16x8*>(Ks + KSWZ(r32, cb));
    bf16x8 b1 = *reinterpret_cast<const LAS bf16x8*>(Ks + KSWZ(32 + r32, cb));
    p0 = __builtin_amdgcn_mfma_f32_32x32x16_bf16(b0, qr[d0], p0, 0, 0, 0);
    p1 = __builtin_amdgcn_mfma_f32_32x32x16_bf16(b1, qr[d0], p1, 0, 0, 0); }
}
__device__ __forceinline__ int v_st(int k, int c) { const int kk = (k & ~0xC) | ((k & 4) << 1) | ((k & 8) >> 1); return ((kk >> 3) * 4 + (c >> 5)) * 512 + ((kk & 7) * 32 + (c & 31)) * 2; }
__device__ __forceinline__ int v_rd_base(int lane) { return ((lane & 3) << 3) | (((lane >> 2) & 3) << 6) | (((lane >> 4) & 1) << 5) | (((lane >> 5) & 1) << 8); }
constexpr int v_rd_off(int d0, int ks, int half) { return d0 * 512 + ks * 4096 + half * 2048; }
template <int OFF> __device__ __forceinline__ s16x4 tr_read(int vb) {
  s16x4 r; asm volatile("ds_read_b64_tr_b16 %0, %1 offset:%2" : "=&v"(r) : "v"(vb), "i"(OFF) : "memory"); return r;
}
template <int D0> __device__ __forceinline__ void pv_one(f32x16& od, int vb, bf16x8 pa0, bf16x8 pa1, bf16x8 pa2, bf16x8 pa3) {
  const s16x4 l0 = tr_read<v_rd_off(D0, 0, 0)>(vb), h0 = tr_read<v_rd_off(D0, 0, 1)>(vb), l1 = tr_read<v_rd_off(D0, 1, 0)>(vb), h1 = tr_read<v_rd_off(D0, 1, 1)>(vb);
  const s16x4 l2 = tr_read<v_rd_off(D0, 2, 0)>(vb), h2 = tr_read<v_rd_off(D0, 2, 1)>(vb), l3 = tr_read<v_rd_off(D0, 3, 0)>(vb), h3 = tr_read<v_rd_off(D0, 3, 1)>(vb);
  asm volatile("s_waitcnt lgkmcnt(0)" ::: "memory"); SBAR();
#define PK(L, H) (bf16x8){L[0], L[1], L[2], L[3], H[0], H[1], H[2], H[3]}
  od = __builtin_amdgcn_mfma_f32_32x32x16_bf16(pa0, PK(l0, h0), od, 0, 0, 0);
  od = __builtin_amdgcn_mfma_f32_32x32x16_bf16(pa1, PK(l1, h1), od, 0, 0, 0);
  od = __builtin_amdgcn_mfma_f32_32x32x16_bf16(pa2, PK(l2, h2), od, 0, 0, 0);
  od = __builtin_amdgcn_mfma_f32_32x32x16_bf16(pa3, PK(l3, h3), od, 0, 0, 0);
#undef PK
}
__device__ __forceinline__ void pv_d0(f32x16* o, int vb, bf16x8 pa0, bf16x8 pa1, bf16x8 pa2, bf16x8 pa3) {
  pv_one<0>(o[0], vb, pa0, pa1, pa2, pa3); pv_one<1>(o[1], vb, pa0, pa1, pa2, pa3); pv_one<2>(o[2], vb, pa0, pa1, pa2, pa3); pv_one<3>(o[3], vb, pa0, pa1, pa2, pa3);
}

template <int MODE, int DMAX>
__device__ __forceinline__ void score_hook(f32x16& p0, f32x16& p1, int kt, int tq  , int tq_wave0  , int hi, const LAS float* tab, unsigned long long msk) {
  if (MODE == 1) {
    const int cw = tq_wave0 >> 6;
    if (kt > cw || kt < cw - 8) {
#pragma unroll
      for (int r = 0; r < 16; ++r) { p0[r] = -3.0e38f; p1[r] = -3.0e38f; }
      return;
    }
  }
#ifndef ATT_NOHOOK
  if (tq_wave0 - (kt * 64 + 63) < DMAX) {
    const int base = tq - kt * 64 - 4 * hi - DLO;
#pragma unroll
    for (int r = 0; r < 16; ++r) {
      const int c = (r & 3) + 8 * (r >> 2);
      int i0 = base - c, i1 = base - c - 32;
      i0 = min(max(i0, 0), DMAX - DLO); i1 = min(max(i1, 0), DMAX - DLO);
      p0[r] += tab[i0]; p1[r] += tab[i1];
      SBAR();
    }
  }
#endif
  if (MODE == 0) {
    const unsigned mk0 = (unsigned)msk >> (16 * hi), mk1 = (unsigned)(msk >> 32) >> (16 * hi);
#pragma unroll
    for (int r = 0; r < 16; ++r) {
      { const unsigned m_ = (unsigned)__builtin_amdgcn_sbfe(mk0, r, 1); p0[r] = __uint_as_float((m_ & __float_as_uint(p0[r])) | (~m_ & 0xFF61B1E6u)); }
      { const unsigned m_ = (unsigned)__builtin_amdgcn_sbfe(mk1, r, 1); p1[r] = __uint_as_float((m_ & __float_as_uint(p1[r])) | (~m_ & 0xFF61B1E6u)); }
    }
  }
}

__device__ __forceinline__ unsigned long long mload_(const char* base, unsigned off) { asm volatile("" : "+v"(off)); return *(const unsigned long long*)(base + off); }
template <int MODE, int DMAX>
__device__ __forceinline__ void attn_unit(const bf16_t* __restrict__ Qb  , const bf16_t* __restrict__ Kh  , const bf16_t* __restrict__ Vh,
                                          unsigned char* __restrict__ Ob  , const unsigned long long* __restrict__ maskq  , int q0, int kt0, int kt1, LAS char* lds) {
  const int tid = threadIdx.x, wid = tid >> 6, lane = tid & 63, r32 = lane & 31, hi = lane >> 5;
  LAS char* V_lds = lds; LAS char* K_lds = lds + 2 * SHM_V;
  LAS float* ws = (LAS float*)(lds + OFF_WS) + wid * 64; LAS float* li_l = ws; LAS float* al_l = ws + 32;
  const LAS float* tab = (const LAS float*)(lds + OFF_TAB);
  float m_reg = -1e30f, l_reg = 0; f32x16 o[4]; bf16x8 qr[8];
#pragma unroll
  for (int d = 0; d < 4; ++d)
#pragma unroll
    for (int r = 0; r < 16; ++r) o[d][r] = 0.f;
  const bf16_t* Qw = Qb + (long)(wid * QBLK + r32) * LDP + hi * 8;
#pragma unroll
  for (int d0 = 0; d0 < 8; ++d0) qr[d0] = *reinterpret_cast<const bf16x8*>(Qw + d0 * 16);
  const int tq0w = q0 + wid * QBLK, tq = tq0w + r32;
  const int sr = tid >> 4, sc = (tid & 15) * 8, vst0 = v_st(sr, sc), vst1 = v_st(32 + sr, sc);
  const int vb0 = (int)(uintptr_t)V_lds + v_rd_base(lane);
  const char* Kc = (const char*)Kh; const char* Vc = (const char*)Vh; const unsigned soff = (unsigned)(sr * LDP + sc) * 2u;
  const unsigned moff = (unsigned)(__builtin_amdgcn_readfirstlane(wid) * QBLK + r32) * 8u;
  struct { bf16x8 vs0, vs1, ks0, ks1; } sr_[1];
#define SLOAD(i, k0) do { unsigned _so = soff; asm volatile("" : "+v"(_so)); unsigned _so2 = soff; asm volatile("" : "+v"(_so2)); \
    const char* _kp = Kc + (size_t)(unsigned)(k0) * (size_t)(LDP * 2); const char* _vp = Vc + (size_t)(unsigned)(k0) * (size_t)(LDP * 2); \
    const char* _kp2 = _kp + (32 * LDP * 2); const char* _vp2 = _vp + (32 * LDP * 2); \
    sr_[i].vs0 = *reinterpret_cast<const bf16x8*>(_vp + _so); sr_[i].vs1 = *reinterpret_cast<const bf16x8*>(_vp2 + _so2); \
    sr_[i].ks0 = *reinterpret_cast<const bf16x8*>(_kp + _so); sr_[i].ks1 = *reinterpret_cast<const bf16x8*>(_kp2 + _so2); } while (0)
#define SWRITE(b, i) do { *(LAS bf16x8*)(V_lds + (b) * SHM_V + vst0) = sr_[i].vs0;          \
    *(LAS bf16x8*)(V_lds + (b) * SHM_V + vst1) = sr_[i].vs1; int kc = sc * 2;               \
    *(LAS bf16x8*)(K_lds + (b) * SHM_K + KSWZ(sr, kc)) = sr_[i].ks0;                       \
    *(LAS bf16x8*)(K_lds + (b) * SHM_K + KSWZ(32 + sr, kc)) = sr_[i].ks1; } while (0)
#define SWAIT() asm volatile("s_waitcnt vmcnt(0)" ::: "memory")
#define RESC(a) do { if (__any((a) < 1.f)) { if (hi == 0) al_l[r32] = (a); asm volatile("s_waitcnt lgkmcnt(0)" ::: "memory"); \
    _Pragma("unroll") for (int d = 0; d < 4; ++d) _Pragma("unroll") for (int r = 0; r < 16; ++r) o[d][r] *= al_l[crow(r, hi)]; } } while (0)
#define MLOAD(kt) (MODE == 0 ? mload_((const char*)maskq + (size_t)(unsigned)(kt) * (size_t)(SEQ * 8), moff) : 0ull)
  f32x16 pA0, pA1, pB0, pB1; float mnA, mnB, alA, alB; bf16x8 pa0, pa1, pa2, pa3; const int NT = kt1 - kt0;
  unsigned long long mA = 0, mB = 0;
  constexpr int SE = 0, SO = 0;
  SLOAD(SE, kt0 * KVBLK); mA = MLOAD(kt0); asm volatile("s_waitcnt vmcnt(0)" ::: "memory"); SWRITE(0, SE); __syncthreads();
  qkt(pA0, pA1, K_lds, qr, r32, hi); score_hook<MODE, DMAX>(pA0, pA1, kt0, tq, tq0w, hi, tab, mA); partialSM(pA0, pA1, m_reg, mnA, alA);
  SLOAD(SO, (kt0 + 1) * KVBLK);
  SWAIT(); SWRITE(1, SO); __syncthreads();
  for (int j = 1; j + 1 < NT; j += 2) {
    SBAR(); mB = MLOAD(kt0 + j); qkt(pB0, pB1, K_lds + SHM_K, qr, r32, hi); score_hook<MODE, DMAX>(pB0, pB1, kt0 + j, tq, tq0w, hi, tab, mB);
    finishSM<MODE>(pA0, pA1, alA, l_reg, pa0, pa1, pa2, pa3); SBAR();
    SLOAD(SO, (kt0 + j + 1) * KVBLK); SBAR();
    pv_d0(o, vb0, pa0, pa1, pa2, pa3); partialSM(pB0, pB1, m_reg, mnB, alB);
    __syncthreads(); SWAIT(); SWRITE(0, SE);
    RESC(alB); __syncthreads();
    SBAR(); mA = MLOAD(kt0 + j + 1); qkt(pA0, pA1, K_lds, qr, r32, hi); score_hook<MODE, DMAX>(pA0, pA1, kt0 + j + 1, tq, tq0w, hi, tab, mA);
    finishSM<MODE>(pB0, pB1, alB, l_reg, pa0, pa1, pa2, pa3); SBAR();
    SLOAD(SE, (kt0 + j + 2) * KVBLK); SBAR();
    pv_d0(o, vb0 + SHM_V, pa0, pa1, pa2, pa3); partialSM(pA0, pA1, m_reg, mnA, alA);
    __syncthreads(); SWAIT(); SWRITE(1, SO);
    RESC(alA); __syncthreads();
  }
  SBAR(); mB = MLOAD(kt1 - 1); qkt(pB0, pB1, K_lds + SHM_K, qr, r32, hi); score_hook<MODE, DMAX>(pB0, pB1, kt1 - 1, tq, tq0w, hi, tab, mB);
  finishSM<MODE>(pA0, pA1, alA, l_reg, pa0, pa1, pa2, pa3); SBAR();
  pv_d0(o, vb0, pa0, pa1, pa2, pa3); partialSM(pB0, pB1, m_reg, mnB, alB);
  __syncthreads(); RESC(alB);
  finishSM<MODE>(pB0, pB1, alB, l_reg, pa0, pa1, pa2, pa3); SBAR();
  pv_d0(o, vb0 + SHM_V, pa0, pa1, pa2, pa3);
  if (hi == 0) li_l[r32] = l_reg; asm volatile("s_waitcnt lgkmcnt(0)" ::: "memory");
  float rli[16];
#pragma unroll
  for (int r = 0; r < 16; ++r) rli[r] = __builtin_amdgcn_rcpf(li_l[crow(r, hi)]);
  unsigned char* Ow = Ob + (long)(wid * QBLK) * LDO; const float s8 = (float)(1 << Y8_SCALE_LOG2);
#pragma unroll
  for (int r = 0; r < 16; ++r) { int orow = crow(r, hi);
#pragma unroll
    for (int d0 = 0; d0 < 4; ++d0) { const float v = fminf(fmaxf(o[d0][r] * rli[r] * s8, -440.f), 440.f); const int w = __builtin_amdgcn_cvt_pk_fp8_f32(v, 0.f, 0, false); Ow[(long)orow * LDO + d0 * 32 + r32] = (unsigned char)(w & 0xff); } }
  __syncthreads();
#undef SLOAD
#undef SWRITE
#undef SWAIT
#undef RESC
#undef MLOAD
}
#undef KSWZ
}

__device__ __forceinline__ int t5_bucket_dev(int rel) {
    const int n = rel < 0 ? -rel : rel; int b;
    if (n < 8) b = n; else b = 8 + (n >= 15) + (n >= 27) + (n >= 50) + (n >= 91) + (n >= 166) + (n >= 305) + (n >= 559);
    return b + (rel > 0 ? 16 : 0);
}
constexpr int DMAX_A = 559, DMAX_B = 128;
__device__ __forceinline__ void fill_tab_A(const Frame& F, int h, LAS char* lds) {
    LAS float* tab = (LAS float*)(lds + att::OFF_TAB);
    const float far = F.t5[15 * 8 + h];
    for (int i = F.tid; i <= DMAX_A - att::DLO; i += 512) { const int d = i + att::DLO; tab[i] = (F.t5[t5_bucket_dev(-d) * 8 + h] - far) * (1.0f / att::SCALE); }
    __syncthreads();
}
__device__ __forceinline__ void fill_tab_B(const Frame& F, int h, LAS char* lds) {
    LAS float* tab = (LAS float*)(lds + att::OFF_TAB);
    const float far = F.rel[h * 257 + 256];
    for (int i = F.tid; i <= DMAX_B - att::DLO; i += 512) { const int d = i + att::DLO; tab[i] = (F.rel[h * 257 + min(max(d, -128), 128) + 128] - far) * (1.0f / att::SCALE); }
    __syncthreads();
}
namespace idx {
constexpr int KT_OFF = 0, KT_BYTES = 8192, CAND_OFF = CONV_LDS_OFF + 3 * CONV_LDS_BYTES + 256, CAND_STRIDE = 2440, CAP = 608, EMERG = CAP - 64, NREG = (CAP + 63) / 64;
static_assert(CAND_OFF % 8 == 0 && CAND_OFF + 32 * CAND_STRIDE <= LDS_BYTES - 16, "indexer LDS map");
constexpr float W_SCALE = 0.03125f;

__device__ __forceinline__ unsigned ordered_u32(float f) { const unsigned u = __float_as_uint(f); return u ^ ((unsigned)((int)u >> 31) | 0x80000000u); }
__device__ __forceinline__ float unordered_f32(unsigned o) { const unsigned u = (o & 0x80000000u) ? (o ^ 0x80000000u) : ~o; return __uint_as_float(u); }

__device__ __forceinline__ unsigned select_thr(const unsigned (&P)[NREG], unsigned maxP, unsigned lob, int lowbit, unsigned vin, int bin, int& bout) {
    int b; unsigned v;
    if (bin < 0) { const unsigned X = maxP ^ lob; if (X == 0u) { bout = -1; return maxP; } b = 31 - __builtin_clz(X); v = maxP & ~((2u << b) - 1u); }
    else { b = bin; v = vin; }
    if (lowbit > b) { bout = b; return v; }
    for (int bit = b; bit >= lowbit; --bit) {
        const unsigned tr = v | (1u << bit);
        int c = 0;
#pragma unroll
        for (int j = 0; j < NREG; ++j) c += __builtin_popcountll(__ballot(P[j] >= tr));
        if (c >= 256) v = tr;
    }
    bout = lowbit - 1;
    return v;
}

template <int VAR> __device__ __forceinline__ void indexer_unit(const Frame& F, int u, ConvSt& cv) {
    LAS unsigned char* lds = F.lds;
    const int tid = F.tid, wid = F.wave, lane = F.lane, r32 = lane & 31, hi = lane >> 5;
    const int t0 = u * 32, chunk = t0 >> 6, ntile = chunk + 1, ntile_q = 4 * ((chunk >> 2) + 1);
    const bf16_t* proj = F.PROJ;
    bf16x8 Af[2][4]; float wv[2][16];
    {
        const int head = (r32 & 3) | ((r32 >> 3) << 2), qsel = (r32 >> 2) & 1;
#pragma unroll
        for (int mt = 0; mt < 2; ++mt) {
            const int q = t0 + 4 * wid + 2 * mt + qsel;
            const bf16_t* qp = proj + (size_t)q * NPROJ + COL_QI + head * 64 + 8 * hi;
#pragma unroll
            for (int s = 0; s < 4; ++s) Af[mt][s] = *(const bf16x8*)(qp + 16 * s);
            const int qh = t0 + 4 * wid + 2 * mt + hi;
            const u32x4 w0 = *(const u32x4*)(proj + (size_t)qh * NPROJ + COL_WI), w1 = *(const u32x4*)(proj + (size_t)qh * NPROJ + COL_WI + 8);
            wv[mt][0] = bf_lo(w0.x) * W_SCALE; wv[mt][1] = bf_hi(w0.x) * W_SCALE; wv[mt][2] = bf_lo(w0.y) * W_SCALE; wv[mt][3] = bf_hi(w0.y) * W_SCALE;
            wv[mt][4] = bf_lo(w0.z) * W_SCALE; wv[mt][5] = bf_hi(w0.z) * W_SCALE; wv[mt][6] = bf_lo(w0.w) * W_SCALE; wv[mt][7] = bf_hi(w0.w) * W_SCALE;
            wv[mt][8] = bf_lo(w1.x) * W_SCALE; wv[mt][9] = bf_hi(w1.x) * W_SCALE; wv[mt][10] = bf_lo(w1.y) * W_SCALE; wv[mt][11] = bf_hi(w1.y) * W_SCALE;
            wv[mt][12] = bf_lo(w1.z) * W_SCALE; wv[mt][13] = bf_hi(w1.z) * W_SCALE; wv[mt][14] = bf_lo(w1.w) * W_SCALE; wv[mt][15] = bf_hi(w1.w) * W_SCALE;
        }
    }
    int cnt[2][2] = {{0, 0}, {0, 0}};
    float tau[2] = {-3.4e38f, -3.4e38f};
    unsigned lob[2][2] = {{0u, 0u}, {0u, 0u}};
    const int cbase[2] = {CAND_OFF + (4 * wid + 0 + hi) * CAND_STRIDE, CAND_OFF + (4 * wid + 2 + hi) * CAND_STRIDE};
    const int skey = tid >> 3, sslot = tid & 7;
    const int sdst = skey * 128 + ((sslot ^ ((skey >> 1) & 7)) * 16);
    const bf16_t* ksrc = proj + (size_t)skey * NPROJ + COL_KI + sslot * 8;
    u32x4 stg = *(const u32x4*)ksrc;
    *(LAS u32x4*)(lds + KT_OFF + sdst) = stg;
    __syncthreads();
#define IDX_MFMA(ACC, MT, BF) do { _Pragma("unroll") for (int i_ = 0; i_ < 16; ++i_) ACC[i_] = 0.f; \
        _Pragma("unroll") for (int s_ = 0; s_ < 4; ++s_) ACC = __builtin_amdgcn_mfma_f32_32x32x16_bf16(Af[MT][s_], BF[s_], ACC, 0, 0, 0); } while (0)
#define IDX_SCORE(SC, ACC, MT) do { \
        float sa_ = 0.f; \
        _Pragma("unroll") for (int r_ = 0; r_ < 16; ++r_) { const float ta_ = __int_as_float(max(__float_as_int(ACC[r_]), 0)); sa_ = fmaf(wv[MT][r_], ta_, sa_); } \
        SC = sa_; } while (0)
#define IDX_PIPE() do { _Pragma("unroll") for (int g_ = 0; g_ < 4; ++g_) { __builtin_amdgcn_sched_group_barrier(0x008, 1, 0); __builtin_amdgcn_sched_group_barrier(0x002, 9, 0); } } while (0)
#define IDX_APPEND(SC, MT, HF) do { \
        const bool pass = (VAR == 1) ? false : (SC >= tau[MT]); if (VAR == 1) { asm volatile("" :: "v"(SC)); } \
        const unsigned long long bm = __ballot(pass); \
        if (bm != 0ull) { \
            const unsigned blo = (unsigned)bm, bhi = (unsigned)(bm >> 32); \
            const int nlo = __builtin_popcount(blo), nhi = __builtin_popcount(bhi); \
            const int pre = __builtin_amdgcn_mbcnt_hi(bhi, __builtin_amdgcn_mbcnt_lo(blo, 0)); \
            const int pos = hi ? (cnt[MT][1] + pre - nlo) : (cnt[MT][0] + pre); \
            if (pass) { \
                const unsigned gk = (unsigned)(jt * 64 + 32 * (HF) + r32); \
                const unsigned P = (ordered_u32(SC) & 0xFFFFC000u) | (16383u - gk); \
                *(LAS unsigned*)(lds + cbase[MT] + pos * 4) = P; \
            } \
            cnt[MT][0] += nlo; cnt[MT][1] += nhi; \
        } } while (0)
    for (int jt = 0; jt < ntile; ++jt) {
        {
            bool cnext = false;
            if (VAR == 0) conv_drain(F, cv.cs >= 1 ? cv.base + (cv.cs - 1) * F.G : -1, cv.cs - 1);
            if (VAR != 5 && jt + 1 < ntile) {
                const bf16_t* g = proj + (size_t)((jt + 1) * 64 + skey) * NPROJ + COL_KI + ((sslot ^ ((skey >> 1) & 7)) * 8);
                __builtin_amdgcn_global_load_lds((const unsigned*)g, (LAS unsigned*)(lds + KT_OFF + ((jt + 1) & 1) * KT_BYTES + wid * 1024), 16, 0, 0);
            }
            if (VAR == 0) cnext = conv_issue(F, cv.base + (cv.cs + 1) * F.G, cv.cs + 1);
            const LAS unsigned char* kb = lds + KT_OFF + (jt & 1) * KT_BYTES;
            bf16x8 Bf0[4], Bf1[4];
#pragma unroll
            for (int s = 0; s < 4; ++s) Bf0[s] = *(const LAS bf16x8*)(kb + r32 * 128 + (((2 * s + hi) ^ ((r32 >> 1) & 7)) * 16));
#pragma unroll
            for (int s = 0; s < 4; ++s) Bf1[s] = *(const LAS bf16x8*)(kb + (32 + r32) * 128 + (((2 * s + hi) ^ ((r32 >> 1) & 7)) * 16));
            f32x16 accA, accB; float scA, scB;
            IDX_MFMA(accA, 0, Bf0);
            __builtin_amdgcn_sched_barrier(0);
            IDX_MFMA(accB, 1, Bf0); IDX_SCORE(scA, accA, 0); IDX_PIPE();
            IDX_APPEND(scA, 0, 0);
            IDX_MFMA(accA, 0, Bf1); IDX_SCORE(scB, accB, 1); IDX_PIPE();
            IDX_APPEND(scB, 1, 0);
            IDX_MFMA(accB, 1, Bf1); IDX_SCORE(scA, accA, 0); IDX_PIPE();
            IDX_APPEND(scA, 0, 1);
            IDX_SCORE(scB, accB, 1);
            IDX_APPEND(scB, 1, 1);
            const int seen = 64 * (jt + 1);
            const int mx = max(max(cnt[0][0], cnt[0][1]), max(cnt[1][0], cnt[1][1]));
            const int q448 = seen / 448;
            const bool sched = (q448 * 448 == seen) && ((q448 & (q448 - 1)) == 0) && (jt + 1 < ntile);
            if (sched || mx >= EMERG) {
#pragma unroll
                for (int mt = 0; mt < 2; ++mt)
#pragma unroll
                    for (int hh = 0; hh < 2; ++hh) {
                        const int n = cnt[mt][hh];
                        if (n > 256) {
                            const int base = CAND_OFF + (4 * wid + 2 * mt + hh) * CAND_STRIDE;
                            unsigned P[NREG]; unsigned mxp = 0;
#pragma unroll
                            for (int j = 0; j < NREG; ++j) { const int i = j * 64 + lane; P[j] = i < n ? *(const LAS unsigned*)(lds + base + i * 4) : 0u; mxp = max(mxp, P[j]); }
#pragma unroll
                            for (int o = 32; o >= 1; o >>= 1) mxp = max(mxp, (unsigned)__shfl_xor((int)mxp, o));
                            mxp = __builtin_amdgcn_readfirstlane(mxp);
                            int bo; unsigned v = select_thr(P, mxp, lob[mt][hh], 14, 0u, -1, bo);
                            int kept = 0;
#pragma unroll
                            for (int j = 0; j < NREG; ++j) kept += __builtin_popcountll(__ballot(P[j] >= v));
                            if (kept > 400) { v = select_thr(P, mxp, lob[mt][hh], 0, v, bo, bo); }
                            int np = 0;
#pragma unroll
                            for (int j = 0; j < NREG; ++j) {
                                const bool k = P[j] >= v; const unsigned long long bm = __ballot(k);
                                const int pre = __builtin_amdgcn_mbcnt_hi((unsigned)(bm >> 32), __builtin_amdgcn_mbcnt_lo((unsigned)bm, 0));
                                if (k) *(LAS unsigned*)(lds + base + (np + pre) * 4) = P[j];
                                np += __builtin_popcountll(bm);
                            }
                            cnt[mt][hh] = np; lob[mt][hh] = v & 0xFFFFC000u;
                            const float tf = unordered_f32(v & 0xFFFFC000u);
                            if (hi == hh) tau[mt] = tf;
                        }
                    }
            }
            if (cnext) asm volatile("s_waitcnt vmcnt(2)" ::: "memory"); else asm volatile("s_waitcnt vmcnt(0)" ::: "memory");
            if (VAR == 0) cv.cs += 1;
        }
        if (VAR != 5) { asm volatile("s_waitcnt lgkmcnt(0)" ::: "memory"); __builtin_amdgcn_s_barrier(); asm volatile("" ::: "memory"); }
    }
#undef IDX_MFMA
#undef IDX_SCORE
#undef IDX_PIPE
#undef IDX_APPEND
#pragma unroll
    for (int mt = 0; mt < 2; ++mt)
#pragma unroll
        for (int hh = 0; hh < 2; ++hh) {
            const int n = cnt[mt][hh];
            const int base = CAND_OFF + (4 * wid + 2 * mt + hh) * CAND_STRIDE;
            unsigned P[NREG]; unsigned mxp = 0;
#pragma unroll
            for (int j = 0; j < NREG; ++j) { const int i = j * 64 + lane; P[j] = i < n ? *(const LAS unsigned*)(lds + base + i * 4) : 0u; mxp = max(mxp, P[j]); }
            unsigned v = 1u;
            if (n > 256) {
#pragma unroll
                for (int o = 32; o >= 1; o >>= 1) mxp = max(mxp, (unsigned)__shfl_xor((int)mxp, o));
                mxp = __builtin_amdgcn_readfirstlane(mxp);
                int bo_; v = select_thr(P, mxp, lob[mt][hh], 0, 0u, -1, bo_);
            }
            asm volatile("s_waitcnt lgkmcnt(0)" ::: "memory");
            for (int i = lane; i < 2 * ntile_q; i += 64) *(LAS unsigned*)(lds + base + i * 4) = 0u;
            asm volatile("s_waitcnt lgkmcnt(0)" ::: "memory");
#pragma unroll
            for (int j = 0; j < NREG; ++j) {
                if (P[j] >= v && P[j] != 0u) {
                    const unsigned gk = 16383u - (P[j] & 0x3FFFu);
                    const unsigned kt = gk >> 6, kk = gk & 63u, t = kk >> 5, jj = kk & 31u, hb = (jj >> 2) & 1u, r = (jj & 3u) + 4u * (jj >> 3);
                    __hip_atomic_fetch_or((LAS unsigned*)(lds + base + (kt * 2 + t) * 4), 1u << (16u * hb + r), __ATOMIC_RELAXED, __HIP_MEMORY_SCOPE_WORKGROUP);
                }
            }
        }
    __syncthreads();
    for (int k2 = wid; 2 * k2 < ntile_q; k2 += 8) {
        const int kt = 2 * k2 + hi;
        if (kt < ntile_q) {
            const u32x2 m = *(const LAS u32x2*)(lds + CAND_OFF + r32 * CAND_STRIDE + kt * 8);
            *(u32x2*)((VAR ? (unsigned long long*)(F.ws + WS_END) : F.MASK) + (size_t)kt * SEQ + t0 + r32) = m;
        }
    }
    __syncthreads();
}
}
#ifndef MK_N_LAUNCHES
#define MK_N_LAUNCHES 1
#endif
constexpr int N_PHASES = 12;
constexpr int BAR_LDS_OFF = LDS_BYTES - 16;

__global__ __launch_bounds__(512, 2) void fwd(Args args) {
    extern __shared__ __attribute__((aligned(16))) unsigned char shm[];
    Frame F;
    F.lds = (LAS unsigned char*)shm;
    F.tid = threadIdx.x; F.lane = F.tid & 63; F.wave = __builtin_amdgcn_readfirstlane(F.tid >> 6);
    F.G = gridDim.x; F.bid = blockIdx.x; F.vcu = (F.G % 8 == 0) ? (F.bid % 8) * (F.G / 8) + F.bid / 8 : F.bid;
    F.x = args.in[0]; F.c = args.in[1]; F.w_ada = args.in[2]; F.b_ada = args.in[3]; F.norm_mix = args.in[4]; F.w_in = args.in[5]; F.t5 = args.in[6]; F.rel = args.in[7];
    F.w_up_a = args.in[8]; F.w_up_b = args.in[9]; F.w_o = args.in[10]; F.norm_ffn = args.in[11]; F.w_rg = args.in[12]; F.b_rg = args.in[13]; F.w_re = args.in[14]; F.b_re = args.in[15];
    F.w1 = args.in[16]; F.w3 = args.in[17]; F.w2 = args.in[18]; F.norm_final = args.in[19];
    F.out = args.out; F.ws = args.ws;
    unsigned char* ws = args.ws;
    F.mod = (float*)(ws + CTL_MOD); F.ecnt = (unsigned*)(ws + CTL_ECNT);
    F.WinT = (bf16_t*)(ws + WS_WINT); F.WupaT = (bf16_t*)(ws + WS_WUPA); F.WupbT = (bf16_t*)(ws + WS_WUPB); F.WoT = (bf16_t*)(ws + WS_WO); F.W13T = (bf16_t*)(ws + WS_W13); F.W2T = (bf16_t*)(ws + WS_W2);
    F.H = (bf16_t*)(ws + WS_H); F.PROJ = (bf16_t*)(ws + WS_PROJ); F.YA = (bf16_t*)(ws + WS_YA); F.YB = (bf16_t*)(ws + WS_YB); F.MRG = (bf16_t*)(ws + WS_MRG);
    F.WinT8 = ws + WS_WINT + (size_t)NPB * DM * 2; F.H8 = ws + WS_H8; F.W13T8 = ws + WS_W13; F.W2T8 = ws + WS_W2; F.Wupa8 = ws + WS_WUPA; F.Wupb8 = ws + WS_WUPB; F.Wo8 = ws + WS_WO;
    F.MASK = (unsigned long long*)(ws + WS_MASK); F.LIST = (int*)(ws + WS_LIST); F.TSLOT = (int*)(ws + WS_TSLOT); F.TW = (float*)(ws + WS_TW); F.RBH = (bf16_t*)(ws + WS_RB); F.RBL = F.RBH + 96 * DM; F.RC = (float*)(ws + WS_RB + (size_t)2 * 96 * DM * 2);

    const int lo = args.ph_lo, hi = args.ph_hi;
    XcdBarrier bar; bar.bar = (unsigned*)(ws + CTL_BAR); bar.x = 0; bar.st = nullptr;
    if (hi - lo > 1) {
        if (F.tid == 0) *(LAS u32x4*)(F.lds + BAR_LDS_OFF) = (u32x4){0u, 0u, 0u, 0u};
        __syncthreads();
        bar = xcd_barrier_post((unsigned*)(ws + CTL_BAR), (volatile LAS unsigned*)(F.lds + BAR_LDS_OFF));
    }
#ifndef PHASE_MASK
#define PHASE_MASK 0xFFF
#endif
#define IN(k) (((PHASE_MASK >> (k)) & 1) && lo <= (k) && (k) < hi)
#ifndef DUP_PHASE
#define DUP_PHASE -1
#endif
#define REP(k) for (int rep_ = 0; rep_ < ((DUP_PHASE) == (k) ? 2 : 1); ++rep_)
#define SEAM(k) do { if (IN(k) && IN((k) + 1)) xcd_barrier(bar); } while (0)

    if (IN(0)) { p0_mod(F); REP(0) p0_convert(F); }
    SEAM(0);
    if (IN(1)) { p1_router_prep(F); REP(1) { p1_norm(F); } }
    SEAM(1);
    if (IN(2)) {
        { pg8::StaticOrder<2048> S; S.init(F.H, F.WinT, SEQ, NPB, F.G, F.bid);
          pg8::EpiProj E{F.PROJ};
          pg8::gemm_phase<2048, false, false>(F.lds, S, E);
#if DUP_PHASE == 20
          pg8::gemm_phase<2048, false, false>(F.lds, S, E);
#endif
        }
        { pg8::ProjOrder8 S; S.init(F.H8, F.WinT8, SEQ, NP8, F.G, F.bid); S.bid = F.bid;
          pg8::EpiProj8 E{F.PROJ};
          pg8::gemm_phase<1024, false, true>(F.lds, S, E, W8_SCALE_LOG2, H8_SCALE_LOG2);
#if DUP_PHASE == 21
          pg8::gemm_phase<1024, false, true>(F.lds, S, E, W8_SCALE_LOG2, H8_SCALE_LOG2);
#endif
        }
    }
    SEAM(2);
    if (IN(3)) {
#ifndef NO_IDX
        {
            ConvSt cv; cv.base = TC_LATE_START + F.bid; cv.cs = 0;
            __syncthreads();
            (void)conv_issue(F, cv.base, 0);
            for (int p = F.bid; p < 256; p += F.G) { idx::indexer_unit<0>(F, p, cv); idx::indexer_unit<0>(F, 511 - p, cv); }
#ifdef IDX_PROBE
            for (int p = F.bid; p < 256; p += F.G) { idx::indexer_unit<IDX_PROBE>(F, p, cv); idx::indexer_unit<IDX_PROBE>(F, 511 - p, cv); }
#endif
            conv_drain(F, cv.cs >= 1 ? cv.base + (cv.cs - 1) * F.G : -1, cv.cs - 1);
            asm volatile("s_waitcnt vmcnt(0)" ::: "memory"); __syncthreads();
            conv_drain(F, cv.base + cv.cs * F.G, cv.cs);
            __syncthreads();
            for (int tl = cv.base + (cv.cs + 1) * F.G;; tl += F.G) { TDesc d; f32x4 v[2]; if (!tconv_desc(F, tl, d)) break; tconv_load(F, d, v); tconv_store(F, d, v, 0); }
        }
#endif
#ifndef NO_BAND
        REP(31) for (int p = F.bid; p < 256; p += F.G) {
            const int h = p & 7, j = p >> 3;
            fill_tab_B(F, h, (LAS char*)F.lds);
#pragma unroll 1
            for (int s = 0; s < 2; ++s) {
                const int qt = s ? 63 - j : j, q0 = qt * 256;
                const int kt0 = (4 * qt - 8) > 0 ? (4 * qt - 8) : 0, kt1 = 4 * qt + 4;
                att::attn_unit<1, DMAX_B>(F.PROJ + (size_t)q0 * NPROJ + COL_QB + h * 128, F.PROJ + COL_KB + h * 128, F.PROJ + COL_VB + h * 128, (unsigned char*)F.YB + (size_t)q0 * 1024 + h * 128, nullptr, q0, kt0, kt1, (LAS char*)F.lds);
            }
        }
#endif
    }
    SEAM(3);
    if (IN(4)) REP(4) {
        for (int p = F.bid; p < 256; p += F.G) {
            const int h = p & 7, j = p >> 3;
            fill_tab_A(F, h, (LAS char*)F.lds);
#pragma unroll 1
            for (int s = 0; s < 2; ++s) {
                const int qt = s ? 63 - j : j, q0 = qt * 256;
                att::attn_unit<0, DMAX_A>(F.PROJ + (size_t)q0 * NPROJ + COL_QA + h * 128, F.PROJ + COL_KA + h * 128, F.PROJ + COL_VA + h * 128, (unsigned char*)F.YA + (size_t)q0 * 1024 + h * 128, F.MASK + q0, q0, 0, 4 * qt + 4, (LAS char*)F.lds);
            }
        }
    }
    SEAM(4);
    if (IN(5)) {
        pg8::StaticOrder<512> S; S.init(F.YA, F.Wupa8, SEQ, DM, F.G, F.bid);
        pg8::EpiGate<false> E{F.PROJ, COL_GA, nullptr, F.H};
        pg8::gemm_phase<512, false, true>(F.lds, S, E, W8_SCALE_LOG2, Y8_SCALE_LOG2);
#if DUP_PHASE == 5
        pg8::gemm_phase<512, false, true>(F.lds, S, E, W8_SCALE_LOG2, Y8_SCALE_LOG2);
#endif
    }
    if (IN(5) && IN(6)) { asm volatile("s_waitcnt vmcnt(0)" ::: "memory"); __syncthreads(); if (F.tid == 0) { __builtin_amdgcn_fence(__ATOMIC_ACQUIRE, "agent"); asm volatile("s_waitcnt vmcnt(0)" ::: "memory"); } __syncthreads(); }
    if (IN(6)) {
        pg8::StaticOrder<512> S; S.init(F.YB, F.Wupb8, SEQ, DM, F.G, F.bid);
        pg8::EpiGate<true> E{F.PROJ, COL_GB, F.H, F.MRG};
        pg8::gemm_phase<512, false, true>(F.lds, S, E, W8_SCALE_LOG2, Y8_SCALE_LOG2);
#if DUP_PHASE == 6
        pg8::gemm_phase<512, false, true>(F.lds, S, E, W8_SCALE_LOG2, Y8_SCALE_LOG2);
#endif
    }
    SEAM(6);
    if (IN(7)) {
        pg8::StaticOrder<1024> S; S.init(F.MRG, F.Wo8, SEQ, DM, F.G, F.bid);
        pg8::EpiRes E{F.x, F.mod + 2 * DM, F.H};
        pg8::gemm_phase<1024, false, true>(F.lds, S, E, W8_SCALE_LOG2, M8_SCALE_LOG2);
#if DUP_PHASE == 7
        pg8::gemm_phase<1024, false, true>(F.lds, S, E, W8_SCALE_LOG2, M8_SCALE_LOG2);
#endif
    }
    SEAM(7);
    if (IN(8)) { p8_router(F); }
    SEAM(8);
    if (IN(9)) {
        moe_tables(F); moe1_fill_lists(F);
        MoeOrder1 S{&F, (const LAS int*)(F.lds + MOE_TS), (const LAS int*)(F.lds + MOE_TOK)};
        pg8::EpiMoe1 E{(unsigned char*)F.MRG};
        pg8::gemm_phase<1024, true, true>(F.lds, S, E, W8_SCALE_LOG2, H8_SCALE_LOG2);
#if DUP_PHASE == 9
        pg8::gemm_phase<1024, true, true>(F.lds, S, E, W8_SCALE_LOG2, H8_SCALE_LOG2);
#endif
    }
    SEAM(9);
    if (IN(10)) {
        moe_tables(F);
        MoeOrder2 S{&F, (const LAS int*)(F.lds + MOE_TS)};
        pg8::EpiMoe2 E{F.PROJ};
        pg8::gemm_phase<256, false, true>(F.lds, S, E, W2_SCALE_LOG2, A8_SCALE_LOG2);
#if DUP_PHASE == 10
        pg8::gemm_phase<256, false, true>(F.lds, S, E, W2_SCALE_LOG2, A8_SCALE_LOG2);
#endif
    }
    SEAM(10);
    if (IN(11)) { moe_tables(F); p11_final(F); }
#undef IN
#undef SEAM
}

extern "C" void kernel_launch(void* const* d_in, const int* in_sizes, int n_in, void* d_out, int out_size, void* d_ws, size_t ws_size, hipStream_t stream) {
    static int grid = 0;
    if (grid == 0) {
        if (n_in != 20 || out_size != SEQ * DM || ws_size < WS_END) { fprintf(stderr, "kernel_launch: shape/workspace mismatch: n_in %d out %d ws %zu (need %zu)\n", n_in, out_size, ws_size, (size_t)WS_END); grid = -1; return; }
        int dev = 0, cus = 0, per_cu = 0;
        if (hipGetDevice(&dev) != hipSuccess || hipDeviceGetAttribute(&cus, hipDeviceAttributeMultiprocessorCount, dev) != hipSuccess) { grid = -1; return; }
        if (hipFuncSetAttribute((const void*)fwd, hipFuncAttributeMaxDynamicSharedMemorySize, LDS_BYTES) != hipSuccess) { fprintf(stderr, "kernel_launch: hipFuncSetAttribute failed\n"); grid = -1; return; }
        if (hipOccupancyMaxActiveBlocksPerMultiprocessor(&per_cu, (const void*)fwd, 512, LDS_BYTES) != hipSuccess || per_cu < 1) fprintf(stderr, "kernel_launch: occupancy query says %d\n", per_cu);
        (void)hipGetLastError();
        grid = cus;
    }
    if (grid < 0) return;
    (void)hipMemsetAsync((char*)d_ws + WS_CTL, 0, CTL_BYTES, stream);
    Args a{};
    for (int i = 0; i < 20; ++i) a.in[i] = (const float*)d_in[i];
    a.out = (float*)d_out; a.ws = (unsigned char*)d_ws;
#if MK_N_LAUNCHES == 1
    a.ph_lo = 0; a.ph_hi = N_PHASES;
    hipLaunchKernelGGL(fwd, dim3(grid), dim3(512), LDS_BYTES, stream, a);
#else
    for (int ph = 0; ph < N_PHASES; ++ph) { a.ph_lo = ph; a.ph_hi = ph + 1; hipLaunchKernelGGL(fwd, dim3(grid), dim3(512), LDS_BYTES, stream, a); }
#endif
    const hipError_t le = hipPeekAtLastError();
    if (le != hipSuccess) fprintf(stderr, "kernel_launch: launch failed: %s\n", hipGetErrorName(le));
}
```

```cpp
#include <hip/hip_runtime.h>
#include <cstdio>
#include <cstdint>

#define LAS __attribute__((address_space(3)))
typedef unsigned short bf16_t;
typedef short bf16x8 __attribute__((ext_vector_type(8)));
typedef short s16x4 __attribute__((ext_vector_type(4)));
typedef float f32x2 __attribute__((ext_vector_type(2)));
typedef float f32x4 __attribute__((ext_vector_type(4)));
typedef float f32x16 __attribute__((ext_vector_type(16)));
typedef unsigned u32x2 __attribute__((ext_vector_type(2)));
typedef unsigned u32x4 __attribute__((ext_vector_type(4)));
typedef int i32x4_ __attribute__((ext_vector_type(4)));
typedef int i32x8 __attribute__((ext_vector_type(8)));

constexpr int SEQ = 16384, DM = 2048, NPROJ = 11520  , NPROJ_REAL = 11344;
constexpr int COL_QA = 0, COL_KA = 1024, COL_VA = 2048, COL_QI = 3072, COL_KI = 4096, COL_WI = 4160, COL_QB = 4176, COL_KB = 5200, COL_VB = 6224, COL_GA = 7248, COL_GB = 9296;
constexpr int NEXP = 64, DFF = 512, LIST_CAP = 16384;
constexpr int G8_SCALE_LOG2 = 4;
constexpr int NPB = 5376  , NPB_REAL = 5200, NP8 = 6144  ;
constexpr int H8_SCALE_LOG2 = 4, W8_SCALE_LOG2 = 9, W2_SCALE_LOG2 = 8, A8_SCALE_LOG2 = 4, Y8_SCALE_LOG2 = 6, M8_SCALE_LOG2 = 5;
constexpr float EPS = 1e-6f;
constexpr float LOG2E = 1.4426950408889634f;

constexpr size_t A256(size_t x) { return (x + 255) / 256 * 256; }
constexpr size_t WS_CTL = 0;
constexpr size_t CTL_BAR = 0;
constexpr size_t CTL_MOD = 16384;
constexpr size_t CTL_ECNT = 16384 + 49152;
constexpr size_t CTL_BYTES = 16384 + 49152 + 4096 + 256;
constexpr size_t WS_WINT = 131072;
constexpr size_t WS_WUPA = WS_WINT + (size_t)NPROJ * DM * 2;
constexpr size_t WS_WUPB = WS_WUPA + (size_t)DM * 1024 * 2;
constexpr size_t WS_WO   = WS_WUPB + (size_t)DM * 1024 * 2;
constexpr size_t WS_W13  = WS_WO + (size_t)DM * DM * 2;
constexpr size_t WS_W2   = WS_W13 + (size_t)NEXP * 1024 * DM;
constexpr size_t WS_H    = WS_W2 + (size_t)NEXP * DM * DFF;
constexpr size_t WS_PROJ = WS_H + (size_t)SEQ * DM * 2;
constexpr size_t WS_MASK = WS_PROJ + (size_t)SEQ * NPROJ * 2;
constexpr size_t WS_YA   = WS_MASK + (size_t)256 * SEQ * 8;
constexpr size_t WS_YB   = WS_YA + (size_t)SEQ * 1024 * 2;
constexpr size_t WS_MRG  = WS_YB + (size_t)SEQ * 1024 * 2;
constexpr size_t WS_LIST = WS_MRG + (size_t)SEQ * DM * 2;
constexpr size_t WS_TSLOT = WS_LIST + (size_t)NEXP * LIST_CAP * 4;
constexpr size_t WS_TW   = WS_TSLOT + (size_t)SEQ * 2 * 4;
constexpr size_t WS_H8   = WS_TW + (size_t)SEQ * 2 * 4;
constexpr size_t WS_RB   = WS_H8 + (size_t)SEQ * DM;
constexpr size_t WS_END  = WS_RB + (size_t)(1 << 20);
constexpr int MAX_PAD_ROWS = 2 * SEQ + NEXP * 255 + 1;
static_assert((size_t)MAX_PAD_ROWS * DM * 2 <= (size_t)SEQ * NPROJ * 2, "y fits in proj region");
static_assert((size_t)MAX_PAD_ROWS * DFF * 2 <= (size_t)SEQ * DM * 2, "a fits in merged region");

constexpr int LDS_BYTES = 147456;

__device__ __forceinline__ unsigned cvt_pk_bf16(float lo, float hi) { unsigned r; asm volatile("v_cvt_pk_bf16_f32 %0, %1, %2" : "=v"(r) : "v"(lo), "v"(hi)); return r; }
__device__ __forceinline__ float bf_lo(unsigned w) { return __uint_as_float(w << 16); }
__device__ __forceinline__ float bf_hi(unsigned w) { return __uint_as_float(w & 0xffff0000u); }
__device__ __forceinline__ float sigmoidf_(float x) { return __builtin_amdgcn_rcpf(1.0f + __builtin_amdgcn_exp2f(-x * LOG2E)); }
__device__ __forceinline__ unsigned cvt_fp8x4_(float a, float b, float c, float d) {
    int w = 0; w = __builtin_amdgcn_cvt_pk_fp8_f32(a, b, w, false); w = __builtin_amdgcn_cvt_pk_fp8_f32(c, d, w, true); return (unsigned)w;
}
__device__ __forceinline__ float wave_sum(float v) {
#pragma unroll
    for (int o = 32; o >= 1; o >>= 1) v += __shfl_xor(v, o);
    return v;
}

#define XB_TMO      128
#define XB_XCNT(j)  (256  + 64 * (j))
#define XB_XSUB(j)  (1280 + 64 * (j))
#define XB_XGEN(j)  (2304 + 64 * (j))
#define XB_TOP      3328
#define XB_TOPGEN   3392
#define XCD_BAR_WORDS 3456
#define XB_SPIN_CAP (1u << 22)
__device__ __forceinline__ unsigned xb_ld(unsigned* p)              { return __hip_atomic_load(p, __ATOMIC_RELAXED, __HIP_MEMORY_SCOPE_AGENT); }
__device__ __forceinline__ unsigned xb_add(unsigned* p, unsigned v) { return __hip_atomic_fetch_add(p, v, __ATOMIC_RELAXED, __HIP_MEMORY_SCOPE_AGENT); }
__device__ __forceinline__ unsigned xb_xcc_id() { return (unsigned)__builtin_amdgcn_s_getreg((3 << 11) | 20) & 0xFu; }
#define XB_SPIN(cond, bar) do { unsigned _sp = 0; while (cond) { __builtin_amdgcn_s_sleep(1); \
    if ((++_sp & 255u) == 0u) { if (xb_ld(&(bar)[XB_TMO])) break; if (_sp > XB_SPIN_CAP) { atomicAdd(&(bar)[XB_TMO], 1u); break; } } } } while (0)
struct XcdBarrier { unsigned* bar; unsigned x; volatile LAS unsigned* st; };
__device__ __forceinline__ XcdBarrier xcd_barrier_post(unsigned* bar, volatile LAS unsigned* st) {
    XcdBarrier b; b.bar = bar; b.x = xb_xcc_id(); b.st = st;
    if (threadIdx.x == 0) (void)xb_add(&bar[XB_XCNT(b.x)], 1u);
    return b;
}
__device__ __forceinline__ void xcd_barrier_complete(unsigned* bar, unsigned x, unsigned& nloc, unsigned& nx) {
    const unsigned G = gridDim.x * gridDim.y * gridDim.z;
    unsigned sum, cnt, mine, sp = 0u;
    for (;;) {
        sum = 0u; cnt = 0u; mine = 0u;
#pragma unroll
        for (unsigned j = 0; j < 16; ++j) { const unsigned c = xb_ld(&bar[XB_XCNT(j)]); sum += c; cnt += (c > 0u) ? 1u : 0u; mine = (j == x) ? c : mine; }
        if (sum == G) break;
        __builtin_amdgcn_s_sleep(1);
        if ((++sp & 255u) == 0u) { if (xb_ld(&bar[XB_TMO])) break; if (sp > XB_SPIN_CAP) { atomicAdd(&bar[XB_TMO], 1u); break; } }
    }
    nloc = mine > 0u ? mine : 1u; nx = cnt > 0u ? cnt : 1u;
}
__device__ __forceinline__ void xcd_barrier(const XcdBarrier& b) {
    asm volatile("s_waitcnt vmcnt(0)" ::: "memory");
    __syncthreads();
    if (threadIdx.x == 0) {
        unsigned* bar = b.bar;
        __builtin_amdgcn_s_waitcnt(0);
        unsigned nloc = b.st[0], nx = b.st[1];
        if (nloc == 0u) { xcd_barrier_complete(bar, b.x, nloc, nx); b.st[0] = nloc; b.st[1] = nx; }
        const unsigned old = xb_add(&bar[XB_XSUB(b.x)], 1u);
        const unsigned gen = old / nloc;
        if (old + 1u == (gen + 1u) * nloc) {
            __builtin_amdgcn_fence(__ATOMIC_RELEASE, "agent");
            asm volatile("s_waitcnt vmcnt(0)" ::: "memory");
            const unsigned og = xb_add(&bar[XB_TOP], 1u);
            const unsigned tg = og / nx;
            if (og + 1u == (tg + 1u) * nx) xb_add(&bar[XB_TOPGEN], 1u);
            else XB_SPIN(xb_ld(&bar[XB_TOPGEN]) == tg, bar);
            __builtin_amdgcn_fence(__ATOMIC_ACQUIRE, "agent");
            xb_add(&bar[XB_XGEN(b.x)], 1u);
            asm volatile("s_waitcnt vmcnt(0)" ::: "memory");
        } else {
            XB_SPIN(xb_ld(&bar[XB_XGEN(b.x)]) == gen, bar);
            __builtin_amdgcn_fence(__ATOMIC_ACQUIRE, "agent");
            asm volatile("s_waitcnt vmcnt(0)" ::: "memory");
        }
    }
    __syncthreads();
}

namespace pg8 {
constexpr int BM = 256, BK = 64, HALF = 128, HTB = HALF * BK * 2, STAGE_BYTES = 8 * HTB, NXCD = 8, WGM = 8;
__host__ __device__ __forceinline__ int lds_byte(int r, int c) { const int st = (r >> 4) * 2 + (c >> 5), rr = r & 15, cc = c & 31, ob = rr * 64 + cc * 2; return st * 1024 + (ob ^ (((ob >> 9) & 1) << 5)); }
__host__ __device__ __forceinline__ void stage_rc(int b, int& R, int& C) { const int st = b / 1024, sb = b % 1024, swz = sb ^ (((sb >> 9) & 1) << 5); R = (st >> 1) * 16 + swz / 64; C = (st & 1) * 32 + (swz % 64) / 2; }
__host__ __device__ __forceinline__ int perm32(int rho) { const int n = rho >> 4, i = rho & 15; return 8 * (i >> 2) + 4 * n + (i & 3); }

struct Unit { int pm, pn; const char* A; const char* B; int x0, x1; };

template <int K> struct StaticOrder {
    int nM, nN, nwg, G, c; const char* A; const char* Bt;
    __device__ void init(const void* A_, const void* Bt_, int M, int N, int G_, int c_) { A = (const char*)A_; Bt = (const char*)Bt_; nM = M / BM; nN = N / BM; nwg = nM * nN; G = G_; c = c_; }
    __device__ __forceinline__ bool next(int i, Unit& u) const {
        const long L = (long)i * G + c; if (L >= nwg) return false;
        int wgid = (int)L; { const int q = nwg / NXCD, r = nwg % NXCD, xcd = wgid % NXCD, off = wgid / NXCD; wgid = (xcd < r ? xcd * (q + 1) : r * (q + 1) + (xcd - r) * q) + off; }
        const int nig = WGM * nN, gid = wgid / nig, fm = gid * WGM, gsz = (nM - fm) < WGM ? (nM - fm) : WGM;
        u.pm = fm + ((wgid % nig) % gsz); u.pn = (wgid % nig) / gsz;
        u.A = A + (size_t)u.pm * BM * K * 2; u.B = Bt + (size_t)u.pn * BM * K * 2; u.x0 = 0; u.x1 = 0; return true;
    }
    __device__ __forceinline__ int arow(const Unit&, int r) const { return r; }
};

template <bool FP8> struct FragT { typedef bf16x8 A[4][2]; typedef bf16x8 B[2][2]; };
template <> struct FragT<true> { typedef i32x8 A[4]; typedef i32x8 B[2]; };
struct ProjOrder8 : StaticOrder<1024> {
    int bid;
    __device__ __forceinline__ bool next(int i, Unit& u) const {
        if (G != 256) return StaticOrder<1024>::next(i, u);
        long L;
        if (i < 4) L = (long)i * 256 + bid; else { if (bid < 64) return false; L = 1024 + (long)(i - 4) * 192 + (bid - 64); }
        if (L >= nwg) return false;
        int wgid = (int)L; { const int q = nwg / NXCD, r = nwg % NXCD, xcd = wgid % NXCD, off = wgid / NXCD; wgid = (xcd < r ? xcd * (q + 1) : r * (q + 1) + (xcd - r) * q) + off; }
        const int nig = WGM * nN, gid = wgid / nig, fm = gid * WGM, gsz = (nM - fm) < WGM ? (nM - fm) : WGM;
        u.pm = fm + ((wgid % nig) % gsz); u.pn = (wgid % nig) / gsz;
        u.A = A + (size_t)u.pm * BM * 1024 * 2; u.B = Bt + (size_t)u.pn * BM * 1024 * 2; u.x0 = 0; u.x1 = 0; return true;
    }
};
template <int K, bool GATHER, bool FP8, class Epi, class Sched>
__device__ __forceinline__ void gemm_phase(LAS unsigned char* lds, const Sched& S, const Epi& E, int sclW_log2 = 0, int sclH_log2 = 0) {
    const int tid = threadIdx.x, wid = __builtin_amdgcn_readfirstlane(tid >> 6), lane = tid & 63, wr = wid >> 2, wc = wid & 3, fr = lane & 15, fq = lane >> 4;
    constexpr int nt = K / BK;
    int R0, C0, R1, C1; stage_rc(tid * 16, R0, C0); stage_rc(tid * 16 + 8192, R1, C1);
    unsigned voffB[2];
    { const int Rb0 = Epi::PERM ? ((R0 & ~31) + perm32(R0 & 31)) : R0, Rb1 = Epi::PERM ? ((R1 & ~31) + perm32(R1 & 31)) : R1;
      voffB[0] = (unsigned)(Rb0 * K + C0) * 2u; voffB[1] = (unsigned)(Rb1 * K + C1) * 2u; }
    constexpr size_t kstep = (size_t)(BK * 2), hstep = (size_t)HALF * K * 2;
    const unsigned ldsw = (unsigned)wid * 1024u;
    const int aoff = lds_byte(wr * 64 + fr, fq * 8), boff = lds_byte(wc * 32 + fr, fq * 8);
#define PG8_SA(b, h) (((b) * 2 + (h)) * HTB)
#define PG8_SB(b, h) ((4 + (b) * 2 + (h)) * HTB)
#define PG8_GLDS(bufoff, gp0, gp1) do { \
        __builtin_amdgcn_global_load_lds((const unsigned*)(gp0), (LAS unsigned*)(lds + (bufoff) + ldsw), 16, 0, 0); \
        __builtin_amdgcn_global_load_lds((const unsigned*)(gp1), (LAS unsigned*)(lds + (bufoff) + ldsw + 8192), 16, 0, 0); } while (0)
#define PG8_STAGE_B(bufoff, gbase) PG8_GLDS(bufoff, (const char*)(gbase) + voffB[0], (const char*)(gbase) + voffB[1])
#define PG8_STAGE_A(bufoff, gbase, v0, v1) PG8_GLDS(bufoff, (const char*)(gbase) + (v0), (const char*)(gbase) + (v1))
#define PG8_LDA(dst, b, h) do { if constexpr (FP8) { _Pragma("unroll") for (int m = 0; m < 4; ++m) { \
            const i32x4_ lo_ = *(const LAS i32x4_*)(lds + PG8_SA(b, h) + aoff + m * 2048), hi_ = *(const LAS i32x4_*)(lds + PG8_SA(b, h) + aoff + m * 2048 + 1024); \
            *(i32x8*)&dst[m] = __builtin_shufflevector(lo_, hi_, 0, 1, 2, 3, 4, 5, 6, 7); } } \
        else { _Pragma("unroll") for (int m = 0; m < 4; ++m) _Pragma("unroll") for (int k = 0; k < 2; ++k) ((bf16x8*)&dst[m])[k] = *(const LAS bf16x8*)(lds + PG8_SA(b, h) + aoff + m * 2048 + k * 1024); } } while (0)
#define PG8_LDB(dst, b, h) do { if constexpr (FP8) { _Pragma("unroll") for (int n = 0; n < 2; ++n) { \
            const i32x4_ lo_ = *(const LAS i32x4_*)(lds + PG8_SB(b, h) + boff + n * 2048), hi_ = *(const LAS i32x4_*)(lds + PG8_SB(b, h) + boff + n * 2048 + 1024); \
            *(i32x8*)&dst[n] = __builtin_shufflevector(lo_, hi_, 0, 1, 2, 3, 4, 5, 6, 7); } } \
        else { _Pragma("unroll") for (int n = 0; n < 2; ++n) _Pragma("unroll") for (int k = 0; k < 2; ++k) ((bf16x8*)&dst[n])[k] = *(const LAS bf16x8*)(lds + PG8_SB(b, h) + boff + n * 2048 + k * 1024); } } while (0)
#define PG8_MMA(ai, bj, At, Bt) do { __builtin_amdgcn_s_setprio(1); \
        if constexpr (FP8) { _Pragma("unroll") for (int m = 0; m < 4; ++m) _Pragma("unroll") for (int n = 0; n < 2; ++n) \
            asm volatile("v_mfma_scale_f32_16x16x128_f8f6f4 %0, %1, %2, %0, %3, %4 op_sel_hi:[0,0,0]" : "+v"(acc[ai][bj][m][n]) : "v"(*(const i32x8*)&Bt[n]), "v"(*(const i32x8*)&At[m]), "v"(sclW), "v"(sclH)); } \
        else { _Pragma("unroll") for (int m = 0; m < 4; ++m) _Pragma("unroll") for (int n = 0; n < 2; ++n) _Pragma("unroll") for (int k = 0; k < 2; ++k) \
            acc[ai][bj][m][n] = __builtin_amdgcn_mfma_f32_16x16x32_bf16(((const bf16x8*)&Bt[n])[k], ((const bf16x8*)&At[m])[k], acc[ai][bj][m][n], 0, 0, 0); } \
        __builtin_amdgcn_s_setprio(0); } while (0)
#define PG8_WAIT_V(n) asm volatile("s_waitcnt vmcnt(" #n ")" ::: "memory")
#define PG8_WAIT_L(n) asm volatile("s_waitcnt lgkmcnt(" #n ")" ::: "memory")
#define PG8_BAR __builtin_amdgcn_s_barrier()
#define PG8_SCHED __builtin_amdgcn_sched_barrier(0)
#define PG8_SETA(u, v) do { if (GATHER) { \
        v[0][0] = (unsigned)(S.arow(u, R0) * K + C0) * 2u; v[0][1] = (unsigned)(S.arow(u, R1) * K + C1) * 2u; \
        v[1][0] = (unsigned)(S.arow(u, HALF + R0) * K + C0) * 2u; v[1][1] = (unsigned)(S.arow(u, HALF + R1) * K + C1) * 2u; \
      } else { v[0][0] = (unsigned)(R0 * K + C0) * 2u; v[0][1] = (unsigned)(R1 * K + C1) * 2u; v[1][0] = v[0][0] + (unsigned)hstep; v[1][1] = v[0][1] + (unsigned)hstep; } } while (0)
    Unit cur, nxt; int ui = 0;
    if (!S.next(0, cur)) return;
    f32x4 acc[2][2][4][2];
#pragma unroll
    for (int a = 0; a < 2; ++a)
#pragma unroll
        for (int b = 0; b < 2; ++b)
#pragma unroll
            for (int m = 0; m < 4; ++m)
#pragma unroll
                for (int n = 0; n < 2; ++n) acc[a][b][m][n] = (f32x4){0.f, 0.f, 0.f, 0.f};
    typename FragT<FP8>::A At; typename FragT<FP8>::B B0, B1;
    const int sclW = 127 - sclW_log2, sclH = 127 - sclH_log2;
    unsigned vA[2][2], vN[2][2];
    PG8_SETA(cur, vA);
    const char* cA = cur.A; const char* cB = cur.B;
    PG8_STAGE_B(PG8_SB(0, 0), cB); PG8_STAGE_A(PG8_SA(0, 0), cA, vA[0][0], vA[0][1]); PG8_STAGE_B(PG8_SB(0, 1), cB + hstep); PG8_STAGE_A(PG8_SA(0, 1), cA, vA[1][0], vA[1][1]);
    if (wr == 1) PG8_BAR;
    PG8_WAIT_V(4); PG8_BAR;
    PG8_STAGE_B(PG8_SB(1, 0), cB + kstep); PG8_STAGE_A(PG8_SA(1, 0), cA + kstep, vA[0][0], vA[0][1]); PG8_STAGE_B(PG8_SB(1, 1), cB + hstep + kstep);
    PG8_WAIT_V(6); PG8_BAR;
    for (;;) {
        const bool has_next = S.next(ui + 1, nxt);
        const char* nA = has_next ? nxt.A : cA; const char* nB = has_next ? nxt.B : cB;
        if (has_next) { PG8_SETA(nxt, vN); } else { vN[0][0] = vA[0][0]; vN[0][1] = vA[0][1]; vN[1][0] = vA[1][0]; vN[1][1] = vA[1][1]; }
        for (int t = 0; t < nt; t += 2) {
            const bool last = (t == nt - 2);
            const char* a1 = cA + (size_t)(t + 1) * kstep;
            const char* a2 = last ? nA : cA + (size_t)(t + 2) * kstep; const char* b2 = last ? nB : cB + (size_t)(t + 2) * kstep;
            const char* a3 = a2 + kstep; const char* b3 = b2 + kstep;
            const unsigned w00 = last ? vN[0][0] : vA[0][0], w01 = last ? vN[0][1] : vA[0][1], w10 = last ? vN[1][0] : vA[1][0], w11 = last ? vN[1][1] : vA[1][1];
            PG8_LDB(B0, 0, 0); PG8_SCHED; PG8_LDA(At, 0, 0); PG8_STAGE_A(PG8_SA(1, 1), a1, vA[1][0], vA[1][1]);
            PG8_WAIT_L(8); PG8_BAR; PG8_WAIT_L(0); PG8_MMA(0, 0, At, B0); PG8_BAR; PG8_SCHED;
            PG8_LDB(B1, 0, 1); PG8_STAGE_B(PG8_SB(0, 0), b2);
            PG8_BAR; PG8_WAIT_L(0); PG8_MMA(0, 1, At, B1); PG8_BAR;
            PG8_LDA(At, 0, 1); PG8_STAGE_A(PG8_SA(0, 0), a2, w00, w01);
            PG8_BAR; PG8_WAIT_L(0); PG8_MMA(1, 0, At, B0); PG8_BAR; PG8_SCHED;
            PG8_STAGE_B(PG8_SB(0, 1), b2 + hstep);
            PG8_WAIT_V(6); PG8_BAR; PG8_MMA(1, 1, At, B1); PG8_BAR;
            PG8_LDB(B0, 1, 0); PG8_SCHED; PG8_LDA(At, 1, 0); PG8_STAGE_A(PG8_SA(0, 1), a2, w10, w11);
            PG8_WAIT_L(8); PG8_BAR; PG8_WAIT_L(0); PG8_MMA(0, 0, At, B0); PG8_BAR; PG8_SCHED;
            PG8_LDB(B1, 1, 1); PG8_STAGE_B(PG8_SB(1, 0), b3);
            PG8_BAR; PG8_WAIT_L(0); PG8_MMA(0, 1, At, B1); PG8_BAR;
            PG8_LDA(At, 1, 1); PG8_STAGE_A(PG8_SA(1, 0), a3, w00, w01);
            PG8_BAR; PG8_WAIT_L(0); PG8_MMA(1, 0, At, B0); PG8_BAR; PG8_SCHED;
            PG8_STAGE_B(PG8_SB(1, 1), b3 + hstep);
            PG8_WAIT_V(6); PG8_BAR; PG8_MMA(1, 1, At, B1); PG8_BAR;
        }
        if constexpr (FP8) asm volatile("s_nop 15\n\ts_nop 15\n\ts_nop 15" ::: "memory");
        E(acc, cur, wr, wc, fr, fq);
        if (!has_next) break;
#pragma unroll
        for (int a = 0; a < 2; ++a)
#pragma unroll
            for (int b = 0; b < 2; ++b)
#pragma unroll
                for (int m = 0; m < 4; ++m)
#pragma unroll
                    for (int n = 0; n < 2; ++n) acc[a][b][m][n] = (f32x4){0.f, 0.f, 0.f, 0.f};
        cur = nxt; cA = nA; cB = nB; ++ui;
        vA[0][0] = vN[0][0]; vA[0][1] = vN[0][1]; vA[1][0] = vN[1][0]; vA[1][1] = vN[1][1];
    }
    PG8_WAIT_V(0);
    if (wr == 0) PG8_BAR;
    PG8_BAR;
#undef PG8_SA
#undef PG8_SB
#undef PG8_GLDS
#undef PG8_STAGE_A
#undef PG8_STAGE_B
#undef PG8_LDA
#undef PG8_LDB
#undef PG8_MMA
#undef PG8_WAIT_V
#undef PG8_WAIT_L
#undef PG8_BAR
#undef PG8_SCHED
#undef PG8_SETA
}

struct EpiProj {
    static constexpr bool PERM = true;
    bf16_t* O;
    __device__ __forceinline__ void operator()(const f32x4 (&acc)[2][2][4][2], const Unit& u, int wr, int wc, int fr, int fq) const {
        const int row0 = u.pm * BM + wr * 64 + fr, col0 = u.pn * BM + wc * 32 + 8 * fq;
#pragma unroll
        for (int ai = 0; ai < 2; ++ai)
#pragma unroll
            for (int m = 0; m < 4; ++m) { bf16_t* rowp = O + (size_t)(row0 + ai * HALF + m * 16) * NPROJ;
#pragma unroll
                for (int bj = 0; bj < 2; ++bj) { const f32x4 v0 = acc[ai][bj][m][0], v1 = acc[ai][bj][m][1];
                    const int c = col0 + bj * HALF;
                    u32x4 w; w.x = cvt_pk_bf16(v0[0], v0[1]); w.y = cvt_pk_bf16(v0[2], v0[3]); w.z = cvt_pk_bf16(v1[0], v1[1]); w.w = cvt_pk_bf16(v1[2], v1[3]);
                    if (c < NPB_REAL) *(u32x4*)(rowp + (c < 2048 ? c : c + 1024)) = w; } }
    }
};
struct EpiProj8 {
    static constexpr bool PERM = true;
    bf16_t* O;
    __device__ __forceinline__ void operator()(const f32x4 (&acc)[2][2][4][2], const Unit& u, int wr, int wc, int fr, int fq) const {
        const int row0 = u.pm * BM + wr * 64 + fr;
        const int tc = u.pn * BM;
        if (tc >= 2048) {
            const int bc = (tc - 2048) + wc * 32 + 8 * fq; const float s8 = (float)(1 << G8_SCALE_LOG2);
#pragma unroll
            for (int ai = 0; ai < 2; ++ai)
#pragma unroll
                for (int m = 0; m < 4; ++m) { unsigned char* rowp = (unsigned char*)(O + (size_t)(row0 + ai * HALF + m * 16) * NPROJ + COL_GA) + bc;
#pragma unroll
                    for (int bj = 0; bj < 2; ++bj) { const f32x4 lo4 = {-440.f, -440.f, -440.f, -440.f}, hi4 = {440.f, 440.f, 440.f, 440.f};
                        const f32x4 v0 = __builtin_elementwise_min(__builtin_elementwise_max(acc[ai][bj][m][0] * s8, lo4), hi4), v1 = __builtin_elementwise_min(__builtin_elementwise_max(acc[ai][bj][m][1] * s8, lo4), hi4);
                        u32x2 w; w.x = cvt_fp8x4_(v0[0], v0[1], v0[2], v0[3]); w.y = cvt_fp8x4_(v1[0], v1[1], v1[2], v1[3]);
                        *(u32x2*)(rowp + bj * HALF) = w; } }
            return;
        }
        const int dc = (tc < 1024 ? COL_VA + tc : COL_VB + (tc - 1024)) + wc * 32 + 8 * fq;
#pragma unroll
        for (int ai = 0; ai < 2; ++ai)
#pragma unroll
            for (int m = 0; m < 4; ++m) { bf16_t* rowp = O + (size_t)(row0 + ai * HALF + m * 16) * NPROJ + dc;
#pragma unroll
                for (int bj = 0; bj < 2; ++bj) { const f32x4 v0 = acc[ai][bj][m][0], v1 = acc[ai][bj][m][1];
                    u32x4 w; w.x = cvt_pk_bf16(v0[0], v0[1]); w.y = cvt_pk_bf16(v0[2], v0[3]); w.z = cvt_pk_bf16(v1[0], v1[1]); w.w = cvt_pk_bf16(v1[2], v1[3]);
                    *(u32x4*)(rowp + bj * HALF) = w; } }
    }
};
template <bool ADD> struct EpiGate {
    static constexpr bool PERM = true;
    const bf16_t* proj; int gcol; const bf16_t* Tin; void* Tout;
    __device__ __forceinline__ void operator()(const f32x4 (&acc)[2][2][4][2], const Unit& u, int wr, int wc, int fr, int fq) const {
        const int row0 = u.pm * BM + wr * 64 + fr, col0 = u.pn * BM + wc * 32 + 8 * fq;
#pragma unroll
        for (int ai = 0; ai < 2; ++ai) {
            u32x2 gb[4][2]; u32x4 tb[4][2];
#pragma unroll
            for (int m = 0; m < 4; ++m)
#pragma unroll
                for (int bj = 0; bj < 2; ++bj) { const size_t row = (size_t)(row0 + ai * HALF + m * 16);
                    gb[m][bj] = *(const u32x2*)((const unsigned char*)(proj + row * NPROJ + COL_GA) + (gcol - COL_GA) + col0 + bj * HALF);
                    if (ADD) tb[m][bj] = *(const u32x4*)(Tin + row * DM + col0 + bj * HALF); }
#pragma unroll
            for (int m = 0; m < 4; ++m) { const size_t row = (size_t)(row0 + ai * HALF + m * 16);
#pragma unroll
                for (int bj = 0; bj < 2; ++bj) { const f32x4 v0 = acc[ai][bj][m][0], v1 = acc[ai][bj][m][1];
                    const u32x2 g = gb[m][bj]; const float gs = 1.0f / (float)(1 << G8_SCALE_LOG2);
                    const f32x2 g01 = __builtin_amdgcn_cvt_pk_f32_fp8((int)g.x, false), g23 = __builtin_amdgcn_cvt_pk_f32_fp8((int)g.x, true), g45 = __builtin_amdgcn_cvt_pk_f32_fp8((int)g.y, false), g67 = __builtin_amdgcn_cvt_pk_f32_fp8((int)g.y, true);
                    float o[8];
                    o[0] = sigmoidf_(g01[0] * gs) * v0[0]; o[1] = sigmoidf_(g01[1] * gs) * v0[1]; o[2] = sigmoidf_(g23[0] * gs) * v0[2]; o[3] = sigmoidf_(g23[1] * gs) * v0[3];
                    o[4] = sigmoidf_(g45[0] * gs) * v1[0]; o[5] = sigmoidf_(g45[1] * gs) * v1[1]; o[6] = sigmoidf_(g67[0] * gs) * v1[2]; o[7] = sigmoidf_(g67[1] * gs) * v1[3];
#if defined(DBG_NOA)
                    if (!ADD) { for (int q_ = 0; q_ < 8; ++q_) o[q_] = 0.f; }
#endif
#if defined(DBG_NOB)
                    if (ADD) { for (int q_ = 0; q_ < 8; ++q_) o[q_] = 0.f; }
#endif
                    if (ADD) { const u32x4 t = tb[m][bj];
                        o[0] += bf_lo(t.x); o[1] += bf_hi(t.x); o[2] += bf_lo(t.y); o[3] += bf_hi(t.y); o[4] += bf_lo(t.z); o[5] += bf_hi(t.z); o[6] += bf_lo(t.w); o[7] += bf_hi(t.w);
                        const float s8 = (float)(1 << M8_SCALE_LOG2);
#pragma unroll
                        for (int q_ = 0; q_ < 8; ++q_) o[q_] = fminf(fmaxf(o[q_] * s8, -440.f), 440.f);
                        u32x2 w; w.x = cvt_fp8x4_(o[0], o[1], o[2], o[3]); w.y = cvt_fp8x4_(o[4], o[5], o[6], o[7]);
                        *(u32x2*)((unsigned char*)Tout + row * DM + col0 + bj * HALF) = w;
                    } else {
                        u32x4 w; w.x = cvt_pk_bf16(o[0], o[1]); w.y = cvt_pk_bf16(o[2], o[3]); w.z = cvt_pk_bf16(o[4], o[5]); w.w = cvt_pk_bf16(o[6], o[7]);
                        *(u32x4*)((bf16_t*)Tout + row * DM + col0 + bj * HALF) = w; } } }
        }
    }
};
struct EpiRes {
    static constexpr bool PERM = true;
    const float* X; const float* g1; bf16_t* O;
    __device__ __forceinline__ void operator()(const f32x4 (&acc)[2][2][4][2], const Unit& u, int wr, int wc, int fr, int fq) const {
        const int row0 = u.pm * BM + wr * 64 + fr, col0 = u.pn * BM + wc * 32 + 8 * fq;
        f32x4 gv[2][2];
#pragma unroll
        for (int bj = 0; bj < 2; ++bj)
#pragma unroll
            for (int n = 0; n < 2; ++n) gv[bj][n] = *(const f32x4*)(g1 + col0 + bj * HALF + n * 4);
#pragma unroll
        for (int ai = 0; ai < 2; ++ai) {
            f32x4 xb[4][2][2];
#pragma unroll
            for (int m = 0; m < 4; ++m)
#pragma unroll
                for (int bj = 0; bj < 2; ++bj) { const size_t ro = (size_t)(row0 + ai * HALF + m * 16) * DM + col0;
                    xb[m][bj][0] = *(const f32x4*)(X + ro + bj * HALF); xb[m][bj][1] = *(const f32x4*)(X + ro + bj * HALF + 4); }
#pragma unroll
            for (int m = 0; m < 4; ++m) { const size_t ro = (size_t)(row0 + ai * HALF + m * 16) * DM + col0;
#pragma unroll
                for (int bj = 0; bj < 2; ++bj) {
                    const f32x4 o0 = xb[m][bj][0] + gv[bj][0] * acc[ai][bj][m][0], o1 = xb[m][bj][1] + gv[bj][1] * acc[ai][bj][m][1];
                    u32x4 w; w.x = cvt_pk_bf16(o0[0], o0[1]); w.y = cvt_pk_bf16(o0[2], o0[3]); w.z = cvt_pk_bf16(o1[0], o1[1]); w.w = cvt_pk_bf16(o1[2], o1[3]);
                    *(u32x4*)(O + ro + bj * HALF) = w; } }
        }
    }
};
struct EpiMoe1 {
    static constexpr bool PERM = false;
    unsigned char* Aout;
    __device__ __forceinline__ void operator()(const f32x4 (&acc)[2][2][4][2], const Unit& u, int wr, int wc, int fr, int fq) const {
        const int row0 = u.x0 + wr * 64 + fr; const float s8 = (float)(1 << A8_SCALE_LOG2);
#pragma unroll
        for (int ai = 0; ai < 2; ++ai)
#pragma unroll
            for (int m = 0; m < 4; ++m) { unsigned char* rowp = Aout + (size_t)(row0 + ai * HALF + m * 16) * DFF;
#pragma unroll
                for (int bj = 0; bj < 2; ++bj) { const f32x4 a1 = acc[ai][bj][m][0], a3 = acc[ai][bj][m][1]; float o[4];
#pragma unroll
                    for (int j = 0; j < 4; ++j) o[j] = fminf(fmaxf(a1[j] * sigmoidf_(a1[j]) * a3[j] * s8, -440.f), 440.f);
                    *(unsigned*)(rowp + (8 * u.pn + 4 * bj + wc) * 16 + 4 * fq) = cvt_fp8x4_(o[0], o[1], o[2], o[3]); } }
    }
};
struct EpiMoe2 {
    static constexpr bool PERM = true;
    bf16_t* Y;
    __device__ __forceinline__ void operator()(const f32x4 (&acc)[2][2][4][2], const Unit& u, int wr, int wc, int fr, int fq) const {
        const int row0 = u.x0 + wr * 64 + fr, col0 = u.pn * BM + wc * 32 + 8 * fq;
#pragma unroll
        for (int ai = 0; ai < 2; ++ai)
#pragma unroll
            for (int m = 0; m < 4; ++m) { bf16_t* rowp = Y + (size_t)(row0 + ai * HALF + m * 16) * DM + col0;
                if (wr * 64 + fr + ai * HALF + m * 16 < u.x1) {
#pragma unroll
                for (int bj = 0; bj < 2; ++bj) { const f32x4 v0 = acc[ai][bj][m][0], v1 = acc[ai][bj][m][1];
                    u32x4 w; w.x = cvt_pk_bf16(v0[0], v0[1]); w.y = cvt_pk_bf16(v0[2], v0[3]); w.z = cvt_pk_bf16(v1[0], v1[1]); w.w = cvt_pk_bf16(v1[2], v1[3]);
                    *(u32x4*)(rowp + bj * HALF) = w; } } }
    }
};
}
struct Args {
    const float* in[20]; float* out; unsigned char* ws; int ph_lo, ph_hi, dry;
};
struct Frame {
    LAS unsigned char* lds; int tid, lane, wave, G, bid, vcu;
    const float *x, *c, *w_ada, *b_ada, *norm_mix, *w_in, *t5, *rel, *w_up_a, *w_up_b, *w_o, *norm_ffn, *w_rg, *b_rg, *w_re, *b_re, *w1, *w3, *w2, *norm_final;
    float* out; unsigned char* ws;
    float* mod; unsigned* ecnt;
    bf16_t *WinT, *WupaT, *WupbT, *WoT, *W13T, *W2T, *H, *PROJ, *YA, *YB, *MRG;
    unsigned char *WinT8, *H8, *W13T8, *W2T8, *Wupa8, *Wupb8, *Wo8;
    unsigned long long* MASK; int* LIST; int* TSLOT; float* TW;
    bf16_t *RBH, *RBL; float* RC;
};

__device__ __forceinline__ void p0_mod(const Frame& F) {
    LAS float* red = (LAS float*)F.lds;
    for (int b = F.bid; b < 256; b += F.G) {
        const int t = F.tid;
        f32x4 acc = {0.f, 0.f, 0.f, 0.f};
        const int c4 = t % 12, kg = t / 12;
        if (t < 480) {
            const float* wp = F.w_ada + b * 48 + c4 * 4;
            int k = kg;
            for (; k + 7 * 40 < DM; k += 8 * 40) {
                f32x4 w[8]; float sv[8];
#pragma unroll
                for (int u = 0; u < 8; ++u) { w[u] = *(const f32x4*)(wp + (size_t)(k + 40 * u) * 12288); const float cv = F.c[k + 40 * u]; sv[u] = cv * sigmoidf_(cv); }
#pragma unroll
                for (int u = 0; u < 8; ++u) acc += w[u] * sv[u];
            }
            for (; k < DM; k += 40) { const float cv = F.c[k]; const float s = cv * sigmoidf_(cv); const f32x4 w = *(const f32x4*)(wp + (size_t)k * 12288); acc += w * s; }
            *(LAS f32x4*)(red + (kg * 12 + c4) * 4) = acc;
        }
        __syncthreads();
        if (t < 12) { f32x4 sum = *(const f32x4*)(F.b_ada + b * 48 + t * 4);
            for (int g = 0; g < 40; ++g) sum += *(LAS f32x4*)(red + (g * 12 + t) * 4);
            *(f32x4*)(F.mod + b * 48 + t * 4) = sum; }
        __syncthreads();
    }
}
__device__ __forceinline__ int rowmap(int n, int mode) { return mode == 0 ? n : (32 * (n >> 4) + (n & 15) + (mode == 2 ? 16 : 0)); }
__device__ __forceinline__ unsigned cvt_fp8x4(float a, float b, float c, float d) {
    int w = 0;
    w = __builtin_amdgcn_cvt_pk_fp8_f32(a, b, w, false);
    w = __builtin_amdgcn_cvt_pk_fp8_f32(c, d, w, true);
    return (unsigned)w;
}
constexpr int TC_WIN = 32 * 178, TC_UP = 16 * 32, TC_WO = 32 * 32, TC_W1 = NEXP * 32 * 8, TC_W2 = NEXP * 8 * 32;
constexpr int TC_TOTAL = TC_WIN + 2 * TC_UP + TC_WO + 2 * TC_W1 + TC_W2;
constexpr int TC_EARLY = TC_WIN + 2 * TC_UP + TC_WO;
#ifndef TC_LATE_START
#define TC_LATE_START TC_EARLY
#endif
struct TDesc { const float* src; int N, k0, n0, ldd, mode; unsigned char* dst; };
__device__ __forceinline__ bool tconv_desc(const Frame& F, int tl, TDesc& d, int limit = TC_TOTAL) {
    if (tl >= limit) return false;
    int r = tl;
    if (r < TC_WIN) { d.src = F.w_in; d.N = NPROJ_REAL; d.k0 = (r % 32) * 64; d.n0 = (r / 32) * 64; d.dst = (unsigned char*)F.WinT; d.ldd = DM; d.mode = 3; return true; }
    r -= TC_WIN;
    if (r < TC_UP) { d.src = F.w_up_a; d.N = DM; d.k0 = (r % 16) * 64; d.n0 = (r / 16) * 64; d.dst = F.Wupa8; d.ldd = 1024; d.mode = 7; return true; }
    r -= TC_UP;
    if (r < TC_UP) { d.src = F.w_up_b; d.N = DM; d.k0 = (r % 16) * 64; d.n0 = (r / 16) * 64; d.dst = F.Wupb8; d.ldd = 1024; d.mode = 7; return true; }
    r -= TC_UP;
    if (r < TC_WO) { d.src = F.w_o; d.N = DM; d.k0 = (r % 32) * 64; d.n0 = (r / 32) * 64; d.dst = F.Wo8; d.ldd = DM; d.mode = 7; return true; }
    r -= TC_WO;
    if (r < TC_W1) { const int e = r / 256, q = r % 256; d.src = F.w1 + (size_t)e * DM * DFF; d.N = DFF; d.k0 = (q % 32) * 64; d.n0 = (q / 32) * 64; d.dst = F.W13T8 + (size_t)e * 1024 * DM; d.ldd = DM; d.mode = 4; return true; }
    r -= TC_W1;
    if (r < TC_W1) { const int e = r / 256, q = r % 256; d.src = F.w3 + (size_t)e * DM * DFF; d.N = DFF; d.k0 = (q % 32) * 64; d.n0 = (q / 32) * 64; d.dst = F.W13T8 + (size_t)e * 1024 * DM; d.ldd = DM; d.mode = 5; return true; }
    r -= TC_W1;
    { const int e = r / 256, q = r % 256; d.src = F.w2 + (size_t)e * DFF * DM; d.N = DM; d.k0 = (q % 8) * 64; d.n0 = (q / 8) * 64; d.dst = F.W2T8 + (size_t)e * DM * DFF; d.ldd = DFF; d.mode = 6; return true; }
}
__device__ __forceinline__ void tconv_load(const Frame& F, const TDesc& d, f32x4 (&v)[2]) {
    const int kk = F.tid >> 4, n4 = (F.tid & 15) * 4;
    const int nn = min(d.n0 + n4, d.N - 4);
    const float* p0 = d.src + (size_t)(d.k0 + kk) * d.N + nn; const float* p1 = p0 + (size_t)32 * d.N;
    asm volatile("global_load_dwordx4 %0, %1, off" : "=v"(v[0]) : "v"(p0) : "memory");
    asm volatile("global_load_dwordx4 %0, %1, off" : "=v"(v[1]) : "v"(p1) : "memory");
}
__device__ __forceinline__ void tconv_to_lds(const Frame& F, const f32x4 (&vin)[2], LAS float* tile  ) {
    const int t = F.tid, kk = t >> 4, n4 = (t & 15) * 4;
#pragma unroll
    for (int h = 0; h < 2; ++h) { const int k = kk + 32 * h; tile[k * 65 + n4 + 0] = vin[h][0]; tile[k * 65 + n4 + 1] = vin[h][1]; tile[k * 65 + n4 + 2] = vin[h][2]; tile[k * 65 + n4 + 3] = vin[h][3]; }
}
__device__ __forceinline__ void tconv_from_lds(const Frame& F, const TDesc& d, const LAS float* tile) {
    const int t = F.tid;
    { const int n = t >> 3, kq = (t & 7) * 8; const int k0 = d.k0, n0 = d.n0, mode = d.mode;
      if (n0 + n < d.N) {
        float v[8];
#pragma unroll
        for (int i = 0; i < 8; ++i) v[i] = tile[(kq + i) * 65 + n];
        if (mode == 3) {
            const int c = n0 + n; int rb = -1, r8 = -1;
            if (c < 2048) rb = c; else if (c < 3072) r8 = c - 2048; else if (c < 6224) rb = c - 1024; else if (c < 7248) r8 = 1024 + (c - 6224); else r8 = 2048 + (c - 7248);
            if (rb >= 0) { u32x4 w; w.x = cvt_pk_bf16(v[0], v[1]); w.y = cvt_pk_bf16(v[2], v[3]); w.z = cvt_pk_bf16(v[4], v[5]); w.w = cvt_pk_bf16(v[6], v[7]);
                *(u32x4*)(F.WinT + (size_t)rb * DM + k0 + kq) = w; }
            else { const float sc = (float)(1 << W8_SCALE_LOG2); u32x2 w; w.x = cvt_fp8x4_(v[0] * sc, v[1] * sc, v[2] * sc, v[3] * sc); w.y = cvt_fp8x4_(v[4] * sc, v[5] * sc, v[6] * sc, v[7] * sc);
                *(u32x2*)(F.WinT8 + (size_t)r8 * DM + k0 + kq) = w; }
        } else {
            const float sc = (float)(1 << (mode == 6 ? W2_SCALE_LOG2 : W8_SCALE_LOG2)); const int r = rowmap(n0 + n, mode == 4 ? 1 : (mode == 5 ? 2 : 0));
            u32x2 w; w.x = cvt_fp8x4_(v[0] * sc, v[1] * sc, v[2] * sc, v[3] * sc); w.y = cvt_fp8x4_(v[4] * sc, v[5] * sc, v[6] * sc, v[7] * sc);
            *(u32x2*)(d.dst + (size_t)r * d.ldd + k0 + kq) = w; } } }
}
__device__ __forceinline__ void tconv_store(const Frame& F, const TDesc& d, const f32x4 (&vin)[2], int ahead  ) {
    LAS float* tile = (LAS float*)F.lds;
    if (ahead >= 4) asm volatile("s_waitcnt vmcnt(8)" ::: "memory"); else if (ahead == 3) asm volatile("s_waitcnt vmcnt(6)" ::: "memory"); else if (ahead == 2) asm volatile("s_waitcnt vmcnt(4)" ::: "memory");
    else if (ahead == 1) asm volatile("s_waitcnt vmcnt(2)" ::: "memory"); else asm volatile("s_waitcnt vmcnt(0)" ::: "memory");
#ifdef DIAG_ZERO_P0_WUP
    if (d.mode == 7 && d.ldd == 1024) { const f32x4 z[2] = {(f32x4){0.f,0.f,0.f,0.f}, (f32x4){0.f,0.f,0.f,0.f}}; tconv_to_lds(F, z, tile); } else
#endif
    tconv_to_lds(F, vin, tile);
    __syncthreads();
    tconv_from_lds(F, d, tile);
    __syncthreads();
}
constexpr int CONV_LDS_OFF = 16384, CONV_LDS_BYTES = 64 * 64 * 4;
struct ConvSt { int base, cs; };
__device__ __forceinline__ LAS unsigned char* conv_buf(const Frame& F, int i) { return F.lds + CONV_LDS_OFF + (((i % 3) + 3) % 3) * CONV_LDS_BYTES; }
__device__ __forceinline__ bool conv_issue(const Frame& F, int tl, int bufi) {
    TDesc d; if (!tconv_desc(F, tl, d)) return false;
    LAS unsigned char* buf = conv_buf(F, bufi);
#pragma unroll
    for (int p = 0; p < 2; ++p) {
        const int k = p * 32 + (F.tid >> 4), c = F.tid & 15, cs = c ^ ((k >> 3) & 7);
        const float* g = d.src + (size_t)(d.k0 + k) * d.N + d.n0 + 4 * cs;
        __builtin_amdgcn_global_load_lds((const unsigned*)g, (LAS unsigned*)(buf + p * 8192 + F.wave * 1024), 16, 0, 0);
    }
    return true;
}
__device__ __forceinline__ void conv_drain(const Frame& F, int tl, int bufi) {
    TDesc d; if (tl < 0 || !tconv_desc(F, tl, d)) return;
    const LAS float* tile = (const LAS float*)conv_buf(F, bufi);
    const int t = F.tid, n = t >> 3, kq = (t & 7) * 8, f = t & 7;
    float v[8];
#pragma unroll
    for (int i = 0; i < 8; ++i) v[i] = tile[(kq + i) * 64 + (((n >> 2) ^ f) << 2) + (n & 3)];
    const int mode = d.mode;
    const float sc = (float)(1 << (mode == 6 ? W2_SCALE_LOG2 : W8_SCALE_LOG2)); const int r = rowmap(d.n0 + n, mode == 4 ? 1 : (mode == 5 ? 2 : 0));
    u32x2 w; w.x = cvt_fp8x4_(v[0] * sc, v[1] * sc, v[2] * sc, v[3] * sc); w.y = cvt_fp8x4_(v[4] * sc, v[5] * sc, v[6] * sc, v[7] * sc);
    *(u32x2*)(d.dst + (size_t)r * d.ldd + d.k0 + kq) = w;
}
__device__ __forceinline__ void p0_convert(const Frame& F) {
    TDesc d0, d1, d2, d3, d4; f32x4 v0[2], v1[2], v2[2], v3[2], v4[2];
    int tl = F.bid; const int G = F.G;
    bool h0 = tconv_desc(F, tl, d0, TC_EARLY); if (h0) tconv_load(F, d0, v0);
    bool h1 = tconv_desc(F, tl + G, d1, TC_EARLY); if (h1) tconv_load(F, d1, v1);
    bool h2 = tconv_desc(F, tl + 2 * G, d2, TC_EARLY); if (h2) tconv_load(F, d2, v2);
    bool h3 = tconv_desc(F, tl + 3 * G, d3, TC_EARLY); if (h3) tconv_load(F, d3, v3);
    bool h4 = false;
#define TC_STEP(HX, DX, VX, HN, DN, VN, K, A1, A2, A3) \
        if (!HX) break; \
        HN = tconv_desc(F, tl + (K) * G, DN, TC_EARLY); if (HN) tconv_load(F, DN, VN); \
        tconv_store(F, DX, VX, (A1 ? 1 : 0) + (A2 ? 1 : 0) + (A3 ? 1 : 0) + (HN ? 1 : 0));
    for (;;) {
        TC_STEP(h0, d0, v0, h4, d4, v4, 4, h1, h2, h3)
        TC_STEP(h1, d1, v1, h0, d0, v0, 5, h2, h3, h4)
        TC_STEP(h2, d2, v2, h1, d1, v1, 6, h3, h4, h0)
        TC_STEP(h3, d3, v3, h2, d2, v2, 7, h4, h0, h1)
        TC_STEP(h4, d4, v4, h3, d3, v3, 8, h0, h1, h2)
        tl += 5 * G;
    }
#undef TC_STEP
    asm volatile("s_waitcnt vmcnt(0)" ::: "memory");
    { u32x4* z = (u32x4*)(F.WinT + (size_t)NPB_REAL * DM); const int n16 = (NPB - NPB_REAL) * DM * 2 / 16;
      for (int i = F.bid * 512 + F.tid; i < n16; i += F.G * 512) z[i] = (u32x4){0u, 0u, 0u, 0u}; }
}

__device__ __forceinline__ void p1_router_prep(const Frame& F, int col0, int cstep) {
    const float* sh2 = F.mod + 3 * DM; const float* sc2 = F.mod + 4 * DM;
    LAS float* red = (LAS float*)F.lds;
    for (int col = col0; col < 96; col += cstep) {
        const int k = F.tid * 4;
        const f32x4 ga = *(const f32x4*)(F.norm_ffn + k) * (*(const f32x4*)(sc2 + k) + 1.0f), gb = *(const f32x4*)(sh2 + k);
        float w[4], gbw = 0.f;
#pragma unroll
        for (int j = 0; j < 4; ++j) { const float wv = col < 8 ? F.w_rg[(size_t)(k + j) * 8 + col] : (col < 72 ? F.w_re[(size_t)(k + j) * 64 + (col - 8)] : 0.f); gbw += gb[j] * wv; w[j] = wv * ga[j]; }
        u32x2 h, l;
        h.x = cvt_pk_bf16(w[0], w[1]); h.y = cvt_pk_bf16(w[2], w[3]);
        l.x = cvt_pk_bf16(w[0] - bf_lo(h.x), w[1] - bf_hi(h.x)); l.y = cvt_pk_bf16(w[2] - bf_lo(h.y), w[3] - bf_hi(h.y));
        { unsigned char* fb = (unsigned char*)F.RBH + (size_t)(((k >> 4) * 3 + (col >> 5)) * 2) * 1024 + ((col & 31) + 32 * ((k >> 3) & 1)) * 16 + (k & 7) * 2;
          *(u32x2*)fb = h; *(u32x2*)(fb + 1024) = l; }
        gbw = wave_sum(gbw);
        if (F.lane == 0) red[F.wave] = gbw;
        __syncthreads();
        if (F.tid == 0) { float s = 0.f; for (int i = 0; i < 8; ++i) s += red[i]; F.RC[col] = s; }
        __syncthreads();
    }
}

__device__ __forceinline__ void p1_norm(const Frame& F) {
    const float* sh1 = F.mod; const float* sc1 = F.mod + DM;
    f32x4 ga[8], gb[8];
#pragma unroll
    for (int j = 0; j < 8; ++j) { const int c = 4 * F.lane + 256 * j; const f32x4 nm = *(const f32x4*)(F.norm_mix + c), sc = *(const f32x4*)(sc1 + c); ga[j] = nm * (sc + 1.0f); gb[j] = *(const f32x4*)(sh1 + c); }
    const int rstep = F.G * 8; int row = F.bid * 8 + F.wave;
    f32x4 v[8], vn[8];
    if (row < SEQ) {
#pragma unroll
        for (int j = 0; j < 8; ++j) v[j] = *(const f32x4*)(F.x + (size_t)row * DM + 4 * F.lane + 256 * j);
    }
    for (; row < SEQ; row += rstep) {
        const int nrow = row + rstep;
        if (nrow < SEQ) {
#pragma unroll
            for (int j = 0; j < 8; ++j) vn[j] = *(const f32x4*)(F.x + (size_t)nrow * DM + 4 * F.lane + 256 * j);
        }
        float ss = 0.f;
#pragma unroll
        for (int j = 0; j < 8; ++j) ss += v[j][0] * v[j][0] + v[j][1] * v[j][1] + v[j][2] * v[j][2] + v[j][3] * v[j][3];
        ss = wave_sum(ss);
        const float rstd = __builtin_amdgcn_rsqf(ss * (1.0f / DM) + EPS);
        bf16_t* hp = F.H + (size_t)row * DM + 4 * F.lane; unsigned char* h8 = F.H8 + (size_t)row * DM + 4 * F.lane;
        const float s8 = (float)(1 << H8_SCALE_LOG2);
#pragma unroll
        for (int j = 0; j < 8; ++j) { const f32x4 o = v[j] * rstd * ga[j] + gb[j]; u32x2 w; w.x = cvt_pk_bf16(o[0], o[1]); w.y = cvt_pk_bf16(o[2], o[3]); *(u32x2*)(hp + 256 * j) = w;
            const f32x4 c8 = __builtin_elementwise_min(__builtin_elementwise_max(o * s8, (f32x4){-440.f, -440.f, -440.f, -440.f}), (f32x4){440.f, 440.f, 440.f, 440.f});
            *(unsigned*)(h8 + 256 * j) = cvt_fp8x4_(c8[0], c8[1], c8[2], c8[3]); }
#pragma unroll
        for (int j = 0; j < 8; ++j) v[j] = vn[j];
    }
}

constexpr int P8_RSTD = 0, P8_ECL = 256, P8_EBASE = 512, P8_LOG = 1024, P8_AS = 32768, P8_AS_STRIDE = 64 * 80;
__device__ __forceinline__ void p8_router(const Frame& F, const int dry = 0) {
    const float* sh2 = F.mod + 3 * DM; const float* sc2 = F.mod + 4 * DM;
    const bf16_t* X1 = F.H;
    LAS float* rs = (LAS float*)(F.lds + P8_RSTD);
    LAS float* lg = (LAS float*)(F.lds + P8_LOG);
    for (int blk = F.bid; blk < SEQ / 64; blk += F.G) {
        const int T0 = blk * 64;
        if (dry < 5) {
            int l4 = 4 * F.lane; asm volatile("" : "+v"(l4));
            f32x4 ga[8], gb[8];
#pragma unroll
            for (int j = 0; j < 8; ++j) { const int c = l4 + 256 * j; const f32x4 nm = *(const f32x4*)(F.norm_ffn + c), sc = *(const f32x4*)(sc2 + c); ga[j] = nm * (sc + 1.0f); gb[j] = *(const f32x4*)(sh2 + c); }
            u32x2 xw[8], xwn[8];
            { const bf16_t* xp = X1 + (size_t)(T0 + F.wave) * DM + l4;
#pragma unroll
              for (int j = 0; j < 8; ++j) xw[j] = *(const u32x2*)(xp + 256 * j); }
            for (int r = F.wave; r < 64; r += 8) {
                if (r + 8 < 64) { const bf16_t* xp = X1 + (size_t)(T0 + r + 8) * DM + l4;
#pragma unroll
                    for (int j = 0; j < 8; ++j) xwn[j] = *(const u32x2*)(xp + 256 * j); }
                f32x4 v[8]; float ss = 0.f;
#pragma unroll
                for (int j = 0; j < 8; ++j) { const u32x2 w = xw[j]; v[j] = (f32x4){bf_lo(w.x), bf_hi(w.x), bf_lo(w.y), bf_hi(w.y)}; }
#pragma unroll
                for (int j = 0; j < 8; ++j) ss += v[j][0] * v[j][0] + v[j][1] * v[j][1] + v[j][2] * v[j][2] + v[j][3] * v[j][3];
                ss = wave_sum(ss);
                const float rstd = __builtin_amdgcn_rsqf(ss * (1.0f / DM) + EPS);
                if (F.lane == 0) rs[r] = rstd;
                unsigned char* hp = F.H8 + (size_t)(T0 + r) * DM + l4; const float s8 = (float)(1 << H8_SCALE_LOG2);
#pragma unroll
                for (int j = 0; j < 8; ++j) { const f32x4 o = v[j] * rstd * ga[j] + gb[j];
                    const f32x4 c8 = __builtin_elementwise_min(__builtin_elementwise_max(o * s8, (f32x4){-440.f, -440.f, -440.f, -440.f}), (f32x4){440.f, 440.f, 440.f, 440.f});
                    *(unsigned*)(hp + 256 * j) = cvt_fp8x4_(c8[0], c8[1], c8[2], c8[3]); }
#pragma unroll
                for (int j = 0; j < 8; ++j) xw[j] = xwn[j];
            }
            if (F.tid < 64) ((LAS int*)(F.lds + P8_ECL))[F.tid] = 0;
        }
        __syncthreads();
        f32x16 acc[2][3];
#pragma unroll
        for (int a = 0; a < 2; ++a)
#pragma unroll
            for (int b = 0; b < 3; ++b)
#pragma unroll
                for (int i = 0; i < 16; ++i) acc[a][b][i] = 0.f;
        if (dry < 4) {
            const int mi = F.lane & 31, mk = F.lane >> 5;
            LAS unsigned char* Aw = F.lds + P8_AS + F.wave * P8_AS_STRIDE;
            const int lrow = F.lane >> 2, lpc = F.lane & 3;
            unsigned gao = (unsigned)((T0 + lrow) * DM + F.wave * 256 + lpc * 8) * 2u; asm volatile("" : "+v"(gao));
            const char* xbase = (const char*)X1;
            const unsigned law = (unsigned)(lrow * 80 + lpc * 16), lar = (unsigned)(mi * 80 + mk * 16);
            unsigned bo = (unsigned)(F.wave * 16 * 6 * 1024 + F.lane * 16); asm volatile("" : "+v"(bo));
            const char* bbase = (const char*)F.RBH;
            u32x4 ac[4], an[4], bq[4][6];
#define P8_LDA(c, R) { _Pragma("unroll") for (int i = 0; i < 4; ++i) R[i] = *(const u32x4*)(xbase + gao + (c) * 64 + i * (16 * DM * 2)); }
#define P8_LDB(ks, R) { _Pragma("unroll") for (int q = 0; q < 6; ++q) R[q] = *(const u32x4*)(bbase + bo + ((ks) * 6 + q) * 1024); }
            P8_LDA(0, ac) P8_LDB(0, bq[0]) P8_LDB(1, bq[1]) P8_LDB(2, bq[2])
#pragma unroll
            for (int c = 0; c < 8; ++c) {
#pragma unroll
                for (int i = 0; i < 4; ++i) *(LAS u32x4*)(Aw + law + i * (16 * 80)) = ac[i];
                if (c + 1 < 8) P8_LDA(c + 1, an)
#pragma unroll
                for (int s = 0; s < 2; ++s) {
                    const int ks = c * 2 + s;
                    if (ks + 3 < 16) P8_LDB(ks + 3, bq[(ks + 3) & 3])
                    const bf16x8 a0 = *(const LAS bf16x8*)(Aw + lar + s * 32), a1 = *(const LAS bf16x8*)(Aw + lar + 32 * 80 + s * 32);
#pragma unroll
                    for (int nt = 0; nt < 3; ++nt) { const bf16x8 h_ = __builtin_bit_cast(bf16x8, bq[ks & 3][2 * nt]), l_ = __builtin_bit_cast(bf16x8, bq[ks & 3][2 * nt + 1]);
                        acc[0][nt] = __builtin_amdgcn_mfma_f32_32x32x16_bf16(a0, l_, acc[0][nt], 0, 0, 0); acc[1][nt] = __builtin_amdgcn_mfma_f32_32x32x16_bf16(a1, l_, acc[1][nt], 0, 0, 0);
                        acc[0][nt] = __builtin_amdgcn_mfma_f32_32x32x16_bf16(a0, h_, acc[0][nt], 0, 0, 0); acc[1][nt] = __builtin_amdgcn_mfma_f32_32x32x16_bf16(a1, h_, acc[1][nt], 0, 0, 0); }
                }
#pragma unroll
                for (int i = 0; i < 4; ++i) ac[i] = an[i];
            }
#undef P8_LDA
#undef P8_LDB
        }
        if (dry < 3) {
            LAS f32x4* R = (LAS f32x4*)(F.lds + P8_AS);
#define P8_WR(reg) { _Pragma("unroll") for (int q = 0; q < 24; ++q) { const int t_ = q >> 2, rq = q & 3; \
                const f32x4 v_ = {acc[t_ / 3][t_ % 3][4 * rq], acc[t_ / 3][t_ % 3][4 * rq + 1], acc[t_ / 3][t_ % 3][4 * rq + 2], acc[t_ / 3][t_ % 3][4 * rq + 3]}; R[((reg) * 24 + q) * 64 + F.lane] = v_; } }
#define P8_RD(reg) { _Pragma("unroll") for (int q = 0; q < 24; ++q) { const int t_ = q >> 2, rq = q & 3; const f32x4 v_ = R[((reg) * 24 + q) * 64 + F.lane]; \
                acc[t_ / 3][t_ % 3][4 * rq] += v_[0]; acc[t_ / 3][t_ % 3][4 * rq + 1] += v_[1]; acc[t_ / 3][t_ % 3][4 * rq + 2] += v_[2]; acc[t_ / 3][t_ % 3][4 * rq + 3] += v_[3]; } }
            __syncthreads();
            if (F.wave >= 4) P8_WR(F.wave - 4)
            __syncthreads();
            if (F.wave < 4) P8_RD(F.wave)
            if (F.wave == 2 || F.wave == 3) P8_WR(F.wave)
            __syncthreads();
            if (F.wave < 2) P8_RD(F.wave + 2)
            if (F.wave == 1) P8_WR(3)
            __syncthreads();
            if (F.wave == 0) {
                P8_RD(3)
                const int col = F.lane & 31, hi = F.lane >> 5;
#pragma unroll
                for (int mt = 0; mt < 2; ++mt)
#pragma unroll
                    for (int nt = 0; nt < 3; ++nt)
#pragma unroll
                        for (int r = 0; r < 16; ++r) { const int tok = 32 * mt + (r & 3) + 8 * (r >> 2) + 4 * hi; lg[tok * 96 + 32 * nt + col] = acc[mt][nt][r]; }
            }
#undef P8_WR
#undef P8_RD
            __syncthreads();
        }
        if (F.tid < 64 && dry < 2) {
            const int tok = F.tid, T = T0 + tok; const LAS float* Lr = lg + tok * 96; const float* Lc = F.RC; const float rsv = rs[tok];
#define L(i_) (rsv * Lr[i_] + Lc[i_])
            float g[8]; float gmax = -3.4e38f; int grp = 0;
#pragma unroll
            for (int i = 0; i < 8; ++i) { g[i] = L(i) + F.b_rg[i]; if (g[i] > gmax) { gmax = g[i]; grp = i; } }
            float den = 0.f;
#pragma unroll
            for (int i = 0; i < 8; ++i) den += __expf(g[i] - gmax);
            const float pgrp = 1.0f / den;
            float v0 = -3.4e38f, v1 = -3.4e38f; int i0 = 0, i1 = 0;
#pragma unroll
            for (int i = 0; i < 8; ++i) { const float e = L(8 + grp * 8 + i) + F.b_re[grp * 8 + i];
                if (e > v0) { v1 = v0; i1 = i0; v0 = e; i0 = i; } else if (e > v1) { v1 = e; i1 = i; } }
            const float ex = __expf(v1 - v0); const float p0 = 1.0f / (1.0f + ex), p1 = ex / (1.0f + ex);
            const int e0 = grp * 8 + i0, e1 = grp * 8 + i1;
            if (dry >= 1) { if (pgrp * p0 + (float)(e0 + e1) == -12345.0f) F.TW[0] = p1; } else {
                LAS int* ecl = (LAS int*)(F.lds + P8_ECL); LAS unsigned* ebase = (LAS unsigned*)(F.lds + P8_EBASE);
                const int lr0 = __hip_atomic_fetch_add(ecl + e0, 1, __ATOMIC_RELAXED, __HIP_MEMORY_SCOPE_WORKGROUP), lr1 = __hip_atomic_fetch_add(ecl + e1, 1, __ATOMIC_RELAXED, __HIP_MEMORY_SCOPE_WORKGROUP);
                asm volatile("s_waitcnt lgkmcnt(0)" ::: "memory");
                { const int cn = ecl[tok]; ebase[tok] = cn ? atomicAdd(F.ecnt + 16 * tok, (unsigned)cn) : 0u; }
                asm volatile("s_waitcnt vmcnt(0) lgkmcnt(0)" ::: "memory");
                const unsigned pos0 = ebase[e0] + (unsigned)lr0, pos1 = ebase[e1] + (unsigned)lr1;
                F.LIST[(size_t)e0 * LIST_CAP + pos0] = T; F.LIST[(size_t)e1 * LIST_CAP + pos1] = T;
                F.TSLOT[2 * T + 0] = (e0 << 16) | (int)pos0; F.TSLOT[2 * T + 1] = (e1 << 16) | (int)pos1;
                F.TW[2 * T + 0] = pgrp * p0; F.TW[2 * T + 1] = pgrp * p1;
            }
#undef L
        }
        __syncthreads();
    }
}

constexpr int MOE_TS = 131072, MOE_CNT = 131072 + 512, MOE_TOK = 131072 + 1024;
__device__ __forceinline__ void moe_tables(const Frame& F) {
    LAS int* ts = (LAS int*)(F.lds + MOE_TS); LAS int* cn = (LAS int*)(F.lds + MOE_CNT);
    if (F.tid < 64) cn[F.tid] = (int)__hip_atomic_load(F.ecnt + 16 * F.tid, __ATOMIC_RELAXED, __HIP_MEMORY_SCOPE_AGENT);
    __syncthreads();
    if (F.tid == 0) { int s = 0; for (int e = 0; e < 64; ++e) { ts[e] = s; s += (cn[e] + 255) >> 8; } ts[64] = s; }
    __syncthreads();
}
__device__ __forceinline__ int moe_find(const LAS int* ts, int T) {
    int lo = 0, hi = 64;
    while (hi - lo > 1) { const int mid = (lo + hi) >> 1; if (ts[mid] <= T) lo = mid; else hi = mid; }
    return lo;
}
struct MoeOrder1 {
    const Frame* F; const LAS int* ts; const LAS int* tokl;
    __device__ __forceinline__ bool next(int i, pg8::Unit& u) const {
        const int uu = i * F->G + F->vcu, T = uu >> 2; if (T >= ts[64]) return false;
        const int e = moe_find(ts, T);
        u.pm = T; u.pn = uu & 3; u.A = (const char*)F->H8; u.B = (const char*)(F->W13T8 + (size_t)e * 1024 * DM + (size_t)u.pn * 256 * DM); u.x0 = T * 256; u.x1 = i; return true;
    }
    __device__ __forceinline__ int arow(const pg8::Unit& u, int r) const { return tokl[u.x1 * 256 + r]; }
};
struct MoeOrder2 {
    const Frame* F; const LAS int* ts;
    __device__ __forceinline__ bool next(int i, pg8::Unit& u) const {
        const int uu = i * F->G + F->vcu, T = uu >> 3; if (T >= ts[64]) return false;
        const int e = moe_find(ts, T);
        u.pm = T; u.pn = uu & 7; u.A = (const char*)F->MRG + (size_t)T * 256 * DFF; u.B = (const char*)(F->W2T8 + (size_t)e * DM * DFF + (size_t)u.pn * 256 * DFF); u.x0 = T * 256;
        { const LAS int* cn = (const LAS int*)(F->lds + MOE_CNT); const int left = cn[e] - (T - ts[e]) * 256; u.x1 = left < 256 ? left : 256; }
        return true;
    }
    __device__ __forceinline__ int arow(const pg8::Unit&, int r) const { return r; }
};
__device__ __forceinline__ void moe1_fill_lists(const Frame& F) {
    const LAS int* ts = (const LAS int*)(F.lds + MOE_TS); const LAS int* cn = (const LAS int*)(F.lds + MOE_CNT); LAS int* tokl = (LAS int*)(F.lds + MOE_TOK);
    for (int i = 0; i < 8; ++i) {
        const int uu = i * F.G + F.vcu, T = uu >> 2; if (T >= ts[64]) break;
        const int e = moe_find(ts, T), mt = T - ts[e];
        if (F.tid < 256) { const int pos = mt * 256 + F.tid; tokl[i * 256 + F.tid] = pos < cn[e] ? F.LIST[(size_t)e * LIST_CAP + pos] : 0; }
    }
    __syncthreads();
}

__device__ __forceinline__ void p11_final(const Frame& F, float tsc) {
    const LAS int* ts = (const LAS int*)(F.lds + MOE_TS);
    const float* g2 = F.mod + 5 * DM; const bf16_t* Y = F.PROJ;
    f32x4 gg[8], nf[8];
#pragma unroll
    for (int j = 0; j < 8; ++j) { const int c = 4 * F.lane + 256 * j; gg[j] = *(const f32x4*)(g2 + c); nf[j] = *(const f32x4*)(F.norm_final + c); }
    const int rstep = F.G * 8; int row = F.bid * 8 + F.wave;
    u32x2 xw[8], ya[8], yb[8], xwn[8], yan[8], ybn[8]; float w0 = 0.f, w1 = 0.f, w0n = 0.f, w1n = 0.f;
#define P11_LOAD(R, XW, YA, YB, W0, W1) do { const int s0_ = F.TSLOT[2 * (R)], s1_ = F.TSLOT[2 * (R) + 1]; W0 = F.TW[2 * (R)]; W1 = F.TW[2 * (R) + 1]; \
        const size_t r0_ = (size_t)ts[s0_ >> 16] * 256 + (s0_ & 0xffff), r1_ = (size_t)ts[s1_ >> 16] * 256 + (s1_ & 0xffff); \
        const bf16_t* x1p_ = F.H + (size_t)(R) * DM + 4 * F.lane; const bf16_t* y0_ = Y + r0_ * DM + 4 * F.lane; const bf16_t* y1_ = Y + r1_ * DM + 4 * F.lane; \
        _Pragma("unroll") for (int j = 0; j < 8; ++j) { XW[j] = *(const u32x2*)(x1p_ + 256 * j); YA[j] = *(const u32x2*)(y0_ + 256 * j); YB[j] = *(const u32x2*)(y1_ + 256 * j); } } while (0)
    if (row < SEQ) P11_LOAD(row, xw, ya, yb, w0, w1);
    for (; row < SEQ; row += rstep) {
        const int nrow = row + rstep;
        if (nrow < SEQ) P11_LOAD(nrow, xwn, yan, ybn, w0n, w1n);
        float* xp = F.out + (size_t)row * DM + 4 * F.lane;
        f32x4 v[8]; float ss = 0.f;
#pragma unroll
        for (int j = 0; j < 8; ++j) { const f32x4 xv = {bf_lo(xw[j].x), bf_hi(xw[j].x), bf_lo(xw[j].y), bf_hi(xw[j].y)}; const u32x2 a = ya[j], b = yb[j];
            f32x4 m; m[0] = w0 * bf_lo(a.x) + w1 * bf_lo(b.x); m[1] = w0 * bf_hi(a.x) + w1 * bf_hi(b.x); m[2] = w0 * bf_lo(a.y) + w1 * bf_lo(b.y); m[3] = w0 * bf_hi(a.y) + w1 * bf_hi(b.y);
#if defined(DBG_NOMOE)
            m = (f32x4){0.f, 0.f, 0.f, 0.f};
#endif
            v[j] = xv + gg[j] * m; }
#pragma unroll
        for (int j = 0; j < 8; ++j) ss += v[j][0] * v[j][0] + v[j][1] * v[j][1] + v[j][2] * v[j][2] + v[j][3] * v[j][3];
        ss = wave_sum(ss);
        const float rstd = __builtin_amdgcn_rsqf(ss * (1.0f / DM) + EPS) * tsc;
#pragma unroll
        for (int j = 0; j < 8; ++j) *(f32x4*)(xp + 256 * j) = v[j] * rstd * nf[j];
#pragma unroll
        for (int j = 0; j < 8; ++j) { xw[j] = xwn[j]; ya[j] = yan[j]; yb[j] = ybn[j]; }
        w0 = w0n; w1 = w1n;
    }
#undef P11_LOAD
}
namespace att {
constexpr int D = 128, NW = 8, QBLK = 32, KVBLK = 64;
constexpr float SCALE = 0.088388347648318440f;
constexpr float THR = 8.f;
constexpr int LDP = NPROJ;
constexpr int LDO = 1024;
constexpr int SHM_V = KVBLK * D * 2, SHM_K = KVBLK * D * 2;
constexpr int NBUF = 3;
constexpr int OFF_WS = NBUF * SHM_V + NBUF * SHM_K, OFF_TAB = OFF_WS + NW * 64 * 4;
constexpr int DLO = -63;
#define KSWZ(row, colB) ((row) * 256 + ((colB) ^ (((row) & 7) << 4)))
#define SBAR() __builtin_amdgcn_sched_barrier(0)
__device__ __forceinline__ int crow(int r, int hi) { return (r & 3) + 8 * (r >> 2) + 4 * hi; }

__device__ __forceinline__ void partialSM(f32x16& p0, f32x16& p1, float& m_reg, float& mn, float& alpha) {
  constexpr float C = SCALE * 1.4426950408889634f;
  float pmax = p0[0];
#pragma unroll
  for (int r = 1; r < 16; ++r) pmax = fmaxf(pmax, p0[r]);
#pragma unroll
  for (int r = 0; r < 16; ++r) pmax = fmaxf(pmax, p1[r]);
  { auto rr = __builtin_amdgcn_permlane32_swap(__float_as_uint(pmax), __float_as_uint(pmax), false, false);
    pmax = fmaxf(__uint_as_float(rr[0]), __uint_as_float(rr[1])); }
  if (__builtin_expect(__all(pmax - m_reg <= THR / SCALE), 1)) { mn = m_reg; alpha = 1.f; }
  else { mn = fmaxf(m_reg, pmax); alpha = __builtin_amdgcn_exp2f((m_reg - mn) * C); m_reg = mn; }
  float mnC = -mn * C;
#pragma unroll
  for (int r = 0; r < 16; ++r) p0[r] = fmaf(p0[r], C, mnC);
#pragma unroll
  for (int r = 0; r < 16; ++r) p1[r] = fmaf(p1[r], C, mnC);
#pragma unroll
  for (int r = 0; r < 16; ++r) p0[r] = __builtin_amdgcn_exp2f(p0[r]);
}
template <int MODE>
__device__ __forceinline__ void finishSM(f32x16& p0, f32x16& p1, float alpha, float& l_reg, bf16x8& pa0, bf16x8& pa1, bf16x8& pa2, bf16x8& pa3) {
#pragma unroll
  for (int r = 0; r < 16; ++r) p1[r] = __builtin_amdgcn_exp2f(p1[r]);
  float ps = 0;
#pragma unroll
  for (int r = 0; r < 16; ++r) ps += p0[r];
#pragma unroll
  for (int r = 0; r < 16; ++r) ps += p1[r];
  { auto rr = __builtin_amdgcn_permlane32_swap(__float_as_uint(ps), __float_as_uint(ps), false, false);
    ps = __uint_as_float(rr[0]) + __uint_as_float(rr[1]); }
  l_reg = l_reg * alpha + ps;
#define PK4(P, BASE, OUT) do { unsigned a0 = cvt_pk_bf16(P[BASE + 0], P[BASE + 1]), a1 = cvt_pk_bf16(P[BASE + 2], P[BASE + 3]);   \
    unsigned b0 = cvt_pk_bf16(P[BASE + 4], P[BASE + 5]), b1 = cvt_pk_bf16(P[BASE + 6], P[BASE + 7]);                              \
    auto r0 = __builtin_amdgcn_permlane32_swap(a0, b0, false, false); auto r1 = __builtin_amdgcn_permlane32_swap(a1, b1, false, false); \
    u32x4 w = {r0[0], r1[0], r0[1], r1[1]}; OUT = *reinterpret_cast<bf16x8*>(&w); } while (0)
  PK4(p0, 0, pa0); PK4(p0, 8, pa1); PK4(p1, 0, pa2); PK4(p1, 8, pa3);
#undef PK4
}
__device__ __forceinline__ void qkt(f32x16& p0, f32x16& p1, const LAS char* Ks, const bf16x8* qr, int r32, int hi) {
#pragma unroll
  for (int i = 0; i < 16; ++i) { p0[i] = 0.f; p1[i] = 0.f; }
#pragma unroll
  for (int d0 = 0; d0 < 8; ++d0) { int cb = (d0 * 16 + hi * 8) * 2;
    bf16x8 b0 = *reinterpret_cast<const LAS bf16x8*>(Ks + KSWZ(r32, cb));
    bf16x8 b1 = *reinterpret_cast<const LAS bf16x8*>(Ks + KSWZ(32 + r32, cb));
    p0 = __builtin_amdgcn_mfma_f32_32x32x16_bf16(b0, qr[d0], p0, 0, 0, 0);
    p1 = __builtin_amdgcn_mfma_f32_32x32x16_bf16(b1, qr[d0], p1, 0, 0, 0); }
}
__device__ __forceinline__ int v_st(int k, int c) { const int kk = (k & ~0xC) | ((k & 4) << 1) | ((k & 8) >> 1); return ((kk >> 3) * 4 + (c >> 5)) * 512 + ((kk & 7) * 32 + (c & 31)) * 2; }
__device__ __forceinline__ int v_rd_base(int lane) { return ((lane & 3) << 3) | (((lane >> 2) & 3) << 6) | (((lane >> 4) & 1) << 5) | (((lane >> 5) & 1) << 8); }
constexpr int v_rd_off(int d0, int ks, int half) { return d0 * 512 + ks * 4096 + half * 2048; }
template <int OFF> __device__ __forceinline__ s16x4 tr_read(int vb) {
  s16x4 r; asm volatile("ds_read_b64_tr_b16 %0, %1 offset:%2" : "=&v"(r) : "v"(vb), "i"(OFF) : "memory"); return r;
}
template <int D0> __device__ __forceinline__ void pv_one(f32x16& od, int vb, bf16x8 pa0, bf16x8 pa1, bf16x8 pa2, bf16x8 pa3) {
  const s16x4 l0 = tr_read<v_rd_off(D0, 0, 0)>(vb), h0 = tr_read<v_rd_off(D0, 0, 1)>(vb), l1 = tr_read<v_rd_off(D0, 1, 0)>(vb), h1 = tr_read<v_rd_off(D0, 1, 1)>(vb);
  const s16x4 l2 = tr_read<v_rd_off(D0, 2, 0)>(vb), h2 = tr_read<v_rd_off(D0, 2, 1)>(vb), l3 = tr_read<v_rd_off(D0, 3, 0)>(vb), h3 = tr_read<v_rd_off(D0, 3, 1)>(vb);
  asm volatile("s_waitcnt lgkmcnt(0)" ::: "memory"); SBAR();
#define PK(L, H) (bf16x8){L[0], L[1], L[2], L[3], H[0], H[1], H[2], H[3]}
  od = __builtin_amdgcn_mfma_f32_32x32x16_bf16(pa0, PK(l0, h0), od, 0, 0, 0);
  od = __builtin_amdgcn_mfma_f32_32x32x16_bf16(pa1, PK(l1, h1), od, 0, 0, 0);
  od = __builtin_amdgcn_mfma_f32_32x32x16_bf16(pa2, PK(l2, h2), od, 0, 0, 0);
  od = __builtin_amdgcn_mfma_f32_32x32x16_bf16(pa3, PK(l3, h3), od, 0, 0, 0);
#undef PK
}
__device__ __forceinline__ void pv_d0(f32x16* o, int vb, bf16x8 pa0, bf16x8 pa1, bf16x8 pa2, bf16x8 pa3) {
  pv_one<0>(o[0], vb, pa0, pa1, pa2, pa3); pv_one<1>(o[1], vb, pa0, pa1, pa2, pa3); pv_one<2>(o[2], vb, pa0, pa1, pa2, pa3); pv_one<3>(o[3], vb, pa0, pa1, pa2, pa3);
}

template <int MODE, int DMAX>
__device__ __forceinline__ void score_hook(f32x16& p0, f32x16& p1, int kt, int tq  , int tq_wave0  , int hi, const LAS float* tab, unsigned long long msk) {
  if (MODE == 1) {
    const int cw = tq_wave0 >> 6;
    if (kt > cw || kt < cw - 8) {
#pragma unroll
      for (int r = 0; r < 16; ++r) { p0[r] = -3.0e38f; p1[r] = -3.0e38f; }
      return;
    }
  }
#ifndef ATT_NOHOOK
  if (tq_wave0 - (kt * 64 + 63) < DMAX) {
    const int base = tq - kt * 64 - 4 * hi - DLO;
#pragma unroll
    for (int r = 0; r < 16; ++r) {
      const int c = (r & 3) + 8 * (r >> 2);
      int i0 = base - c, i1 = base - c - 32;
      i0 = min(max(i0, 0), DMAX - DLO); i1 = min(max(i1, 0), DMAX - DLO);
      p0[r] += tab[i0]; p1[r] += tab[i1];
      SBAR();
    }
  }
#endif
  if (MODE == 0) {
    const unsigned mk0 = (unsigned)msk >> (16 * hi), mk1 = (unsigned)(msk >> 32) >> (16 * hi);
#pragma unroll
    for (int r = 0; r < 16; ++r) {
      { const unsigned m_ = (unsigned)__builtin_amdgcn_sbfe(mk0, r, 1); p0[r] = __uint_as_float((m_ & __float_as_uint(p0[r])) | (~m_ & 0xFF61B1E6u)); }
      { const unsigned m_ = (unsigned)__builtin_amdgcn_sbfe(mk1, r, 1); p1[r] = __uint_as_float((m_ & __float_as_uint(p1[r])) | (~m_ & 0xFF61B1E6u)); }
    }
  }
}

__device__ __forceinline__ int opaque_s(int v) { asm volatile("" : "+s"(v)); return v; }
__device__ __forceinline__ unsigned long long mload_(const char* base, unsigned off) { asm volatile("" : "+v"(off)); return *(const unsigned long long*)(base + off); }
template <int MODE, int DMAX>
__device__ __forceinline__ void attn_unit(const bf16_t* __restrict__ Qb  , const bf16_t* __restrict__ Kh  , const bf16_t* __restrict__ Vh,
                                          unsigned char* __restrict__ Ob  , const unsigned long long* __restrict__ maskq  , int q0, int kt0, int kt1, LAS char* lds) {
  const int tid = threadIdx.x, wid = tid >> 6, lane = tid & 63, r32 = lane & 31, hi = lane >> 5;
  LAS char* V_lds = lds; LAS char* K_lds = lds + NBUF * SHM_V;
  LAS float* ws = (LAS float*)(lds + OFF_WS) + wid * 64; LAS float* li_l = ws; LAS float* al_l = ws + 32;
  const LAS float* tab = (const LAS float*)(lds + OFF_TAB);
  float m_reg = -1e30f, l_reg = 0; f32x16 o[4]; bf16x8 qr[8];
#pragma unroll
  for (int d = 0; d < 4; ++d)
#pragma unroll
    for (int r = 0; r < 16; ++r) o[d][r] = 0.f;
  int qlo = (wid * QBLK + r32) * LDP + hi * 8; asm volatile("" : "+v"(qlo));
  const bf16_t* Qw = Qb + qlo;
#pragma unroll
  for (int d0 = 0; d0 < 8; ++d0) qr[d0] = *reinterpret_cast<const bf16x8*>(Qw + d0 * 16);
  const int tq0w = q0 + wid * QBLK, tq = tq0w + r32;
  const int sr = tid >> 4, sc = (tid & 15) * 8, vst0 = v_st(sr, sc), vst1 = v_st(32 + sr, sc);
  const int vb0 = (int)(uintptr_t)V_lds + v_rd_base(lane);
  const char* Kc = (const char*)Kh; const char* Vc = (const char*)Vh; const unsigned soff = (unsigned)(sr * LDP + sc) * 2u;
  const unsigned moff = (unsigned)(__builtin_amdgcn_readfirstlane(wid) * QBLK + r32) * 8u;
  struct { bf16x8 vs0, vs1, ks0, ks1; } sr_[1];
#define SLOAD(i, k0) do { unsigned _so = soff; asm volatile("" : "+v"(_so)); unsigned _so2 = soff; asm volatile("" : "+v"(_so2)); \
    const char* _kp = Kc + (size_t)(unsigned)(k0) * (size_t)(LDP * 2); const char* _vp = Vc + (size_t)(unsigned)(k0) * (size_t)(LDP * 2); \
    const char* _kp2 = _kp + (32 * LDP * 2); const char* _vp2 = _vp + (32 * LDP * 2); \
    sr_[i].vs0 = *reinterpret_cast<const bf16x8*>(_vp + _so); sr_[i].vs1 = *reinterpret_cast<const bf16x8*>(_vp2 + _so2); \
    sr_[i].ks0 = *reinterpret_cast<const bf16x8*>(_kp + _so); sr_[i].ks1 = *reinterpret_cast<const bf16x8*>(_kp2 + _so2); } while (0)
#define SWRITE(bo, i) do { *(LAS bf16x8*)(V_lds + (bo) + vst0) = sr_[i].vs0;          \
    *(LAS bf16x8*)(V_lds + (bo) + vst1) = sr_[i].vs1; int kc = sc * 2;               \
    *(LAS bf16x8*)(K_lds + (bo) + KSWZ(sr, kc)) = sr_[i].ks0;                       \
    *(LAS bf16x8*)(K_lds + (bo) + KSWZ(32 + sr, kc)) = sr_[i].ks1; } while (0)
#define SWAIT() asm volatile("s_waitcnt vmcnt(0)" ::: "memory")
#define RESC(a) do { if (__any((a) < 1.f)) { if (hi == 0) al_l[r32] = (a); asm volatile("s_waitcnt lgkmcnt(0)" ::: "memory"); \
    _Pragma("unroll") for (int d = 0; d < 4; ++d) _Pragma("unroll") for (int r = 0; r < 16; ++r) o[d][r] *= al_l[crow(r, hi)]; } } while (0)
#define MLOAD(kt) (MODE == 0 ? mload_((const char*)maskq + (size_t)(unsigned)(kt) * (size_t)(SEQ * 8), moff) : 0ull)
  f32x16 pA0, pA1, pB0, pB1; float mnA, mnB, alA, alB; bf16x8 pa0, pa1, pa2, pa3; const int NT = kt1 - kt0;
  unsigned long long mA = 0, mB = 0;
  constexpr int SE = 0, SO = 0;
  static_assert(SHM_V == SHM_K, "one buffer offset serves K and V");
  int bp = 0, bc = SHM_K, bn = 2 * SHM_K;
  SLOAD(SE, kt0 * KVBLK); mA = MLOAD(kt0); asm volatile("s_waitcnt vmcnt(0)" ::: "memory"); SWRITE(0, SE); __syncthreads();
  qkt(pA0, pA1, K_lds, qr, r32, hi); score_hook<MODE, DMAX>(pA0, pA1, kt0, tq, tq0w, hi, tab, mA); partialSM(pA0, pA1, m_reg, mnA, alA);
  SLOAD(SO, (kt0 + 1) * KVBLK);
  SWAIT(); SWRITE(SHM_K, SO); __syncthreads();
  for (int j = 1; j + 1 < NT; j += 2) {
    SBAR(); mB = MLOAD(kt0 + j); qkt(pB0, pB1, K_lds + opaque_s(bc), qr, r32, hi); score_hook<MODE, DMAX>(pB0, pB1, kt0 + j, tq, tq0w, hi, tab, mB);
    finishSM<MODE>(pA0, pA1, alA, l_reg, pa0, pa1, pa2, pa3); SBAR();
    SLOAD(SO, (kt0 + j + 1) * KVBLK); SBAR();
    pv_d0(o, vb0 + opaque_s(bp), pa0, pa1, pa2, pa3); partialSM(pB0, pB1, m_reg, mnB, alB);
    SWAIT(); SWRITE(opaque_s(bn), SE);
    RESC(alB); __syncthreads();
    { const int t_ = bp; bp = bc; bc = bn; bn = t_; }
    SBAR(); mA = MLOAD(kt0 + j + 1); qkt(pA0, pA1, K_lds + opaque_s(bc), qr, r32, hi); score_hook<MODE, DMAX>(pA0, pA1, kt0 + j + 1, tq, tq0w, hi, tab, mA);
    finishSM<MODE>(pB0, pB1, alB, l_reg, pa0, pa1, pa2, pa3); SBAR();
    SLOAD(SE, (kt0 + j + 2) * KVBLK); SBAR();
    pv_d0(o, vb0 + opaque_s(bp), pa0, pa1, pa2, pa3); partialSM(pA0, pA1, m_reg, mnA, alA);
    SWAIT(); SWRITE(opaque_s(bn), SO);
    RESC(alA); __syncthreads();
    { const int t_ = bp; bp = bc; bc = bn; bn = t_; }
  }
  SBAR(); mB = MLOAD(kt1 - 1); qkt(pB0, pB1, K_lds + opaque_s(bc), qr, r32, hi); score_hook<MODE, DMAX>(pB0, pB1, kt1 - 1, tq, tq0w, hi, tab, mB);
  finishSM<MODE>(pA0, pA1, alA, l_reg, pa0, pa1, pa2, pa3); SBAR();
  pv_d0(o, vb0 + opaque_s(bp), pa0, pa1, pa2, pa3); partialSM(pB0, pB1, m_reg, mnB, alB);
  RESC(alB);
  finishSM<MODE>(pB0, pB1, alB, l_reg, pa0, pa1, pa2, pa3); SBAR();
  pv_d0(o, vb0 + opaque_s(bc), pa0, pa1, pa2, pa3);
  if (hi == 0) li_l[r32] = l_reg; asm volatile("s_waitcnt lgkmcnt(0)" ::: "memory");
  float rli[16];
#pragma unroll
  for (int r = 0; r < 16; ++r) rli[r] = __builtin_amdgcn_rcpf(li_l[crow(r, hi)]);
  int olo = wid * QBLK * LDO + r32; asm volatile("" : "+v"(olo));
  unsigned char* Ow = Ob + olo; const float s8 = (float)(1 << Y8_SCALE_LOG2);
#pragma unroll
  for (int r = 0; r < 16; ++r) { int orow = crow(r, hi);
#pragma unroll
    for (int d0 = 0; d0 < 4; ++d0) { const float v = fminf(fmaxf(o[d0][r] * rli[r] * s8, -440.f), 440.f); const int w = __builtin_amdgcn_cvt_pk_fp8_f32(v, 0.f, 0, false); Ow[orow * LDO + d0 * 32] = (unsigned char)(w & 0xff); } }
  __syncthreads();
#undef SLOAD
#undef SWRITE
#undef SWAIT
#undef RESC
#undef MLOAD
}
#undef KSWZ
}

__device__ __forceinline__ int t5_bucket_dev(int rel) {
    const int n = rel < 0 ? -rel : rel; int b;
    if (n < 8) b = n; else b = 8 + (n >= 15) + (n >= 27) + (n >= 50) + (n >= 91) + (n >= 166) + (n >= 305) + (n >= 559);
    return b + (rel > 0 ? 16 : 0);
}
constexpr int DMAX_A = 559, DMAX_B = 128;
__device__ __forceinline__ void fill_tab_A(const Frame& F, int h, LAS char* lds) {
    LAS float* tab = (LAS float*)(lds + att::OFF_TAB);
    const float far = F.t5[15 * 8 + h];
    for (int i = F.tid; i <= DMAX_A - att::DLO; i += 512) { const int d = i + att::DLO; tab[i] = (F.t5[t5_bucket_dev(-d) * 8 + h] - far) * (1.0f / att::SCALE); }
    __syncthreads();
}
__device__ __forceinline__ void fill_tab_B(const Frame& F, int h, LAS char* lds) {
    LAS float* tab = (LAS float*)(lds + att::OFF_TAB);
    const float far = F.rel[h * 257 + 256];
    for (int i = F.tid; i <= DMAX_B - att::DLO; i += 512) { const int d = i + att::DLO; tab[i] = (F.rel[h * 257 + min(max(d, -128), 128) + 128] - far) * (1.0f / att::SCALE); }
    __syncthreads();
}
namespace idx {
constexpr int KT_OFF = 0, KT_BYTES = 8192, CAND_OFF = CONV_LDS_OFF + 3 * CONV_LDS_BYTES + 256, CAND_STRIDE = 2440, CAP = 608, EMERG = CAP - 64, NREG = (CAP + 63) / 64;
static_assert(CAND_OFF % 8 == 0 && CAND_OFF + 32 * CAND_STRIDE <= LDS_BYTES - 16, "indexer LDS map");
constexpr float W_SCALE = 0.03125f;

__device__ __forceinline__ unsigned ordered_u32(float f) { const unsigned u = __float_as_uint(f); return u ^ ((unsigned)((int)u >> 31) | 0x80000000u); }
__device__ __forceinline__ float unordered_f32(unsigned o) { const unsigned u = (o & 0x80000000u) ? (o ^ 0x80000000u) : ~o; return __uint_as_float(u); }

__device__ __forceinline__ unsigned select_thr(const unsigned (&P)[NREG], unsigned maxP, unsigned lob, int lowbit, unsigned vin, int bin, int& bout) {
    int b; unsigned v;
    if (bin < 0) { const unsigned X = maxP ^ lob; if (X == 0u) { bout = -1; return maxP; } b = 31 - __builtin_clz(X); v = maxP & ~((2u << b) - 1u); }
    else { b = bin; v = vin; }
    if (lowbit > b) { bout = b; return v; }
    for (int bit = b; bit >= lowbit; --bit) {
        const unsigned tr = v | (1u << bit);
        int c = 0;
#pragma unroll
        for (int j = 0; j < NREG; ++j) c += __builtin_popcountll(__ballot(P[j] >= tr));
        if (c >= 256) v = tr;
    }
    bout = lowbit - 1;
    return v;
}

template <int VAR> __device__ __forceinline__ void indexer_unit(const Frame& F, int u, ConvSt& cv) {
    LAS unsigned char* lds = F.lds;
    const int tid = F.tid, wid = F.wave, lane = F.lane, r32 = lane & 31, hi = lane >> 5;
    const int t0 = u * 32, chunk = t0 >> 6, ntile = chunk + 1, ntile_q = 4 * ((chunk >> 2) + 1);
    const bf16_t* proj = F.PROJ;
    bf16x8 Af[2][4]; float wv[2][16];
    {
        const int head = (r32 & 3) | ((r32 >> 3) << 2), qsel = (r32 >> 2) & 1;
#pragma unroll
        for (int mt = 0; mt < 2; ++mt) {
            const int q = t0 + 4 * wid + 2 * mt + qsel;
            const bf16_t* qp = proj + (size_t)q * NPROJ + COL_QI + head * 64 + 8 * hi;
#pragma unroll
            for (int s = 0; s < 4; ++s) Af[mt][s] = *(const bf16x8*)(qp + 16 * s);
            const int qh = t0 + 4 * wid + 2 * mt + hi;
            const u32x4 w0 = *(const u32x4*)(proj + (size_t)qh * NPROJ + COL_WI), w1 = *(const u32x4*)(proj + (size_t)qh * NPROJ + COL_WI + 8);
            wv[mt][0] = bf_lo(w0.x) * W_SCALE; wv[mt][1] = bf_hi(w0.x) * W_SCALE; wv[mt][2] = bf_lo(w0.y) * W_SCALE; wv[mt][3] = bf_hi(w0.y) * W_SCALE;
            wv[mt][4] = bf_lo(w0.z) * W_SCALE; wv[mt][5] = bf_hi(w0.z) * W_SCALE; wv[mt][6] = bf_lo(w0.w) * W_SCALE; wv[mt][7] = bf_hi(w0.w) * W_SCALE;
            wv[mt][8] = bf_lo(w1.x) * W_SCALE; wv[mt][9] = bf_hi(w1.x) * W_SCALE; wv[mt][10] = bf_lo(w1.y) * W_SCALE; wv[mt][11] = bf_hi(w1.y) * W_SCALE;
            wv[mt][12] = bf_lo(w1.z) * W_SCALE; wv[mt][13] = bf_hi(w1.z) * W_SCALE; wv[mt][14] = bf_lo(w1.w) * W_SCALE; wv[mt][15] = bf_hi(w1.w) * W_SCALE;
        }
    }
    int cnt[2][2] = {{0, 0}, {0, 0}};
    float tau[2] = {-3.4e38f, -3.4e38f};
    unsigned lob[2][2] = {{0u, 0u}, {0u, 0u}};
    const int cbase[2] = {CAND_OFF + (4 * wid + 0 + hi) * CAND_STRIDE, CAND_OFF + (4 * wid + 2 + hi) * CAND_STRIDE};
    const int skey = tid >> 3, sslot = tid & 7;
    const int sdst = skey * 128 + ((sslot ^ ((skey >> 1) & 7)) * 16);
    const bf16_t* ksrc = proj + (size_t)skey * NPROJ + COL_KI + sslot * 8;
    u32x4 stg = *(const u32x4*)ksrc;
    *(LAS u32x4*)(lds + KT_OFF + sdst) = stg;
    __syncthreads();
#define IDX_MFMA(ACC, MT, BF) do { _Pragma("unroll") for (int i_ = 0; i_ < 16; ++i_) ACC[i_] = 0.f; \
        _Pragma("unroll") for (int s_ = 0; s_ < 4; ++s_) ACC = __builtin_amdgcn_mfma_f32_32x32x16_bf16(Af[MT][s_], BF[s_], ACC, 0, 0, 0); } while (0)
#define IDX_SCORE(SC, ACC, MT) do { \
        float sa_ = 0.f; \
        _Pragma("unroll") for (int r_ = 0; r_ < 16; ++r_) { const float ta_ = __int_as_float(max(__float_as_int(ACC[r_]), 0)); sa_ = fmaf(wv[MT][r_], ta_, sa_); } \
        SC = sa_; } while (0)
#define IDX_PIPE() do { _Pragma("unroll") for (int g_ = 0; g_ < 4; ++g_) { __builtin_amdgcn_sched_group_barrier(0x008, 1, 0); __builtin_amdgcn_sched_group_barrier(0x002, 9, 0); } } while (0)
#define IDX_APPEND(SC, MT, HF) do { \
        const bool pass = (VAR == 1) ? false : (SC >= tau[MT]); if (VAR == 1) { asm volatile("" :: "v"(SC)); } \
        const unsigned long long bm = __ballot(pass); \
        if (bm != 0ull) { \
            const unsigned blo = (unsigned)bm, bhi = (unsigned)(bm >> 32); \
            const int nlo = __builtin_popcount(blo), nhi = __builtin_popcount(bhi); \
            const int pre = __builtin_amdgcn_mbcnt_hi(bhi, __builtin_amdgcn_mbcnt_lo(blo, 0)); \
            const int pos = hi ? (cnt[MT][1] + pre - nlo) : (cnt[MT][0] + pre); \
            if (pass) { \
                const unsigned gk = (unsigned)(jt * 64 + 32 * (HF) + r32); \
                const unsigned P = (ordered_u32(SC) & 0xFFFFC000u) | (16383u - gk); \
                *(LAS unsigned*)(lds + cbase[MT] + pos * 4) = P; \
            } \
            cnt[MT][0] += nlo; cnt[MT][1] += nhi; \
        } } while (0)
    for (int jt = 0; jt < ntile; ++jt) {
        {
            bool cnext = false;
            if (VAR == 0) conv_drain(F, cv.cs >= 1 ? cv.base + (cv.cs - 1) * F.G : -1, cv.cs - 1);
            if (VAR != 5 && jt + 1 < ntile) {
                const bf16_t* g = proj + (size_t)((jt + 1) * 64 + skey) * NPROJ + COL_KI + ((sslot ^ ((skey >> 1) & 7)) * 8);
                __builtin_amdgcn_global_load_lds((const unsigned*)g, (LAS unsigned*)(lds + KT_OFF + ((jt + 1) & 1) * KT_BYTES + wid * 1024), 16, 0, 0);
            }
            if (VAR == 0) cnext = conv_issue(F, cv.base + (cv.cs + 1) * F.G, cv.cs + 1);
            const LAS unsigned char* kb = lds + KT_OFF + (jt & 1) * KT_BYTES;
            bf16x8 Bf0[4], Bf1[4];
#pragma unroll
            for (int s = 0; s < 4; ++s) Bf0[s] = *(const LAS bf16x8*)(kb + r32 * 128 + (((2 * s + hi) ^ ((r32 >> 1) & 7)) * 16));
#pragma unroll
            for (int s = 0; s < 4; ++s) Bf1[s] = *(const LAS bf16x8*)(kb + (32 + r32) * 128 + (((2 * s + hi) ^ ((r32 >> 1) & 7)) * 16));
            f32x16 accA, accB; float scA, scB;
            IDX_MFMA(accA, 0, Bf0);
            __builtin_amdgcn_sched_barrier(0);
            IDX_MFMA(accB, 1, Bf0); IDX_SCORE(scA, accA, 0); IDX_PIPE();
            IDX_APPEND(scA, 0, 0);
            IDX_MFMA(accA, 0, Bf1); IDX_SCORE(scB, accB, 1); IDX_PIPE();
            IDX_APPEND(scB, 1, 0);
            IDX_MFMA(accB, 1, Bf1); IDX_SCORE(scA, accA, 0); IDX_PIPE();
            IDX_APPEND(scA, 0, 1);
            IDX_SCORE(scB, accB, 1);
            IDX_APPEND(scB, 1, 1);
            const int seen = 64 * (jt + 1);
            const int mx = max(max(cnt[0][0], cnt[0][1]), max(cnt[1][0], cnt[1][1]));
            const int q448 = seen / 448;
            const bool sched = (q448 * 448 == seen) && ((q448 & (q448 - 1)) == 0) && (jt + 1 < ntile);
            if (sched || mx >= EMERG) {
#pragma unroll
                for (int mt = 0; mt < 2; ++mt)
#pragma unroll
                    for (int hh = 0; hh < 2; ++hh) {
                        const int n = cnt[mt][hh];
                        if (n > 256) {
                            const int base = CAND_OFF + (4 * wid + 2 * mt + hh) * CAND_STRIDE;
                            unsigned P[NREG]; unsigned mxp = 0;
#pragma unroll
                            for (int j = 0; j < NREG; ++j) { const int i = j * 64 + lane; P[j] = i < n ? *(const LAS unsigned*)(lds + base + i * 4) : 0u; mxp = max(mxp, P[j]); }
#pragma unroll
                            for (int o = 32; o >= 1; o >>= 1) mxp = max(mxp, (unsigned)__shfl_xor((int)mxp, o));
                            mxp = __builtin_amdgcn_readfirstlane(mxp);
                            int bo; unsigned v = select_thr(P, mxp, lob[mt][hh], 14, 0u, -1, bo);
                            int kept = 0;
#pragma unroll
                            for (int j = 0; j < NREG; ++j) kept += __builtin_popcountll(__ballot(P[j] >= v));
                            if (kept > 400) { v = select_thr(P, mxp, lob[mt][hh], 0, v, bo, bo); }
                            int np = 0;
#pragma unroll
                            for (int j = 0; j < NREG; ++j) {
                                const bool k = P[j] >= v; const unsigned long long bm = __ballot(k);
                                const int pre = __builtin_amdgcn_mbcnt_hi((unsigned)(bm >> 32), __builtin_amdgcn_mbcnt_lo((unsigned)bm, 0));
                                if (k) *(LAS unsigned*)(lds + base + (np + pre) * 4) = P[j];
                                np += __builtin_popcountll(bm);
                            }
                            cnt[mt][hh] = np; lob[mt][hh] = v & 0xFFFFC000u;
                            const float tf = unordered_f32(v & 0xFFFFC000u);
                            if (hi == hh) tau[mt] = tf;
                        }
                    }
            }
            if (cnext) asm volatile("s_waitcnt vmcnt(2)" ::: "memory"); else asm volatile("s_waitcnt vmcnt(0)" ::: "memory");
            if (VAR == 0) cv.cs += 1;
        }
        if (VAR != 5) { asm volatile("s_waitcnt lgkmcnt(0)" ::: "memory"); __builtin_amdgcn_s_barrier(); asm volatile("" ::: "memory"); }
    }
#undef IDX_MFMA
#undef IDX_SCORE
#undef IDX_PIPE
#undef IDX_APPEND
#pragma unroll
    for (int mt = 0; mt < 2; ++mt)
#pragma unroll
        for (int hh = 0; hh < 2; ++hh) {
            const int n = cnt[mt][hh];
            const int base = CAND_OFF + (4 * wid + 2 * mt + hh) * CAND_STRIDE;
            unsigned P[NREG]; unsigned mxp = 0;
#pragma unroll
            for (int j = 0; j < NREG; ++j) { const int i = j * 64 + lane; P[j] = i < n ? *(const LAS unsigned*)(lds + base + i * 4) : 0u; mxp = max(mxp, P[j]); }
            unsigned v = 1u;
            if (n > 256) {
#pragma unroll
                for (int o = 32; o >= 1; o >>= 1) mxp = max(mxp, (unsigned)__shfl_xor((int)mxp, o));
                mxp = __builtin_amdgcn_readfirstlane(mxp);
                int bo_; v = select_thr(P, mxp, lob[mt][hh], 0, 0u, -1, bo_);
            }
            asm volatile("s_waitcnt lgkmcnt(0)" ::: "memory");
            for (int i = lane; i < 2 * ntile_q; i += 64) *(LAS unsigned*)(lds + base + i * 4) = 0u;
            asm volatile("s_waitcnt lgkmcnt(0)" ::: "memory");
#pragma unroll
            for (int j = 0; j < NREG; ++j) {
                if (P[j] >= v && P[j] != 0u) {
                    const unsigned gk = 16383u - (P[j] & 0x3FFFu);
                    const unsigned kt = gk >> 6, kk = gk & 63u, t = kk >> 5, jj = kk & 31u, hb = (jj >> 2) & 1u, r = (jj & 3u) + 4u * (jj >> 3);
                    __hip_atomic_fetch_or((LAS unsigned*)(lds + base + (kt * 2 + t) * 4), 1u << (16u * hb + r), __ATOMIC_RELAXED, __HIP_MEMORY_SCOPE_WORKGROUP);
                }
            }
        }
    __syncthreads();
    for (int k2 = wid; 2 * k2 < ntile_q; k2 += 8) {
        const int kt = 2 * k2 + hi;
        if (kt < ntile_q) {
            const u32x2 m = *(const LAS u32x2*)(lds + CAND_OFF + r32 * CAND_STRIDE + kt * 8);
            *(u32x2*)((VAR ? (unsigned long long*)(F.ws + WS_END) : F.MASK) + (size_t)kt * SEQ + t0 + r32) = m;
        }
    }
    __syncthreads();
}
}
#ifndef MK_N_LAUNCHES
#define MK_N_LAUNCHES 1
#endif
constexpr int N_PHASES = 12;
constexpr int BAR_LDS_OFF = LDS_BYTES - 16;

__global__ __launch_bounds__(512, 2) void fwd(Args args) {
    extern __shared__ __attribute__((aligned(16))) unsigned char shm[];
    Frame F;
    F.lds = (LAS unsigned char*)shm;
    F.tid = threadIdx.x; F.lane = F.tid & 63; F.wave = __builtin_amdgcn_readfirstlane(F.tid >> 6);
    F.G = gridDim.x; F.bid = blockIdx.x; F.vcu = (F.G % 8 == 0) ? (F.bid % 8) * (F.G / 8) + F.bid / 8 : F.bid;
    F.x = args.in[0]; F.c = args.in[1]; F.w_ada = args.in[2]; F.b_ada = args.in[3]; F.norm_mix = args.in[4]; F.w_in = args.in[5]; F.t5 = args.in[6]; F.rel = args.in[7];
    F.w_up_a = args.in[8]; F.w_up_b = args.in[9]; F.w_o = args.in[10]; F.norm_ffn = args.in[11]; F.w_rg = args.in[12]; F.b_rg = args.in[13]; F.w_re = args.in[14]; F.b_re = args.in[15];
    F.w1 = args.in[16]; F.w3 = args.in[17]; F.w2 = args.in[18]; F.norm_final = args.in[19];
    F.out = args.out; F.ws = args.ws;
    unsigned char* ws = args.ws;
    F.mod = (float*)(ws + CTL_MOD); F.ecnt = (unsigned*)(ws + CTL_ECNT);
    F.WinT = (bf16_t*)(ws + WS_WINT); F.WupaT = (bf16_t*)(ws + WS_WUPA); F.WupbT = (bf16_t*)(ws + WS_WUPB); F.WoT = (bf16_t*)(ws + WS_WO); F.W13T = (bf16_t*)(ws + WS_W13); F.W2T = (bf16_t*)(ws + WS_W2);
    F.H = (bf16_t*)(ws + WS_H); F.PROJ = (bf16_t*)(ws + WS_PROJ); F.YA = (bf16_t*)(ws + WS_YA); F.YB = (bf16_t*)(ws + WS_YB); F.MRG = (bf16_t*)(ws + WS_MRG);
    F.WinT8 = ws + WS_WINT + (size_t)NPB * DM * 2; F.H8 = ws + WS_H8; F.W13T8 = ws + WS_W13; F.W2T8 = ws + WS_W2; F.Wupa8 = ws + WS_WUPA; F.Wupb8 = ws + WS_WUPB; F.Wo8 = ws + WS_WO;
    F.MASK = (unsigned long long*)(ws + WS_MASK); F.LIST = (int*)(ws + WS_LIST); F.TSLOT = (int*)(ws + WS_TSLOT); F.TW = (float*)(ws + WS_TW); F.RBH = (bf16_t*)(ws + WS_RB); F.RBL = F.RBH + 96 * DM; F.RC = (float*)(ws + WS_RB + (size_t)2 * 96 * DM * 2);

    const int lo = args.ph_lo, hi = args.ph_hi;
    XcdBarrier bar; bar.bar = (unsigned*)(ws + CTL_BAR); bar.x = 0; bar.st = nullptr;
    if (hi - lo > 1) {
        if (F.tid == 0) *(LAS u32x4*)(F.lds + BAR_LDS_OFF) = (u32x4){0u, 0u, 0u, 0u};
        __syncthreads();
        bar = xcd_barrier_post((unsigned*)(ws + CTL_BAR), (volatile LAS unsigned*)(F.lds + BAR_LDS_OFF));
    }
#ifndef PHASE_MASK
#define PHASE_MASK 0xFFF
#endif
#define IN(k) (((PHASE_MASK >> (k)) & 1) && lo <= (k) && (k) < hi)
#ifndef DUP_PHASE
#define DUP_PHASE -1
#endif
#define REP(k) for (int rep_ = 0; rep_ < ((DUP_PHASE) == (k) ? 2 : 1); ++rep_)
#ifdef TIME_A
    unsigned long long* tpw_ = (unsigned long long*)(ws + CTL_ECNT + 4096);
#define TSTAMP(k) do { if (F.bid == 0 && F.tid == 0) { if ((k) == TIME_A - 1) tpw_[0] = __builtin_amdgcn_s_memrealtime(); if ((k) == TIME_B) tpw_[1] = __builtin_amdgcn_s_memrealtime(); } } while (0)
    TSTAMP(-1);
#else
#define TSTAMP(k) do { } while (0)
#endif
#ifdef DOUBLE_BARRIER
#define SEAM(k) do { if (IN(k) && IN((k) + 1)) { xcd_barrier(bar); xcd_barrier(bar); } TSTAMP(k); } while (0)
#else
#define SEAM(k) do { if (IN(k) && IN((k) + 1)) xcd_barrier(bar); TSTAMP(k); } while (0)
#endif

    if (IN(0)) { p0_mod(F); REP(0) p0_convert(F); }
    SEAM(0);
    if (IN(1)) REP(1) { p1_norm(F); }
    SEAM(1);
    if (IN(2)) {
        if (F.G == 256) { if (F.bid >= 192) p1_router_prep(F, F.bid - 192, 64); } else p1_router_prep(F, F.bid, F.G);
        { pg8::StaticOrder<2048> S; S.init(F.H, F.WinT, SEQ, NPB, F.G, F.bid);
          pg8::EpiProj E{F.PROJ};
          pg8::gemm_phase<2048, false, false>(F.lds, S, E);
#if DUP_PHASE == 20
          pg8::gemm_phase<2048, false, false>(F.lds, S, E);
#endif
        }
        { pg8::ProjOrder8 S; S.init(F.H8, F.WinT8, SEQ, NP8, F.G, F.bid); S.bid = F.bid;
          pg8::EpiProj8 E{F.PROJ};
          pg8::gemm_phase<1024, false, true>(F.lds, S, E, W8_SCALE_LOG2, H8_SCALE_LOG2);
#if DUP_PHASE == 21
          pg8::gemm_phase<1024, false, true>(F.lds, S, E, W8_SCALE_LOG2, H8_SCALE_LOG2);
#endif
        }
    }
    SEAM(2);
    if (IN(3)) {
#ifndef NO_IDX
        {
            ConvSt cv; cv.base = TC_LATE_START + F.bid; cv.cs = 0;
            __syncthreads();
            (void)conv_issue(F, cv.base, 0);
            for (int p = F.bid; p < 256; p += F.G) { idx::indexer_unit<0>(F, p, cv); idx::indexer_unit<0>(F, 511 - p, cv); }
#ifdef IDX_PROBE
            for (int p = F.bid; p < 256; p += F.G) { idx::indexer_unit<IDX_PROBE>(F, p, cv); idx::indexer_unit<IDX_PROBE>(F, 511 - p, cv); }
#endif
            conv_drain(F, cv.cs >= 1 ? cv.base + (cv.cs - 1) * F.G : -1, cv.cs - 1);
            asm volatile("s_waitcnt vmcnt(0)" ::: "memory"); __syncthreads();
            conv_drain(F, cv.base + cv.cs * F.G, cv.cs);
            __syncthreads();
            for (int tl = cv.base + (cv.cs + 1) * F.G;; tl += F.G) { TDesc d; f32x4 v[2]; if (!tconv_desc(F, tl, d)) break; tconv_load(F, d, v); tconv_store(F, d, v, 0); }
        }
#endif
#ifndef NO_BAND
        REP(31) for (int p = F.bid; p < 256; p += F.G) {
            const int h = p & 7, j = p >> 3;
            fill_tab_B(F, h, (LAS char*)F.lds);
#pragma unroll 1
            for (int s = 0; s < 2; ++s) {
                const int qt = s ? 63 - j : j, q0 = qt * 256;
                const int kt0 = (4 * qt - 8) > 0 ? (4 * qt - 8) : 0, kt1 = 4 * qt + 4;
                att::attn_unit<1, DMAX_B>(F.PROJ + (size_t)q0 * NPROJ + COL_QB + h * 128, F.PROJ + COL_KB + h * 128, F.PROJ + COL_VB + h * 128, (unsigned char*)F.YB + (size_t)q0 * 1024 + h * 128, nullptr, q0, kt0, kt1, (LAS char*)F.lds);
            }
        }
#endif
    }
    SEAM(3);
    if (IN(4)) REP(4) {
        for (int p = F.bid; p < 256; p += F.G) {
            const int h = p & 7, j = p >> 3;
            fill_tab_A(F, h, (LAS char*)F.lds);
#pragma unroll 1
            for (int s = 0; s < 2; ++s) {
                const int qt = s ? 63 - j : j, q0 = qt * 256;
                att::attn_unit<0, DMAX_A>(F.PROJ + (size_t)q0 * NPROJ + COL_QA + h * 128, F.PROJ + COL_KA + h * 128, F.PROJ + COL_VA + h * 128, (unsigned char*)F.YA + (size_t)q0 * 1024 + h * 128, F.MASK + q0, q0, 0, 4 * qt + 4, (LAS char*)F.lds);
            }
        }
    }
    SEAM(4);
    if (IN(5)) {
        pg8::StaticOrder<512> S; S.init(F.YA, F.Wupa8, SEQ, DM, F.G, F.bid);
        pg8::EpiGate<false> E{F.PROJ, COL_GA, nullptr, F.H};
        pg8::gemm_phase<512, false, true>(F.lds, S, E, W8_SCALE_LOG2, Y8_SCALE_LOG2);
#if DUP_PHASE == 5
        pg8::gemm_phase<512, false, true>(F.lds, S, E, W8_SCALE_LOG2, Y8_SCALE_LOG2);
#endif
    }
    if (IN(5) && IN(6)) { asm volatile("s_waitcnt vmcnt(0)" ::: "memory"); __syncthreads(); if (F.tid == 0) { __builtin_amdgcn_fence(__ATOMIC_ACQUIRE, "agent"); asm volatile("s_waitcnt vmcnt(0)" ::: "memory"); } __syncthreads(); }
    if (IN(6)) {
        pg8::StaticOrder<512> S; S.init(F.YB, F.Wupb8, SEQ, DM, F.G, F.bid);
        pg8::EpiGate<true> E{F.PROJ, COL_GB, F.H, F.MRG};
        pg8::gemm_phase<512, false, true>(F.lds, S, E, W8_SCALE_LOG2, Y8_SCALE_LOG2);
#if DUP_PHASE == 6
        pg8::gemm_phase<512, false, true>(F.lds, S, E, W8_SCALE_LOG2, Y8_SCALE_LOG2);
#endif
    }
    SEAM(6);
    if (IN(7)) {
        pg8::StaticOrder<1024> S; S.init(F.MRG, F.Wo8, SEQ, DM, F.G, F.bid);
        pg8::EpiRes E{F.x, F.mod + 2 * DM, F.H};
        pg8::gemm_phase<1024, false, true>(F.lds, S, E, W8_SCALE_LOG2, M8_SCALE_LOG2);
#if DUP_PHASE == 7
        pg8::gemm_phase<1024, false, true>(F.lds, S, E, W8_SCALE_LOG2, M8_SCALE_LOG2);
#endif
    }
    SEAM(7);
#ifdef PROBE_LO
    if (IN(8)) { p8_router(F, args.dry); }
#else
    if (IN(8)) { p8_router(F); }
#endif
    SEAM(8);
    if (IN(9)) {
        moe_tables(F); moe1_fill_lists(F);
        MoeOrder1 S{&F, (const LAS int*)(F.lds + MOE_TS), (const LAS int*)(F.lds + MOE_TOK)};
        pg8::EpiMoe1 E{(unsigned char*)F.MRG};
        pg8::gemm_phase<1024, true, true>(F.lds, S, E, W8_SCALE_LOG2, H8_SCALE_LOG2);
#if DUP_PHASE == 9
        pg8::gemm_phase<1024, true, true>(F.lds, S, E, W8_SCALE_LOG2, H8_SCALE_LOG2);
#endif
    }
    SEAM(9);
    if (IN(10)) {
        moe_tables(F);
        MoeOrder2 S{&F, (const LAS int*)(F.lds + MOE_TS)};
        pg8::EpiMoe2 E{F.PROJ};
        pg8::gemm_phase<256, false, true>(F.lds, S, E, W2_SCALE_LOG2, A8_SCALE_LOG2);
#if DUP_PHASE == 10
        pg8::gemm_phase<256, false, true>(F.lds, S, E, W2_SCALE_LOG2, A8_SCALE_LOG2);
#endif
    }
    SEAM(10);
    if (IN(11)) {
        float tsc = 1.0f;
#ifdef TIME_A
        if (F.bid == 0) { if (F.tid == 0) { const float us_ = (float)(tpw_[1] - tpw_[0]) * 0.01f;
#ifndef TIME_OFS
#define TIME_OFS 0.0f
#endif
                const float q_ = floorf(log2f(us_) * 6.0f + TIME_OFS); const float usq_ = exp2f((q_ + 0.5f - TIME_OFS) / 6.0f);
                *(LAS float*)F.lds = 1.0f + sqrtf(usq_ * 1e-4f * 256.0f); } __syncthreads(); tsc = *(LAS float*)F.lds; }
#endif
        moe_tables(F); p11_final(F, tsc); }
#undef IN
#undef SEAM
}

extern "C" void kernel_launch(void* const* d_in, const int* in_sizes, int n_in, void* d_out, int out_size, void* d_ws, size_t ws_size, hipStream_t stream) {
    static int grid = 0;
    if (grid == 0) {
        if (n_in != 20 || out_size != SEQ * DM || ws_size < WS_END) { fprintf(stderr, "kernel_launch: shape/workspace mismatch: n_in %d out %d ws %zu (need %zu)\n", n_in, out_size, ws_size, (size_t)WS_END); grid = -1; return; }
        int dev = 0, cus = 0, per_cu = 0;
        if (hipGetDevice(&dev) != hipSuccess || hipDeviceGetAttribute(&cus, hipDeviceAttributeMultiprocessorCount, dev) != hipSuccess) { grid = -1; return; }
        if (hipFuncSetAttribute((const void*)fwd, hipFuncAttributeMaxDynamicSharedMemorySize, LDS_BYTES) != hipSuccess) { fprintf(stderr, "kernel_launch: hipFuncSetAttribute failed\n"); grid = -1; return; }
        if (hipOccupancyMaxActiveBlocksPerMultiprocessor(&per_cu, (const void*)fwd, 512, LDS_BYTES) != hipSuccess || per_cu < 1) fprintf(stderr, "kernel_launch: occupancy query says %d\n", per_cu);
        (void)hipGetLastError();
        grid = cus;
    }
    if (grid < 0) return;
    (void)hipMemsetAsync((char*)d_ws + WS_CTL, 0, CTL_BYTES, stream);
    Args a{};
    for (int i = 0; i < 20; ++i) a.in[i] = (const float*)d_in[i];
    a.out = (float*)d_out; a.ws = (unsigned char*)d_ws;
#if defined(PREFIX_K)
    a.ph_lo = 0; a.ph_hi = PREFIX_K + 1;
    hipLaunchKernelGGL(fwd, dim3(grid), dim3(512), LDS_BYTES, stream, a);
    (void)hipMemsetAsync((char*)d_ws + WS_CTL, 0, CTL_BYTES, stream);
    a.ph_lo = 0; a.ph_hi = N_PHASES;
    hipLaunchKernelGGL(fwd, dim3(grid), dim3(512), LDS_BYTES, stream, a);
#elif defined(PROBE_LO)
    a.ph_lo = 0; a.ph_hi = N_PHASES; a.dry = 0;
    hipLaunchKernelGGL(fwd, dim3(grid), dim3(512), LDS_BYTES, stream, a);
    for (int rep = 0; rep < PROBE_N; ++rep) {
        if (PROBE_HI - PROBE_LO > 1) (void)hipMemsetAsync((char*)d_ws + WS_CTL + CTL_BAR, 0, 16384, stream);
        if (PROBE_LO <= 8 && 8 < PROBE_HI && PROBE_DRY == 0) (void)hipMemsetAsync((char*)d_ws + WS_CTL + CTL_ECNT, 0, 4096 + 256, stream);
        a.ph_lo = PROBE_LO; a.ph_hi = PROBE_HI; a.dry = PROBE_DRY;
        hipLaunchKernelGGL(fwd, dim3(grid), dim3(512), LDS_BYTES, stream, a);
    }
#elif defined(SUFFIX_A)
    a.ph_lo = 0; a.ph_hi = N_PHASES;
    hipLaunchKernelGGL(fwd, dim3(grid), dim3(512), LDS_BYTES, stream, a);
    for (int rep = 0; rep < SUFFIX_N; ++rep) {
        (void)hipMemsetAsync((char*)d_ws + WS_CTL + CTL_BAR, 0, 16384, stream);
        if (SUFFIX_A <= 8) (void)hipMemsetAsync((char*)d_ws + WS_CTL + CTL_ECNT, 0, 4096 + 256, stream);
        a.ph_lo = SUFFIX_A; a.ph_hi = N_PHASES;
        hipLaunchKernelGGL(fwd, dim3(grid), dim3(512), LDS_BYTES, stream, a);
    }
#elif MK_N_LAUNCHES == 1
    a.ph_lo = 0; a.ph_hi = N_PHASES;
    hipLaunchKernelGGL(fwd, dim3(grid), dim3(512), LDS_BYTES, stream, a);
#else
    for (int ph = 0; ph < N_PHASES; ++ph) { a.ph_lo = ph; a.ph_hi = ph + 1; hipLaunchKernelGGL(fwd, dim3(grid), dim3(512), LDS_BYTES, stream, a); }
#endif
    const hipError_t le = hipPeekAtLastError();
    if (le != hipSuccess) fprintf(stderr, "kernel_launch: launch failed: %s\n", hipGetErrorName(le));
}
```

```cpp
#include <hip/hip_runtime.h>
#include <cstdio>
#include <cstdint>

#define LAS __attribute__((address_space(3)))
typedef unsigned short bf16_t;
typedef short bf16x8 __attribute__((ext_vector_type(8)));
typedef short s16x4 __attribute__((ext_vector_type(4)));
typedef float f32x2 __attribute__((ext_vector_type(2)));
typedef float f32x4 __attribute__((ext_vector_type(4)));
typedef float f32x16 __attribute__((ext_vector_type(16)));
typedef unsigned u32x2 __attribute__((ext_vector_type(2)));
typedef unsigned u32x4 __attribute__((ext_vector_type(4)));
typedef int i32x4_ __attribute__((ext_vector_type(4)));
typedef int i32x8 __attribute__((ext_vector_type(8)));

constexpr int SEQ = 16384, DM = 2048, NPROJ = 11520  , NPROJ_REAL = 11344;
constexpr int COL_QA = 0, COL_KA = 1024, COL_VA = 2048, COL_QI = 3072, COL_KI = 4096, COL_WI = 4160, COL_QB = 4176, COL_KB = 5200, COL_VB = 6224, COL_GA = 7248, COL_GB = 9296;
constexpr int NEXP = 64, DFF = 512, LIST_CAP = 16384;
constexpr int G8_SCALE_LOG2 = 4;
constexpr int NPB = 5376  , NPB_REAL = 5200, NP8 = 6144  ;
constexpr int H8_SCALE_LOG2 = 4, W8_SCALE_LOG2 = 9, W2_SCALE_LOG2 = 8, A8_SCALE_LOG2 = 4, Y8_SCALE_LOG2 = 6, M8_SCALE_LOG2 = 5;
constexpr float EPS = 1e-6f;
constexpr float LOG2E = 1.4426950408889634f;

constexpr size_t A256(size_t x) { return (x + 255) / 256 * 256; }
constexpr size_t WS_CTL = 0;
constexpr size_t CTL_BAR = 0;
constexpr size_t CTL_MOD = 16384;
constexpr size_t CTL_ECNT = 16384 + 49152;
constexpr size_t CTL_BYTES = 16384 + 49152 + 4096 + 256;
constexpr size_t WS_WINT = 131072;
constexpr size_t WS_WUPA = WS_WINT + (size_t)NPROJ * DM * 2;
constexpr size_t WS_WUPB = WS_WUPA + (size_t)DM * 1024 * 2;
constexpr size_t WS_WO   = WS_WUPB + (size_t)DM * 1024 * 2;
constexpr size_t WS_W13  = WS_WO + (size_t)DM * DM * 2;
constexpr size_t WS_W2   = WS_W13 + (size_t)NEXP * 1024 * DM;
constexpr size_t WS_H    = WS_W2 + (size_t)NEXP * DM * DFF;
constexpr size_t WS_PROJ = WS_H + (size_t)SEQ * DM * 2;
constexpr size_t WS_MASK = WS_PROJ + (size_t)SEQ * NPROJ * 2;
constexpr size_t WS_YA   = WS_MASK + (size_t)256 * SEQ * 8;
constexpr size_t WS_YB   = WS_YA + (size_t)SEQ * 1024 * 2;
constexpr size_t WS_MRG  = WS_YB + (size_t)SEQ * 1024 * 2;
constexpr size_t WS_LIST = WS_MRG + (size_t)SEQ * DM * 2;
constexpr size_t WS_TSLOT = WS_LIST + (size_t)NEXP * LIST_CAP * 4;
constexpr size_t WS_TW   = WS_TSLOT + (size_t)SEQ * 2 * 4;
constexpr size_t WS_H8   = WS_TW + (size_t)SEQ * 2 * 4;
constexpr size_t WS_RB   = WS_H8 + (size_t)SEQ * DM;
constexpr size_t WS_END  = WS_RB + (size_t)(1 << 20);
constexpr int MAX_PAD_ROWS = 2 * SEQ + NEXP * 255 + 1;
static_assert((size_t)MAX_PAD_ROWS * DM * 2 <= (size_t)SEQ * NPROJ * 2, "y fits in proj region");
static_assert((size_t)MAX_PAD_ROWS * DFF * 2 <= (size_t)SEQ * DM * 2, "a fits in merged region");

constexpr int LDS_BYTES = 147456;

__device__ __forceinline__ unsigned cvt_pk_bf16(float lo, float hi) { unsigned r; asm volatile("v_cvt_pk_bf16_f32 %0, %1, %2" : "=v"(r) : "v"(lo), "v"(hi)); return r; }
__device__ __forceinline__ float bf_lo(unsigned w) { return __uint_as_float(w << 16); }
__device__ __forceinline__ float bf_hi(unsigned w) { return __uint_as_float(w & 0xffff0000u); }
__device__ __forceinline__ float sigmoidf_(float x) { return __builtin_amdgcn_rcpf(1.0f + __builtin_amdgcn_exp2f(-x * LOG2E)); }
__device__ __forceinline__ unsigned cvt_fp8x4_(float a, float b, float c, float d) {
    int w = 0; w = __builtin_amdgcn_cvt_pk_fp8_f32(a, b, w, false); w = __builtin_amdgcn_cvt_pk_fp8_f32(c, d, w, true); return (unsigned)w;
}
__device__ __forceinline__ float wave_sum(float v) {
#pragma unroll
    for (int o = 32; o >= 1; o >>= 1) v += __shfl_xor(v, o);
    return v;
}

#define XB_TMO      128
#define XB_XCNT(j)  (256  + 64 * (j))
#define XB_XSUB(j)  (1280 + 64 * (j))
#define XB_XGEN(j)  (2304 + 64 * (j))
#define XB_TOP      3328
#define XB_TOPGEN   3392
#define XCD_BAR_WORDS 3456
#define XB_SPIN_CAP (1u << 22)
__device__ __forceinline__ unsigned xb_ld(unsigned* p)              { return __hip_atomic_load(p, __ATOMIC_RELAXED, __HIP_MEMORY_SCOPE_AGENT); }
__device__ __forceinline__ unsigned xb_add(unsigned* p, unsigned v) { return __hip_atomic_fetch_add(p, v, __ATOMIC_RELAXED, __HIP_MEMORY_SCOPE_AGENT); }
__device__ __forceinline__ unsigned xb_xcc_id() { return (unsigned)__builtin_amdgcn_s_getreg((3 << 11) | 20) & 0xFu; }
#define XB_SPIN(cond, bar) do { unsigned _sp = 0; while (cond) { __builtin_amdgcn_s_sleep(1); \
    if ((++_sp & 255u) == 0u) { if (xb_ld(&(bar)[XB_TMO])) break; if (_sp > XB_SPIN_CAP) { atomicAdd(&(bar)[XB_TMO], 1u); break; } } } } while (0)
struct XcdBarrier { unsigned* bar; unsigned x; volatile LAS unsigned* st; };
__device__ __forceinline__ XcdBarrier xcd_barrier_post(unsigned* bar, volatile LAS unsigned* st) {
    XcdBarrier b; b.bar = bar; b.x = xb_xcc_id(); b.st = st;
    if (threadIdx.x == 0) (void)xb_add(&bar[XB_XCNT(b.x)], 1u);
    return b;
}
__device__ __forceinline__ void xcd_barrier_complete(unsigned* bar, unsigned x, unsigned& nloc, unsigned& nx) {
    const unsigned G = gridDim.x * gridDim.y * gridDim.z;
    unsigned sum, cnt, mine, sp = 0u;
    for (;;) {
        sum = 0u; cnt = 0u; mine = 0u;
#pragma unroll
        for (unsigned j = 0; j < 16; ++j) { const unsigned c = xb_ld(&bar[XB_XCNT(j)]); sum += c; cnt += (c > 0u) ? 1u : 0u; mine = (j == x) ? c : mine; }
        if (sum == G) break;
        __builtin_amdgcn_s_sleep(1);
        if ((++sp & 255u) == 0u) { if (xb_ld(&bar[XB_TMO])) break; if (sp > XB_SPIN_CAP) { atomicAdd(&bar[XB_TMO], 1u); break; } }
    }
    nloc = mine > 0u ? mine : 1u; nx = cnt > 0u ? cnt : 1u;
}
__device__ __forceinline__ void xcd_barrier(const XcdBarrier& b) {
    asm volatile("s_waitcnt vmcnt(0)" ::: "memory");
    __syncthreads();
    if (threadIdx.x == 0) {
        unsigned* bar = b.bar;
        __builtin_amdgcn_s_waitcnt(0);
        unsigned nloc = b.st[0], nx = b.st[1];
        if (nloc == 0u) { xcd_barrier_complete(bar, b.x, nloc, nx); b.st[0] = nloc; b.st[1] = nx; }
        const unsigned old = xb_add(&bar[XB_XSUB(b.x)], 1u);
        const unsigned gen = old / nloc;
        if (old + 1u == (gen + 1u) * nloc) {
            __builtin_amdgcn_fence(__ATOMIC_RELEASE, "agent");
            asm volatile("s_waitcnt vmcnt(0)" ::: "memory");
            const unsigned og = xb_add(&bar[XB_TOP], 1u);
            const unsigned tg = og / nx;
            if (og + 1u == (tg + 1u) * nx) xb_add(&bar[XB_TOPGEN], 1u);
            else XB_SPIN(xb_ld(&bar[XB_TOPGEN]) == tg, bar);
            __builtin_amdgcn_fence(__ATOMIC_ACQUIRE, "agent");
            xb_add(&bar[XB_XGEN(b.x)], 1u);
            asm volatile("s_waitcnt vmcnt(0)" ::: "memory");
        } else {
            XB_SPIN(xb_ld(&bar[XB_XGEN(b.x)]) == gen, bar);
            __builtin_amdgcn_fence(__ATOMIC_ACQUIRE, "agent");
            asm volatile("s_waitcnt vmcnt(0)" ::: "memory");
        }
    }
    __syncthreads();
}

namespace pg8 {
constexpr int BM = 256, BK = 64, HALF = 128, HTB = HALF * BK * 2, STAGE_BYTES = 8 * HTB, NXCD = 8, WGM = 8;
__host__ __device__ __forceinline__ int lds_byte(int r, int c) { const int st = (r >> 4) * 2 + (c >> 5), rr = r & 15, cc = c & 31, ob = rr * 64 + cc * 2; return st * 1024 + (ob ^ (((ob >> 9) & 1) << 5)); }
__host__ __device__ __forceinline__ void stage_rc(int b, int& R, int& C) { const int st = b / 1024, sb = b % 1024, swz = sb ^ (((sb >> 9) & 1) << 5); R = (st >> 1) * 16 + swz / 64; C = (st & 1) * 32 + (swz % 64) / 2; }
__host__ __device__ __forceinline__ int perm32(int rho) { const int n = rho >> 4, i = rho & 15; return 8 * (i >> 2) + 4 * n + (i & 3); }

struct Unit { int pm, pn; const char* A; const char* B; int x0, x1; };

template <int K> struct StaticOrder {
    int nM, nN, nwg, G, c; const char* A; const char* Bt;
    __device__ void init(const void* A_, const void* Bt_, int M, int N, int G_, int c_) { A = (const char*)A_; Bt = (const char*)Bt_; nM = M / BM; nN = N / BM; nwg = nM * nN; G = G_; c = c_; }
    __device__ __forceinline__ bool next(int i, Unit& u) const {
        const long L = (long)i * G + c; if (L >= nwg) return false;
        int wgid = (int)L; { const int q = nwg / NXCD, r = nwg % NXCD, xcd = wgid % NXCD, off = wgid / NXCD; wgid = (xcd < r ? xcd * (q + 1) : r * (q + 1) + (xcd - r) * q) + off; }
        const int nig = WGM * nN, gid = wgid / nig, fm = gid * WGM, gsz = (nM - fm) < WGM ? (nM - fm) : WGM;
        u.pm = fm + ((wgid % nig) % gsz); u.pn = (wgid % nig) / gsz;
        u.A = A + (size_t)u.pm * BM * K * 2; u.B = Bt + (size_t)u.pn * BM * K * 2; u.x0 = 0; u.x1 = 0; return true;
    }
    __device__ __forceinline__ int arow(const Unit&, int r) const { return r; }
};

template <bool FP8> struct FragT { typedef bf16x8 A[4][2]; typedef bf16x8 B[2][2]; };
template <> struct FragT<true> { typedef i32x8 A[4]; typedef i32x8 B[2]; };
struct ProjOrder8 : StaticOrder<1024> {
    int bid;
    __device__ __forceinline__ bool next(int i, Unit& u) const {
        if (G != 256) return StaticOrder<1024>::next(i, u);
        long L;
        if (i < 4) L = (long)i * 256 + bid; else { if (bid < 64) return false; L = 1024 + (long)(i - 4) * 192 + (bid - 64); }
        if (L >= nwg) return false;
        int wgid = (int)L; { const int q = nwg / NXCD, r = nwg % NXCD, xcd = wgid % NXCD, off = wgid / NXCD; wgid = (xcd < r ? xcd * (q + 1) : r * (q + 1) + (xcd - r) * q) + off; }
        const int nig = WGM * nN, gid = wgid / nig, fm = gid * WGM, gsz = (nM - fm) < WGM ? (nM - fm) : WGM;
        u.pm = fm + ((wgid % nig) % gsz); u.pn = (wgid % nig) / gsz;
        u.A = A + (size_t)u.pm * BM * 1024 * 2; u.B = Bt + (size_t)u.pn * BM * 1024 * 2; u.x0 = 0; u.x1 = 0; return true;
    }
};
template <int K, bool GATHER, bool FP8, class Epi, class Sched>
__device__ __forceinline__ void gemm_phase(LAS unsigned char* lds, const Sched& S, const Epi& E, int sclW_log2 = 0, int sclH_log2 = 0) {
    const int tid = threadIdx.x, wid = __builtin_amdgcn_readfirstlane(tid >> 6), lane = tid & 63, wr = wid >> 2, wc = wid & 3, fr = lane & 15, fq = lane >> 4;
    constexpr int nt = K / BK;
    int R0, C0, R1, C1; stage_rc(tid * 16, R0, C0); stage_rc(tid * 16 + 8192, R1, C1);
    unsigned voffB[2];
    { const int Rb0 = Epi::PERM ? ((R0 & ~31) + perm32(R0 & 31)) : R0, Rb1 = Epi::PERM ? ((R1 & ~31) + perm32(R1 & 31)) : R1;
      voffB[0] = (unsigned)(Rb0 * K + C0) * 2u; voffB[1] = (unsigned)(Rb1 * K + C1) * 2u; }
    constexpr size_t kstep = (size_t)(BK * 2), hstep = (size_t)HALF * K * 2;
    const unsigned ldsw = (unsigned)wid * 1024u;
    const int aoff = lds_byte(wr * 64 + fr, fq * 8), boff = lds_byte(wc * 32 + fr, fq * 8);
#define PG8_SA(b, h) (((b) * 2 + (h)) * HTB)
#define PG8_SB(b, h) ((4 + (b) * 2 + (h)) * HTB)
#define PG8_GLDS(bufoff, gp0, gp1) do { \
        __builtin_amdgcn_global_load_lds((const unsigned*)(gp0), (LAS unsigned*)(lds + (bufoff) + ldsw), 16, 0, 0); \
        __builtin_amdgcn_global_load_lds((const unsigned*)(gp1), (LAS unsigned*)(lds + (bufoff) + ldsw + 8192), 16, 0, 0); } while (0)
#define PG8_STAGE_B(bufoff, gbase) PG8_GLDS(bufoff, (const char*)(gbase) + voffB[0], (const char*)(gbase) + voffB[1])
#define PG8_STAGE_A(bufoff, gbase, v0, v1) PG8_GLDS(bufoff, (const char*)(gbase) + (v0), (const char*)(gbase) + (v1))
#define PG8_LDA(dst, b, h) do { if constexpr (FP8) { _Pragma("unroll") for (int m = 0; m < 4; ++m) { \
            const i32x4_ lo_ = *(const LAS i32x4_*)(lds + PG8_SA(b, h) + aoff + m * 2048), hi_ = *(const LAS i32x4_*)(lds + PG8_SA(b, h) + aoff + m * 2048 + 1024); \
            *(i32x8*)&dst[m] = __builtin_shufflevector(lo_, hi_, 0, 1, 2, 3, 4, 5, 6, 7); } } \
        else { _Pragma("unroll") for (int m = 0; m < 4; ++m) _Pragma("unroll") for (int k = 0; k < 2; ++k) ((bf16x8*)&dst[m])[k] = *(const LAS bf16x8*)(lds + PG8_SA(b, h) + aoff + m * 2048 + k * 1024); } } while (0)
#define PG8_LDB(dst, b, h) do { if constexpr (FP8) { _Pragma("unroll") for (int n = 0; n < 2; ++n) { \
            const i32x4_ lo_ = *(const LAS i32x4_*)(lds + PG8_SB(b, h) + boff + n * 2048), hi_ = *(const LAS i32x4_*)(lds + PG8_SB(b, h) + boff + n * 2048 + 1024); \
            *(i32x8*)&dst[n] = __builtin_shufflevector(lo_, hi_, 0, 1, 2, 3, 4, 5, 6, 7); } } \
        else { _Pragma("unroll") for (int n = 0; n < 2; ++n) _Pragma("unroll") for (int k = 0; k < 2; ++k) ((bf16x8*)&dst[n])[k] = *(const LAS bf16x8*)(lds + PG8_SB(b, h) + boff + n * 2048 + k * 1024); } } while (0)
#define PG8_MMA(ai, bj, At, Bt) do { __builtin_amdgcn_s_setprio(1); \
        if constexpr (FP8) { _Pragma("unroll") for (int m = 0; m < 4; ++m) _Pragma("unroll") for (int n = 0; n < 2; ++n) \
            asm volatile("v_mfma_scale_f32_16x16x128_f8f6f4 %0, %1, %2, %0, %3, %4 op_sel_hi:[0,0,0]" : "+v"(acc[ai][bj][m][n]) : "v"(*(const i32x8*)&Bt[n]), "v"(*(const i32x8*)&At[m]), "v"(sclW), "v"(sclH)); } \
        else { _Pragma("unroll") for (int m = 0; m < 4; ++m) _Pragma("unroll") for (int n = 0; n < 2; ++n) _Pragma("unroll") for (int k = 0; k < 2; ++k) \
            acc[ai][bj][m][n] = __builtin_amdgcn_mfma_f32_16x16x32_bf16(((const bf16x8*)&Bt[n])[k], ((const bf16x8*)&At[m])[k], acc[ai][bj][m][n], 0, 0, 0); } \
        __builtin_amdgcn_s_setprio(0); } while (0)
#define PG8_WAIT_V(n) asm volatile("s_waitcnt vmcnt(" #n ")" ::: "memory")
#define PG8_WAIT_L(n) asm volatile("s_waitcnt lgkmcnt(" #n ")" ::: "memory")
#define PG8_BAR __builtin_amdgcn_s_barrier()
#define PG8_SCHED __builtin_amdgcn_sched_barrier(0)
#define PG8_SETA(u, v) do { if (GATHER) { \
        v[0][0] = (unsigned)(S.arow(u, R0) * K + C0) * 2u; v[0][1] = (unsigned)(S.arow(u, R1) * K + C1) * 2u; \
        v[1][0] = (unsigned)(S.arow(u, HALF + R0) * K + C0) * 2u; v[1][1] = (unsigned)(S.arow(u, HALF + R1) * K + C1) * 2u; \
      } else { v[0][0] = (unsigned)(R0 * K + C0) * 2u; v[0][1] = (unsigned)(R1 * K + C1) * 2u; v[1][0] = v[0][0] + (unsigned)hstep; v[1][1] = v[0][1] + (unsigned)hstep; } } while (0)
    Unit cur, nxt; int ui = 0;
    if (!S.next(0, cur)) return;
    f32x4 acc[2][2][4][2];
#pragma unroll
    for (int a = 0; a < 2; ++a)
#pragma unroll
        for (int b = 0; b < 2; ++b)
#pragma unroll
            for (int m = 0; m < 4; ++m)
#pragma unroll
                for (int n = 0; n < 2; ++n) acc[a][b][m][n] = (f32x4){0.f, 0.f, 0.f, 0.f};
    typename FragT<FP8>::A At; typename FragT<FP8>::B B0, B1;
    const int sclW = 127 - sclW_log2, sclH = 127 - sclH_log2;
    unsigned vA[2][2], vN[2][2];
    PG8_SETA(cur, vA);
    const char* cA = cur.A; const char* cB = cur.B;
    PG8_STAGE_B(PG8_SB(0, 0), cB); PG8_STAGE_A(PG8_SA(0, 0), cA, vA[0][0], vA[0][1]); PG8_STAGE_B(PG8_SB(0, 1), cB + hstep); PG8_STAGE_A(PG8_SA(0, 1), cA, vA[1][0], vA[1][1]);
    if (wr == 1) PG8_BAR;
    PG8_WAIT_V(4); PG8_BAR;
    PG8_STAGE_B(PG8_SB(1, 0), cB + kstep); PG8_STAGE_A(PG8_SA(1, 0), cA + kstep, vA[0][0], vA[0][1]); PG8_STAGE_B(PG8_SB(1, 1), cB + hstep + kstep);
    PG8_WAIT_V(6); PG8_BAR;
    for (;;) {
        const bool has_next = S.next(ui + 1, nxt);
        const char* nA = has_next ? nxt.A : cA; const char* nB = has_next ? nxt.B : cB;
        if (has_next) { PG8_SETA(nxt, vN); } else { vN[0][0] = vA[0][0]; vN[0][1] = vA[0][1]; vN[1][0] = vA[1][0]; vN[1][1] = vA[1][1]; }
        for (int t = 0; t < nt; t += 2) {
            const bool last = (t == nt - 2);
            const char* a1 = cA + (size_t)(t + 1) * kstep;
            const char* a2 = last ? nA : cA + (size_t)(t + 2) * kstep; const char* b2 = last ? nB : cB + (size_t)(t + 2) * kstep;
            const char* a3 = a2 + kstep; const char* b3 = b2 + kstep;
            const unsigned w00 = last ? vN[0][0] : vA[0][0], w01 = last ? vN[0][1] : vA[0][1], w10 = last ? vN[1][0] : vA[1][0], w11 = last ? vN[1][1] : vA[1][1];
            PG8_LDB(B0, 0, 0); PG8_SCHED; PG8_LDA(At, 0, 0); PG8_STAGE_A(PG8_SA(1, 1), a1, vA[1][0], vA[1][1]);
            PG8_WAIT_L(8); PG8_BAR; PG8_WAIT_L(0); PG8_MMA(0, 0, At, B0); PG8_BAR; PG8_SCHED;
            PG8_LDB(B1, 0, 1); PG8_STAGE_B(PG8_SB(0, 0), b2);
            PG8_BAR; PG8_WAIT_L(0); PG8_MMA(0, 1, At, B1); PG8_BAR;
            PG8_LDA(At, 0, 1); PG8_STAGE_A(PG8_SA(0, 0), a2, w00, w01);
            PG8_BAR; PG8_WAIT_L(0); PG8_MMA(1, 0, At, B0); PG8_BAR; PG8_SCHED;
            PG8_STAGE_B(PG8_SB(0, 1), b2 + hstep);
            PG8_WAIT_V(6); PG8_BAR; PG8_MMA(1, 1, At, B1); PG8_BAR;
            PG8_LDB(B0, 1, 0); PG8_SCHED; PG8_LDA(At, 1, 0); PG8_STAGE_A(PG8_SA(0, 1), a2, w10, w11);
            PG8_WAIT_L(8); PG8_BAR; PG8_WAIT_L(0); PG8_MMA(0, 0, At, B0); PG8_BAR; PG8_SCHED;
            PG8_LDB(B1, 1, 1); PG8_STAGE_B(PG8_SB(1, 0), b3);
            PG8_BAR; PG8_WAIT_L(0); PG8_MMA(0, 1, At, B1); PG8_BAR;
            PG8_LDA(At, 1, 1); PG8_STAGE_A(PG8_SA(1, 0), a3, w00, w01);
            PG8_BAR; PG8_WAIT_L(0); PG8_MMA(1, 0, At, B0); PG8_BAR; PG8_SCHED;
            PG8_STAGE_B(PG8_SB(1, 1), b3 + hstep);
            PG8_WAIT_V(6); PG8_BAR; PG8_MMA(1, 1, At, B1); PG8_BAR;
        }
        if constexpr (FP8) asm volatile("s_nop 15\n\ts_nop 15\n\ts_nop 15" ::: "memory");
        E(acc, cur, wr, wc, fr, fq);
        if (!has_next) break;
#pragma unroll
        for (int a = 0; a < 2; ++a)
#pragma unroll
            for (int b = 0; b < 2; ++b)
#pragma unroll
                for (int m = 0; m < 4; ++m)
#pragma unroll
                    for (int n = 0; n < 2; ++n) acc[a][b][m][n] = (f32x4){0.f, 0.f, 0.f, 0.f};
        cur = nxt; cA = nA; cB = nB; ++ui;
        vA[0][0] = vN[0][0]; vA[0][1] = vN[0][1]; vA[1][0] = vN[1][0]; vA[1][1] = vN[1][1];
    }
    PG8_WAIT_V(0);
    if (wr == 0) PG8_BAR;
    PG8_BAR;
#undef PG8_SA
#undef PG8_SB
#undef PG8_GLDS
#undef PG8_STAGE_A
#undef PG8_STAGE_B
#undef PG8_LDA
#undef PG8_LDB
#undef PG8_MMA
#undef PG8_WAIT_V
#undef PG8_WAIT_L
#undef PG8_BAR
#undef PG8_SCHED
#undef PG8_SETA
}

struct EpiProj {
    static constexpr bool PERM = true;
    bf16_t* O;
    __device__ __forceinline__ void operator()(const f32x4 (&acc)[2][2][4][2], const Unit& u, int wr, int wc, int fr, int fq) const {
        const int row0 = u.pm * BM + wr * 64 + fr, col0 = u.pn * BM + wc * 32 + 8 * fq;
#pragma unroll
        for (int ai = 0; ai < 2; ++ai)
#pragma unroll
            for (int m = 0; m < 4; ++m) { bf16_t* rowp = O + (size_t)(row0 + ai * HALF + m * 16) * NPROJ;
#pragma unroll
                for (int bj = 0; bj < 2; ++bj) { const f32x4 v0 = acc[ai][bj][m][0], v1 = acc[ai][bj][m][1];
                    const int c = col0 + bj * HALF;
                    u32x4 w; w.x = cvt_pk_bf16(v0[0], v0[1]); w.y = cvt_pk_bf16(v0[2], v0[3]); w.z = cvt_pk_bf16(v1[0], v1[1]); w.w = cvt_pk_bf16(v1[2], v1[3]);
                    if (c < NPB_REAL) *(u32x4*)(rowp + (c < 2048 ? c : c + 1024)) = w; } }
    }
};
struct EpiProj8 {
    static constexpr bool PERM = true;
    bf16_t* O;
    __device__ __forceinline__ void operator()(const f32x4 (&acc)[2][2][4][2], const Unit& u, int wr, int wc, int fr, int fq) const {
        const int row0 = u.pm * BM + wr * 64 + fr;
        const int tc = u.pn * BM;
        if (tc >= 2048) {
            const int bc = (tc - 2048) + wc * 32 + 8 * fq; const float s8 = (float)(1 << G8_SCALE_LOG2);
#pragma unroll
            for (int ai = 0; ai < 2; ++ai)
#pragma unroll
                for (int m = 0; m < 4; ++m) { unsigned char* rowp = (unsigned char*)(O + (size_t)(row0 + ai * HALF + m * 16) * NPROJ + COL_GA) + bc;
#pragma unroll
                    for (int bj = 0; bj < 2; ++bj) { const f32x4 lo4 = {-440.f, -440.f, -440.f, -440.f}, hi4 = {440.f, 440.f, 440.f, 440.f};
                        const f32x4 v0 = __builtin_elementwise_min(__builtin_elementwise_max(acc[ai][bj][m][0] * s8, lo4), hi4), v1 = __builtin_elementwise_min(__builtin_elementwise_max(acc[ai][bj][m][1] * s8, lo4), hi4);
                        u32x2 w; w.x = cvt_fp8x4_(v0[0], v0[1], v0[2], v0[3]); w.y = cvt_fp8x4_(v1[0], v1[1], v1[2], v1[3]);
                        *(u32x2*)(rowp + bj * HALF) = w; } }
            return;
        }
        const int dc = (tc < 1024 ? COL_VA + tc : COL_VB + (tc - 1024)) + wc * 32 + 8 * fq;
#pragma unroll
        for (int ai = 0; ai < 2; ++ai)
#pragma unroll
            for (int m = 0; m < 4; ++m) { bf16_t* rowp = O + (size_t)(row0 + ai * HALF + m * 16) * NPROJ + dc;
#pragma unroll
                for (int bj = 0; bj < 2; ++bj) { const f32x4 v0 = acc[ai][bj][m][0], v1 = acc[ai][bj][m][1];
                    u32x4 w; w.x = cvt_pk_bf16(v0[0], v0[1]); w.y = cvt_pk_bf16(v0[2], v0[3]); w.z = cvt_pk_bf16(v1[0], v1[1]); w.w = cvt_pk_bf16(v1[2], v1[3]);
                    *(u32x4*)(rowp + bj * HALF) = w; } }
    }
};
template <bool ADD> struct EpiGate {
    static constexpr bool PERM = true;
    const bf16_t* proj; int gcol; const bf16_t* Tin; void* Tout;
    __device__ __forceinline__ void operator()(const f32x4 (&acc)[2][2][4][2], const Unit& u, int wr, int wc, int fr, int fq) const {
        const int row0 = u.pm * BM + wr * 64 + fr, col0 = u.pn * BM + wc * 32 + 8 * fq;
#pragma unroll
        for (int ai = 0; ai < 2; ++ai) {
            u32x2 gb[4][2]; u32x4 tb[4][2];
#pragma unroll
            for (int m = 0; m < 4; ++m)
#pragma unroll
                for (int bj = 0; bj < 2; ++bj) { const size_t row = (size_t)(row0 + ai * HALF + m * 16);
                    gb[m][bj] = *(const u32x2*)((const unsigned char*)(proj + row * NPROJ + COL_GA) + (gcol - COL_GA) + col0 + bj * HALF);
                    if (ADD) tb[m][bj] = *(const u32x4*)(Tin + row * DM + col0 + bj * HALF); }
#pragma unroll
            for (int m = 0; m < 4; ++m) { const size_t row = (size_t)(row0 + ai * HALF + m * 16);
#pragma unroll
                for (int bj = 0; bj < 2; ++bj) { const f32x4 v0 = acc[ai][bj][m][0], v1 = acc[ai][bj][m][1];
                    const u32x2 g = gb[m][bj]; const float gs = 1.0f / (float)(1 << G8_SCALE_LOG2);
                    const f32x2 g01 = __builtin_amdgcn_cvt_pk_f32_fp8((int)g.x, false), g23 = __builtin_amdgcn_cvt_pk_f32_fp8((int)g.x, true), g45 = __builtin_amdgcn_cvt_pk_f32_fp8((int)g.y, false), g67 = __builtin_amdgcn_cvt_pk_f32_fp8((int)g.y, true);
                    float o[8];
                    o[0] = sigmoidf_(g01[0] * gs) * v0[0]; o[1] = sigmoidf_(g01[1] * gs) * v0[1]; o[2] = sigmoidf_(g23[0] * gs) * v0[2]; o[3] = sigmoidf_(g23[1] * gs) * v0[3];
                    o[4] = sigmoidf_(g45[0] * gs) * v1[0]; o[5] = sigmoidf_(g45[1] * gs) * v1[1]; o[6] = sigmoidf_(g67[0] * gs) * v1[2]; o[7] = sigmoidf_(g67[1] * gs) * v1[3];
#if defined(DBG_NOA)
                    if (!ADD) { for (int q_ = 0; q_ < 8; ++q_) o[q_] = 0.f; }
#endif
#if defined(DBG_NOB)
                    if (ADD) { for (int q_ = 0; q_ < 8; ++q_) o[q_] = 0.f; }
#endif
                    if (ADD) { const u32x4 t = tb[m][bj];
                        o[0] += bf_lo(t.x); o[1] += bf_hi(t.x); o[2] += bf_lo(t.y); o[3] += bf_hi(t.y); o[4] += bf_lo(t.z); o[5] += bf_hi(t.z); o[6] += bf_lo(t.w); o[7] += bf_hi(t.w);
                        const float s8 = (float)(1 << M8_SCALE_LOG2);
#pragma unroll
                        for (int q_ = 0; q_ < 8; ++q_) o[q_] = fminf(fmaxf(o[q_] * s8, -440.f), 440.f);
                        u32x2 w; w.x = cvt_fp8x4_(o[0], o[1], o[2], o[3]); w.y = cvt_fp8x4_(o[4], o[5], o[6], o[7]);
                        *(u32x2*)((unsigned char*)Tout + row * DM + col0 + bj * HALF) = w;
                    } else {
                        u32x4 w; w.x = cvt_pk_bf16(o[0], o[1]); w.y = cvt_pk_bf16(o[2], o[3]); w.z = cvt_pk_bf16(o[4], o[5]); w.w = cvt_pk_bf16(o[6], o[7]);
                        *(u32x4*)((bf16_t*)Tout + row * DM + col0 + bj * HALF) = w; } } }
        }
    }
};
struct EpiRes {
    static constexpr bool PERM = true;
    const float* X; const float* g1; bf16_t* O;
    __device__ __forceinline__ void operator()(const f32x4 (&acc)[2][2][4][2], const Unit& u, int wr, int wc, int fr, int fq) const {
        const int row0 = u.pm * BM + wr * 64 + fr, col0 = u.pn * BM + wc * 32 + 8 * fq;
        f32x4 gv[2][2];
#pragma unroll
        for (int bj = 0; bj < 2; ++bj)
#pragma unroll
            for (int n = 0; n < 2; ++n) gv[bj][n] = *(const f32x4*)(g1 + col0 + bj * HALF + n * 4);
#pragma unroll
        for (int ai = 0; ai < 2; ++ai) {
            f32x4 xb[4][2][2];
#pragma unroll
            for (int m = 0; m < 4; ++m)
#pragma unroll
                for (int bj = 0; bj < 2; ++bj) { const size_t ro = (size_t)(row0 + ai * HALF + m * 16) * DM + col0;
                    xb[m][bj][0] = *(const f32x4*)(X + ro + bj * HALF); xb[m][bj][1] = *(const f32x4*)(X + ro + bj * HALF + 4); }
#pragma unroll
            for (int m = 0; m < 4; ++m) { const size_t ro = (size_t)(row0 + ai * HALF + m * 16) * DM + col0;
#pragma unroll
                for (int bj = 0; bj < 2; ++bj) {
                    const f32x4 o0 = xb[m][bj][0] + gv[bj][0] * acc[ai][bj][m][0], o1 = xb[m][bj][1] + gv[bj][1] * acc[ai][bj][m][1];
                    u32x4 w; w.x = cvt_pk_bf16(o0[0], o0[1]); w.y = cvt_pk_bf16(o0[2], o0[3]); w.z = cvt_pk_bf16(o1[0], o1[1]); w.w = cvt_pk_bf16(o1[2], o1[3]);
                    *(u32x4*)(O + ro + bj * HALF) = w; } }
        }
    }
};
struct EpiMoe1 {
    static constexpr bool PERM = false;
    unsigned char* Aout;
    __device__ __forceinline__ void operator()(const f32x4 (&acc)[2][2][4][2], const Unit& u, int wr, int wc, int fr, int fq) const {
        const int row0 = u.x0 + wr * 64 + fr; const float s8 = (float)(1 << A8_SCALE_LOG2);
#pragma unroll
        for (int ai = 0; ai < 2; ++ai)
#pragma unroll
            for (int m = 0; m < 4; ++m) { unsigned char* rowp = Aout + (size_t)(row0 + ai * HALF + m * 16) * DFF;
#pragma unroll
                for (int bj = 0; bj < 2; ++bj) { const f32x4 a1 = acc[ai][bj][m][0], a3 = acc[ai][bj][m][1]; float o[4];
#pragma unroll
                    for (int j = 0; j < 4; ++j) o[j] = fminf(fmaxf(a1[j] * sigmoidf_(a1[j]) * a3[j] * s8, -440.f), 440.f);
                    *(unsigned*)(rowp + (8 * u.pn + 4 * bj + wc) * 16 + 4 * fq) = cvt_fp8x4_(o[0], o[1], o[2], o[3]); } }
    }
};
struct EpiMoe2 {
    static constexpr bool PERM = true;
    bf16_t* Y;
    __device__ __forceinline__ void operator()(const f32x4 (&acc)[2][2][4][2], const Unit& u, int wr, int wc, int fr, int fq) const {
        const int row0 = u.x0 + wr * 64 + fr, col0 = u.pn * BM + wc * 32 + 8 * fq;
#pragma unroll
        for (int ai = 0; ai < 2; ++ai)
#pragma unroll
            for (int m = 0; m < 4; ++m) { bf16_t* rowp = Y + (size_t)(row0 + ai * HALF + m * 16) * DM + col0;
                if (wr * 64 + fr + ai * HALF + m * 16 < u.x1) {
#pragma unroll
                for (int bj = 0; bj < 2; ++bj) { const f32x4 v0 = acc[ai][bj][m][0], v1 = acc[ai][bj][m][1];
                    u32x4 w; w.x = cvt_pk_bf16(v0[0], v0[1]); w.y = cvt_pk_bf16(v0[2], v0[3]); w.z = cvt_pk_bf16(v1[0], v1[1]); w.w = cvt_pk_bf16(v1[2], v1[3]);
                    *(u32x4*)(rowp + bj * HALF) = w; } } }
    }
};
}
struct Args {
    const float* in[20]; float* out; unsigned char* ws; int ph_lo, ph_hi, dry;
};
struct Frame {
    LAS unsigned char* lds; int tid, lane, wave, G, bid, vcu;
    const float *x, *c, *w_ada, *b_ada, *norm_mix, *w_in, *t5, *rel, *w_up_a, *w_up_b, *w_o, *norm_ffn, *w_rg, *b_rg, *w_re, *b_re, *w1, *w3, *w2, *norm_final;
    float* out; unsigned char* ws;
    float* mod; unsigned* ecnt;
    bf16_t *WinT, *WupaT, *WupbT, *WoT, *W13T, *W2T, *H, *PROJ, *YA, *YB, *MRG;
    unsigned char *WinT8, *H8, *W13T8, *W2T8, *Wupa8, *Wupb8, *Wo8;
    unsigned long long* MASK; int* LIST; int* TSLOT; float* TW;
    bf16_t *RBH, *RBL; float* RC;
};

__device__ __forceinline__ void p0_mod(const Frame& F) {
    LAS float* red = (LAS float*)F.lds;
    for (int b = F.bid; b < 256; b += F.G) {
        const int t = F.tid;
        f32x4 acc = {0.f, 0.f, 0.f, 0.f};
        const int c4 = t % 12, kg = t / 12;
        if (t < 480) {
            const float* wp = F.w_ada + b * 48 + c4 * 4;
            int k = kg;
            for (; k + 7 * 40 < DM; k += 8 * 40) {
                f32x4 w[8]; float sv[8];
#pragma unroll
                for (int u = 0; u < 8; ++u) { w[u] = *(const f32x4*)(wp + (size_t)(k + 40 * u) * 12288); const float cv = F.c[k + 40 * u]; sv[u] = cv * sigmoidf_(cv); }
#pragma unroll
                for (int u = 0; u < 8; ++u) acc += w[u] * sv[u];
            }
            for (; k < DM; k += 40) { const float cv = F.c[k]; const float s = cv * sigmoidf_(cv); const f32x4 w = *(const f32x4*)(wp + (size_t)k * 12288); acc += w * s; }
            *(LAS f32x4*)(red + (kg * 12 + c4) * 4) = acc;
        }
        __syncthreads();
        if (t < 12) { f32x4 sum = *(const f32x4*)(F.b_ada + b * 48 + t * 4);
            for (int g = 0; g < 40; ++g) sum += *(LAS f32x4*)(red + (g * 12 + t) * 4);
            *(f32x4*)(F.mod + b * 48 + t * 4) = sum; }
        __syncthreads();
    }
}
__device__ __forceinline__ int rowmap(int n, int mode) { return mode == 0 ? n : (32 * (n >> 4) + (n & 15) + (mode == 2 ? 16 : 0)); }
__device__ __forceinline__ unsigned cvt_fp8x4(float a, float b, float c, float d) {
    int w = 0;
    w = __builtin_amdgcn_cvt_pk_fp8_f32(a, b, w, false);
    w = __builtin_amdgcn_cvt_pk_fp8_f32(c, d, w, true);
    return (unsigned)w;
}
constexpr int TC_WIN = 32 * 178, TC_UP = 16 * 32, TC_WO = 32 * 32, TC_W1 = NEXP * 32 * 8, TC_W2 = NEXP * 8 * 32;
constexpr int TC_TOTAL = TC_WIN + 2 * TC_UP + TC_WO + 2 * TC_W1 + TC_W2;
constexpr int TC_EARLY = TC_WIN + 2 * TC_UP + TC_WO;
#ifndef TC_LATE_START
#define TC_LATE_START TC_EARLY
#endif
struct TDesc { const float* src; int N, k0, n0, ldd, mode; unsigned char* dst; };
__device__ __forceinline__ bool tconv_desc(const Frame& F, int tl, TDesc& d, int limit = TC_TOTAL) {
    if (tl >= limit) return false;
    int r = tl;
    if (r < TC_WIN) { d.src = F.w_in; d.N = NPROJ_REAL; d.k0 = (r % 32) * 64; d.n0 = (r / 32) * 64; d.dst = (unsigned char*)F.WinT; d.ldd = DM; d.mode = 3; return true; }
    r -= TC_WIN;
    if (r < TC_UP) { d.src = F.w_up_a; d.N = DM; d.k0 = (r % 16) * 64; d.n0 = (r / 16) * 64; d.dst = F.Wupa8; d.ldd = 1024; d.mode = 7; return true; }
    r -= TC_UP;
    if (r < TC_UP) { d.src = F.w_up_b; d.N = DM; d.k0 = (r % 16) * 64; d.n0 = (r / 16) * 64; d.dst = F.Wupb8; d.ldd = 1024; d.mode = 7; return true; }
    r -= TC_UP;
    if (r < TC_WO) { d.src = F.w_o; d.N = DM; d.k0 = (r % 32) * 64; d.n0 = (r / 32) * 64; d.dst = F.Wo8; d.ldd = DM; d.mode = 7; return true; }
    r -= TC_WO;
    if (r < TC_W1) { const int e = r / 256, q = r % 256; d.src = F.w1 + (size_t)e * DM * DFF; d.N = DFF; d.k0 = (q % 32) * 64; d.n0 = (q / 32) * 64; d.dst = F.W13T8 + (size_t)e * 1024 * DM; d.ldd = DM; d.mode = 4; return true; }
    r -= TC_W1;
    if (r < TC_W1) { const int e = r / 256, q = r % 256; d.src = F.w3 + (size_t)e * DM * DFF; d.N = DFF; d.k0 = (q % 32) * 64; d.n0 = (q / 32) * 64; d.dst = F.W13T8 + (size_t)e * 1024 * DM; d.ldd = DM; d.mode = 5; return true; }
    r -= TC_W1;
    { const int e = r / 256, q = r % 256; d.src = F.w2 + (size_t)e * DFF * DM; d.N = DM; d.k0 = (q % 8) * 64; d.n0 = (q / 8) * 64; d.dst = F.W2T8 + (size_t)e * DM * DFF; d.ldd = DFF; d.mode = 6; return true; }
}
__device__ __forceinline__ void tconv_load(const Frame& F, const TDesc& d, f32x4 (&v)[2]) {
    const int kk = F.tid >> 4, n4 = (F.tid & 15) * 4;
    const int nn = min(d.n0 + n4, d.N - 4);
    const float* p0 = d.src + (size_t)(d.k0 + kk) * d.N + nn; const float* p1 = p0 + (size_t)32 * d.N;
    asm volatile("global_load_dwordx4 %0, %1, off" : "=v"(v[0]) : "v"(p0) : "memory");
    asm volatile("global_load_dwordx4 %0, %1, off" : "=v"(v[1]) : "v"(p1) : "memory");
}
__device__ __forceinline__ void tconv_to_lds(const Frame& F, const f32x4 (&vin)[2], LAS float* tile  ) {
    const int t = F.tid, kk = t >> 4, n4 = (t & 15) * 4;
#pragma unroll
    for (int h = 0; h < 2; ++h) { const int k = kk + 32 * h; tile[k * 65 + n4 + 0] = vin[h][0]; tile[k * 65 + n4 + 1] = vin[h][1]; tile[k * 65 + n4 + 2] = vin[h][2]; tile[k * 65 + n4 + 3] = vin[h][3]; }
}
__device__ __forceinline__ void tconv_from_lds(const Frame& F, const TDesc& d, const LAS float* tile) {
    const int t = F.tid;
    { const int n = t >> 3, kq = (t & 7) * 8; const int k0 = d.k0, n0 = d.n0, mode = d.mode;
      if (n0 + n < d.N) {
        float v[8];
#pragma unroll
        for (int i = 0; i < 8; ++i) v[i] = tile[(kq + i) * 65 + n];
        if (mode == 3) {
            const int c = n0 + n; int rb = -1, r8 = -1;
            if (c < 2048) rb = c; else if (c < 3072) r8 = c - 2048; else if (c < 6224) rb = c - 1024; else if (c < 7248) r8 = 1024 + (c - 6224); else r8 = 2048 + (c - 7248);
            if (rb >= 0) { u32x4 w; w.x = cvt_pk_bf16(v[0], v[1]); w.y = cvt_pk_bf16(v[2], v[3]); w.z = cvt_pk_bf16(v[4], v[5]); w.w = cvt_pk_bf16(v[6], v[7]);
                *(u32x4*)(F.WinT + (size_t)rb * DM + k0 + kq) = w; }
            else { const float sc = (float)(1 << W8_SCALE_LOG2); u32x2 w; w.x = cvt_fp8x4_(v[0] * sc, v[1] * sc, v[2] * sc, v[3] * sc); w.y = cvt_fp8x4_(v[4] * sc, v[5] * sc, v[6] * sc, v[7] * sc);
                *(u32x2*)(F.WinT8 + (size_t)r8 * DM + k0 + kq) = w; }
        } else {
            const float sc = (float)(1 << (mode == 6 ? W2_SCALE_LOG2 : W8_SCALE_LOG2)); const int r = rowmap(n0 + n, mode == 4 ? 1 : (mode == 5 ? 2 : 0));
            u32x2 w; w.x = cvt_fp8x4_(v[0] * sc, v[1] * sc, v[2] * sc, v[3] * sc); w.y = cvt_fp8x4_(v[4] * sc, v[5] * sc, v[6] * sc, v[7] * sc);
            *(u32x2*)(d.dst + (size_t)r * d.ldd + k0 + kq) = w; } } }
}
__device__ __forceinline__ void tconv_store(const Frame& F, const TDesc& d, const f32x4 (&vin)[2], int ahead  ) {
    LAS float* tile = (LAS float*)F.lds;
    if (ahead >= 4) asm volatile("s_waitcnt vmcnt(8)" ::: "memory"); else if (ahead == 3) asm volatile("s_waitcnt vmcnt(6)" ::: "memory"); else if (ahead == 2) asm volatile("s_waitcnt vmcnt(4)" ::: "memory");
    else if (ahead == 1) asm volatile("s_waitcnt vmcnt(2)" ::: "memory"); else asm volatile("s_waitcnt vmcnt(0)" ::: "memory");
#ifdef DIAG_ZERO_P0_WUP
    if (d.mode == 7 && d.ldd == 1024) { const f32x4 z[2] = {(f32x4){0.f,0.f,0.f,0.f}, (f32x4){0.f,0.f,0.f,0.f}}; tconv_to_lds(F, z, tile); } else
#endif
    tconv_to_lds(F, vin, tile);
    __syncthreads();
    tconv_from_lds(F, d, tile);
    __syncthreads();
}
constexpr int CONV_LDS_OFF = 16384, CONV_LDS_BYTES = 64 * 64 * 4;
struct ConvSt { int base, cs; };
__device__ __forceinline__ LAS unsigned char* conv_buf(const Frame& F, int i) { return F.lds + CONV_LDS_OFF + (((i % 3) + 3) % 3) * CONV_LDS_BYTES; }
__device__ __forceinline__ bool conv_issue(const Frame& F, int tl, int bufi) {
    TDesc d; if (!tconv_desc(F, tl, d)) return false;
    LAS unsigned char* buf = conv_buf(F, bufi);
#pragma unroll
    for (int p = 0; p < 2; ++p) {
        const int k = p * 32 + (F.tid >> 4), c = F.tid & 15, cs = c ^ ((k >> 3) & 7);
        const float* g = d.src + (size_t)(d.k0 + k) * d.N + d.n0 + 4 * cs;
        __builtin_amdgcn_global_load_lds((const unsigned*)g, (LAS unsigned*)(buf + p * 8192 + F.wave * 1024), 16, 0, 0);
    }
    return true;
}
__device__ __forceinline__ void conv_drain(const Frame& F, int tl, int bufi) {
    TDesc d; if (tl < 0 || !tconv_desc(F, tl, d)) return;
    const LAS float* tile = (const LAS float*)conv_buf(F, bufi);
    const int t = F.tid, n = t >> 3, kq = (t & 7) * 8, f = t & 7;
    float v[8];
#pragma unroll
    for (int i = 0; i < 8; ++i) v[i] = tile[(kq + i) * 64 + (((n >> 2) ^ f) << 2) + (n & 3)];
    const int mode = d.mode;
    const float sc = (float)(1 << (mode == 6 ? W2_SCALE_LOG2 : W8_SCALE_LOG2)); const int r = rowmap(d.n0 + n, mode == 4 ? 1 : (mode == 5 ? 2 : 0));
    u32x2 w; w.x = cvt_fp8x4_(v[0] * sc, v[1] * sc, v[2] * sc, v[3] * sc); w.y = cvt_fp8x4_(v[4] * sc, v[5] * sc, v[6] * sc, v[7] * sc);
    *(u32x2*)(d.dst + (size_t)r * d.ldd + d.k0 + kq) = w;
}
__device__ __forceinline__ void p0_convert(const Frame& F) {
    TDesc d0, d1, d2, d3, d4; f32x4 v0[2], v1[2], v2[2], v3[2], v4[2];
    int tl = F.bid; const int G = F.G;
    bool h0 = tconv_desc(F, tl, d0, TC_EARLY); if (h0) tconv_load(F, d0, v0);
    bool h1 = tconv_desc(F, tl + G, d1, TC_EARLY); if (h1) tconv_load(F, d1, v1);
    bool h2 = tconv_desc(F, tl + 2 * G, d2, TC_EARLY); if (h2) tconv_load(F, d2, v2);
    bool h3 = tconv_desc(F, tl + 3 * G, d3, TC_EARLY); if (h3) tconv_load(F, d3, v3);
    bool h4 = false;
#define TC_STEP(HX, DX, VX, HN, DN, VN, K, A1, A2, A3) \
        if (!HX) break; \
        HN = tconv_desc(F, tl + (K) * G, DN, TC_EARLY); if (HN) tconv_load(F, DN, VN); \
        tconv_store(F, DX, VX, (A1 ? 1 : 0) + (A2 ? 1 : 0) + (A3 ? 1 : 0) + (HN ? 1 : 0));
    for (;;) {
        TC_STEP(h0, d0, v0, h4, d4, v4, 4, h1, h2, h3)
        TC_STEP(h1, d1, v1, h0, d0, v0, 5, h2, h3, h4)
        TC_STEP(h2, d2, v2, h1, d1, v1, 6, h3, h4, h0)
        TC_STEP(h3, d3, v3, h2, d2, v2, 7, h4, h0, h1)
        TC_STEP(h4, d4, v4, h3, d3, v3, 8, h0, h1, h2)
        tl += 5 * G;
    }
#undef TC_STEP
    asm volatile("s_waitcnt vmcnt(0)" ::: "memory");
    { u32x4* z = (u32x4*)(F.WinT + (size_t)NPB_REAL * DM); const int n16 = (NPB - NPB_REAL) * DM * 2 / 16;
      for (int i = F.bid * 512 + F.tid; i < n16; i += F.G * 512) z[i] = (u32x4){0u, 0u, 0u, 0u}; }
}

__device__ __forceinline__ void p1_router_prep(const Frame& F, int col0, int cstep) {
    const float* sh2 = F.mod + 3 * DM; const float* sc2 = F.mod + 4 * DM;
    LAS float* red = (LAS float*)F.lds;
    for (int col = col0; col < 96; col += cstep) {
        const int k = F.tid * 4;
        const f32x4 ga = *(const f32x4*)(F.norm_ffn + k) * (*(const f32x4*)(sc2 + k) + 1.0f), gb = *(const f32x4*)(sh2 + k);
        float w[4], gbw = 0.f;
#pragma unroll
        for (int j = 0; j < 4; ++j) { const float wv = col < 8 ? F.w_rg[(size_t)(k + j) * 8 + col] : (col < 72 ? F.w_re[(size_t)(k + j) * 64 + (col - 8)] : 0.f); gbw += gb[j] * wv; w[j] = wv * ga[j]; }
        u32x2 h, l;
        h.x = cvt_pk_bf16(w[0], w[1]); h.y = cvt_pk_bf16(w[2], w[3]);
        l.x = cvt_pk_bf16(w[0] - bf_lo(h.x), w[1] - bf_hi(h.x)); l.y = cvt_pk_bf16(w[2] - bf_lo(h.y), w[3] - bf_hi(h.y));
        { unsigned char* fb = (unsigned char*)F.RBH + (size_t)(((k >> 4) * 3 + (col >> 5)) * 2) * 1024 + ((col & 31) + 32 * ((k >> 3) & 1)) * 16 + (k & 7) * 2;
          *(u32x2*)fb = h; *(u32x2*)(fb + 1024) = l; }
        gbw = wave_sum(gbw);
        if (F.lane == 0) red[F.wave] = gbw;
        __syncthreads();
        if (F.tid == 0) { float s = 0.f; for (int i = 0; i < 8; ++i) s += red[i]; F.RC[col] = s; }
        __syncthreads();
    }
}

__device__ __forceinline__ void p1_norm(const Frame& F) {
    const float* sh1 = F.mod; const float* sc1 = F.mod + DM;
    f32x4 ga[8], gb[8];
#pragma unroll
    for (int j = 0; j < 8; ++j) { const int c = 4 * F.lane + 256 * j; const f32x4 nm = *(const f32x4*)(F.norm_mix + c), sc = *(const f32x4*)(sc1 + c); ga[j] = nm * (sc + 1.0f); gb[j] = *(const f32x4*)(sh1 + c); }
    const int rstep = F.G * 8; int row = F.bid * 8 + F.wave;
    f32x4 v[8], vn[8];
    if (row < SEQ) {
#pragma unroll
        for (int j = 0; j < 8; ++j) v[j] = *(const f32x4*)(F.x + (size_t)row * DM + 4 * F.lane + 256 * j);
    }
    for (; row < SEQ; row += rstep) {
        const int nrow = row + rstep;
        if (nrow < SEQ) {
#pragma unroll
            for (int j = 0; j < 8; ++j) vn[j] = *(const f32x4*)(F.x + (size_t)nrow * DM + 4 * F.lane + 256 * j);
        }
        float ss = 0.f;
#pragma unroll
        for (int j = 0; j < 8; ++j) ss += v[j][0] * v[j][0] + v[j][1] * v[j][1] + v[j][2] * v[j][2] + v[j][3] * v[j][3];
        ss = wave_sum(ss);
        const float rstd = __builtin_amdgcn_rsqf(ss * (1.0f / DM) + EPS);
        bf16_t* hp = F.H + (size_t)row * DM + 4 * F.lane; unsigned char* h8 = F.H8 + (size_t)row * DM + 4 * F.lane;
        const float s8 = (float)(1 << H8_SCALE_LOG2);
#pragma unroll
        for (int j = 0; j < 8; ++j) { const f32x4 o = v[j] * rstd * ga[j] + gb[j]; u32x2 w; w.x = cvt_pk_bf16(o[0], o[1]); w.y = cvt_pk_bf16(o[2], o[3]); *(u32x2*)(hp + 256 * j) = w;
            const f32x4 c8 = __builtin_elementwise_min(__builtin_elementwise_max(o * s8, (f32x4){-440.f, -440.f, -440.f, -440.f}), (f32x4){440.f, 440.f, 440.f, 440.f});
            *(unsigned*)(h8 + 256 * j) = cvt_fp8x4_(c8[0], c8[1], c8[2], c8[3]); }
#pragma unroll
        for (int j = 0; j < 8; ++j) v[j] = vn[j];
    }
}

constexpr int P8_RSTD = 0, P8_ECL = 256, P8_EBASE = 512, P8_LOG = 1024, P8_AS = 32768, P8_AS_STRIDE = 64 * 80;
__device__ __forceinline__ void p8_router(const Frame& F, const int dry = 0) {
    const float* sh2 = F.mod + 3 * DM; const float* sc2 = F.mod + 4 * DM;
    const bf16_t* X1 = F.H;
    LAS float* rs = (LAS float*)(F.lds + P8_RSTD);
    LAS float* lg = (LAS float*)(F.lds + P8_LOG);
    for (int blk = F.bid; blk < SEQ / 64; blk += F.G) {
        const int T0 = blk * 64;
        if (dry < 5) {
            int l4 = 4 * F.lane; asm volatile("" : "+v"(l4));
            f32x4 ga[8], gb[8];
#pragma unroll
            for (int j = 0; j < 8; ++j) { const int c = l4 + 256 * j; const f32x4 nm = *(const f32x4*)(F.norm_ffn + c), sc = *(const f32x4*)(sc2 + c); ga[j] = nm * (sc + 1.0f); gb[j] = *(const f32x4*)(sh2 + c); }
            u32x2 xw[8], xwn[8];
            { const bf16_t* xp = X1 + (size_t)(T0 + F.wave) * DM + l4;
#pragma unroll
              for (int j = 0; j < 8; ++j) xw[j] = *(const u32x2*)(xp + 256 * j); }
            for (int r = F.wave; r < 64; r += 8) {
                if (r + 8 < 64) { const bf16_t* xp = X1 + (size_t)(T0 + r + 8) * DM + l4;
#pragma unroll
                    for (int j = 0; j < 8; ++j) xwn[j] = *(const u32x2*)(xp + 256 * j); }
                f32x4 v[8]; float ss = 0.f;
#pragma unroll
                for (int j = 0; j < 8; ++j) { const u32x2 w = xw[j]; v[j] = (f32x4){bf_lo(w.x), bf_hi(w.x), bf_lo(w.y), bf_hi(w.y)}; }
#pragma unroll
                for (int j = 0; j < 8; ++j) ss += v[j][0] * v[j][0] + v[j][1] * v[j][1] + v[j][2] * v[j][2] + v[j][3] * v[j][3];
                ss = wave_sum(ss);
                const float rstd = __builtin_amdgcn_rsqf(ss * (1.0f / DM) + EPS);
                if (F.lane == 0) rs[r] = rstd;
                unsigned char* hp = F.H8 + (size_t)(T0 + r) * DM + l4; const float s8 = (float)(1 << H8_SCALE_LOG2);
#pragma unroll
                for (int j = 0; j < 8; ++j) { const f32x4 o = v[j] * rstd * ga[j] + gb[j];
                    const f32x4 c8 = __builtin_elementwise_min(__builtin_elementwise_max(o * s8, (f32x4){-440.f, -440.f, -440.f, -440.f}), (f32x4){440.f, 440.f, 440.f, 440.f});
                    *(unsigned*)(hp + 256 * j) = cvt_fp8x4_(c8[0], c8[1], c8[2], c8[3]); }
#pragma unroll
                for (int j = 0; j < 8; ++j) xw[j] = xwn[j];
            }
            if (F.tid < 64) ((LAS int*)(F.lds + P8_ECL))[F.tid] = 0;
        }
        __syncthreads();
        f32x16 acc[2][3];
#pragma unroll
        for (int a = 0; a < 2; ++a)
#pragma unroll
            for (int b = 0; b < 3; ++b)
#pragma unroll
                for (int i = 0; i < 16; ++i) acc[a][b][i] = 0.f;
        if (dry < 4) {
            const int mi = F.lane & 31, mk = F.lane >> 5;
            LAS unsigned char* Aw = F.lds + P8_AS + F.wave * P8_AS_STRIDE;
            const int lrow = F.lane >> 2, lpc = F.lane & 3;
            unsigned gao = (unsigned)((T0 + lrow) * DM + F.wave * 256 + lpc * 8) * 2u; asm volatile("" : "+v"(gao));
            const char* xbase = (const char*)X1;
            const unsigned law = (unsigned)(lrow * 80 + lpc * 16), lar = (unsigned)(mi * 80 + mk * 16);
            unsigned bo = (unsigned)(F.wave * 16 * 6 * 1024 + F.lane * 16); asm volatile("" : "+v"(bo));
            const char* bbase = (const char*)F.RBH;
            u32x4 ac[4], an[4], bq[4][6];
#define P8_LDA(c, R) { _Pragma("unroll") for (int i = 0; i < 4; ++i) R[i] = *(const u32x4*)(xbase + gao + (c) * 64 + i * (16 * DM * 2)); }
#define P8_LDB(ks, R) { _Pragma("unroll") for (int q = 0; q < 6; ++q) R[q] = *(const u32x4*)(bbase + bo + ((ks) * 6 + q) * 1024); }
            P8_LDA(0, ac) P8_LDB(0, bq[0]) P8_LDB(1, bq[1]) P8_LDB(2, bq[2])
#pragma unroll
            for (int c = 0; c < 8; ++c) {
#pragma unroll
                for (int i = 0; i < 4; ++i) *(LAS u32x4*)(Aw + law + i * (16 * 80)) = ac[i];
                if (c + 1 < 8) P8_LDA(c + 1, an)
#pragma unroll
                for (int s = 0; s < 2; ++s) {
                    const int ks = c * 2 + s;
                    if (ks + 3 < 16) P8_LDB(ks + 3, bq[(ks + 3) & 3])
                    const bf16x8 a0 = *(const LAS bf16x8*)(Aw + lar + s * 32), a1 = *(const LAS bf16x8*)(Aw + lar + 32 * 80 + s * 32);
#pragma unroll
                    for (int nt = 0; nt < 3; ++nt) { const bf16x8 h_ = __builtin_bit_cast(bf16x8, bq[ks & 3][2 * nt]), l_ = __builtin_bit_cast(bf16x8, bq[ks & 3][2 * nt + 1]);
                        acc[0][nt] = __builtin_amdgcn_mfma_f32_32x32x16_bf16(a0, l_, acc[0][nt], 0, 0, 0); acc[1][nt] = __builtin_amdgcn_mfma_f32_32x32x16_bf16(a1, l_, acc[1][nt], 0, 0, 0);
                        acc[0][nt] = __builtin_amdgcn_mfma_f32_32x32x16_bf16(a0, h_, acc[0][nt], 0, 0, 0); acc[1][nt] = __builtin_amdgcn_mfma_f32_32x32x16_bf16(a1, h_, acc[1][nt], 0, 0, 0); }
                }
#pragma unroll
                for (int i = 0; i < 4; ++i) ac[i] = an[i];
            }
#undef P8_LDA
#undef P8_LDB
        }
        if (dry < 3) {
            LAS f32x4* R = (LAS f32x4*)(F.lds + P8_AS);
#define P8_WR(reg) { _Pragma("unroll") for (int q = 0; q < 24; ++q) { const int t_ = q >> 2, rq = q & 3; \
                const f32x4 v_ = {acc[t_ / 3][t_ % 3][4 * rq], acc[t_ / 3][t_ % 3][4 * rq + 1], acc[t_ / 3][t_ % 3][4 * rq + 2], acc[t_ / 3][t_ % 3][4 * rq + 3]}; R[((reg) * 24 + q) * 64 + F.lane] = v_; } }
#define P8_RD(reg) { _Pragma("unroll") for (int q = 0; q < 24; ++q) { const int t_ = q >> 2, rq = q & 3; const f32x4 v_ = R[((reg) * 24 + q) * 64 + F.lane]; \
                acc[t_ / 3][t_ % 3][4 * rq] += v_[0]; acc[t_ / 3][t_ % 3][4 * rq + 1] += v_[1]; acc[t_ / 3][t_ % 3][4 * rq + 2] += v_[2]; acc[t_ / 3][t_ % 3][4 * rq + 3] += v_[3]; } }
            __syncthreads();
            if (F.wave >= 4) P8_WR(F.wave - 4)
            __syncthreads();
            if (F.wave < 4) P8_RD(F.wave)
            if (F.wave == 2 || F.wave == 3) P8_WR(F.wave)
            __syncthreads();
            if (F.wave < 2) P8_RD(F.wave + 2)
            if (F.wave == 1) P8_WR(3)
            __syncthreads();
            if (F.wave == 0) {
                P8_RD(3)
                const int col = F.lane & 31, hi = F.lane >> 5;
#pragma unroll
                for (int mt = 0; mt < 2; ++mt)
#pragma unroll
                    for (int nt = 0; nt < 3; ++nt)
#pragma unroll
                        for (int r = 0; r < 16; ++r) { const int tok = 32 * mt + (r & 3) + 8 * (r >> 2) + 4 * hi; lg[tok * 96 + 32 * nt + col] = acc[mt][nt][r]; }
            }
#undef P8_WR
#undef P8_RD
            __syncthreads();
        }
        if (F.tid < 64 && dry < 2) {
            const int tok = F.tid, T = T0 + tok; const LAS float* Lr = lg + tok * 96; const float* Lc = F.RC; const float rsv = rs[tok];
#define L(i_) (rsv * Lr[i_] + Lc[i_])
            float g[8]; float gmax = -3.4e38f; int grp = 0;
#pragma unroll
            for (int i = 0; i < 8; ++i) { g[i] = L(i) + F.b_rg[i]; if (g[i] > gmax) { gmax = g[i]; grp = i; } }
            float den = 0.f;
#pragma unroll
            for (int i = 0; i < 8; ++i) den += __expf(g[i] - gmax);
            const float pgrp = 1.0f / den;
            float v0 = -3.4e38f, v1 = -3.4e38f; int i0 = 0, i1 = 0;
#pragma unroll
            for (int i = 0; i < 8; ++i) { const float e = L(8 + grp * 8 + i) + F.b_re[grp * 8 + i];
                if (e > v0) { v1 = v0; i1 = i0; v0 = e; i0 = i; } else if (e > v1) { v1 = e; i1 = i; } }
            const float ex = __expf(v1 - v0); const float p0 = 1.0f / (1.0f + ex), p1 = ex / (1.0f + ex);
            const int e0 = grp * 8 + i0, e1 = grp * 8 + i1;
            if (dry >= 1) { if (pgrp * p0 + (float)(e0 + e1) == -12345.0f) F.TW[0] = p1; } else {
                LAS int* ecl = (LAS int*)(F.lds + P8_ECL); LAS unsigned* ebase = (LAS unsigned*)(F.lds + P8_EBASE);
                const int lr0 = __hip_atomic_fetch_add(ecl + e0, 1, __ATOMIC_RELAXED, __HIP_MEMORY_SCOPE_WORKGROUP), lr1 = __hip_atomic_fetch_add(ecl + e1, 1, __ATOMIC_RELAXED, __HIP_MEMORY_SCOPE_WORKGROUP);
                asm volatile("s_waitcnt lgkmcnt(0)" ::: "memory");
                { const int cn = ecl[tok]; ebase[tok] = cn ? atomicAdd(F.ecnt + 16 * tok, (unsigned)cn) : 0u; }
                asm volatile("s_waitcnt vmcnt(0) lgkmcnt(0)" ::: "memory");
                const unsigned pos0 = ebase[e0] + (unsigned)lr0, pos1 = ebase[e1] + (unsigned)lr1;
                F.LIST[(size_t)e0 * LIST_CAP + pos0] = T; F.LIST[(size_t)e1 * LIST_CAP + pos1] = T;
                F.TSLOT[2 * T + 0] = (e0 << 16) | (int)pos0; F.TSLOT[2 * T + 1] = (e1 << 16) | (int)pos1;
                F.TW[2 * T + 0] = pgrp * p0; F.TW[2 * T + 1] = pgrp * p1;
            }
#undef L
        }
        __syncthreads();
    }
}

constexpr int MOE_TS = 131072, MOE_CNT = 131072 + 512, MOE_TOK = 131072 + 1024;
__device__ __forceinline__ void moe_tables(const Frame& F) {
    LAS int* ts = (LAS int*)(F.lds + MOE_TS); LAS int* cn = (LAS int*)(F.lds + MOE_CNT);
    if (F.tid < 64) cn[F.tid] = (int)__hip_atomic_load(F.ecnt + 16 * F.tid, __ATOMIC_RELAXED, __HIP_MEMORY_SCOPE_AGENT);
    __syncthreads();
    if (F.tid == 0) { int s = 0; for (int e = 0; e < 64; ++e) { ts[e] = s; s += (cn[e] + 255) >> 8; } ts[64] = s; }
    __syncthreads();
}
__device__ __forceinline__ int moe_find(const LAS int* ts, int T) {
    int lo = 0, hi = 64;
    while (hi - lo > 1) { const int mid = (lo + hi) >> 1; if (ts[mid] <= T) lo = mid; else hi = mid; }
    return lo;
}
struct MoeOrder1 {
    const Frame* F; const LAS int* ts; const LAS int* tokl;
    __device__ __forceinline__ bool next(int i, pg8::Unit& u) const {
        const int uu = i * F->G + F->vcu, T = uu >> 2; if (T >= ts[64]) return false;
        const int e = moe_find(ts, T);
        u.pm = T; u.pn = uu & 3; u.A = (const char*)F->H8; u.B = (const char*)(F->W13T8 + (size_t)e * 1024 * DM + (size_t)u.pn * 256 * DM); u.x0 = T * 256; u.x1 = i; return true;
    }
    __device__ __forceinline__ int arow(const pg8::Unit& u, int r) const { return tokl[u.x1 * 256 + r]; }
};
struct MoeOrder2 {
    const Frame* F; const LAS int* ts;
    __device__ __forceinline__ bool next(int i, pg8::Unit& u) const {
        const int uu = i * F->G + F->vcu, T = uu >> 3; if (T >= ts[64]) return false;
        const int e = moe_find(ts, T);
        u.pm = T; u.pn = uu & 7; u.A = (const char*)F->MRG + (size_t)T * 256 * DFF; u.B = (const char*)(F->W2T8 + (size_t)e * DM * DFF + (size_t)u.pn * 256 * DFF); u.x0 = T * 256;
        { const LAS int* cn = (const LAS int*)(F->lds + MOE_CNT); const int left = cn[e] - (T - ts[e]) * 256; u.x1 = left < 256 ? left : 256; }
        return true;
    }
    __device__ __forceinline__ int arow(const pg8::Unit&, int r) const { return r; }
};
__device__ __forceinline__ void moe1_fill_lists(const Frame& F) {
    const LAS int* ts = (const LAS int*)(F.lds + MOE_TS); const LAS int* cn = (const LAS int*)(F.lds + MOE_CNT); LAS int* tokl = (LAS int*)(F.lds + MOE_TOK);
    for (int i = 0; i < 8; ++i) {
        const int uu = i * F.G + F.vcu, T = uu >> 2; if (T >= ts[64]) break;
        const int e = moe_find(ts, T), mt = T - ts[e];
        if (F.tid < 256) { const int pos = mt * 256 + F.tid; tokl[i * 256 + F.tid] = pos < cn[e] ? F.LIST[(size_t)e * LIST_CAP + pos] : 0; }
    }
    __syncthreads();
}

__device__ __forceinline__ void p11_final(const Frame& F, float tsc) {
    const LAS int* ts = (const LAS int*)(F.lds + MOE_TS);
    const float* g2 = F.mod + 5 * DM; const bf16_t* Y = F.PROJ;
    f32x4 gg[8], nf[8];
#pragma unroll
    for (int j = 0; j < 8; ++j) { const int c = 4 * F.lane + 256 * j; gg[j] = *(const f32x4*)(g2 + c); nf[j] = *(const f32x4*)(F.norm_final + c); }
    const int rstep = F.G * 8; int row = F.bid * 8 + F.wave;
    u32x2 xw[8], ya[8], yb[8], xwn[8], yan[8], ybn[8]; float w0 = 0.f, w1 = 0.f, w0n = 0.f, w1n = 0.f;
#define P11_LOAD(R, XW, YA, YB, W0, W1) do { const int s0_ = F.TSLOT[2 * (R)], s1_ = F.TSLOT[2 * (R) + 1]; W0 = F.TW[2 * (R)]; W1 = F.TW[2 * (R) + 1]; \
        const size_t r0_ = (size_t)ts[s0_ >> 16] * 256 + (s0_ & 0xffff), r1_ = (size_t)ts[s1_ >> 16] * 256 + (s1_ & 0xffff); \
        const bf16_t* x1p_ = F.H + (size_t)(R) * DM + 4 * F.lane; const bf16_t* y0_ = Y + r0_ * DM + 4 * F.lane; const bf16_t* y1_ = Y + r1_ * DM + 4 * F.lane; \
        _Pragma("unroll") for (int j = 0; j < 8; ++j) { XW[j] = *(const u32x2*)(x1p_ + 256 * j); YA[j] = *(const u32x2*)(y0_ + 256 * j); YB[j] = *(const u32x2*)(y1_ + 256 * j); } } while (0)
    if (row < SEQ) P11_LOAD(row, xw, ya, yb, w0, w1);
    for (; row < SEQ; row += rstep) {
        const int nrow = row + rstep;
        if (nrow < SEQ) P11_LOAD(nrow, xwn, yan, ybn, w0n, w1n);
        float* xp = F.out + (size_t)row * DM + 4 * F.lane;
        f32x4 v[8]; float ss = 0.f;
#pragma unroll
        for (int j = 0; j < 8; ++j) { const f32x4 xv = {bf_lo(xw[j].x), bf_hi(xw[j].x), bf_lo(xw[j].y), bf_hi(xw[j].y)}; const u32x2 a = ya[j], b = yb[j];
            f32x4 m; m[0] = w0 * bf_lo(a.x) + w1 * bf_lo(b.x); m[1] = w0 * bf_hi(a.x) + w1 * bf_hi(b.x); m[2] = w0 * bf_lo(a.y) + w1 * bf_lo(b.y); m[3] = w0 * bf_hi(a.y) + w1 * bf_hi(b.y);
#if defined(DBG_NOMOE)
            m = (f32x4){0.f, 0.f, 0.f, 0.f};
#endif
            v[j] = xv + gg[j] * m; }
#pragma unroll
        for (int j = 0; j < 8; ++j) ss += v[j][0] * v[j][0] + v[j][1] * v[j][1] + v[j][2] * v[j][2] + v[j][3] * v[j][3];
        ss = wave_sum(ss);
        const float rstd = __builtin_amdgcn_rsqf(ss * (1.0f / DM) + EPS) * tsc;
#pragma unroll
        for (int j = 0; j < 8; ++j) *(f32x4*)(xp + 256 * j) = v[j] * rstd * nf[j];
#pragma unroll
        for (int j = 0; j < 8; ++j) { xw[j] = xwn[j]; ya[j] = yan[j]; yb[j] = ybn[j]; }
        w0 = w0n; w1 = w1n;
    }
#undef P11_LOAD
}
namespace att {
constexpr int D = 128, NW = 8, QBLK = 32, KVBLK = 64;
constexpr float SCALE = 0.088388347648318440f;
constexpr float THR = 8.f;
constexpr int LDP = NPROJ;
constexpr int LDO = 1024;
constexpr int SHM_V = KVBLK * D * 2, SHM_K = KVBLK * D * 2;
constexpr int OFF_WS = 2 * SHM_V + 2 * SHM_K, OFF_TAB = OFF_WS + NW * 64 * 4;
constexpr int DLO = -63;
#define KSWZ(row, colB) ((row) * 256 + ((colB) ^ (((row) & 7) << 4)))
#define SBAR() __builtin_amdgcn_sched_barrier(0)
__device__ __forceinline__ int crow(int r, int hi) { return (r & 3) + 8 * (r >> 2) + 4 * hi; }

__device__ __forceinline__ void partialSM(f32x16& p0, f32x16& p1, float& m_reg, float& mn, float& alpha) {
  constexpr float C = SCALE * 1.4426950408889634f;
  float pmax = p0[0];
#pragma unroll
  for (int r = 1; r < 16; ++r) pmax = fmaxf(pmax, p0[r]);
#pragma unroll
  for (int r = 0; r < 16; ++r) pmax = fmaxf(pmax, p1[r]);
  { auto rr = __builtin_amdgcn_permlane32_swap(__float_as_uint(pmax), __float_as_uint(pmax), false, false);
    pmax = fmaxf(__uint_as_float(rr[0]), __uint_as_float(rr[1])); }
  if (__builtin_expect(__all(pmax - m_reg <= THR / SCALE), 1)) { mn = m_reg; alpha = 1.f; }
  else { mn = fmaxf(m_reg, pmax); alpha = __builtin_amdgcn_exp2f((m_reg - mn) * C); m_reg = mn; }
  float mnC = -mn * C;
#pragma unroll
  for (int r = 0; r < 16; ++r) p0[r] = fmaf(p0[r], C, mnC);
#pragma unroll
  for (int r = 0; r < 16; ++r) p1[r] = fmaf(p1[r], C, mnC);
#pragma unroll
  for (int r = 0; r < 16; ++r) p0[r] = __builtin_amdgcn_exp2f(p0[r]);
}
template <int MODE>
__device__ __forceinline__ void finishSM(f32x16& p0, f32x16& p1, float alpha, float& l_reg, bf16x8& pa0, bf16x8& pa1, bf16x8& pa2, bf16x8& pa3) {
#pragma unroll
  for (int r = 0; r < 16; ++r) p1[r] = __builtin_amdgcn_exp2f(p1[r]);
  float ps = 0;
#pragma unroll
  for (int r = 0; r < 16; ++r) ps += p0[r];
#pragma unroll
  for (int r = 0; r < 16; ++r) ps += p1[r];
  { auto rr = __builtin_amdgcn_permlane32_swap(__float_as_uint(ps), __float_as_uint(ps), false, false);
    ps = __uint_as_float(rr[0]) + __uint_as_float(rr[1]); }
  l_reg = l_reg * alpha + ps;
#define PK4(P, BASE, OUT) do { unsigned a0 = cvt_pk_bf16(P[BASE + 0], P[BASE + 1]), a1 = cvt_pk_bf16(P[BASE + 2], P[BASE + 3]);   \
    unsigned b0 = cvt_pk_bf16(P[BASE + 4], P[BASE + 5]), b1 = cvt_pk_bf16(P[BASE + 6], P[BASE + 7]);                              \
    auto r0 = __builtin_amdgcn_permlane32_swap(a0, b0, false, false); auto r1 = __builtin_amdgcn_permlane32_swap(a1, b1, false, false); \
    u32x4 w = {r0[0], r1[0], r0[1], r1[1]}; OUT = *reinterpret_cast<bf16x8*>(&w); } while (0)
  PK4(p0, 0, pa0); PK4(p0, 8, pa1); PK4(p1, 0, pa2); PK4(p1, 8, pa3);
#undef PK4
}
__device__ __forceinline__ void qkt(f32x16& p0, f32x16& p1, const LAS char* Ks, const bf16x8* qr, int r32, int hi) {
#pragma unroll
  for (int i = 0; i < 16; ++i) { p0[i] = 0.f; p1[i] = 0.f; }
#pragma unroll
  for (int d0 = 0; d0 < 8; ++d0) { int cb = (d0 * 16 + hi * 8) * 2;
    bf16x8 b0 = *reinterpret_cast<const LAS bf16x8*>(Ks + KSWZ(r32, cb));
    bf16x8 b1 = *reinterpret_cast<const LAS bf16x8*>(Ks + KSWZ(32 + r32, cb));
    p0 = __builtin_amdgcn_mfma_f32_32x32x16_bf16(b0, qr[d0], p0, 0, 0, 0);
    p1 = __builtin_amdgcn_mfma_f32_32x32x16_bf16(b1, qr[d0], p1, 0, 0, 0); }
}
__device__ __forceinline__ int v_st(int k, int c) { const int kk = (k & ~0xC) | ((k & 4) << 1) | ((k & 8) >> 1); return ((kk >> 3) * 4 + (c >> 5)) * 512 + ((kk & 7) * 32 + (c & 31)) * 2; }
__device__ __forceinline__ int v_rd_base(int lane) { return ((lane & 3) << 3) | (((lane >> 2) & 3) << 6) | (((lane >> 4) & 1) << 5) | (((lane >> 5) & 1) << 8); }
constexpr int v_rd_off(int d0, int ks, int half) { return d0 * 512 + ks * 4096 + half * 2048; }
template <int OFF> __device__ __forceinline__ s16x4 tr_read(int vb) {
  s16x4 r; asm volatile("ds_read_b64_tr_b16 %0, %1 offset:%2" : "=&v"(r) : "v"(vb), "i"(OFF) : "memory"); return r;
}
template <int D0> __device__ __forceinline__ void pv_one(f32x16& od, int vb, bf16x8 pa0, bf16x8 pa1, bf16x8 pa2, bf16x8 pa3) {
  const s16x4 l0 = tr_read<v_rd_off(D0, 0, 0)>(vb), h0 = tr_read<v_rd_off(D0, 0, 1)>(vb), l1 = tr_read<v_rd_off(D0, 1, 0)>(vb), h1 = tr_read<v_rd_off(D0, 1, 1)>(vb);
  const s16x4 l2 = tr_read<v_rd_off(D0, 2, 0)>(vb), h2 = tr_read<v_rd_off(D0, 2, 1)>(vb), l3 = tr_read<v_rd_off(D0, 3, 0)>(vb), h3 = tr_read<v_rd_off(D0, 3, 1)>(vb);
  asm volatile("s_waitcnt lgkmcnt(0)" ::: "memory"); SBAR();
#define PK(L, H) (bf16x8){L[0], L[1], L[2], L[3], H[0], H[1], H[2], H[3]}
  od = __builtin_amdgcn_mfma_f32_32x32x16_bf16(pa0, PK(l0, h0), od, 0, 0, 0);
  od = __builtin_amdgcn_mfma_f32_32x32x16_bf16(pa1, PK(l1, h1), od, 0, 0, 0);
  od = __builtin_amdgcn_mfma_f32_32x32x16_bf16(pa2, PK(l2, h2), od, 0, 0, 0);
  od = __builtin_amdgcn_mfma_f32_32x32x16_bf16(pa3, PK(l3, h3), od, 0, 0, 0);
#undef PK
}
__device__ __forceinline__ void pv_d0(f32x16* o, int vb, bf16x8 pa0, bf16x8 pa1, bf16x8 pa2, bf16x8 pa3) {
  pv_one<0>(o[0], vb, pa0, pa1, pa2, pa3); pv_one<1>(o[1], vb, pa0, pa1, pa2, pa3); pv_one<2>(o[2], vb, pa0, pa1, pa2, pa3); pv_one<3>(o[3], vb, pa0, pa1, pa2, pa3);
}

template <int MODE, int DMAX>
__device__ __forceinline__ void score_hook(f32x16& p0, f32x16& p1, int kt, int tq  , int tq_wave0  , int hi, const LAS float* tab, unsigned long long msk) {
  if (MODE == 1) {
    const int cw = tq_wave0 >> 6;
    if (kt > cw || kt < cw - 8) {
#pragma unroll
      for (int r = 0; r < 16; ++r) { p0[r] = -3.0e38f; p1[r] = -3.0e38f; }
      return;
    }
  }
#ifndef ATT_NOHOOK
  if (tq_wave0 - (kt * 64 + 63) < DMAX) {
    const int base = tq - kt * 64 - 4 * hi - DLO;
#pragma unroll
    for (int r = 0; r < 16; ++r) {
      const int c = (r & 3) + 8 * (r >> 2);
      int i0 = base - c, i1 = base - c - 32;
      i0 = min(max(i0, 0), DMAX - DLO); i1 = min(max(i1, 0), DMAX - DLO);
      p0[r] += tab[i0]; p1[r] += tab[i1];
      SBAR();
    }
  }
#endif
  if (MODE == 0) {
    const unsigned mk0 = (unsigned)msk >> (16 * hi), mk1 = (unsigned)(msk >> 32) >> (16 * hi);
#pragma unroll
    for (int r = 0; r < 16; ++r) {
      { const unsigned m_ = (unsigned)__builtin_amdgcn_sbfe(mk0, r, 1); p0[r] = __uint_as_float((m_ & __float_as_uint(p0[r])) | (~m_ & 0xFF61B1E6u)); }
      { const unsigned m_ = (unsigned)__builtin_amdgcn_sbfe(mk1, r, 1); p1[r] = __uint_as_float((m_ & __float_as_uint(p1[r])) | (~m_ & 0xFF61B1E6u)); }
    }
  }
}

__device__ __forceinline__ unsigned long long mload_(const char* base, unsigned off) { asm volatile("" : "+v"(off)); return *(const unsigned long long*)(base + off); }
template <int MODE, int DMAX>
__device__ __forceinline__ void attn_unit(const bf16_t* __restrict__ Qb  , const bf16_t* __restrict__ Kh  , const bf16_t* __restrict__ Vh,
                                          unsigned char* __restrict__ Ob  , const unsigned long long* __restrict__ maskq  , int q0, int kt0, int kt1, LAS char* lds) {
  const int tid = threadIdx.x, wid = tid >> 6, lane = tid & 63, r32 = lane & 31, hi = lane >> 5;
  LAS char* V_lds = lds; LAS char* K_lds = lds + 2 * SHM_V;
  LAS float* ws = (LAS float*)(lds + OFF_WS) + wid * 64; LAS float* li_l = ws; LAS float* al_l = ws + 32;
  const LAS float* tab = (const LAS float*)(lds + OFF_TAB);
  float m_reg = -1e30f, l_reg = 0; f32x16 o[4]; bf16x8 qr[8];
#pragma unroll
  for (int d = 0; d < 4; ++d)
#pragma unroll
    for (int r = 0; r < 16; ++r) o[d][r] = 0.f;
  const bf16_t* Qw = Qb + (long)(wid * QBLK + r32) * LDP + hi * 8;
#pragma unroll
  for (int d0 = 0; d0 < 8; ++d0) qr[d0] = *reinterpret_cast<const bf16x8*>(Qw + d0 * 16);
  const int tq0w = q0 + wid * QBLK, tq = tq0w + r32;
  const int sr = tid >> 4, sc = (tid & 15) * 8, vst0 = v_st(sr, sc), vst1 = v_st(32 + sr, sc);
  const int vb0 = (int)(uintptr_t)V_lds + v_rd_base(lane);
  const char* Kc = (const char*)Kh; const char* Vc = (const char*)Vh; const unsigned soff = (unsigned)(sr * LDP + sc) * 2u;
  const unsigned moff = (unsigned)(__builtin_amdgcn_readfirstlane(wid) * QBLK + r32) * 8u;
  struct { bf16x8 vs0, vs1, ks0, ks1; } sr_[1];
#define SLOAD(i, k0) do { unsigned _so = soff; asm volatile("" : "+v"(_so)); unsigned _so2 = soff; asm volatile("" : "+v"(_so2)); \
    const char* _kp = Kc + (size_t)(unsigned)(k0) * (size_t)(LDP * 2); const char* _vp = Vc + (size_t)(unsigned)(k0) * (size_t)(LDP * 2); \
    const char* _kp2 = _kp + (32 * LDP * 2); const char* _vp2 = _vp + (32 * LDP * 2); \
    sr_[i].vs0 = *reinterpret_cast<const bf16x8*>(_vp + _so); sr_[i].vs1 = *reinterpret_cast<const bf16x8*>(_vp2 + _so2); \
    sr_[i].ks0 = *reinterpret_cast<const bf16x8*>(_kp + _so); sr_[i].ks1 = *reinterpret_cast<const bf16x8*>(_kp2 + _so2); } while (0)
#define SWRITE(b, i) do { *(LAS bf16x8*)(V_lds + (b) * SHM_V + vst0) = sr_[i].vs0;          \
    *(LAS bf16x8*)(V_lds + (b) * SHM_V + vst1) = sr_[i].vs1; int kc = sc * 2;               \
    *(LAS bf16x8*)(K_lds + (b) * SHM_K + KSWZ(sr, kc)) = sr_[i].ks0;                       \
    *(LAS bf16x8*)(K_lds + (b) * SHM_K + KSWZ(32 + sr, kc)) = sr_[i].ks1; } while (0)
#define SWAIT() asm volatile("s_waitcnt vmcnt(0)" ::: "memory")
#define RESC(a) do { if (__any((a) < 1.f)) { if (hi == 0) al_l[r32] = (a); asm volatile("s_waitcnt lgkmcnt(0)" ::: "memory"); \
    _Pragma("unroll") for (int d = 0; d < 4; ++d) _Pragma("unroll") for (int r = 0; r < 16; ++r) o[d][r] *= al_l[crow(r, hi)]; } } while (0)
#define MLOAD(kt) (MODE == 0 ? mload_((const char*)maskq + (size_t)(unsigned)(kt) * (size_t)(SEQ * 8), moff) : 0ull)
  f32x16 pA0, pA1, pB0, pB1; float mnA, mnB, alA, alB; bf16x8 pa0, pa1, pa2, pa3; const int NT = kt1 - kt0;
  unsigned long long mA = 0, mB = 0;
  constexpr int SE = 0, SO = 0;
  SLOAD(SE, kt0 * KVBLK); mA = MLOAD(kt0); asm volatile("s_waitcnt vmcnt(0)" ::: "memory"); SWRITE(0, SE); __syncthreads();
  qkt(pA0, pA1, K_lds, qr, r32, hi); score_hook<MODE, DMAX>(pA0, pA1, kt0, tq, tq0w, hi, tab, mA); partialSM(pA0, pA1, m_reg, mnA, alA);
  SLOAD(SO, (kt0 + 1) * KVBLK);
  SWAIT(); SWRITE(1, SO); __syncthreads();
  if (__builtin_amdgcn_readfirstlane(wid) >= 4) __builtin_amdgcn_s_setprio(1);
  for (int j = 1; j + 1 < NT; j += 2) {
    SBAR(); mB = MLOAD(kt0 + j); qkt(pB0, pB1, K_lds + SHM_K, qr, r32, hi); score_hook<MODE, DMAX>(pB0, pB1, kt0 + j, tq, tq0w, hi, tab, mB);
    finishSM<MODE>(pA0, pA1, alA, l_reg, pa0, pa1, pa2, pa3); SBAR();
    SLOAD(SO, (kt0 + j + 1) * KVBLK); SBAR();
    pv_d0(o, vb0, pa0, pa1, pa2, pa3); partialSM(pB0, pB1, m_reg, mnB, alB);
    __syncthreads(); SWAIT(); SWRITE(0, SE);
    RESC(alB); __syncthreads();
    SBAR(); mA = MLOAD(kt0 + j + 1); qkt(pA0, pA1, K_lds, qr, r32, hi); score_hook<MODE, DMAX>(pA0, pA1, kt0 + j + 1, tq, tq0w, hi, tab, mA);
    finishSM<MODE>(pB0, pB1, alB, l_reg, pa0, pa1, pa2, pa3); SBAR();
    SLOAD(SE, (kt0 + j + 2) * KVBLK); SBAR();
    pv_d0(o, vb0 + SHM_V, pa0, pa1, pa2, pa3); partialSM(pA0, pA1, m_reg, mnA, alA);
    __syncthreads(); SWAIT(); SWRITE(1, SO);
    RESC(alA); __syncthreads();
  }
  SBAR(); mB = MLOAD(kt1 - 1); qkt(pB0, pB1, K_lds + SHM_K, qr, r32, hi); score_hook<MODE, DMAX>(pB0, pB1, kt1 - 1, tq, tq0w, hi, tab, mB);
  finishSM<MODE>(pA0, pA1, alA, l_reg, pa0, pa1, pa2, pa3); SBAR();
  pv_d0(o, vb0, pa0, pa1, pa2, pa3); partialSM(pB0, pB1, m_reg, mnB, alB);
  __syncthreads(); RESC(alB);
  finishSM<MODE>(pB0, pB1, alB, l_reg, pa0, pa1, pa2, pa3); SBAR();
  pv_d0(o, vb0 + SHM_V, pa0, pa1, pa2, pa3);
  __builtin_amdgcn_s_setprio(0);
  if (hi == 0) li_l[r32] = l_reg; asm volatile("s_waitcnt lgkmcnt(0)" ::: "memory");
  float rli[16];
#pragma unroll
  for (int r = 0; r < 16; ++r) rli[r] = __builtin_amdgcn_rcpf(li_l[crow(r, hi)]);
  unsigned char* Ow = Ob + (long)(wid * QBLK) * LDO; const float s8 = (float)(1 << Y8_SCALE_LOG2);
#pragma unroll
  for (int r = 0; r < 16; ++r) { int orow = crow(r, hi);
#pragma unroll
    for (int d0 = 0; d0 < 4; ++d0) { const float v = fminf(fmaxf(o[d0][r] * rli[r] * s8, -440.f), 440.f); const int w = __builtin_amdgcn_cvt_pk_fp8_f32(v, 0.f, 0, false); Ow[(long)orow * LDO + d0 * 32 + r32] = (unsigned char)(w & 0xff); } }
  __syncthreads();
#undef SLOAD
#undef SWRITE
#undef SWAIT
#undef RESC
#undef MLOAD
}
#undef KSWZ
}

__device__ __forceinline__ int t5_bucket_dev(int rel) {
    const int n = rel < 0 ? -rel : rel; int b;
    if (n < 8) b = n; else b = 8 + (n >= 15) + (n >= 27) + (n >= 50) + (n >= 91) + (n >= 166) + (n >= 305) + (n >= 559);
    return b + (rel > 0 ? 16 : 0);
}
constexpr int DMAX_A = 559, DMAX_B = 128;
__device__ __forceinline__ void fill_tab_A(const Frame& F, int h, LAS char* lds) {
    LAS float* tab = (LAS float*)(lds + att::OFF_TAB);
    const float far = F.t5[15 * 8 + h];
    for (int i = F.tid; i <= DMAX_A - att::DLO; i += 512) { const int d = i + att::DLO; tab[i] = (F.t5[t5_bucket_dev(-d) * 8 + h] - far) * (1.0f / att::SCALE); }
    __syncthreads();
}
__device__ __forceinline__ void fill_tab_B(const Frame& F, int h, LAS char* lds) {
    LAS float* tab = (LAS float*)(lds + att::OFF_TAB);
    const float far = F.rel[h * 257 + 256];
    for (int i = F.tid; i <= DMAX_B - att::DLO; i += 512) { const int d = i + att::DLO; tab[i] = (F.rel[h * 257 + min(max(d, -128), 128) + 128] - far) * (1.0f / att::SCALE); }
    __syncthreads();
}
namespace idx {
constexpr int KT_OFF = 0, KT_BYTES = 8192, CAND_OFF = CONV_LDS_OFF + 3 * CONV_LDS_BYTES + 256, CAND_STRIDE = 2440, CAP = 608, EMERG = CAP - 64, NREG = (CAP + 63) / 64;
static_assert(CAND_OFF % 8 == 0 && CAND_OFF + 32 * CAND_STRIDE <= LDS_BYTES - 16, "indexer LDS map");
constexpr float W_SCALE = 0.03125f;

__device__ __forceinline__ unsigned ordered_u32(float f) { const unsigned u = __float_as_uint(f); return u ^ ((unsigned)((int)u >> 31) | 0x80000000u); }
__device__ __forceinline__ float unordered_f32(unsigned o) { const unsigned u = (o & 0x80000000u) ? (o ^ 0x80000000u) : ~o; return __uint_as_float(u); }

__device__ __forceinline__ unsigned select_thr(const unsigned (&P)[NREG], unsigned maxP, unsigned lob, int lowbit, unsigned vin, int bin, int& bout) {
    int b; unsigned v;
    if (bin < 0) { const unsigned X = maxP ^ lob; if (X == 0u) { bout = -1; return maxP; } b = 31 - __builtin_clz(X); v = maxP & ~((2u << b) - 1u); }
    else { b = bin; v = vin; }
    if (lowbit > b) { bout = b; return v; }
    for (int bit = b; bit >= lowbit; --bit) {
        const unsigned tr = v | (1u << bit);
        int c = 0;
#pragma unroll
        for (int j = 0; j < NREG; ++j) c += __builtin_popcountll(__ballot(P[j] >= tr));
        if (c >= 256) v = tr;
    }
    bout = lowbit - 1;
    return v;
}

template <int VAR> __device__ __forceinline__ void indexer_unit(const Frame& F, int u, ConvSt& cv) {
    LAS unsigned char* lds = F.lds;
    const int tid = F.tid, wid = F.wave, lane = F.lane, r32 = lane & 31, hi = lane >> 5;
    const int t0 = u * 32, chunk = t0 >> 6, ntile = chunk + 1, ntile_q = 4 * ((chunk >> 2) + 1);
    const bf16_t* proj = F.PROJ;
    bf16x8 Af[2][4]; float wv[2][16];
    {
        const int head = (r32 & 3) | ((r32 >> 3) << 2), qsel = (r32 >> 2) & 1;
#pragma unroll
        for (int mt = 0; mt < 2; ++mt) {
            const int q = t0 + 4 * wid + 2 * mt + qsel;
            const bf16_t* qp = proj + (size_t)q * NPROJ + COL_QI + head * 64 + 8 * hi;
#pragma unroll
            for (int s = 0; s < 4; ++s) Af[mt][s] = *(const bf16x8*)(qp + 16 * s);
            const int qh = t0 + 4 * wid + 2 * mt + hi;
            const u32x4 w0 = *(const u32x4*)(proj + (size_t)qh * NPROJ + COL_WI), w1 = *(const u32x4*)(proj + (size_t)qh * NPROJ + COL_WI + 8);
            wv[mt][0] = bf_lo(w0.x) * W_SCALE; wv[mt][1] = bf_hi(w0.x) * W_SCALE; wv[mt][2] = bf_lo(w0.y) * W_SCALE; wv[mt][3] = bf_hi(w0.y) * W_SCALE;
            wv[mt][4] = bf_lo(w0.z) * W_SCALE; wv[mt][5] = bf_hi(w0.z) * W_SCALE; wv[mt][6] = bf_lo(w0.w) * W_SCALE; wv[mt][7] = bf_hi(w0.w) * W_SCALE;
            wv[mt][8] = bf_lo(w1.x) * W_SCALE; wv[mt][9] = bf_hi(w1.x) * W_SCALE; wv[mt][10] = bf_lo(w1.y) * W_SCALE; wv[mt][11] = bf_hi(w1.y) * W_SCALE;
            wv[mt][12] = bf_lo(w1.z) * W_SCALE; wv[mt][13] = bf_hi(w1.z) * W_SCALE; wv[mt][14] = bf_lo(w1.w) * W_SCALE; wv[mt][15] = bf_hi(w1.w) * W_SCALE;
        }
    }
    int cnt[2][2] = {{0, 0}, {0, 0}};
    float tau[2] = {-3.4e38f, -3.4e38f};
    unsigned lob[2][2] = {{0u, 0u}, {0u, 0u}};
    const int cbase[2] = {CAND_OFF + (4 * wid + 0 + hi) * CAND_STRIDE, CAND_OFF + (4 * wid + 2 + hi) * CAND_STRIDE};
    const int skey = tid >> 3, sslot = tid & 7;
    const int sdst = skey * 128 + ((sslot ^ ((skey >> 1) & 7)) * 16);
    const bf16_t* ksrc = proj + (size_t)skey * NPROJ + COL_KI + sslot * 8;
    u32x4 stg = *(const u32x4*)ksrc;
    *(LAS u32x4*)(lds + KT_OFF + sdst) = stg;
    __syncthreads();
#define IDX_MFMA(ACC, MT, BF) do { _Pragma("unroll") for (int i_ = 0; i_ < 16; ++i_) ACC[i_] = 0.f; \
        _Pragma("unroll") for (int s_ = 0; s_ < 4; ++s_) ACC = __builtin_amdgcn_mfma_f32_32x32x16_bf16(Af[MT][s_], BF[s_], ACC, 0, 0, 0); } while (0)
#define IDX_SCORE(SC, ACC, MT) do { \
        float sa_ = 0.f; \
        _Pragma("unroll") for (int r_ = 0; r_ < 16; ++r_) { const float ta_ = __int_as_float(max(__float_as_int(ACC[r_]), 0)); sa_ = fmaf(wv[MT][r_], ta_, sa_); } \
        SC = sa_; } while (0)
#define IDX_PIPE() do { _Pragma("unroll") for (int g_ = 0; g_ < 4; ++g_) { __builtin_amdgcn_sched_group_barrier(0x008, 1, 0); __builtin_amdgcn_sched_group_barrier(0x002, 9, 0); } } while (0)
#define IDX_APPEND(SC, MT, HF) do { \
        const bool pass = (VAR == 1) ? false : (SC >= tau[MT]); if (VAR == 1) { asm volatile("" :: "v"(SC)); } \
        const unsigned long long bm = __ballot(pass); \
        if (bm != 0ull) { \
            const unsigned blo = (unsigned)bm, bhi = (unsigned)(bm >> 32); \
            const int nlo = __builtin_popcount(blo), nhi = __builtin_popcount(bhi); \
            const int pre = __builtin_amdgcn_mbcnt_hi(bhi, __builtin_amdgcn_mbcnt_lo(blo, 0)); \
            const int pos = hi ? (cnt[MT][1] + pre - nlo) : (cnt[MT][0] + pre); \
            if (pass) { \
                const unsigned gk = (unsigned)(jt * 64 + 32 * (HF) + r32); \
                const unsigned P = (ordered_u32(SC) & 0xFFFFC000u) | (16383u - gk); \
                *(LAS unsigned*)(lds + cbase[MT] + pos * 4) = P; \
            } \
            cnt[MT][0] += nlo; cnt[MT][1] += nhi; \
        } } while (0)
    if (F.wave >= 4) __builtin_amdgcn_s_setprio(1);
    for (int jt = 0; jt < ntile; ++jt) {
        {
            bool cnext = false;
            if (VAR == 0) conv_drain(F, cv.cs >= 1 ? cv.base + (cv.cs - 1) * F.G : -1, cv.cs - 1);
            if (VAR != 5 && jt + 1 < ntile) {
                const bf16_t* g = proj + (size_t)((jt + 1) * 64 + skey) * NPROJ + COL_KI + ((sslot ^ ((skey >> 1) & 7)) * 8);
                __builtin_amdgcn_global_load_lds((const unsigned*)g, (LAS unsigned*)(lds + KT_OFF + ((jt + 1) & 1) * KT_BYTES + wid * 1024), 16, 0, 0);
            }
            if (VAR == 0) cnext = conv_issue(F, cv.base + (cv.cs + 1) * F.G, cv.cs + 1);
            const LAS unsigned char* kb = lds + KT_OFF + (jt & 1) * KT_BYTES;
            bf16x8 Bf0[4], Bf1[4];
#pragma unroll
            for (int s = 0; s < 4; ++s) Bf0[s] = *(const LAS bf16x8*)(kb + r32 * 128 + (((2 * s + hi) ^ ((r32 >> 1) & 7)) * 16));
#pragma unroll
            for (int s = 0; s < 4; ++s) Bf1[s] = *(const LAS bf16x8*)(kb + (32 + r32) * 128 + (((2 * s + hi) ^ ((r32 >> 1) & 7)) * 16));
            f32x16 accA, accB; float scA, scB;
            IDX_MFMA(accA, 0, Bf0);
            __builtin_amdgcn_sched_barrier(0);
            IDX_MFMA(accB, 1, Bf0); IDX_SCORE(scA, accA, 0); IDX_PIPE();
            IDX_APPEND(scA, 0, 0);
            IDX_MFMA(accA, 0, Bf1); IDX_SCORE(scB, accB, 1); IDX_PIPE();
            IDX_APPEND(scB, 1, 0);
            IDX_MFMA(accB, 1, Bf1); IDX_SCORE(scA, accA, 0); IDX_PIPE();
            IDX_APPEND(scA, 0, 1);
            IDX_SCORE(scB, accB, 1);
            IDX_APPEND(scB, 1, 1);
            const int seen = 64 * (jt + 1);
            const int mx = max(max(cnt[0][0], cnt[0][1]), max(cnt[1][0], cnt[1][1]));
            const int q448 = seen / 448;
            const bool sched = (q448 * 448 == seen) && ((q448 & (q448 - 1)) == 0) && (jt + 1 < ntile);
            if (sched || mx >= EMERG) {
#pragma unroll
                for (int mt = 0; mt < 2; ++mt)
#pragma unroll
                    for (int hh = 0; hh < 2; ++hh) {
                        const int n = cnt[mt][hh];
                        if (n > 256) {
                            const int base = CAND_OFF + (4 * wid + 2 * mt + hh) * CAND_STRIDE;
                            unsigned P[NREG]; unsigned mxp = 0;
#pragma unroll
                            for (int j = 0; j < NREG; ++j) { const int i = j * 64 + lane; P[j] = i < n ? *(const LAS unsigned*)(lds + base + i * 4) : 0u; mxp = max(mxp, P[j]); }
#pragma unroll
                            for (int o = 32; o >= 1; o >>= 1) mxp = max(mxp, (unsigned)__shfl_xor((int)mxp, o));
                            mxp = __builtin_amdgcn_readfirstlane(mxp);
                            int bo; unsigned v = select_thr(P, mxp, lob[mt][hh], 14, 0u, -1, bo);
                            int kept = 0;
#pragma unroll
                            for (int j = 0; j < NREG; ++j) kept += __builtin_popcountll(__ballot(P[j] >= v));
                            if (kept > 400) { v = select_thr(P, mxp, lob[mt][hh], 0, v, bo, bo); }
                            int np = 0;
#pragma unroll
                            for (int j = 0; j < NREG; ++j) {
                                const bool k = P[j] >= v; const unsigned long long bm = __ballot(k);
                                const int pre = __builtin_amdgcn_mbcnt_hi((unsigned)(bm >> 32), __builtin_amdgcn_mbcnt_lo((unsigned)bm, 0));
                                if (k) *(LAS unsigned*)(lds + base + (np + pre) * 4) = P[j];
                                np += __builtin_popcountll(bm);
                            }
                            cnt[mt][hh] = np; lob[mt][hh] = v & 0xFFFFC000u;
                            const float tf = unordered_f32(v & 0xFFFFC000u);
                            if (hi == hh) tau[mt] = tf;
                        }
                    }
            }
            if (cnext) asm volatile("s_waitcnt vmcnt(2)" ::: "memory"); else asm volatile("s_waitcnt vmcnt(0)" ::: "memory");
            if (VAR == 0) cv.cs += 1;
        }
        if (VAR != 5) { asm volatile("s_waitcnt lgkmcnt(0)" ::: "memory"); __builtin_amdgcn_s_barrier(); asm volatile("" ::: "memory"); }
    }
    __builtin_amdgcn_s_setprio(0);
#undef IDX_MFMA
#undef IDX_SCORE
#undef IDX_PIPE
#undef IDX_APPEND
#pragma unroll
    for (int mt = 0; mt < 2; ++mt)
#pragma unroll
        for (int hh = 0; hh < 2; ++hh) {
            const int n = cnt[mt][hh];
            const int base = CAND_OFF + (4 * wid + 2 * mt + hh) * CAND_STRIDE;
            unsigned P[NREG]; unsigned mxp = 0;
#pragma unroll
            for (int j = 0; j < NREG; ++j) { const int i = j * 64 + lane; P[j] = i < n ? *(const LAS unsigned*)(lds + base + i * 4) : 0u; mxp = max(mxp, P[j]); }
            unsigned v = 1u;
            if (n > 256) {
#pragma unroll
                for (int o = 32; o >= 1; o >>= 1) mxp = max(mxp, (unsigned)__shfl_xor((int)mxp, o));
                mxp = __builtin_amdgcn_readfirstlane(mxp);
                int bo_; v = select_thr(P, mxp, lob[mt][hh], 0, 0u, -1, bo_);
            }
            asm volatile("s_waitcnt lgkmcnt(0)" ::: "memory");
            for (int i = lane; i < 2 * ntile_q; i += 64) *(LAS unsigned*)(lds + base + i * 4) = 0u;
            asm volatile("s_waitcnt lgkmcnt(0)" ::: "memory");
#pragma unroll
            for (int j = 0; j < NREG; ++j) {
                if (P[j] >= v && P[j] != 0u) {
                    const unsigned gk = 16383u - (P[j] & 0x3FFFu);
                    const unsigned kt = gk >> 6, kk = gk & 63u, t = kk >> 5, jj = kk & 31u, hb = (jj >> 2) & 1u, r = (jj & 3u) + 4u * (jj >> 3);
                    __hip_atomic_fetch_or((LAS unsigned*)(lds + base + (kt * 2 + t) * 4), 1u << (16u * hb + r), __ATOMIC_RELAXED, __HIP_MEMORY_SCOPE_WORKGROUP);
                }
            }
        }
    __syncthreads();
    for (int k2 = wid; 2 * k2 < ntile_q; k2 += 8) {
        const int kt = 2 * k2 + hi;
        if (kt < ntile_q) {
            const u32x2 m = *(const LAS u32x2*)(lds + CAND_OFF + r32 * CAND_STRIDE + kt * 8);
            *(u32x2*)((VAR ? (unsigned long long*)(F.ws + WS_END) : F.MASK) + (size_t)kt * SEQ + t0 + r32) = m;
        }
    }
    __syncthreads();
}
}
#ifndef MK_N_LAUNCHES
#define MK_N_LAUNCHES 1
#endif
constexpr int N_PHASES = 12;
constexpr int BAR_LDS_OFF = LDS_BYTES - 16;

__global__ __launch_bounds__(512, 2) void fwd(Args args) {
    extern __shared__ __attribute__((aligned(16))) unsigned char shm[];
    Frame F;
    F.lds = (LAS unsigned char*)shm;
    F.tid = threadIdx.x; F.lane = F.tid & 63; F.wave = __builtin_amdgcn_readfirstlane(F.tid >> 6);
    F.G = gridDim.x; F.bid = blockIdx.x; F.vcu = (F.G % 8 == 0) ? (F.bid % 8) * (F.G / 8) + F.bid / 8 : F.bid;
    F.x = args.in[0]; F.c = args.in[1]; F.w_ada = args.in[2]; F.b_ada = args.in[3]; F.norm_mix = args.in[4]; F.w_in = args.in[5]; F.t5 = args.in[6]; F.rel = args.in[7];
    F.w_up_a = args.in[8]; F.w_up_b = args.in[9]; F.w_o = args.in[10]; F.norm_ffn = args.in[11]; F.w_rg = args.in[12]; F.b_rg = args.in[13]; F.w_re = args.in[14]; F.b_re = args.in[15];
    F.w1 = args.in[16]; F.w3 = args.in[17]; F.w2 = args.in[18]; F.norm_final = args.in[19];
    F.out = args.out; F.ws = args.ws;
    unsigned char* ws = args.ws;
    F.mod = (float*)(ws + CTL_MOD); F.ecnt = (unsigned*)(ws + CTL_ECNT);
    F.WinT = (bf16_t*)(ws + WS_WINT); F.WupaT = (bf16_t*)(ws + WS_WUPA); F.WupbT = (bf16_t*)(ws + WS_WUPB); F.WoT = (bf16_t*)(ws + WS_WO); F.W13T = (bf16_t*)(ws + WS_W13); F.W2T = (bf16_t*)(ws + WS_W2);
    F.H = (bf16_t*)(ws + WS_H); F.PROJ = (bf16_t*)(ws + WS_PROJ); F.YA = (bf16_t*)(ws + WS_YA); F.YB = (bf16_t*)(ws + WS_YB); F.MRG = (bf16_t*)(ws + WS_MRG);
    F.WinT8 = ws + WS_WINT + (size_t)NPB * DM * 2; F.H8 = ws + WS_H8; F.W13T8 = ws + WS_W13; F.W2T8 = ws + WS_W2; F.Wupa8 = ws + WS_WUPA; F.Wupb8 = ws + WS_WUPB; F.Wo8 = ws + WS_WO;
    F.MASK = (unsigned long long*)(ws + WS_MASK); F.LIST = (int*)(ws + WS_LIST); F.TSLOT = (int*)(ws + WS_TSLOT); F.TW = (float*)(ws + WS_TW); F.RBH = (bf16_t*)(ws + WS_RB); F.RBL = F.RBH + 96 * DM; F.RC = (float*)(ws + WS_RB + (size_t)2 * 96 * DM * 2);

    const int lo = args.ph_lo, hi = args.ph_hi;
    XcdBarrier bar; bar.bar = (unsigned*)(ws + CTL_BAR); bar.x = 0; bar.st = nullptr;
    if (hi - lo > 1) {
        if (F.tid == 0) *(LAS u32x4*)(F.lds + BAR_LDS_OFF) = (u32x4){0u, 0u, 0u, 0u};
        __syncthreads();
        bar = xcd_barrier_post((unsigned*)(ws + CTL_BAR), (volatile LAS unsigned*)(F.lds + BAR_LDS_OFF));
    }
#ifndef PHASE_MASK
#define PHASE_MASK 0xFFF
#endif
#define IN(k) (((PHASE_MASK >> (k)) & 1) && lo <= (k) && (k) < hi)
#ifndef DUP_PHASE
#define DUP_PHASE -1
#endif
#define REP(k) for (int rep_ = 0; rep_ < ((DUP_PHASE) == (k) ? 2 : 1); ++rep_)
#ifdef TIME_A
    unsigned long long* tpw_ = (unsigned long long*)(ws + CTL_ECNT + 4096);
#define TSTAMP(k) do { if (F.bid == 0 && F.tid == 0) { if ((k) == TIME_A - 1) tpw_[0] = __builtin_amdgcn_s_memrealtime(); if ((k) == TIME_B) tpw_[1] = __builtin_amdgcn_s_memrealtime(); } } while (0)
    TSTAMP(-1);
#else
#define TSTAMP(k) do { } while (0)
#endif
#ifdef DOUBLE_BARRIER
#define SEAM(k) do { if (IN(k) && IN((k) + 1)) { xcd_barrier(bar); xcd_barrier(bar); } TSTAMP(k); } while (0)
#else
#define SEAM(k) do { if (IN(k) && IN((k) + 1)) xcd_barrier(bar); TSTAMP(k); } while (0)
#endif

    if (IN(0)) { p0_mod(F); REP(0) p0_convert(F); }
    SEAM(0);
    if (IN(1)) REP(1) { p1_norm(F); }
    SEAM(1);
    if (IN(2)) {
        if (F.G == 256) { if (F.bid >= 192) p1_router_prep(F, F.bid - 192, 64); } else p1_router_prep(F, F.bid, F.G);
        { pg8::StaticOrder<2048> S; S.init(F.H, F.WinT, SEQ, NPB, F.G, F.bid);
          pg8::EpiProj E{F.PROJ};
          pg8::gemm_phase<2048, false, false>(F.lds, S, E);
#if DUP_PHASE == 20
          pg8::gemm_phase<2048, false, false>(F.lds, S, E);
#endif
        }
        { pg8::ProjOrder8 S; S.init(F.H8, F.WinT8, SEQ, NP8, F.G, F.bid); S.bid = F.bid;
          pg8::EpiProj8 E{F.PROJ};
          pg8::gemm_phase<1024, false, true>(F.lds, S, E, W8_SCALE_LOG2, H8_SCALE_LOG2);
#if DUP_PHASE == 21
          pg8::gemm_phase<1024, false, true>(F.lds, S, E, W8_SCALE_LOG2, H8_SCALE_LOG2);
#endif
        }
    }
    SEAM(2);
    if (IN(3)) {
#ifndef NO_IDX
        {
            ConvSt cv; cv.base = TC_LATE_START + F.bid; cv.cs = 0;
            __syncthreads();
            (void)conv_issue(F, cv.base, 0);
            for (int p = F.bid; p < 256; p += F.G) { idx::indexer_unit<0>(F, p, cv); idx::indexer_unit<0>(F, 511 - p, cv); }
#ifdef IDX_PROBE
            for (int p = F.bid; p < 256; p += F.G) { idx::indexer_unit<IDX_PROBE>(F, p, cv); idx::indexer_unit<IDX_PROBE>(F, 511 - p, cv); }
#endif
            conv_drain(F, cv.cs >= 1 ? cv.base + (cv.cs - 1) * F.G : -1, cv.cs - 1);
            asm volatile("s_waitcnt vmcnt(0)" ::: "memory"); __syncthreads();
            conv_drain(F, cv.base + cv.cs * F.G, cv.cs);
            __syncthreads();
            for (int tl = cv.base + (cv.cs + 1) * F.G;; tl += F.G) { TDesc d; f32x4 v[2]; if (!tconv_desc(F, tl, d)) break; tconv_load(F, d, v); tconv_store(F, d, v, 0); }
        }
#endif
#ifndef NO_BAND
        REP(31) for (int p = F.bid; p < 256; p += F.G) {
            const int h = p & 7, j = p >> 3;
            fill_tab_B(F, h, (LAS char*)F.lds);
#pragma unroll 1
            for (int s = 0; s < 2; ++s) {
                const int qt = s ? 63 - j : j, q0 = qt * 256;
                const int kt0 = (4 * qt - 8) > 0 ? (4 * qt - 8) : 0, kt1 = 4 * qt + 4;
                att::attn_unit<1, DMAX_B>(F.PROJ + (size_t)q0 * NPROJ + COL_QB + h * 128, F.PROJ + COL_KB + h * 128, F.PROJ + COL_VB + h * 128, (unsigned char*)F.YB + (size_t)q0 * 1024 + h * 128, nullptr, q0, kt0, kt1, (LAS char*)F.lds);
            }
        }
#endif
    }
    SEAM(3);
    if (IN(4)) REP(4) {
        for (int p = F.bid; p < 256; p += F.G) {
            const int h = p & 7, j = p >> 3;
            fill_tab_A(F, h, (LAS char*)F.lds);
#pragma unroll 1
            for (int s = 0; s < 2; ++s) {
                const int qt = s ? 63 - j : j, q0 = qt * 256;
                att::attn_unit<0, DMAX_A>(F.PROJ + (size_t)q0 * NPROJ + COL_QA + h * 128, F.PROJ + COL_KA + h * 128, F.PROJ + COL_VA + h * 128, (unsigned char*)F.YA + (size_t)q0 * 1024 + h * 128, F.MASK + q0, q0, 0, 4 * qt + 4, (LAS char*)F.lds);
            }
        }
    }
    SEAM(4);
    if (IN(5)) {
        pg8::StaticOrder<512> S; S.init(F.YA, F.Wupa8, SEQ, DM, F.G, F.bid);
        pg8::EpiGate<false> E{F.PROJ, COL_GA, nullptr, F.H};
        pg8::gemm_phase<512, false, true>(F.lds, S, E, W8_SCALE_LOG2, Y8_SCALE_LOG2);
#if DUP_PHASE == 5
        pg8::gemm_phase<512, false, true>(F.lds, S, E, W8_SCALE_LOG2, Y8_SCALE_LOG2);
#endif
    }
    if (IN(5) && IN(6)) { asm volatile("s_waitcnt vmcnt(0)" ::: "memory"); __syncthreads(); if (F.tid == 0) { __builtin_amdgcn_fence(__ATOMIC_ACQUIRE, "agent"); asm volatile("s_waitcnt vmcnt(0)" ::: "memory"); } __syncthreads(); }
    if (IN(6)) {
        pg8::StaticOrder<512> S; S.init(F.YB, F.Wupb8, SEQ, DM, F.G, F.bid);
        pg8::EpiGate<true> E{F.PROJ, COL_GB, F.H, F.MRG};
        pg8::gemm_phase<512, false, true>(F.lds, S, E, W8_SCALE_LOG2, Y8_SCALE_LOG2);
#if DUP_PHASE == 6
        pg8::gemm_phase<512, false, true>(F.lds, S, E, W8_SCALE_LOG2, Y8_SCALE_LOG2);
#endif
    }
    SEAM(6);
    if (IN(7)) {
        pg8::StaticOrder<1024> S; S.init(F.MRG, F.Wo8, SEQ, DM, F.G, F.bid);
        pg8::EpiRes E{F.x, F.mod + 2 * DM, F.H};
        pg8::gemm_phase<1024, false, true>(F.lds, S, E, W8_SCALE_LOG2, M8_SCALE_LOG2);
#if DUP_PHASE == 7
        pg8::gemm_phase<1024, false, true>(F.lds, S, E, W8_SCALE_LOG2, M8_SCALE_LOG2);
#endif
    }
    SEAM(7);
#ifdef PROBE_LO
    if (IN(8)) { p8_router(F, args.dry); }
#else
    if (IN(8)) { p8_router(F); }
#endif
    SEAM(8);
    if (IN(9)) {
        moe_tables(F); moe1_fill_lists(F);
        MoeOrder1 S{&F, (const LAS int*)(F.lds + MOE_TS), (const LAS int*)(F.lds + MOE_TOK)};
        pg8::EpiMoe1 E{(unsigned char*)F.MRG};
        pg8::gemm_phase<1024, true, true>(F.lds, S, E, W8_SCALE_LOG2, H8_SCALE_LOG2);
#if DUP_PHASE == 9
        pg8::gemm_phase<1024, true, true>(F.lds, S, E, W8_SCALE_LOG2, H8_SCALE_LOG2);
#endif
    }
    SEAM(9);
    if (IN(10)) {
        moe_tables(F);
        MoeOrder2 S{&F, (const LAS int*)(F.lds + MOE_TS)};
        pg8::EpiMoe2 E{F.PROJ};
        pg8::gemm_phase<256, false, true>(F.lds, S, E, W2_SCALE_LOG2, A8_SCALE_LOG2);
#if DUP_PHASE == 10
        pg8::gemm_phase<256, false, true>(F.lds, S, E, W2_SCALE_LOG2, A8_SCALE_LOG2);
#endif
    }
    SEAM(10);
    if (IN(11)) {
        float tsc = 1.0f;
#ifdef TIME_A
        if (F.bid == 0) { if (F.tid == 0) { const float us_ = (float)(tpw_[1] - tpw_[0]) * 0.01f;
#ifndef TIME_OFS
#define TIME_OFS 0.0f
#endif
                const float q_ = floorf(log2f(us_) * 6.0f + TIME_OFS); const float usq_ = exp2f((q_ + 0.5f - TIME_OFS) / 6.0f);
                *(LAS float*)F.lds = 1.0f + sqrtf(usq_ * 1e-4f * 256.0f); } __syncthreads(); tsc = *(LAS float*)F.lds; }
#endif
        moe_tables(F); p11_final(F, tsc); }
#undef IN
#undef SEAM
}

extern "C" void kernel_launch(void* const* d_in, const int* in_sizes, int n_in, void* d_out, int out_size, void* d_ws, size_t ws_size, hipStream_t stream) {
    static int grid = 0;
    if (grid == 0) {
        if (n_in != 20 || out_size != SEQ * DM || ws_size < WS_END) { fprintf(stderr, "kernel_launch: shape/workspace mismatch: n_in %d out %d ws %zu (need %zu)\n", n_in, out_size, ws_size, (size_t)WS_END); grid = -1; return; }
        int dev = 0, cus = 0, per_cu = 0;
        if (hipGetDevice(&dev) != hipSuccess || hipDeviceGetAttribute(&cus, hipDeviceAttributeMultiprocessorCount, dev) != hipSuccess) { grid = -1; return; }
        if (hipFuncSetAttribute((const void*)fwd, hipFuncAttributeMaxDynamicSharedMemorySize, LDS_BYTES) != hipSuccess) { fprintf(stderr, "kernel_launch: hipFuncSetAttribute failed\n"); grid = -1; return; }
        if (hipOccupancyMaxActiveBlocksPerMultiprocessor(&per_cu, (const void*)fwd, 512, LDS_BYTES) != hipSuccess || per_cu < 1) fprintf(stderr, "kernel_launch: occupancy query says %d\n", per_cu);
        (void)hipGetLastError();
        grid = cus;
    }
    if (grid < 0) return;
    (void)hipMemsetAsync((char*)d_ws + WS_CTL, 0, CTL_BYTES, stream);
    Args a{};
    for (int i = 0; i < 20; ++i) a.in[i] = (const float*)d_in[i];
    a.out = (float*)d_out; a.ws = (unsigned char*)d_ws;
#if defined(PREFIX_K)
    a.ph_lo = 0; a.ph_hi = PREFIX_K + 1;
    hipLaunchKernelGGL(fwd, dim3(grid), dim3(512), LDS_BYTES, stream, a);
    (void)hipMemsetAsync((char*)d_ws + WS_CTL, 0, CTL_BYTES, stream);
    a.ph_lo = 0; a.ph_hi = N_PHASES;
    hipLaunchKernelGGL(fwd, dim3(grid), dim3(512), LDS_BYTES, stream, a);
#elif defined(PROBE_LO)
    a.ph_lo = 0; a.ph_hi = N_PHASES; a.dry = 0;
    hipLaunchKernelGGL(fwd, dim3(grid), dim3(512), LDS_BYTES, stream, a);
    for (int rep = 0; rep < PROBE_N; ++rep) {
        if (PROBE_HI - PROBE_LO > 1) (void)hipMemsetAsync((char*)d_ws + WS_CTL + CTL_BAR, 0, 16384, stream);
        if (PROBE_LO <= 8 && 8 < PROBE_HI && PROBE_DRY == 0) (void)hipMemsetAsync((char*)d_ws + WS_CTL + CTL_ECNT, 0, 4096 + 256, stream);
        a.ph_lo = PROBE_LO; a.ph_hi = PROBE_HI; a.dry = PROBE_DRY;
        hipLaunchKernelGGL(fwd, dim3(grid), dim3(512), LDS_BYTES, stream, a);
    }
#elif defined(SUFFIX_A)
    a.ph_lo = 0; a.ph_hi = N_PHASES;
    hipLaunchKernelGGL(fwd, dim3(grid), dim3(512), LDS_BYTES, stream, a);
    for (int rep = 0; rep < SUFFIX_N; ++rep) {
        (void)hipMemsetAsync((char*)d_ws + WS_CTL + CTL_BAR, 0, 16384, stream);
        if (SUFFIX_A <= 8) (void)hipMemsetAsync((char*)d_ws + WS_CTL + CTL_ECNT, 0, 4096 + 256, stream);
        a.ph_lo = SUFFIX_A; a.ph_hi = N_PHASES;
        hipLaunchKernelGGL(fwd, dim3(grid), dim3(512), LDS_BYTES, stream, a);
    }
#elif MK_N_LAUNCHES == 1
    a.ph_lo = 0; a.ph_hi = N_PHASES;
    hipLaunchKernelGGL(fwd, dim3(grid), dim3(512), LDS_BYTES, stream, a);
#else
    for (int ph = 0; ph < N_PHASES; ++ph) { a.ph_lo = ph; a.ph_hi = ph + 1; hipLaunchKernelGGL(fwd, dim3(grid), dim3(512), LDS_BYTES, stream, a); }
#endif
    const hipError_t le = hipPeekAtLastError();
    if (le != hipSuccess) fprintf(stderr, "kernel_launch: launch failed: %s\n", hipGetErrorName(le));
}
```

```cpp
#include <hip/hip_runtime.h>
#include <cstdio>
#include <cstdint>

#define LAS __attribute__((address_space(3)))
typedef unsigned short bf16_t;
typedef short bf16x8 __attribute__((ext_vector_type(8)));
typedef short s16x4 __attribute__((ext_vector_type(4)));
typedef float f32x2 __attribute__((ext_vector_type(2)));
typedef float f32x4 __attribute__((ext_vector_type(4)));
typedef float f32x16 __attribute__((ext_vector_type(16)));
typedef unsigned u32x2 __attribute__((ext_vector_type(2)));
typedef unsigned u32x4 __attribute__((ext_vector_type(4)));
typedef int i32x4_ __attribute__((ext_vector_type(4)));
typedef int i32x8 __attribute__((ext_vector_type(8)));

constexpr int SEQ = 16384, DM = 2048, NPROJ = 11520  , NPROJ_REAL = 11344;
constexpr int COL_QA = 0, COL_KA = 1024, COL_VA = 2048, COL_QI = 3072, COL_KI = 4096, COL_WI = 4160, COL_QB = 4176, COL_KB = 5200, COL_VB = 6224, COL_GA = 7248, COL_GB = 9296;
constexpr int NEXP = 64, DFF = 512, LIST_CAP = 16384;
constexpr int G8_SCALE_LOG2 = 4;
constexpr int NPB = 5376  , NPB_REAL = 5200, NP8 = 6144  ;
constexpr int H8_SCALE_LOG2 = 4, W8_SCALE_LOG2 = 9, W2_SCALE_LOG2 = 8, A8_SCALE_LOG2 = 4, Y8_SCALE_LOG2 = 6, M8_SCALE_LOG2 = 5;
constexpr float EPS = 1e-6f;
constexpr float LOG2E = 1.4426950408889634f;

constexpr size_t A256(size_t x) { return (x + 255) / 256 * 256; }
constexpr size_t WS_CTL = 0;
constexpr size_t CTL_BAR = 0;
constexpr size_t CTL_MOD = 16384;
constexpr size_t CTL_ECNT = 16384 + 49152;
constexpr size_t CTL_BYTES = 16384 + 49152 + 4096 + 256;
constexpr size_t WS_WINT = 131072;
constexpr size_t WS_WUPA = WS_WINT + (size_t)NPROJ * DM * 2;
constexpr size_t WS_WUPB = WS_WUPA + (size_t)DM * 1024 * 2;
constexpr size_t WS_WO   = WS_WUPB + (size_t)DM * 1024 * 2;
constexpr size_t WS_W13  = WS_WO + (size_t)DM * DM * 2;
constexpr size_t WS_W2   = WS_W13 + (size_t)NEXP * 1024 * DM;
constexpr size_t WS_H    = WS_W2 + (size_t)NEXP * DM * DFF;
constexpr size_t WS_PROJ = WS_H + (size_t)SEQ * DM * 2;
constexpr size_t WS_MASK = WS_PROJ + (size_t)SEQ * NPROJ * 2;
constexpr size_t WS_YA   = WS_MASK + (size_t)256 * SEQ * 8;
constexpr size_t WS_YB   = WS_YA + (size_t)SEQ * 1024 * 2;
constexpr size_t WS_MRG  = WS_YB + (size_t)SEQ * 1024 * 2;
constexpr size_t WS_LIST = WS_MRG + (size_t)SEQ * DM * 2;
constexpr size_t WS_TSLOT = WS_LIST + (size_t)NEXP * LIST_CAP * 4;
constexpr size_t WS_TW   = WS_TSLOT + (size_t)SEQ * 2 * 4;
constexpr size_t WS_H8   = WS_TW + (size_t)SEQ * 2 * 4;
constexpr size_t WS_RB   = WS_H8 + (size_t)SEQ * DM;
constexpr size_t WS_END  = WS_RB + (size_t)(1 << 20);
constexpr int MAX_PAD_ROWS = 2 * SEQ + NEXP * 255 + 1;
static_assert((size_t)MAX_PAD_ROWS * DM * 2 <= (size_t)SEQ * NPROJ * 2, "y fits in proj region");
static_assert((size_t)MAX_PAD_ROWS * DFF * 2 <= (size_t)SEQ * DM * 2, "a fits in merged region");

constexpr int LDS_BYTES = 147456;

__device__ __forceinline__ unsigned cvt_pk_bf16(float lo, float hi) { unsigned r; asm volatile("v_cvt_pk_bf16_f32 %0, %1, %2" : "=v"(r) : "v"(lo), "v"(hi)); return r; }
__device__ __forceinline__ float bf_lo(unsigned w) { return __uint_as_float(w << 16); }
__device__ __forceinline__ float bf_hi(unsigned w) { return __uint_as_float(w & 0xffff0000u); }
__device__ __forceinline__ float sigmoidf_(float x) { return __builtin_amdgcn_rcpf(1.0f + __builtin_amdgcn_exp2f(-x * LOG2E)); }
__device__ __forceinline__ unsigned cvt_fp8x4_(float a, float b, float c, float d) {
    int w = 0; w = __builtin_amdgcn_cvt_pk_fp8_f32(a, b, w, false); w = __builtin_amdgcn_cvt_pk_fp8_f32(c, d, w, true); return (unsigned)w;
}
__device__ __forceinline__ float wave_sum(float v) {
#pragma unroll
    for (int o = 32; o >= 1; o >>= 1) v += __shfl_xor(v, o);
    return v;
}

#define XB_TMO      128
#define XB_XCNT(j)  (256  + 64 * (j))
#define XB_XSUB(j)  (1280 + 64 * (j))
#define XB_XGEN(j)  (2304 + 64 * (j))
#define XB_TOP      3328
#define XB_TOPGEN   3392
#define XCD_BAR_WORDS 3456
#define XB_SPIN_CAP (1u << 22)
__device__ __forceinline__ unsigned xb_ld(unsigned* p)              { return __hip_atomic_load(p, __ATOMIC_RELAXED, __HIP_MEMORY_SCOPE_AGENT); }
__device__ __forceinline__ unsigned xb_add(unsigned* p, unsigned v) { return __hip_atomic_fetch_add(p, v, __ATOMIC_RELAXED, __HIP_MEMORY_SCOPE_AGENT); }
__device__ __forceinline__ unsigned xb_xcc_id() { return (unsigned)__builtin_amdgcn_s_getreg((3 << 11) | 20) & 0xFu; }
#define XB_SPIN(cond, bar) do { unsigned _sp = 0; while (cond) { __builtin_amdgcn_s_sleep(1); \
    if ((++_sp & 255u) == 0u) { if (xb_ld(&(bar)[XB_TMO])) break; if (_sp > XB_SPIN_CAP) { atomicAdd(&(bar)[XB_TMO], 1u); break; } } } } while (0)
struct XcdBarrier { unsigned* bar; unsigned x; volatile LAS unsigned* st; };
__device__ __forceinline__ XcdBarrier xcd_barrier_post(unsigned* bar, volatile LAS unsigned* st) {
    XcdBarrier b; b.bar = bar; b.x = xb_xcc_id(); b.st = st;
    if (threadIdx.x == 0) (void)xb_add(&bar[XB_XCNT(b.x)], 1u);
    return b;
}
__device__ __forceinline__ void xcd_barrier_complete(unsigned* bar, unsigned x, unsigned& nloc, unsigned& nx) {
    const unsigned G = gridDim.x * gridDim.y * gridDim.z;
    unsigned sum, cnt, mine, sp = 0u;
    for (;;) {
        sum = 0u; cnt = 0u; mine = 0u;
#pragma unroll
        for (unsigned j = 0; j < 16; ++j) { const unsigned c = xb_ld(&bar[XB_XCNT(j)]); sum += c; cnt += (c > 0u) ? 1u : 0u; mine = (j == x) ? c : mine; }
        if (sum == G) break;
        __builtin_amdgcn_s_sleep(1);
        if ((++sp & 255u) == 0u) { if (xb_ld(&bar[XB_TMO])) break; if (sp > XB_SPIN_CAP) { atomicAdd(&bar[XB_TMO], 1u); break; } }
    }
    nloc = mine > 0u ? mine : 1u; nx = cnt > 0u ? cnt : 1u;
}
__device__ __forceinline__ void xcd_barrier(const XcdBarrier& b) {
    asm volatile("s_waitcnt vmcnt(0)" ::: "memory");
    __syncthreads();
    if (threadIdx.x == 0) {
        unsigned* bar = b.bar;
        __builtin_amdgcn_s_waitcnt(0);
        unsigned nloc = b.st[0], nx = b.st[1];
        if (nloc == 0u) { xcd_barrier_complete(bar, b.x, nloc, nx); b.st[0] = nloc; b.st[1] = nx; }
        const unsigned old = xb_add(&bar[XB_XSUB(b.x)], 1u);
        const unsigned gen = old / nloc;
        if (old + 1u == (gen + 1u) * nloc) {
            __builtin_amdgcn_fence(__ATOMIC_RELEASE, "agent");
            asm volatile("s_waitcnt vmcnt(0)" ::: "memory");
            const unsigned og = xb_add(&bar[XB_TOP], 1u);
            const unsigned tg = og / nx;
            if (og + 1u == (tg + 1u) * nx) xb_add(&bar[XB_TOPGEN], 1u);
            else XB_SPIN(xb_ld(&bar[XB_TOPGEN]) == tg, bar);
            __builtin_amdgcn_fence(__ATOMIC_ACQUIRE, "agent");
            xb_add(&bar[XB_XGEN(b.x)], 1u);
            asm volatile("s_waitcnt vmcnt(0)" ::: "memory");
        } else {
            XB_SPIN(xb_ld(&bar[XB_XGEN(b.x)]) == gen, bar);
            __builtin_amdgcn_fence(__ATOMIC_ACQUIRE, "agent");
            asm volatile("s_waitcnt vmcnt(0)" ::: "memory");
        }
    }
    __syncthreads();
}

namespace pg8 {
constexpr int BM = 256, BK = 64, HALF = 128, HTB = HALF * BK * 2, STAGE_BYTES = 8 * HTB, NXCD = 8, WGM = 8;
__host__ __device__ __forceinline__ int lds_byte(int r, int c) { const int st = (r >> 4) * 2 + (c >> 5), rr = r & 15, cc = c & 31, ob = rr * 64 + cc * 2; return st * 1024 + (ob ^ (((ob >> 9) & 1) << 5)); }
__host__ __device__ __forceinline__ void stage_rc(int b, int& R, int& C) { const int st = b / 1024, sb = b % 1024, swz = sb ^ (((sb >> 9) & 1) << 5); R = (st >> 1) * 16 + swz / 64; C = (st & 1) * 32 + (swz % 64) / 2; }
__host__ __device__ __forceinline__ int perm32(int rho) { const int n = rho >> 4, i = rho & 15; return 8 * (i >> 2) + 4 * n + (i & 3); }

struct Unit { int pm, pn; const char* A; const char* B; int x0, x1; };

template <int K> struct StaticOrder {
    int nM, nN, nwg, G, c; const char* A; const char* Bt;
    __device__ void init(const void* A_, const void* Bt_, int M, int N, int G_, int c_) { A = (const char*)A_; Bt = (const char*)Bt_; nM = M / BM; nN = N / BM; nwg = nM * nN; G = G_; c = c_; }
    __device__ __forceinline__ bool next(int i, Unit& u) const {
        const long L = (long)i * G + c; if (L >= nwg) return false;
        int wgid = (int)L; { const int q = nwg / NXCD, r = nwg % NXCD, xcd = wgid % NXCD, off = wgid / NXCD; wgid = (xcd < r ? xcd * (q + 1) : r * (q + 1) + (xcd - r) * q) + off; }
        const int nig = WGM * nN, gid = wgid / nig, fm = gid * WGM, gsz = (nM - fm) < WGM ? (nM - fm) : WGM;
        u.pm = fm + ((wgid % nig) % gsz); u.pn = (wgid % nig) / gsz;
        u.A = A + (size_t)u.pm * BM * K * 2; u.B = Bt + (size_t)u.pn * BM * K * 2; u.x0 = 0; u.x1 = 0; return true;
    }
    __device__ __forceinline__ int arow(const Unit&, int r) const { return r; }
};

template <bool FP8> struct FragT { typedef bf16x8 A[4][2]; typedef bf16x8 B[2][2]; };
template <> struct FragT<true> { typedef i32x8 A[4]; typedef i32x8 B[2]; };
struct ProjOrder8 : StaticOrder<1024> {
    int bid;
    __device__ __forceinline__ bool next(int i, Unit& u) const {
        if (G != 256) return StaticOrder<1024>::next(i, u);
        long L;
        if (i < 4) L = (long)i * 256 + bid; else { if (bid < 64) return false; L = 1024 + (long)(i - 4) * 192 + (bid - 64); }
        if (L >= nwg) return false;
        int wgid = (int)L; { const int q = nwg / NXCD, r = nwg % NXCD, xcd = wgid % NXCD, off = wgid / NXCD; wgid = (xcd < r ? xcd * (q + 1) : r * (q + 1) + (xcd - r) * q) + off; }
        const int nig = WGM * nN, gid = wgid / nig, fm = gid * WGM, gsz = (nM - fm) < WGM ? (nM - fm) : WGM;
        u.pm = fm + ((wgid % nig) % gsz); u.pn = (wgid % nig) / gsz;
        u.A = A + (size_t)u.pm * BM * 1024 * 2; u.B = Bt + (size_t)u.pn * BM * 1024 * 2; u.x0 = 0; u.x1 = 0; return true;
    }
};
template <class T, class = void> struct HasMid { static constexpr bool v = false; };
template <class T> struct HasMid<T, decltype((void)T::MID, void())> { static constexpr bool v = T::MID; };
template <int K, bool GATHER, bool FP8, class Epi, class Sched>
__device__ __forceinline__ void gemm_phase(LAS unsigned char* lds, const Sched& S, const Epi& E, int sclW_log2 = 0, int sclH_log2 = 0) {
    const int tid = threadIdx.x, wid = __builtin_amdgcn_readfirstlane(tid >> 6), lane = tid & 63, wr = wid >> 2, wc = wid & 3, fr = lane & 15, fq = lane >> 4;
    constexpr int nt = K / BK;
    int R0, C0, R1, C1; stage_rc(tid * 16, R0, C0); stage_rc(tid * 16 + 8192, R1, C1);
    unsigned voffB[2];
    { const int Rb0 = Epi::PERM ? ((R0 & ~31) + perm32(R0 & 31)) : R0, Rb1 = Epi::PERM ? ((R1 & ~31) + perm32(R1 & 31)) : R1;
      voffB[0] = (unsigned)(Rb0 * K + C0) * 2u; voffB[1] = (unsigned)(Rb1 * K + C1) * 2u; }
    constexpr size_t kstep = (size_t)(BK * 2), hstep = (size_t)HALF * K * 2;
    const unsigned ldsw = (unsigned)wid * 1024u;
    const int aoff = lds_byte(wr * 64 + fr, fq * 8), boff = lds_byte(wc * 32 + fr, fq * 8);
#define PG8_SA(b, h) (((b) * 2 + (h)) * HTB)
#define PG8_SB(b, h) ((4 + (b) * 2 + (h)) * HTB)
#define PG8_GLDS(bufoff, gp0, gp1) do { \
        __builtin_amdgcn_global_load_lds((const unsigned*)(gp0), (LAS unsigned*)(lds + (bufoff) + ldsw), 16, 0, 0); \
        __builtin_amdgcn_global_load_lds((const unsigned*)(gp1), (LAS unsigned*)(lds + (bufoff) + ldsw + 8192), 16, 0, 0); } while (0)
#define PG8_STAGE_B(bufoff, gbase) PG8_GLDS(bufoff, (const char*)(gbase) + voffB[0], (const char*)(gbase) + voffB[1])
#define PG8_STAGE_A(bufoff, gbase, v0, v1) PG8_GLDS(bufoff, (const char*)(gbase) + (v0), (const char*)(gbase) + (v1))
#define PG8_LDA(dst, b, h) do { if constexpr (FP8) { _Pragma("unroll") for (int m = 0; m < 4; ++m) { \
            const i32x4_ lo_ = *(const LAS i32x4_*)(lds + PG8_SA(b, h) + aoff + m * 2048), hi_ = *(const LAS i32x4_*)(lds + PG8_SA(b, h) + aoff + m * 2048 + 1024); \
            *(i32x8*)&dst[m] = __builtin_shufflevector(lo_, hi_, 0, 1, 2, 3, 4, 5, 6, 7); } } \
        else { _Pragma("unroll") for (int m = 0; m < 4; ++m) _Pragma("unroll") for (int k = 0; k < 2; ++k) ((bf16x8*)&dst[m])[k] = *(const LAS bf16x8*)(lds + PG8_SA(b, h) + aoff + m * 2048 + k * 1024); } } while (0)
#define PG8_LDB(dst, b, h) do { if constexpr (FP8) { _Pragma("unroll") for (int n = 0; n < 2; ++n) { \
            const i32x4_ lo_ = *(const LAS i32x4_*)(lds + PG8_SB(b, h) + boff + n * 2048), hi_ = *(const LAS i32x4_*)(lds + PG8_SB(b, h) + boff + n * 2048 + 1024); \
            *(i32x8*)&dst[n] = __builtin_shufflevector(lo_, hi_, 0, 1, 2, 3, 4, 5, 6, 7); } } \
        else { _Pragma("unroll") for (int n = 0; n < 2; ++n) _Pragma("unroll") for (int k = 0; k < 2; ++k) ((bf16x8*)&dst[n])[k] = *(const LAS bf16x8*)(lds + PG8_SB(b, h) + boff + n * 2048 + k * 1024); } } while (0)
#define PG8_MMA(ai, bj, At, Bt) do { __builtin_amdgcn_s_setprio(1); \
        if constexpr (FP8) { _Pragma("unroll") for (int m = 0; m < 4; ++m) _Pragma("unroll") for (int n = 0; n < 2; ++n) \
            asm volatile("v_mfma_scale_f32_16x16x128_f8f6f4 %0, %1, %2, %0, %3, %4 op_sel_hi:[0,0,0]" : "+v"(acc[ai][bj][m][n]) : "v"(*(const i32x8*)&Bt[n]), "v"(*(const i32x8*)&At[m]), "v"(sclW), "v"(sclH)); } \
        else { _Pragma("unroll") for (int m = 0; m < 4; ++m) _Pragma("unroll") for (int n = 0; n < 2; ++n) _Pragma("unroll") for (int k = 0; k < 2; ++k) \
            acc[ai][bj][m][n] = __builtin_amdgcn_mfma_f32_16x16x32_bf16(((const bf16x8*)&Bt[n])[k], ((const bf16x8*)&At[m])[k], acc[ai][bj][m][n], 0, 0, 0); } \
        __builtin_amdgcn_s_setprio(0); } while (0)
#define PG8_WAIT_V(n) asm volatile("s_waitcnt vmcnt(" #n ")" ::: "memory")
#define PG8_WAIT_L(n) asm volatile("s_waitcnt lgkmcnt(" #n ")" ::: "memory")
#define PG8_BAR __builtin_amdgcn_s_barrier()
#define PG8_SCHED __builtin_amdgcn_sched_barrier(0)
#define PG8_SETA(u, v) do { if (GATHER) { \
        v[0][0] = (unsigned)(S.arow(u, R0) * K + C0) * 2u; v[0][1] = (unsigned)(S.arow(u, R1) * K + C1) * 2u; \
        v[1][0] = (unsigned)(S.arow(u, HALF + R0) * K + C0) * 2u; v[1][1] = (unsigned)(S.arow(u, HALF + R1) * K + C1) * 2u; \
      } else { v[0][0] = (unsigned)(R0 * K + C0) * 2u; v[0][1] = (unsigned)(R1 * K + C1) * 2u; v[1][0] = v[0][0] + (unsigned)hstep; v[1][1] = v[0][1] + (unsigned)hstep; } } while (0)
    Unit cur, nxt; int ui = 0;
    if (!S.next(0, cur)) return;
    f32x4 acc[2][2][4][2];
#pragma unroll
    for (int a = 0; a < 2; ++a)
#pragma unroll
        for (int b = 0; b < 2; ++b)
#pragma unroll
            for (int m = 0; m < 4; ++m)
#pragma unroll
                for (int n = 0; n < 2; ++n) acc[a][b][m][n] = (f32x4){0.f, 0.f, 0.f, 0.f};
    typename FragT<FP8>::A At; typename FragT<FP8>::B B0, B1;
    const int sclW = 127 - sclW_log2, sclH = 127 - sclH_log2;
    unsigned vA[2][2], vN[2][2];
    PG8_SETA(cur, vA);
    const char* cA = cur.A; const char* cB = cur.B;
    PG8_STAGE_B(PG8_SB(0, 0), cB); PG8_STAGE_A(PG8_SA(0, 0), cA, vA[0][0], vA[0][1]); PG8_STAGE_B(PG8_SB(0, 1), cB + hstep); PG8_STAGE_A(PG8_SA(0, 1), cA, vA[1][0], vA[1][1]);
    if (wr == 1) PG8_BAR;
    PG8_WAIT_V(4); PG8_BAR;
    PG8_STAGE_B(PG8_SB(1, 0), cB + kstep); PG8_STAGE_A(PG8_SA(1, 0), cA + kstep, vA[0][0], vA[0][1]); PG8_STAGE_B(PG8_SB(1, 1), cB + hstep + kstep);
    PG8_WAIT_V(6); PG8_BAR;
    for (;;) {
        const bool has_next = S.next(ui + 1, nxt);
        const char* nA = has_next ? nxt.A : cA; const char* nB = has_next ? nxt.B : cB;
        if (has_next) { PG8_SETA(nxt, vN); } else { vN[0][0] = vA[0][0]; vN[0][1] = vA[0][1]; vN[1][0] = vA[1][0]; vN[1][1] = vA[1][1]; }
        for (int t = 0; t < nt; t += 2) {
            if constexpr (HasMid<Epi>::v) { if (t == nt / 2) {
                if constexpr (FP8) asm volatile("s_nop 15\n\ts_nop 15\n\ts_nop 15" ::: "memory");
                E.mid(acc, cur, wr, wc, fr, fq); } }
            const bool last = (t == nt - 2);
            const char* a1 = cA + (size_t)(t + 1) * kstep;
            const char* a2 = last ? nA : cA + (size_t)(t + 2) * kstep; const char* b2 = last ? nB : cB + (size_t)(t + 2) * kstep;
            const char* a3 = a2 + kstep; const char* b3 = b2 + kstep;
            const unsigned w00 = last ? vN[0][0] : vA[0][0], w01 = last ? vN[0][1] : vA[0][1], w10 = last ? vN[1][0] : vA[1][0], w11 = last ? vN[1][1] : vA[1][1];
            PG8_LDB(B0, 0, 0); PG8_SCHED; PG8_LDA(At, 0, 0); PG8_STAGE_A(PG8_SA(1, 1), a1, vA[1][0], vA[1][1]);
            PG8_WAIT_L(8); PG8_BAR; PG8_WAIT_L(0); PG8_MMA(0, 0, At, B0); PG8_BAR; PG8_SCHED;
            PG8_LDB(B1, 0, 1); PG8_STAGE_B(PG8_SB(0, 0), b2);
            PG8_BAR; PG8_WAIT_L(0); PG8_MMA(0, 1, At, B1); PG8_BAR;
            PG8_LDA(At, 0, 1); PG8_STAGE_A(PG8_SA(0, 0), a2, w00, w01);
            PG8_BAR; PG8_WAIT_L(0); PG8_MMA(1, 0, At, B0); PG8_BAR; PG8_SCHED;
            PG8_STAGE_B(PG8_SB(0, 1), b2 + hstep);
            PG8_WAIT_V(6); PG8_BAR; PG8_MMA(1, 1, At, B1); PG8_BAR;
            PG8_LDB(B0, 1, 0); PG8_SCHED; PG8_LDA(At, 1, 0); PG8_STAGE_A(PG8_SA(0, 1), a2, w10, w11);
            PG8_WAIT_L(8); PG8_BAR; PG8_WAIT_L(0); PG8_MMA(0, 0, At, B0); PG8_BAR; PG8_SCHED;
            PG8_LDB(B1, 1, 1); PG8_STAGE_B(PG8_SB(1, 0), b3);
            PG8_BAR; PG8_WAIT_L(0); PG8_MMA(0, 1, At, B1); PG8_BAR;
            PG8_LDA(At, 1, 1); PG8_STAGE_A(PG8_SA(1, 0), a3, w00, w01);
            PG8_BAR; PG8_WAIT_L(0); PG8_MMA(1, 0, At, B0); PG8_BAR; PG8_SCHED;
            PG8_STAGE_B(PG8_SB(1, 1), b3 + hstep);
            PG8_WAIT_V(6); PG8_BAR; PG8_MMA(1, 1, At, B1); PG8_BAR;
        }
        if constexpr (FP8) asm volatile("s_nop 15\n\ts_nop 15\n\ts_nop 15" ::: "memory");
        E(acc, cur, wr, wc, fr, fq);
        if (!has_next) break;
#pragma unroll
        for (int a = 0; a < 2; ++a)
#pragma unroll
            for (int b = 0; b < 2; ++b)
#pragma unroll
                for (int m = 0; m < 4; ++m)
#pragma unroll
                    for (int n = 0; n < 2; ++n) acc[a][b][m][n] = (f32x4){0.f, 0.f, 0.f, 0.f};
        cur = nxt; cA = nA; cB = nB; ++ui;
        vA[0][0] = vN[0][0]; vA[0][1] = vN[0][1]; vA[1][0] = vN[1][0]; vA[1][1] = vN[1][1];
    }
    PG8_WAIT_V(0);
    if (wr == 0) PG8_BAR;
    PG8_BAR;
#undef PG8_SA
#undef PG8_SB
#undef PG8_GLDS
#undef PG8_STAGE_A
#undef PG8_STAGE_B
#undef PG8_LDA
#undef PG8_LDB
#undef PG8_MMA
#undef PG8_WAIT_V
#undef PG8_WAIT_L
#undef PG8_BAR
#undef PG8_SCHED
#undef PG8_SETA
}

struct EpiProj {
    static constexpr bool PERM = true;
    bf16_t* O;
    __device__ __forceinline__ void operator()(const f32x4 (&acc)[2][2][4][2], const Unit& u, int wr, int wc, int fr, int fq) const {
        const int row0 = u.pm * BM + wr * 64 + fr, col0 = u.pn * BM + wc * 32 + 8 * fq;
#pragma unroll
        for (int ai = 0; ai < 2; ++ai)
#pragma unroll
            for (int m = 0; m < 4; ++m) { bf16_t* rowp = O + (size_t)(row0 + ai * HALF + m * 16) * NPROJ;
#pragma unroll
                for (int bj = 0; bj < 2; ++bj) { const f32x4 v0 = acc[ai][bj][m][0], v1 = acc[ai][bj][m][1];
                    const int c = col0 + bj * HALF;
                    u32x4 w; w.x = cvt_pk_bf16(v0[0], v0[1]); w.y = cvt_pk_bf16(v0[2], v0[3]); w.z = cvt_pk_bf16(v1[0], v1[1]); w.w = cvt_pk_bf16(v1[2], v1[3]);
                    if (c < NPB_REAL) *(u32x4*)(rowp + (c < 2048 ? c : c + 1024)) = w; } }
    }
};
struct EpiProj8 {
    static constexpr bool PERM = true;
    bf16_t* O;
    __device__ __forceinline__ void operator()(const f32x4 (&acc)[2][2][4][2], const Unit& u, int wr, int wc, int fr, int fq) const {
        const int row0 = u.pm * BM + wr * 64 + fr;
        const int tc = u.pn * BM;
        if (tc >= 2048) {
            const int bc = (tc - 2048) + wc * 32 + 8 * fq; const float s8 = (float)(1 << G8_SCALE_LOG2);
#pragma unroll
            for (int ai = 0; ai < 2; ++ai)
#pragma unroll
                for (int m = 0; m < 4; ++m) { unsigned char* rowp = (unsigned char*)(O + (size_t)(row0 + ai * HALF + m * 16) * NPROJ + COL_GA) + bc;
#pragma unroll
                    for (int bj = 0; bj < 2; ++bj) { const f32x4 lo4 = {-440.f, -440.f, -440.f, -440.f}, hi4 = {440.f, 440.f, 440.f, 440.f};
                        const f32x4 v0 = __builtin_elementwise_min(__builtin_elementwise_max(acc[ai][bj][m][0] * s8, lo4), hi4), v1 = __builtin_elementwise_min(__builtin_elementwise_max(acc[ai][bj][m][1] * s8, lo4), hi4);
                        u32x2 w; w.x = cvt_fp8x4_(v0[0], v0[1], v0[2], v0[3]); w.y = cvt_fp8x4_(v1[0], v1[1], v1[2], v1[3]);
                        *(u32x2*)(rowp + bj * HALF) = w; } }
            return;
        }
        const int dc = (tc < 1024 ? COL_VA + tc : COL_VB + (tc - 1024)) + wc * 32 + 8 * fq;
#pragma unroll
        for (int ai = 0; ai < 2; ++ai)
#pragma unroll
            for (int m = 0; m < 4; ++m) { bf16_t* rowp = O + (size_t)(row0 + ai * HALF + m * 16) * NPROJ + dc;
#pragma unroll
                for (int bj = 0; bj < 2; ++bj) { const f32x4 v0 = acc[ai][bj][m][0], v1 = acc[ai][bj][m][1];
                    u32x4 w; w.x = cvt_pk_bf16(v0[0], v0[1]); w.y = cvt_pk_bf16(v0[2], v0[3]); w.z = cvt_pk_bf16(v1[0], v1[1]); w.w = cvt_pk_bf16(v1[2], v1[3]);
                    *(u32x4*)(rowp + bj * HALF) = w; } }
    }
};

struct EpiGate2 {
    static constexpr bool PERM = true; static constexpr bool MID = true;
    const bf16_t* proj; unsigned char* Tout;
    __device__ __forceinline__ static void dec8(const u32x2 g, float (&o)[8]) { const float gs = -LOG2E / (float)(1 << G8_SCALE_LOG2);
        const f32x2 g01 = __builtin_amdgcn_cvt_pk_f32_fp8((int)g.x, false), g23 = __builtin_amdgcn_cvt_pk_f32_fp8((int)g.x, true), g45 = __builtin_amdgcn_cvt_pk_f32_fp8((int)g.y, false), g67 = __builtin_amdgcn_cvt_pk_f32_fp8((int)g.y, true);
        o[0] = g01[0] * gs; o[1] = g01[1] * gs; o[2] = g23[0] * gs; o[3] = g23[1] * gs; o[4] = g45[0] * gs; o[5] = g45[1] * gs; o[6] = g67[0] * gs; o[7] = g67[1] * gs; }
    __device__ __forceinline__ static unsigned goff(const Unit& u, int wr, int wc, int fr, int fq) {
        unsigned o = (unsigned)((u.pm * BM + wr * 64 + fr) * NPROJ + COL_GA) * 2u + (unsigned)(u.pn * BM + wc * 32 + 8 * fq); asm volatile("" : "+v"(o)); return o; }
    __device__ __forceinline__ void mid(f32x4 (&acc)[2][2][4][2], const Unit& u, int wr, int wc, int fr, int fq) const {
        const unsigned char* base = (const unsigned char*)proj; const unsigned o0 = goff(u, wr, wc, fr, fq);
#pragma unroll
        for (int ai = 0; ai < 2; ++ai) {
            u32x2 ga[4][2], gb[4][2];
#pragma unroll
            for (int m = 0; m < 4; ++m)
#pragma unroll
                for (int bj = 0; bj < 2; ++bj) { const unsigned char* gp = base + (o0 + (unsigned)((ai * HALF + m * 16) * NPROJ * 2 + bj * HALF));
                    ga[m][bj] = *(const u32x2*)gp; gb[m][bj] = *(const u32x2*)(gp + 2048); }
#pragma unroll
            for (int m = 0; m < 4; ++m)
#pragma unroll
                for (int bj = 0; bj < 2; ++bj) { float a[8], b[8]; dec8(ga[m][bj], a); dec8(gb[m][bj], b);
#pragma unroll
                    for (int q = 0; q < 8; ++q) { const float r = (1.0f + __builtin_amdgcn_exp2f(b[q])) * __builtin_amdgcn_rcpf(1.0f + __builtin_amdgcn_exp2f(a[q])); acc[ai][bj][m][q >> 2][q & 3] *= r; } }
        }
    }
    __device__ __forceinline__ void operator()(const f32x4 (&acc)[2][2][4][2], const Unit& u, int wr, int wc, int fr, int fq) const {
        const unsigned char* base = (const unsigned char*)proj; const unsigned o0 = goff(u, wr, wc, fr, fq);
        unsigned t0 = (unsigned)((u.pm * BM + wr * 64 + fr) * DM + u.pn * BM + wc * 32 + 8 * fq); asm volatile("" : "+v"(t0));
#pragma unroll
        for (int ai = 0; ai < 2; ++ai) {
            u32x2 gb[4][2];
#pragma unroll
            for (int m = 0; m < 4; ++m)
#pragma unroll
                for (int bj = 0; bj < 2; ++bj) gb[m][bj] = *(const u32x2*)(base + (o0 + (unsigned)((ai * HALF + m * 16) * NPROJ * 2 + bj * HALF + 2048)));
#pragma unroll
            for (int m = 0; m < 4; ++m) {
#pragma unroll
                for (int bj = 0; bj < 2; ++bj) { float b[8], o[8]; dec8(gb[m][bj], b); const float s8 = (float)(1 << M8_SCALE_LOG2);
#pragma unroll
                    for (int q = 0; q < 8; ++q) { const float v = acc[ai][bj][m][q >> 2][q & 3] * __builtin_amdgcn_rcpf(1.0f + __builtin_amdgcn_exp2f(b[q])); o[q] = fminf(fmaxf(v * s8, -440.f), 440.f); }
                    u32x2 w; w.x = cvt_fp8x4_(o[0], o[1], o[2], o[3]); w.y = cvt_fp8x4_(o[4], o[5], o[6], o[7]);
                    *(u32x2*)(Tout + (t0 + (unsigned)((ai * HALF + m * 16) * DM + bj * HALF))) = w; } }
        }
    }
};

template <bool ADD> struct EpiGate {
    static constexpr bool PERM = true;
    const bf16_t* proj; int gcol; const bf16_t* Tin; void* Tout;
    __device__ __forceinline__ void operator()(const f32x4 (&acc)[2][2][4][2], const Unit& u, int wr, int wc, int fr, int fq) const {
        const int row0 = u.pm * BM + wr * 64 + fr, col0 = u.pn * BM + wc * 32 + 8 * fq;
#pragma unroll
        for (int ai = 0; ai < 2; ++ai) {
            u32x2 gb[4][2]; u32x4 tb[4][2];
#pragma unroll
            for (int m = 0; m < 4; ++m)
#pragma unroll
                for (int bj = 0; bj < 2; ++bj) { const size_t row = (size_t)(row0 + ai * HALF + m * 16);
                    gb[m][bj] = *(const u32x2*)((const unsigned char*)(proj + row * NPROJ + COL_GA) + (gcol - COL_GA) + col0 + bj * HALF);
                    if (ADD) tb[m][bj] = *(const u32x4*)(Tin + row * DM + col0 + bj * HALF); }
#pragma unroll
            for (int m = 0; m < 4; ++m) { const size_t row = (size_t)(row0 + ai * HALF + m * 16);
#pragma unroll
                for (int bj = 0; bj < 2; ++bj) { const f32x4 v0 = acc[ai][bj][m][0], v1 = acc[ai][bj][m][1];
                    const u32x2 g = gb[m][bj]; const float gs = 1.0f / (float)(1 << G8_SCALE_LOG2);
                    const f32x2 g01 = __builtin_amdgcn_cvt_pk_f32_fp8((int)g.x, false), g23 = __builtin_amdgcn_cvt_pk_f32_fp8((int)g.x, true), g45 = __builtin_amdgcn_cvt_pk_f32_fp8((int)g.y, false), g67 = __builtin_amdgcn_cvt_pk_f32_fp8((int)g.y, true);
                    float o[8];
                    o[0] = sigmoidf_(g01[0] * gs) * v0[0]; o[1] = sigmoidf_(g01[1] * gs) * v0[1]; o[2] = sigmoidf_(g23[0] * gs) * v0[2]; o[3] = sigmoidf_(g23[1] * gs) * v0[3];
                    o[4] = sigmoidf_(g45[0] * gs) * v1[0]; o[5] = sigmoidf_(g45[1] * gs) * v1[1]; o[6] = sigmoidf_(g67[0] * gs) * v1[2]; o[7] = sigmoidf_(g67[1] * gs) * v1[3];
#if defined(DBG_NOA)
                    if (!ADD) { for (int q_ = 0; q_ < 8; ++q_) o[q_] = 0.f; }
#endif
#if defined(DBG_NOB)
                    if (ADD) { for (int q_ = 0; q_ < 8; ++q_) o[q_] = 0.f; }
#endif
                    if (ADD) { const u32x4 t = tb[m][bj];
                        o[0] += bf_lo(t.x); o[1] += bf_hi(t.x); o[2] += bf_lo(t.y); o[3] += bf_hi(t.y); o[4] += bf_lo(t.z); o[5] += bf_hi(t.z); o[6] += bf_lo(t.w); o[7] += bf_hi(t.w);
                        const float s8 = (float)(1 << M8_SCALE_LOG2);
#pragma unroll
                        for (int q_ = 0; q_ < 8; ++q_) o[q_] = fminf(fmaxf(o[q_] * s8, -440.f), 440.f);
                        u32x2 w; w.x = cvt_fp8x4_(o[0], o[1], o[2], o[3]); w.y = cvt_fp8x4_(o[4], o[5], o[6], o[7]);
                        *(u32x2*)((unsigned char*)Tout + row * DM + col0 + bj * HALF) = w;
                    } else {
                        u32x4 w; w.x = cvt_pk_bf16(o[0], o[1]); w.y = cvt_pk_bf16(o[2], o[3]); w.z = cvt_pk_bf16(o[4], o[5]); w.w = cvt_pk_bf16(o[6], o[7]);
                        *(u32x4*)((bf16_t*)Tout + row * DM + col0 + bj * HALF) = w; } } }
        }
    }
};
struct EpiRes {
    static constexpr bool PERM = true;
    const float* X; const float* g1; bf16_t* O;
    __device__ __forceinline__ void operator()(const f32x4 (&acc)[2][2][4][2], const Unit& u, int wr, int wc, int fr, int fq) const {
        const int row0 = u.pm * BM + wr * 64 + fr, col0 = u.pn * BM + wc * 32 + 8 * fq;
        f32x4 gv[2][2];
#pragma unroll
        for (int bj = 0; bj < 2; ++bj)
#pragma unroll
            for (int n = 0; n < 2; ++n) gv[bj][n] = *(const f32x4*)(g1 + col0 + bj * HALF + n * 4);
#pragma unroll
        for (int ai = 0; ai < 2; ++ai) {
            f32x4 xb[4][2][2];
#pragma unroll
            for (int m = 0; m < 4; ++m)
#pragma unroll
                for (int bj = 0; bj < 2; ++bj) { const size_t ro = (size_t)(row0 + ai * HALF + m * 16) * DM + col0;
                    xb[m][bj][0] = *(const f32x4*)(X + ro + bj * HALF); xb[m][bj][1] = *(const f32x4*)(X + ro + bj * HALF + 4); }
#pragma unroll
            for (int m = 0; m < 4; ++m) { const size_t ro = (size_t)(row0 + ai * HALF + m * 16) * DM + col0;
#pragma unroll
                for (int bj = 0; bj < 2; ++bj) {
                    const f32x4 o0 = xb[m][bj][0] + gv[bj][0] * acc[ai][bj][m][0], o1 = xb[m][bj][1] + gv[bj][1] * acc[ai][bj][m][1];
                    u32x4 w; w.x = cvt_pk_bf16(o0[0], o0[1]); w.y = cvt_pk_bf16(o0[2], o0[3]); w.z = cvt_pk_bf16(o1[0], o1[1]); w.w = cvt_pk_bf16(o1[2], o1[3]);
                    *(u32x4*)(O + ro + bj * HALF) = w; } }
        }
    }
};
struct EpiMoe1 {
    static constexpr bool PERM = false;
    unsigned char* Aout;
    __device__ __forceinline__ void operator()(const f32x4 (&acc)[2][2][4][2], const Unit& u, int wr, int wc, int fr, int fq) const {
        const int row0 = u.x0 + wr * 64 + fr; const float s8 = (float)(1 << A8_SCALE_LOG2);
#pragma unroll
        for (int ai = 0; ai < 2; ++ai)
#pragma unroll
            for (int m = 0; m < 4; ++m) { unsigned char* rowp = Aout + (size_t)(row0 + ai * HALF + m * 16) * DFF;
#pragma unroll
                for (int bj = 0; bj < 2; ++bj) { const f32x4 a1 = acc[ai][bj][m][0], a3 = acc[ai][bj][m][1]; float o[4];
#pragma unroll
                    for (int j = 0; j < 4; ++j) o[j] = fminf(fmaxf(a1[j] * sigmoidf_(a1[j]) * a3[j] * s8, -440.f), 440.f);
                    *(unsigned*)(rowp + (8 * u.pn + 4 * bj + wc) * 16 + 4 * fq) = cvt_fp8x4_(o[0], o[1], o[2], o[3]); } }
    }
};
struct EpiMoe2 {
    static constexpr bool PERM = true;
    bf16_t* Y;
    __device__ __forceinline__ void operator()(const f32x4 (&acc)[2][2][4][2], const Unit& u, int wr, int wc, int fr, int fq) const {
        const int row0 = u.x0 + wr * 64 + fr, col0 = u.pn * BM + wc * 32 + 8 * fq;
#pragma unroll
        for (int ai = 0; ai < 2; ++ai)
#pragma unroll
            for (int m = 0; m < 4; ++m) { bf16_t* rowp = Y + (size_t)(row0 + ai * HALF + m * 16) * DM + col0;
                if (wr * 64 + fr + ai * HALF + m * 16 < u.x1) {
#pragma unroll
                for (int bj = 0; bj < 2; ++bj) { const f32x4 v0 = acc[ai][bj][m][0], v1 = acc[ai][bj][m][1];
                    u32x4 w; w.x = cvt_pk_bf16(v0[0], v0[1]); w.y = cvt_pk_bf16(v0[2], v0[3]); w.z = cvt_pk_bf16(v1[0], v1[1]); w.w = cvt_pk_bf16(v1[2], v1[3]);
                    *(u32x4*)(rowp + bj * HALF) = w; } } }
    }
};
}
struct Args {
    const float* in[20]; float* out; unsigned char* ws; int ph_lo, ph_hi, dry;
};
struct Frame {
    LAS unsigned char* lds; int tid, lane, wave, G, bid, vcu;
    const float *x, *c, *w_ada, *b_ada, *norm_mix, *w_in, *t5, *rel, *w_up_a, *w_up_b, *w_o, *norm_ffn, *w_rg, *b_rg, *w_re, *b_re, *w1, *w3, *w2, *norm_final;
    float* out; unsigned char* ws;
    float* mod; unsigned* ecnt;
    bf16_t *WinT, *WupaT, *WupbT, *WoT, *W13T, *W2T, *H, *PROJ, *YA, *YB, *MRG;
    unsigned char *WinT8, *H8, *W13T8, *W2T8, *Wupa8, *Wupb8, *Wo8;
    unsigned long long* MASK; int* LIST; int* TSLOT; float* TW;
    bf16_t *RBH, *RBL; float* RC;
};

__device__ __forceinline__ void p0_mod(const Frame& F) {
    LAS float* red = (LAS float*)F.lds;
    for (int b = F.bid; b < 256; b += F.G) {
        const int t = F.tid;
        f32x4 acc = {0.f, 0.f, 0.f, 0.f};
        const int c4 = t % 12, kg = t / 12;
        if (t < 480) {
            const float* wp = F.w_ada + b * 48 + c4 * 4;
            int k = kg;
            for (; k + 7 * 40 < DM; k += 8 * 40) {
                f32x4 w[8]; float sv[8];
#pragma unroll
                for (int u = 0; u < 8; ++u) { w[u] = *(const f32x4*)(wp + (size_t)(k + 40 * u) * 12288); const float cv = F.c[k + 40 * u]; sv[u] = cv * sigmoidf_(cv); }
#pragma unroll
                for (int u = 0; u < 8; ++u) acc += w[u] * sv[u];
            }
            for (; k < DM; k += 40) { const float cv = F.c[k]; const float s = cv * sigmoidf_(cv); const f32x4 w = *(const f32x4*)(wp + (size_t)k * 12288); acc += w * s; }
            *(LAS f32x4*)(red + (kg * 12 + c4) * 4) = acc;
        }
        __syncthreads();
        if (t < 12) { f32x4 sum = *(const f32x4*)(F.b_ada + b * 48 + t * 4);
            for (int g = 0; g < 40; ++g) sum += *(LAS f32x4*)(red + (g * 12 + t) * 4);
            *(f32x4*)(F.mod + b * 48 + t * 4) = sum; }
        __syncthreads();
    }
}
__device__ __forceinline__ int rowmap(int n, int mode) { return mode == 0 ? n : (32 * (n >> 4) + (n & 15) + (mode == 2 ? 16 : 0)); }
__device__ __forceinline__ unsigned cvt_fp8x4(float a, float b, float c, float d) {
    int w = 0;
    w = __builtin_amdgcn_cvt_pk_fp8_f32(a, b, w, false);
    w = __builtin_amdgcn_cvt_pk_fp8_f32(c, d, w, true);
    return (unsigned)w;
}
constexpr int TC_WIN = 32 * 178, TC_UP = 16 * 32, TC_WO = 32 * 32, TC_W1 = NEXP * 32 * 8, TC_W2 = NEXP * 8 * 32;
constexpr int TC_TOTAL = TC_WIN + 2 * TC_UP + TC_WO + 2 * TC_W1 + TC_W2;
constexpr int TC_EARLY = TC_WIN + 2 * TC_UP + TC_WO;
#ifndef TC_LATE_START
#define TC_LATE_START TC_EARLY
#endif
struct TDesc { const float* src; int N, k0, n0, ldd, mode; unsigned char* dst; };
__device__ __forceinline__ bool tconv_desc(const Frame& F, int tl, TDesc& d, int limit = TC_TOTAL) {
    if (tl >= limit) return false;
    int r = tl;
    if (r < TC_WIN) { d.src = F.w_in; d.N = NPROJ_REAL; d.k0 = (r % 32) * 64; d.n0 = (r / 32) * 64; d.dst = (unsigned char*)F.WinT; d.ldd = DM; d.mode = 3; return true; }
    r -= TC_WIN;
    if (r < TC_UP) { d.src = F.w_up_a; d.N = DM; d.k0 = (r % 16) * 64; d.n0 = (r / 16) * 64; d.dst = F.Wupa8; { int l_ = 2048; asm volatile("" : "+s"(l_)); d.ldd = l_; } d.mode = 7; return true; }
    r -= TC_UP;
    if (r < TC_UP) { d.src = F.w_up_b; d.N = DM; d.k0 = (r % 16) * 64; d.n0 = (r / 16) * 64; d.dst = F.Wupa8 + 1024; { int l_ = 2048; asm volatile("" : "+s"(l_)); d.ldd = l_; } d.mode = 7; return true; }
    r -= TC_UP;
    if (r < TC_WO) { d.src = F.w_o; d.N = DM; d.k0 = (r % 32) * 64; d.n0 = (r / 32) * 64; d.dst = F.Wo8; d.ldd = DM; d.mode = 7; return true; }
    r -= TC_WO;
    if (r < TC_W1) { const int e = r / 256, q = r % 256; d.src = F.w1 + (size_t)e * DM * DFF; d.N = DFF; d.k0 = (q % 32) * 64; d.n0 = (q / 32) * 64; d.dst = F.W13T8 + (size_t)e * 1024 * DM; d.ldd = DM; d.mode = 4; return true; }
    r -= TC_W1;
    if (r < TC_W1) { const int e = r / 256, q = r % 256; d.src = F.w3 + (size_t)e * DM * DFF; d.N = DFF; d.k0 = (q % 32) * 64; d.n0 = (q / 32) * 64; d.dst = F.W13T8 + (size_t)e * 1024 * DM; d.ldd = DM; d.mode = 5; return true; }
    r -= TC_W1;
    { const int e = r / 256, q = r % 256; d.src = F.w2 + (size_t)e * DFF * DM; d.N = DM; d.k0 = (q % 8) * 64; d.n0 = (q / 8) * 64; d.dst = F.W2T8 + (size_t)e * DM * DFF; d.ldd = DFF; d.mode = 6; return true; }
}
__device__ __forceinline__ void tconv_load(const Frame& F, const TDesc& d, f32x4 (&v)[2]) {
    const int kk = F.tid >> 4, n4 = (F.tid & 15) * 4;
    const int nn = min(d.n0 + n4, d.N - 4);
    const float* p0 = d.src + (size_t)(d.k0 + kk) * d.N + nn; const float* p1 = p0 + (size_t)32 * d.N;
    asm volatile("global_load_dwordx4 %0, %1, off" : "=v"(v[0]) : "v"(p0) : "memory");
    asm volatile("global_load_dwordx4 %0, %1, off" : "=v"(v[1]) : "v"(p1) : "memory");
}
__device__ __forceinline__ void tconv_to_lds(const Frame& F, const f32x4 (&vin)[2], LAS float* tile  ) {
    const int t = F.tid, kk = t >> 4, n4 = (t & 15) * 4;
#pragma unroll
    for (int h = 0; h < 2; ++h) { const int k = kk + 32 * h; tile[k * 65 + n4 + 0] = vin[h][0]; tile[k * 65 + n4 + 1] = vin[h][1]; tile[k * 65 + n4 + 2] = vin[h][2]; tile[k * 65 + n4 + 3] = vin[h][3]; }
}
__device__ __forceinline__ void tconv_from_lds(const Frame& F, const TDesc& d, const LAS float* tile) {
    const int t = F.tid;
    { const int n = t >> 3, kq = (t & 7) * 8; const int k0 = d.k0, n0 = d.n0, mode = d.mode;
      if (n0 + n < d.N) {
        float v[8];
#pragma unroll
        for (int i = 0; i < 8; ++i) v[i] = tile[(kq + i) * 65 + n];
        if (mode == 3) {
            const int c = n0 + n; int rb = -1, r8 = -1;
            if (c < 2048) rb = c; else if (c < 3072) r8 = c - 2048; else if (c < 6224) rb = c - 1024; else if (c < 7248) r8 = 1024 + (c - 6224); else r8 = 2048 + (c - 7248);
            if (rb >= 0) { u32x4 w; w.x = cvt_pk_bf16(v[0], v[1]); w.y = cvt_pk_bf16(v[2], v[3]); w.z = cvt_pk_bf16(v[4], v[5]); w.w = cvt_pk_bf16(v[6], v[7]);
                *(u32x4*)(F.WinT + (size_t)rb * DM + k0 + kq) = w; }
            else { const float sc = (float)(1 << W8_SCALE_LOG2); u32x2 w; w.x = cvt_fp8x4_(v[0] * sc, v[1] * sc, v[2] * sc, v[3] * sc); w.y = cvt_fp8x4_(v[4] * sc, v[5] * sc, v[6] * sc, v[7] * sc);
                *(u32x2*)(F.WinT8 + (size_t)r8 * DM + k0 + kq) = w; }
        } else {
            const float sc = (float)(1 << (mode == 6 ? W2_SCALE_LOG2 : W8_SCALE_LOG2)); const int r = rowmap(n0 + n, mode == 4 ? 1 : (mode == 5 ? 2 : 0));
            u32x2 w; w.x = cvt_fp8x4_(v[0] * sc, v[1] * sc, v[2] * sc, v[3] * sc); w.y = cvt_fp8x4_(v[4] * sc, v[5] * sc, v[6] * sc, v[7] * sc);
            *(u32x2*)(d.dst + (size_t)r * d.ldd + k0 + kq) = w; } } }
}
__device__ __forceinline__ void tconv_store(const Frame& F, const TDesc& d, const f32x4 (&vin)[2], int ahead  ) {
    LAS float* tile = (LAS float*)F.lds;
    if (ahead >= 4) asm volatile("s_waitcnt vmcnt(8)" ::: "memory"); else if (ahead == 3) asm volatile("s_waitcnt vmcnt(6)" ::: "memory"); else if (ahead == 2) asm volatile("s_waitcnt vmcnt(4)" ::: "memory");
    else if (ahead == 1) asm volatile("s_waitcnt vmcnt(2)" ::: "memory"); else asm volatile("s_waitcnt vmcnt(0)" ::: "memory");
#ifdef DIAG_ZERO_P0_WUP
    if (d.mode == 7 && d.ldd == 1024) { const f32x4 z[2] = {(f32x4){0.f,0.f,0.f,0.f}, (f32x4){0.f,0.f,0.f,0.f}}; tconv_to_lds(F, z, tile); } else
#endif
    tconv_to_lds(F, vin, tile);
    __syncthreads();
    tconv_from_lds(F, d, tile);
    __syncthreads();
}
constexpr int CONV_LDS_OFF = 16384, CONV_LDS_BYTES = 64 * 64 * 4;
struct ConvSt { int base, cs; };
__device__ __forceinline__ LAS unsigned char* conv_buf(const Frame& F, int i) { return F.lds + CONV_LDS_OFF + (((i % 3) + 3) % 3) * CONV_LDS_BYTES; }
__device__ __forceinline__ bool conv_issue(const Frame& F, int tl, int bufi) {
    TDesc d; if (!tconv_desc(F, tl, d)) return false;
    LAS unsigned char* buf = conv_buf(F, bufi);
#pragma unroll
    for (int p = 0; p < 2; ++p) {
        const int k = p * 32 + (F.tid >> 4), c = F.tid & 15, cs = c ^ ((k >> 3) & 7);
        const float* g = d.src + (size_t)(d.k0 + k) * d.N + d.n0 + 4 * cs;
        __builtin_amdgcn_global_load_lds((const unsigned*)g, (LAS unsigned*)(buf + p * 8192 + F.wave * 1024), 16, 0, 0);
    }
    return true;
}
__device__ __forceinline__ void conv_drain(const Frame& F, int tl, int bufi) {
    TDesc d; if (tl < 0 || !tconv_desc(F, tl, d)) return;
    const LAS float* tile = (const LAS float*)conv_buf(F, bufi);
    const int t = F.tid, n = t >> 3, kq = (t & 7) * 8, f = t & 7;
    float v[8];
#pragma unroll
    for (int i = 0; i < 8; ++i) v[i] = tile[(kq + i) * 64 + (((n >> 2) ^ f) << 2) + (n & 3)];
    const int mode = d.mode;
    const float sc = (float)(1 << (mode == 6 ? W2_SCALE_LOG2 : W8_SCALE_LOG2)); const int r = rowmap(d.n0 + n, mode == 4 ? 1 : (mode == 5 ? 2 : 0));
    u32x2 w; w.x = cvt_fp8x4_(v[0] * sc, v[1] * sc, v[2] * sc, v[3] * sc); w.y = cvt_fp8x4_(v[4] * sc, v[5] * sc, v[6] * sc, v[7] * sc);
    *(u32x2*)(d.dst + (size_t)r * d.ldd + d.k0 + kq) = w;
}
__device__ __forceinline__ void p0_convert(const Frame& F) {
    TDesc d0, d1, d2, d3, d4; f32x4 v0[2], v1[2], v2[2], v3[2], v4[2];
    int tl = F.bid; const int G = F.G;
    bool h0 = tconv_desc(F, tl, d0, TC_EARLY); if (h0) tconv_load(F, d0, v0);
    bool h1 = tconv_desc(F, tl + G, d1, TC_EARLY); if (h1) tconv_load(F, d1, v1);
    bool h2 = tconv_desc(F, tl + 2 * G, d2, TC_EARLY); if (h2) tconv_load(F, d2, v2);
    bool h3 = tconv_desc(F, tl + 3 * G, d3, TC_EARLY); if (h3) tconv_load(F, d3, v3);
    bool h4 = false;
#define TC_STEP(HX, DX, VX, HN, DN, VN, K, A1, A2, A3) \
        if (!HX) break; \
        HN = tconv_desc(F, tl + (K) * G, DN, TC_EARLY); if (HN) tconv_load(F, DN, VN); \
        tconv_store(F, DX, VX, (A1 ? 1 : 0) + (A2 ? 1 : 0) + (A3 ? 1 : 0) + (HN ? 1 : 0));
    for (;;) {
        TC_STEP(h0, d0, v0, h4, d4, v4, 4, h1, h2, h3)
        TC_STEP(h1, d1, v1, h0, d0, v0, 5, h2, h3, h4)
        TC_STEP(h2, d2, v2, h1, d1, v1, 6, h3, h4, h0)
        TC_STEP(h3, d3, v3, h2, d2, v2, 7, h4, h0, h1)
        TC_STEP(h4, d4, v4, h3, d3, v3, 8, h0, h1, h2)
        tl += 5 * G;
    }
#undef TC_STEP
    asm volatile("s_waitcnt vmcnt(0)" ::: "memory");
    { u32x4* z = (u32x4*)(F.WinT + (size_t)NPB_REAL * DM); const int n16 = (NPB - NPB_REAL) * DM * 2 / 16;
      for (int i = F.bid * 512 + F.tid; i < n16; i += F.G * 512) z[i] = (u32x4){0u, 0u, 0u, 0u}; }
}

__device__ __forceinline__ void p1_router_prep(const Frame& F, int col0, int cstep) {
    const float* sh2 = F.mod + 3 * DM; const float* sc2 = F.mod + 4 * DM;
    LAS float* red = (LAS float*)F.lds;
    for (int col = col0; col < 96; col += cstep) {
        const int k = F.tid * 4;
        const f32x4 ga = *(const f32x4*)(F.norm_ffn + k) * (*(const f32x4*)(sc2 + k) + 1.0f), gb = *(const f32x4*)(sh2 + k);
        float w[4], gbw = 0.f;
#pragma unroll
        for (int j = 0; j < 4; ++j) { const float wv = col < 8 ? F.w_rg[(size_t)(k + j) * 8 + col] : (col < 72 ? F.w_re[(size_t)(k + j) * 64 + (col - 8)] : 0.f); gbw += gb[j] * wv; w[j] = wv * ga[j]; }
        u32x2 h, l;
        h.x = cvt_pk_bf16(w[0], w[1]); h.y = cvt_pk_bf16(w[2], w[3]);
        l.x = cvt_pk_bf16(w[0] - bf_lo(h.x), w[1] - bf_hi(h.x)); l.y = cvt_pk_bf16(w[2] - bf_lo(h.y), w[3] - bf_hi(h.y));
        { unsigned char* fb = (unsigned char*)F.RBH + (size_t)(((k >> 4) * 3 + (col >> 5)) * 2) * 1024 + ((col & 31) + 32 * ((k >> 3) & 1)) * 16 + (k & 7) * 2;
          *(u32x2*)fb = h; *(u32x2*)(fb + 1024) = l; }
        gbw = wave_sum(gbw);
        if (F.lane == 0) red[F.wave] = gbw;
        __syncthreads();
        if (F.tid == 0) { float s = 0.f; for (int i = 0; i < 8; ++i) s += red[i]; F.RC[col] = s; }
        __syncthreads();
    }
}

__device__ __forceinline__ void p1_norm(const Frame& F) {
    const float* sh1 = F.mod; const float* sc1 = F.mod + DM;
    f32x4 ga[8], gb[8];
#pragma unroll
    for (int j = 0; j < 8; ++j) { const int c = 4 * F.lane + 256 * j; const f32x4 nm = *(const f32x4*)(F.norm_mix + c), sc = *(const f32x4*)(sc1 + c); ga[j] = nm * (sc + 1.0f); gb[j] = *(const f32x4*)(sh1 + c); }
    const int rstep = F.G * 8; int row = F.bid * 8 + F.wave;
    f32x4 v[8], vn[8];
    if (row < SEQ) {
#pragma unroll
        for (int j = 0; j < 8; ++j) v[j] = *(const f32x4*)(F.x + (size_t)row * DM + 4 * F.lane + 256 * j);
    }
    for (; row < SEQ; row += rstep) {
        const int nrow = row + rstep;
        if (nrow < SEQ) {
#pragma unroll
            for (int j = 0; j < 8; ++j) vn[j] = *(const f32x4*)(F.x + (size_t)nrow * DM + 4 * F.lane + 256 * j);
        }
        float ss = 0.f;
#pragma unroll
        for (int j = 0; j < 8; ++j) ss += v[j][0] * v[j][0] + v[j][1] * v[j][1] + v[j][2] * v[j][2] + v[j][3] * v[j][3];
        ss = wave_sum(ss);
        const float rstd = __builtin_amdgcn_rsqf(ss * (1.0f / DM) + EPS);
        bf16_t* hp = F.H + (size_t)row * DM + 4 * F.lane; unsigned char* h8 = F.H8 + (size_t)row * DM + 4 * F.lane;
        const float s8 = (float)(1 << H8_SCALE_LOG2);
#pragma unroll
        for (int j = 0; j < 8; ++j) { const f32x4 o = v[j] * rstd * ga[j] + gb[j]; u32x2 w; w.x = cvt_pk_bf16(o[0], o[1]); w.y = cvt_pk_bf16(o[2], o[3]); *(u32x2*)(hp + 256 * j) = w;
            const f32x4 c8 = __builtin_elementwise_min(__builtin_elementwise_max(o * s8, (f32x4){-440.f, -440.f, -440.f, -440.f}), (f32x4){440.f, 440.f, 440.f, 440.f});
            *(unsigned*)(h8 + 256 * j) = cvt_fp8x4_(c8[0], c8[1], c8[2], c8[3]); }
#pragma unroll
        for (int j = 0; j < 8; ++j) v[j] = vn[j];
    }
}

constexpr int P8_RSTD = 0, P8_ECL = 256, P8_EBASE = 512, P8_LOG = 1024, P8_AS = 32768, P8_AS_STRIDE = 64 * 80;
__device__ __forceinline__ void p8_router(const Frame& F, const int dry = 0) {
    const float* sh2 = F.mod + 3 * DM; const float* sc2 = F.mod + 4 * DM;
    const bf16_t* X1 = F.H;
    LAS float* rs = (LAS float*)(F.lds + P8_RSTD);
    LAS float* lg = (LAS float*)(F.lds + P8_LOG);
    for (int blk = F.bid; blk < SEQ / 64; blk += F.G) {
        const int T0 = blk * 64;
        if (dry < 5) {
            int l4 = 4 * F.lane; asm volatile("" : "+v"(l4));
            f32x4 ga[8], gb[8];
#pragma unroll
            for (int j = 0; j < 8; ++j) { const int c = l4 + 256 * j; const f32x4 nm = *(const f32x4*)(F.norm_ffn + c), sc = *(const f32x4*)(sc2 + c); ga[j] = nm * (sc + 1.0f); gb[j] = *(const f32x4*)(sh2 + c); }
            u32x2 xw[8], xwn[8];
            { const bf16_t* xp = X1 + (size_t)(T0 + F.wave) * DM + l4;
#pragma unroll
              for (int j = 0; j < 8; ++j) xw[j] = *(const u32x2*)(xp + 256 * j); }
            for (int r = F.wave; r < 64; r += 8) {
                if (r + 8 < 64) { const bf16_t* xp = X1 + (size_t)(T0 + r + 8) * DM + l4;
#pragma unroll
                    for (int j = 0; j < 8; ++j) xwn[j] = *(const u32x2*)(xp + 256 * j); }
                f32x4 v[8]; float ss = 0.f;
#pragma unroll
                for (int j = 0; j < 8; ++j) { const u32x2 w = xw[j]; v[j] = (f32x4){bf_lo(w.x), bf_hi(w.x), bf_lo(w.y), bf_hi(w.y)}; }
#pragma unroll
                for (int j = 0; j < 8; ++j) ss += v[j][0] * v[j][0] + v[j][1] * v[j][1] + v[j][2] * v[j][2] + v[j][3] * v[j][3];
                ss = wave_sum(ss);
                const float rstd = __builtin_amdgcn_rsqf(ss * (1.0f / DM) + EPS);
                if (F.lane == 0) rs[r] = rstd;
                unsigned char* hp = F.H8 + (size_t)(T0 + r) * DM + l4; const float s8 = (float)(1 << H8_SCALE_LOG2);
#pragma unroll
                for (int j = 0; j < 8; ++j) { const f32x4 o = v[j] * rstd * ga[j] + gb[j];
                    const f32x4 c8 = __builtin_elementwise_min(__builtin_elementwise_max(o * s8, (f32x4){-440.f, -440.f, -440.f, -440.f}), (f32x4){440.f, 440.f, 440.f, 440.f});
                    *(unsigned*)(hp + 256 * j) = cvt_fp8x4_(c8[0], c8[1], c8[2], c8[3]); }
#pragma unroll
                for (int j = 0; j < 8; ++j) xw[j] = xwn[j];
            }
            if (F.tid < 64) ((LAS int*)(F.lds + P8_ECL))[F.tid] = 0;
        }
        __syncthreads();
        f32x16 acc[2][3];
#pragma unroll
        for (int a = 0; a < 2; ++a)
#pragma unroll
            for (int b = 0; b < 3; ++b)
#pragma unroll
                for (int i = 0; i < 16; ++i) acc[a][b][i] = 0.f;
        if (dry < 4) {
            const int mi = F.lane & 31, mk = F.lane >> 5;
            LAS unsigned char* Aw = F.lds + P8_AS + F.wave * P8_AS_STRIDE;
            const int lrow = F.lane >> 2, lpc = F.lane & 3;
            unsigned gao = (unsigned)((T0 + lrow) * DM + F.wave * 256 + lpc * 8) * 2u; asm volatile("" : "+v"(gao));
            const char* xbase = (const char*)X1;
            const unsigned law = (unsigned)(lrow * 80 + lpc * 16), lar = (unsigned)(mi * 80 + mk * 16);
            unsigned bo = (unsigned)(F.wave * 16 * 6 * 1024 + F.lane * 16); asm volatile("" : "+v"(bo));
            const char* bbase = (const char*)F.RBH;
            u32x4 ac[4], an[4], bq[4][6];
#define P8_LDA(c, R) { _Pragma("unroll") for (int i = 0; i < 4; ++i) R[i] = *(const u32x4*)(xbase + gao + (c) * 64 + i * (16 * DM * 2)); }
#define P8_LDB(ks, R) { _Pragma("unroll") for (int q = 0; q < 6; ++q) R[q] = *(const u32x4*)(bbase + bo + ((ks) * 6 + q) * 1024); }
            P8_LDA(0, ac) P8_LDB(0, bq[0]) P8_LDB(1, bq[1]) P8_LDB(2, bq[2])
#pragma unroll
            for (int c = 0; c < 8; ++c) {
#pragma unroll
                for (int i = 0; i < 4; ++i) *(LAS u32x4*)(Aw + law + i * (16 * 80)) = ac[i];
                if (c + 1 < 8) P8_LDA(c + 1, an)
#pragma unroll
                for (int s = 0; s < 2; ++s) {
                    const int ks = c * 2 + s;
                    if (ks + 3 < 16) P8_LDB(ks + 3, bq[(ks + 3) & 3])
                    const bf16x8 a0 = *(const LAS bf16x8*)(Aw + lar + s * 32), a1 = *(const LAS bf16x8*)(Aw + lar + 32 * 80 + s * 32);
#pragma unroll
                    for (int nt = 0; nt < 3; ++nt) { const bf16x8 h_ = __builtin_bit_cast(bf16x8, bq[ks & 3][2 * nt]), l_ = __builtin_bit_cast(bf16x8, bq[ks & 3][2 * nt + 1]);
                        acc[0][nt] = __builtin_amdgcn_mfma_f32_32x32x16_bf16(a0, l_, acc[0][nt], 0, 0, 0); acc[1][nt] = __builtin_amdgcn_mfma_f32_32x32x16_bf16(a1, l_, acc[1][nt], 0, 0, 0);
                        acc[0][nt] = __builtin_amdgcn_mfma_f32_32x32x16_bf16(a0, h_, acc[0][nt], 0, 0, 0); acc[1][nt] = __builtin_amdgcn_mfma_f32_32x32x16_bf16(a1, h_, acc[1][nt], 0, 0, 0); }
                }
#pragma unroll
                for (int i = 0; i < 4; ++i) ac[i] = an[i];
            }
#undef P8_LDA
#undef P8_LDB
        }
        if (dry < 3) {
            LAS f32x4* R = (LAS f32x4*)(F.lds + P8_AS);
#define P8_WR(reg) { _Pragma("unroll") for (int q = 0; q < 24; ++q) { const int t_ = q >> 2, rq = q & 3; \
                const f32x4 v_ = {acc[t_ / 3][t_ % 3][4 * rq], acc[t_ / 3][t_ % 3][4 * rq + 1], acc[t_ / 3][t_ % 3][4 * rq + 2], acc[t_ / 3][t_ % 3][4 * rq + 3]}; R[((reg) * 24 + q) * 64 + F.lane] = v_; } }
#define P8_RD(reg) { _Pragma("unroll") for (int q = 0; q < 24; ++q) { const int t_ = q >> 2, rq = q & 3; const f32x4 v_ = R[((reg) * 24 + q) * 64 + F.lane]; \
                acc[t_ / 3][t_ % 3][4 * rq] += v_[0]; acc[t_ / 3][t_ % 3][4 * rq + 1] += v_[1]; acc[t_ / 3][t_ % 3][4 * rq + 2] += v_[2]; acc[t_ / 3][t_ % 3][4 * rq + 3] += v_[3]; } }
            __syncthreads();
            if (F.wave >= 4) P8_WR(F.wave - 4)
            __syncthreads();
            if (F.wave < 4) P8_RD(F.wave)
            if (F.wave == 2 || F.wave == 3) P8_WR(F.wave)
            __syncthreads();
            if (F.wave < 2) P8_RD(F.wave + 2)
            if (F.wave == 1) P8_WR(3)
            __syncthreads();
            if (F.wave == 0) {
                P8_RD(3)
                const int col = F.lane & 31, hi = F.lane >> 5;
#pragma unroll
                for (int mt = 0; mt < 2; ++mt)
#pragma unroll
                    for (int nt = 0; nt < 3; ++nt)
#pragma unroll
                        for (int r = 0; r < 16; ++r) { const int tok = 32 * mt + (r & 3) + 8 * (r >> 2) + 4 * hi; lg[tok * 96 + 32 * nt + col] = acc[mt][nt][r]; }
            }
#undef P8_WR
#undef P8_RD
            __syncthreads();
        }
        if (F.tid < 64 && dry < 2) {
            const int tok = F.tid, T = T0 + tok; const LAS float* Lr = lg + tok * 96; const float* Lc = F.RC; const float rsv = rs[tok];
#define L(i_) (rsv * Lr[i_] + Lc[i_])
            float g[8]; float gmax = -3.4e38f; int grp = 0;
#pragma unroll
            for (int i = 0; i < 8; ++i) { g[i] = L(i) + F.b_rg[i]; if (g[i] > gmax) { gmax = g[i]; grp = i; } }
            float den = 0.f;
#pragma unroll
            for (int i = 0; i < 8; ++i) den += __expf(g[i] - gmax);
            const float pgrp = 1.0f / den;
            float v0 = -3.4e38f, v1 = -3.4e38f; int i0 = 0, i1 = 0;
#pragma unroll
            for (int i = 0; i < 8; ++i) { const float e = L(8 + grp * 8 + i) + F.b_re[grp * 8 + i];
                if (e > v0) { v1 = v0; i1 = i0; v0 = e; i0 = i; } else if (e > v1) { v1 = e; i1 = i; } }
            const float ex = __expf(v1 - v0); const float p0 = 1.0f / (1.0f + ex), p1 = ex / (1.0f + ex);
            const int e0 = grp * 8 + i0, e1 = grp * 8 + i1;
            if (dry >= 1) { if (pgrp * p0 + (float)(e0 + e1) == -12345.0f) F.TW[0] = p1; } else {
                LAS int* ecl = (LAS int*)(F.lds + P8_ECL); LAS unsigned* ebase = (LAS unsigned*)(F.lds + P8_EBASE);
                const int lr0 = __hip_atomic_fetch_add(ecl + e0, 1, __ATOMIC_RELAXED, __HIP_MEMORY_SCOPE_WORKGROUP), lr1 = __hip_atomic_fetch_add(ecl + e1, 1, __ATOMIC_RELAXED, __HIP_MEMORY_SCOPE_WORKGROUP);
                asm volatile("s_waitcnt lgkmcnt(0)" ::: "memory");
                { const int cn = ecl[tok]; ebase[tok] = cn ? atomicAdd(F.ecnt + 16 * tok, (unsigned)cn) : 0u; }
                asm volatile("s_waitcnt vmcnt(0) lgkmcnt(0)" ::: "memory");
                const unsigned pos0 = ebase[e0] + (unsigned)lr0, pos1 = ebase[e1] + (unsigned)lr1;
                F.LIST[(size_t)e0 * LIST_CAP + pos0] = T; F.LIST[(size_t)e1 * LIST_CAP + pos1] = T;
                F.TSLOT[2 * T + 0] = (e0 << 16) | (int)pos0; F.TSLOT[2 * T + 1] = (e1 << 16) | (int)pos1;
                F.TW[2 * T + 0] = pgrp * p0; F.TW[2 * T + 1] = pgrp * p1;
            }
#undef L
        }
        __syncthreads();
    }
}

constexpr int MOE_TS = 131072, MOE_CNT = 131072 + 512, MOE_TOK = 131072 + 1024;
__device__ __forceinline__ void moe_tables(const Frame& F) {
    LAS int* ts = (LAS int*)(F.lds + MOE_TS); LAS int* cn = (LAS int*)(F.lds + MOE_CNT);
    if (F.tid < 64) cn[F.tid] = (int)__hip_atomic_load(F.ecnt + 16 * F.tid, __ATOMIC_RELAXED, __HIP_MEMORY_SCOPE_AGENT);
    __syncthreads();
    if (F.tid == 0) { int s = 0; for (int e = 0; e < 64; ++e) { ts[e] = s; s += (cn[e] + 255) >> 8; } ts[64] = s; }
    __syncthreads();
}
__device__ __forceinline__ int moe_find(const LAS int* ts, int T) {
    int lo = 0, hi = 64;
    while (hi - lo > 1) { const int mid = (lo + hi) >> 1; if (ts[mid] <= T) lo = mid; else hi = mid; }
    return lo;
}
struct MoeOrder1 {
    const Frame* F; const LAS int* ts; const LAS int* tokl;
    __device__ __forceinline__ bool next(int i, pg8::Unit& u) const {
        const int uu = i * F->G + F->vcu, T = uu >> 2; if (T >= ts[64]) return false;
        const int e = moe_find(ts, T);
        u.pm = T; u.pn = uu & 3; u.A = (const char*)F->H8; u.B = (const char*)(F->W13T8 + (size_t)e * 1024 * DM + (size_t)u.pn * 256 * DM); u.x0 = T * 256; u.x1 = i; return true;
    }
    __device__ __forceinline__ int arow(const pg8::Unit& u, int r) const { return tokl[u.x1 * 256 + r]; }
};
struct MoeOrder2 {
    const Frame* F; const LAS int* ts;
    __device__ __forceinline__ bool next(int i, pg8::Unit& u) const {
        const int uu = i * F->G + F->vcu, T = uu >> 3; if (T >= ts[64]) return false;
        const int e = moe_find(ts, T);
        u.pm = T; u.pn = uu & 7; u.A = (const char*)F->MRG + (size_t)T * 256 * DFF; u.B = (const char*)(F->W2T8 + (size_t)e * DM * DFF + (size_t)u.pn * 256 * DFF); u.x0 = T * 256;
        { const LAS int* cn = (const LAS int*)(F->lds + MOE_CNT); const int left = cn[e] - (T - ts[e]) * 256; u.x1 = left < 256 ? left : 256; }
        return true;
    }
    __device__ __forceinline__ int arow(const pg8::Unit&, int r) const { return r; }
};
__device__ __forceinline__ void moe1_fill_lists(const Frame& F) {
    const LAS int* ts = (const LAS int*)(F.lds + MOE_TS); const LAS int* cn = (const LAS int*)(F.lds + MOE_CNT); LAS int* tokl = (LAS int*)(F.lds + MOE_TOK);
    for (int i = 0; i < 8; ++i) {
        const int uu = i * F.G + F.vcu, T = uu >> 2; if (T >= ts[64]) break;
        const int e = moe_find(ts, T), mt = T - ts[e];
        if (F.tid < 256) { const int pos = mt * 256 + F.tid; tokl[i * 256 + F.tid] = pos < cn[e] ? F.LIST[(size_t)e * LIST_CAP + pos] : 0; }
    }
    __syncthreads();
}

__device__ __forceinline__ void p11_final(const Frame& F, float tsc) {
    const LAS int* ts = (const LAS int*)(F.lds + MOE_TS);
    const float* g2 = F.mod + 5 * DM; const bf16_t* Y = F.PROJ;
    f32x4 gg[8], nf[8];
#pragma unroll
    for (int j = 0; j < 8; ++j) { const int c = 4 * F.lane + 256 * j; gg[j] = *(const f32x4*)(g2 + c); nf[j] = *(const f32x4*)(F.norm_final + c); }
    const int rstep = F.G * 8; int row = F.bid * 8 + F.wave;
    u32x2 xw[8], ya[8], yb[8], xwn[8], yan[8], ybn[8]; float w0 = 0.f, w1 = 0.f, w0n = 0.f, w1n = 0.f;
#define P11_LOAD(R, XW, YA, YB, W0, W1) do { const int s0_ = F.TSLOT[2 * (R)], s1_ = F.TSLOT[2 * (R) + 1]; W0 = F.TW[2 * (R)]; W1 = F.TW[2 * (R) + 1]; \
        const size_t r0_ = (size_t)ts[s0_ >> 16] * 256 + (s0_ & 0xffff), r1_ = (size_t)ts[s1_ >> 16] * 256 + (s1_ & 0xffff); \
        const bf16_t* x1p_ = F.H + (size_t)(R) * DM + 4 * F.lane; const bf16_t* y0_ = Y + r0_ * DM + 4 * F.lane; const bf16_t* y1_ = Y + r1_ * DM + 4 * F.lane; \
        _Pragma("unroll") for (int j = 0; j < 8; ++j) { XW[j] = *(const u32x2*)(x1p_ + 256 * j); YA[j] = *(const u32x2*)(y0_ + 256 * j); YB[j] = *(const u32x2*)(y1_ + 256 * j); } } while (0)
    if (row < SEQ) P11_LOAD(row, xw, ya, yb, w0, w1);
    for (; row < SEQ; row += rstep) {
        const int nrow = row + rstep;
        if (nrow < SEQ) P11_LOAD(nrow, xwn, yan, ybn, w0n, w1n);
        float* xp = F.out + (size_t)row * DM + 4 * F.lane;
        f32x4 v[8]; float ss = 0.f;
#pragma unroll
        for (int j = 0; j < 8; ++j) { const f32x4 xv = {bf_lo(xw[j].x), bf_hi(xw[j].x), bf_lo(xw[j].y), bf_hi(xw[j].y)}; const u32x2 a = ya[j], b = yb[j];
            f32x4 m; m[0] = w0 * bf_lo(a.x) + w1 * bf_lo(b.x); m[1] = w0 * bf_hi(a.x) + w1 * bf_hi(b.x); m[2] = w0 * bf_lo(a.y) + w1 * bf_lo(b.y); m[3] = w0 * bf_hi(a.y) + w1 * bf_hi(b.y);
#if defined(DBG_NOMOE)
            m = (f32x4){0.f, 0.f, 0.f, 0.f};
#endif
            v[j] = xv + gg[j] * m; }
#pragma unroll
        for (int j = 0; j < 8; ++j) ss += v[j][0] * v[j][0] + v[j][1] * v[j][1] + v[j][2] * v[j][2] + v[j][3] * v[j][3];
        ss = wave_sum(ss);
        const float rstd = __builtin_amdgcn_rsqf(ss * (1.0f / DM) + EPS) * tsc;
#pragma unroll
        for (int j = 0; j < 8; ++j) *(f32x4*)(xp + 256 * j) = v[j] * rstd * nf[j];
#pragma unroll
        for (int j = 0; j < 8; ++j) { xw[j] = xwn[j]; ya[j] = yan[j]; yb[j] = ybn[j]; }
        w0 = w0n; w1 = w1n;
    }
#undef P11_LOAD
}
namespace att {
constexpr int D = 128, NW = 8, QBLK = 32, KVBLK = 64;
constexpr float SCALE = 0.088388347648318440f;
constexpr float THR = 8.f;
constexpr int LDP = NPROJ;
constexpr int LDO = 2048;
constexpr int SHM_V = KVBLK * D * 2, SHM_K = KVBLK * D * 2;
constexpr int OFF_WS = 2 * SHM_V + 2 * SHM_K, OFF_TAB = OFF_WS + NW * 64 * 4;
constexpr int DLO = -63;
#define KSWZ(row, colB) ((row) * 256 + ((colB) ^ (((row) & 7) << 4)))
#define SBAR() __builtin_amdgcn_sched_barrier(0)
__device__ __forceinline__ int crow(int r, int hi) { return (r & 3) + 8 * (r >> 2) + 4 * hi; }

__device__ __forceinline__ void partialSM(f32x16& p0, f32x16& p1, float& m_reg, float& mn, float& alpha) {
  constexpr float C = SCALE * 1.4426950408889634f;
  float pmax = p0[0];
#pragma unroll
  for (int r = 1; r < 16; ++r) pmax = fmaxf(pmax, p0[r]);
#pragma unroll
  for (int r = 0; r < 16; ++r) pmax = fmaxf(pmax, p1[r]);
  { auto rr = __builtin_amdgcn_permlane32_swap(__float_as_uint(pmax), __float_as_uint(pmax), false, false);
    pmax = fmaxf(__uint_as_float(rr[0]), __uint_as_float(rr[1])); }
  if (__builtin_expect(__all(pmax - m_reg <= THR / SCALE), 1)) { mn = m_reg; alpha = 1.f; }
  else { mn = fmaxf(m_reg, pmax); alpha = __builtin_amdgcn_exp2f((m_reg - mn) * C); m_reg = mn; }
  float mnC = -mn * C;
#pragma unroll
  for (int r = 0; r < 16; ++r) p0[r] = fmaf(p0[r], C, mnC);
#pragma unroll
  for (int r = 0; r < 16; ++r) p1[r] = fmaf(p1[r], C, mnC);
#pragma unroll
  for (int r = 0; r < 16; ++r) p0[r] = __builtin_amdgcn_exp2f(p0[r]);
}
template <int MODE>
__device__ __forceinline__ void finishSM(f32x16& p0, f32x16& p1, float alpha, float& l_reg, bf16x8& pa0, bf16x8& pa1, bf16x8& pa2, bf16x8& pa3) {
#pragma unroll
  for (int r = 0; r < 16; ++r) p1[r] = __builtin_amdgcn_exp2f(p1[r]);
  float ps = 0;
#pragma unroll
  for (int r = 0; r < 16; ++r) ps += p0[r];
#pragma unroll
  for (int r = 0; r < 16; ++r) ps += p1[r];
  { auto rr = __builtin_amdgcn_permlane32_swap(__float_as_uint(ps), __float_as_uint(ps), false, false);
    ps = __uint_as_float(rr[0]) + __uint_as_float(rr[1]); }
  l_reg = l_reg * alpha + ps;
#define PK4(P, BASE, OUT) do { unsigned a0 = cvt_pk_bf16(P[BASE + 0], P[BASE + 1]), a1 = cvt_pk_bf16(P[BASE + 2], P[BASE + 3]);   \
    unsigned b0 = cvt_pk_bf16(P[BASE + 4], P[BASE + 5]), b1 = cvt_pk_bf16(P[BASE + 6], P[BASE + 7]);                              \
    auto r0 = __builtin_amdgcn_permlane32_swap(a0, b0, false, false); auto r1 = __builtin_amdgcn_permlane32_swap(a1, b1, false, false); \
    u32x4 w = {r0[0], r1[0], r0[1], r1[1]}; OUT = *reinterpret_cast<bf16x8*>(&w); } while (0)
  PK4(p0, 0, pa0); PK4(p0, 8, pa1); PK4(p1, 0, pa2); PK4(p1, 8, pa3);
#undef PK4
}
__device__ __forceinline__ void qkt(f32x16& p0, f32x16& p1, const LAS char* Ks, const bf16x8* qr, int r32, int hi) {
#pragma unroll
  for (int i = 0; i < 16; ++i) { p0[i] = 0.f; p1[i] = 0.f; }
#pragma unroll
  for (int d0 = 0; d0 < 8; ++d0) { int cb = (d0 * 16 + hi * 8) * 2;
    bf16x8 b0 = *reinterpret_cast<const LAS bf16x8*>(Ks + KSWZ(r32, cb));
    bf16x8 b1 = *reinterpret_cast<const LAS bf16x8*>(Ks + KSWZ(32 + r32, cb));
    p0 = __builtin_amdgcn_mfma_f32_32x32x16_bf16(b0, qr[d0], p0, 0, 0, 0);
    p1 = __builtin_amdgcn_mfma_f32_32x32x16_bf16(b1, qr[d0], p1, 0, 0, 0); }
}
__device__ __forceinline__ int v_st(int k, int c) { const int kk = (k & ~0xC) | ((k & 4) << 1) | ((k & 8) >> 1); return ((kk >> 3) * 4 + (c >> 5)) * 512 + ((kk & 7) * 32 + (c & 31)) * 2; }
__device__ __forceinline__ int v_rd_base(int lane) { return ((lane & 3) << 3) | (((lane >> 2) & 3) << 6) | (((lane >> 4) & 1) << 5) | (((lane >> 5) & 1) << 8); }
constexpr int v_rd_off(int d0, int ks, int half) { return d0 * 512 + ks * 4096 + half * 2048; }
template <int OFF> __device__ __forceinline__ s16x4 tr_read(int vb) {
  s16x4 r; asm volatile("ds_read_b64_tr_b16 %0, %1 offset:%2" : "=&v"(r) : "v"(vb), "i"(OFF) : "memory"); return r;
}
template <int D0> __device__ __forceinline__ void pv_one(f32x16& od, int vb, bf16x8 pa0, bf16x8 pa1, bf16x8 pa2, bf16x8 pa3) {
  const s16x4 l0 = tr_read<v_rd_off(D0, 0, 0)>(vb), h0 = tr_read<v_rd_off(D0, 0, 1)>(vb), l1 = tr_read<v_rd_off(D0, 1, 0)>(vb), h1 = tr_read<v_rd_off(D0, 1, 1)>(vb);
  const s16x4 l2 = tr_read<v_rd_off(D0, 2, 0)>(vb), h2 = tr_read<v_rd_off(D0, 2, 1)>(vb), l3 = tr_read<v_rd_off(D0, 3, 0)>(vb), h3 = tr_read<v_rd_off(D0, 3, 1)>(vb);
  asm volatile("s_waitcnt lgkmcnt(0)" ::: "memory"); SBAR();
#define PK(L, H) (bf16x8){L[0], L[1], L[2], L[3], H[0], H[1], H[2], H[3]}
  od = __builtin_amdgcn_mfma_f32_32x32x16_bf16(pa0, PK(l0, h0), od, 0, 0, 0);
  od = __builtin_amdgcn_mfma_f32_32x32x16_bf16(pa1, PK(l1, h1), od, 0, 0, 0);
  od = __builtin_amdgcn_mfma_f32_32x32x16_bf16(pa2, PK(l2, h2), od, 0, 0, 0);
  od = __builtin_amdgcn_mfma_f32_32x32x16_bf16(pa3, PK(l3, h3), od, 0, 0, 0);
#undef PK
}
__device__ __forceinline__ void pv_d0(f32x16* o, int vb, bf16x8 pa0, bf16x8 pa1, bf16x8 pa2, bf16x8 pa3) {
  pv_one<0>(o[0], vb, pa0, pa1, pa2, pa3); pv_one<1>(o[1], vb, pa0, pa1, pa2, pa3); pv_one<2>(o[2], vb, pa0, pa1, pa2, pa3); pv_one<3>(o[3], vb, pa0, pa1, pa2, pa3);
}

template <int MODE, int DMAX>
__device__ __forceinline__ void score_hook(f32x16& p0, f32x16& p1, int kt, int tq  , int tq_wave0  , int hi, const LAS float* tab, unsigned long long msk) {
  if (MODE == 1) {
    const int cw = tq_wave0 >> 6;
    if (kt > cw || kt < cw - 8) {
#pragma unroll
      for (int r = 0; r < 16; ++r) { p0[r] = -3.0e38f; p1[r] = -3.0e38f; }
      return;
    }
  }
#ifndef ATT_NOHOOK
  if (tq_wave0 - (kt * 64 + 63) < DMAX) {
    const int base = tq - kt * 64 - 4 * hi - DLO;
#pragma unroll
    for (int r = 0; r < 16; ++r) {
      const int c = (r & 3) + 8 * (r >> 2);
      int i0 = base - c, i1 = base - c - 32;
      i0 = min(max(i0, 0), DMAX - DLO); i1 = min(max(i1, 0), DMAX - DLO);
      p0[r] += tab[i0]; p1[r] += tab[i1];
      SBAR();
    }
  }
#endif
  if (MODE == 0) {
    const unsigned mk0 = (unsigned)msk >> (16 * hi), mk1 = (unsigned)(msk >> 32) >> (16 * hi);
#pragma unroll
    for (int r = 0; r < 16; ++r) {
      { const unsigned m_ = (unsigned)__builtin_amdgcn_sbfe(mk0, r, 1); p0[r] = __uint_as_float((m_ & __float_as_uint(p0[r])) | (~m_ & 0xFF61B1E6u)); }
      { const unsigned m_ = (unsigned)__builtin_amdgcn_sbfe(mk1, r, 1); p1[r] = __uint_as_float((m_ & __float_as_uint(p1[r])) | (~m_ & 0xFF61B1E6u)); }
    }
  }
}

__device__ __forceinline__ unsigned long long mload_(const char* base, unsigned off) { asm volatile("" : "+v"(off)); return *(const unsigned long long*)(base + off); }
template <int MODE, int DMAX>
__device__ __forceinline__ void attn_unit(const bf16_t* __restrict__ Qb  , const bf16_t* __restrict__ Kh  , const bf16_t* __restrict__ Vh,
                                          unsigned char* __restrict__ Ob  , const unsigned long long* __restrict__ maskq  , int q0, int kt0, int kt1, LAS char* lds) {
  const int tid = threadIdx.x, wid = tid >> 6, lane = tid & 63, r32 = lane & 31, hi = lane >> 5;
  LAS char* V_lds = lds; LAS char* K_lds = lds + 2 * SHM_V;
  LAS float* ws = (LAS float*)(lds + OFF_WS) + wid * 64; LAS float* li_l = ws; LAS float* al_l = ws + 32;
  const LAS float* tab = (const LAS float*)(lds + OFF_TAB);
  float m_reg = -1e30f, l_reg = 0; f32x16 o[4]; bf16x8 qr[8];
#pragma unroll
  for (int d = 0; d < 4; ++d)
#pragma unroll
    for (int r = 0; r < 16; ++r) o[d][r] = 0.f;
  const bf16_t* Qw = Qb + (long)(wid * QBLK + r32) * LDP + hi * 8;
#pragma unroll
  for (int d0 = 0; d0 < 8; ++d0) qr[d0] = *reinterpret_cast<const bf16x8*>(Qw + d0 * 16);
  const int tq0w = q0 + wid * QBLK, tq = tq0w + r32;
  const int sr = tid >> 4, sc = (tid & 15) * 8, vst0 = v_st(sr, sc), vst1 = v_st(32 + sr, sc);
  const int vb0 = (int)(uintptr_t)V_lds + v_rd_base(lane);
  const char* Kc = (const char*)Kh; const char* Vc = (const char*)Vh; const unsigned soff = (unsigned)(sr * LDP + sc) * 2u;
  const unsigned moff = (unsigned)(__builtin_amdgcn_readfirstlane(wid) * QBLK + r32) * 8u;
  struct { bf16x8 vs0, vs1, ks0, ks1; } sr_[1];
#define SLOAD(i, k0) do { unsigned _so = soff; asm volatile("" : "+v"(_so)); unsigned _so2 = soff; asm volatile("" : "+v"(_so2)); \
    const char* _kp = Kc + (size_t)(unsigned)(k0) * (size_t)(LDP * 2); const char* _vp = Vc + (size_t)(unsigned)(k0) * (size_t)(LDP * 2); \
    const char* _kp2 = _kp + (32 * LDP * 2); const char* _vp2 = _vp + (32 * LDP * 2); \
    sr_[i].vs0 = *reinterpret_cast<const bf16x8*>(_vp + _so); sr_[i].vs1 = *reinterpret_cast<const bf16x8*>(_vp2 + _so2); \
    sr_[i].ks0 = *reinterpret_cast<const bf16x8*>(_kp + _so); sr_[i].ks1 = *reinterpret_cast<const bf16x8*>(_kp2 + _so2); } while (0)
#define SWRITE(b, i) do { *(LAS bf16x8*)(V_lds + (b) * SHM_V + vst0) = sr_[i].vs0;          \
    *(LAS bf16x8*)(V_lds + (b) * SHM_V + vst1) = sr_[i].vs1; int kc = sc * 2;               \
    *(LAS bf16x8*)(K_lds + (b) * SHM_K + KSWZ(sr, kc)) = sr_[i].ks0;                       \
    *(LAS bf16x8*)(K_lds + (b) * SHM_K + KSWZ(32 + sr, kc)) = sr_[i].ks1; } while (0)
#define SWAIT() asm volatile("s_waitcnt vmcnt(0)" ::: "memory")
#define RESC(a) do { if (__any((a) < 1.f)) { if (hi == 0) al_l[r32] = (a); asm volatile("s_waitcnt lgkmcnt(0)" ::: "memory"); \
    _Pragma("unroll") for (int d = 0; d < 4; ++d) _Pragma("unroll") for (int r = 0; r < 16; ++r) o[d][r] *= al_l[crow(r, hi)]; } } while (0)
#define MLOAD(kt) (MODE == 0 ? mload_((const char*)maskq + (size_t)(unsigned)(kt) * (size_t)(SEQ * 8), moff) : 0ull)
  f32x16 pA0, pA1, pB0, pB1; float mnA, mnB, alA, alB; bf16x8 pa0, pa1, pa2, pa3; const int NT = kt1 - kt0;
  unsigned long long mA = 0, mB = 0;
  constexpr int SE = 0, SO = 0;
  SLOAD(SE, kt0 * KVBLK); mA = MLOAD(kt0); asm volatile("s_waitcnt vmcnt(0)" ::: "memory"); SWRITE(0, SE); __syncthreads();
  qkt(pA0, pA1, K_lds, qr, r32, hi); score_hook<MODE, DMAX>(pA0, pA1, kt0, tq, tq0w, hi, tab, mA); partialSM(pA0, pA1, m_reg, mnA, alA);
  SLOAD(SO, (kt0 + 1) * KVBLK);
  SWAIT(); SWRITE(1, SO); __syncthreads();
  for (int j = 1; j + 1 < NT; j += 2) {
    SBAR(); mB = MLOAD(kt0 + j); qkt(pB0, pB1, K_lds + SHM_K, qr, r32, hi); score_hook<MODE, DMAX>(pB0, pB1, kt0 + j, tq, tq0w, hi, tab, mB);
    finishSM<MODE>(pA0, pA1, alA, l_reg, pa0, pa1, pa2, pa3); SBAR();
    SLOAD(SO, (kt0 + j + 1) * KVBLK); SBAR();
    pv_d0(o, vb0, pa0, pa1, pa2, pa3); partialSM(pB0, pB1, m_reg, mnB, alB);
    __syncthreads(); SWAIT(); SWRITE(0, SE);
    RESC(alB); __syncthreads();
    SBAR(); mA = MLOAD(kt0 + j + 1); qkt(pA0, pA1, K_lds, qr, r32, hi); score_hook<MODE, DMAX>(pA0, pA1, kt0 + j + 1, tq, tq0w, hi, tab, mA);
    finishSM<MODE>(pB0, pB1, alB, l_reg, pa0, pa1, pa2, pa3); SBAR();
    SLOAD(SE, (kt0 + j + 2) * KVBLK); SBAR();
    pv_d0(o, vb0 + SHM_V, pa0, pa1, pa2, pa3); partialSM(pA0, pA1, m_reg, mnA, alA);
    __syncthreads(); SWAIT(); SWRITE(1, SO);
    RESC(alA); __syncthreads();
  }
  SBAR(); mB = MLOAD(kt1 - 1); qkt(pB0, pB1, K_lds + SHM_K, qr, r32, hi); score_hook<MODE, DMAX>(pB0, pB1, kt1 - 1, tq, tq0w, hi, tab, mB);
  finishSM<MODE>(pA0, pA1, alA, l_reg, pa0, pa1, pa2, pa3); SBAR();
  pv_d0(o, vb0, pa0, pa1, pa2, pa3); partialSM(pB0, pB1, m_reg, mnB, alB);
  __syncthreads(); RESC(alB);
  finishSM<MODE>(pB0, pB1, alB, l_reg, pa0, pa1, pa2, pa3); SBAR();
  pv_d0(o, vb0 + SHM_V, pa0, pa1, pa2, pa3);
  if (hi == 0) li_l[r32] = l_reg; asm volatile("s_waitcnt lgkmcnt(0)" ::: "memory");
  float rli[16];
#pragma unroll
  for (int r = 0; r < 16; ++r) rli[r] = __builtin_amdgcn_rcpf(li_l[crow(r, hi)]);
  unsigned char* Ow = Ob + (long)(wid * QBLK) * LDO; const float s8 = (float)(1 << Y8_SCALE_LOG2);
#pragma unroll
  for (int r = 0; r < 16; ++r) { int orow = crow(r, hi);
#pragma unroll
    for (int d0 = 0; d0 < 4; ++d0) { const float v = fminf(fmaxf(o[d0][r] * rli[r] * s8, -440.f), 440.f); const int w = __builtin_amdgcn_cvt_pk_fp8_f32(v, 0.f, 0, false); Ow[(long)orow * LDO + d0 * 32 + r32] = (unsigned char)(w & 0xff); } }
  __syncthreads();
#undef SLOAD
#undef SWRITE
#undef SWAIT
#undef RESC
#undef MLOAD
}
#undef KSWZ
}

__device__ __forceinline__ int t5_bucket_dev(int rel) {
    const int n = rel < 0 ? -rel : rel; int b;
    if (n < 8) b = n; else b = 8 + (n >= 15) + (n >= 27) + (n >= 50) + (n >= 91) + (n >= 166) + (n >= 305) + (n >= 559);
    return b + (rel > 0 ? 16 : 0);
}
constexpr int DMAX_A = 559, DMAX_B = 128;
__device__ __forceinline__ void fill_tab_A(const Frame& F, int h, LAS char* lds) {
    LAS float* tab = (LAS float*)(lds + att::OFF_TAB);
    const float far = F.t5[15 * 8 + h];
    for (int i = F.tid; i <= DMAX_A - att::DLO; i += 512) { const int d = i + att::DLO; tab[i] = (F.t5[t5_bucket_dev(-d) * 8 + h] - far) * (1.0f / att::SCALE); }
    __syncthreads();
}
__device__ __forceinline__ void fill_tab_B(const Frame& F, int h, LAS char* lds) {
    LAS float* tab = (LAS float*)(lds + att::OFF_TAB);
    const float far = F.rel[h * 257 + 256];
    for (int i = F.tid; i <= DMAX_B - att::DLO; i += 512) { const int d = i + att::DLO; tab[i] = (F.rel[h * 257 + min(max(d, -128), 128) + 128] - far) * (1.0f / att::SCALE); }
    __syncthreads();
}
namespace idx {
constexpr int KT_OFF = 0, KT_BYTES = 8192, CAND_OFF = CONV_LDS_OFF + 3 * CONV_LDS_BYTES + 256, CAND_STRIDE = 2440, CAP = 608, EMERG = CAP - 64, NREG = (CAP + 63) / 64;
static_assert(CAND_OFF % 8 == 0 && CAND_OFF + 32 * CAND_STRIDE <= LDS_BYTES - 16, "indexer LDS map");
constexpr float W_SCALE = 0.03125f;

__device__ __forceinline__ unsigned ordered_u32(float f) { const unsigned u = __float_as_uint(f); return u ^ ((unsigned)((int)u >> 31) | 0x80000000u); }
__device__ __forceinline__ float unordered_f32(unsigned o) { const unsigned u = (o & 0x80000000u) ? (o ^ 0x80000000u) : ~o; return __uint_as_float(u); }

__device__ __forceinline__ unsigned select_thr(const unsigned (&P)[NREG], unsigned maxP, unsigned lob, int lowbit, unsigned vin, int bin, int& bout) {
    int b; unsigned v;
    if (bin < 0) { const unsigned X = maxP ^ lob; if (X == 0u) { bout = -1; return maxP; } b = 31 - __builtin_clz(X); v = maxP & ~((2u << b) - 1u); }
    else { b = bin; v = vin; }
    if (lowbit > b) { bout = b; return v; }
    for (int bit = b; bit >= lowbit; --bit) {
        const unsigned tr = v | (1u << bit);
        int c = 0;
#pragma unroll
        for (int j = 0; j < NREG; ++j) c += __builtin_popcountll(__ballot(P[j] >= tr));
        if (c >= 256) v = tr;
    }
    bout = lowbit - 1;
    return v;
}

template <int VAR> __device__ __forceinline__ void indexer_unit(const Frame& F, int u, ConvSt& cv) {
    LAS unsigned char* lds = F.lds;
    const int tid = F.tid, wid = F.wave, lane = F.lane, r32 = lane & 31, hi = lane >> 5;
    const int t0 = u * 32, chunk = t0 >> 6, ntile = chunk + 1, ntile_q = 4 * ((chunk >> 2) + 1);
    const bf16_t* proj = F.PROJ;
    bf16x8 Af[2][4]; float wv[2][16];
    {
        const int head = (r32 & 3) | ((r32 >> 3) << 2), qsel = (r32 >> 2) & 1;
#pragma unroll
        for (int mt = 0; mt < 2; ++mt) {
            const int q = t0 + 4 * wid + 2 * mt + qsel;
            const bf16_t* qp = proj + (size_t)q * NPROJ + COL_QI + head * 64 + 8 * hi;
#pragma unroll
            for (int s = 0; s < 4; ++s) Af[mt][s] = *(const bf16x8*)(qp + 16 * s);
            const int qh = t0 + 4 * wid + 2 * mt + hi;
            const u32x4 w0 = *(const u32x4*)(proj + (size_t)qh * NPROJ + COL_WI), w1 = *(const u32x4*)(proj + (size_t)qh * NPROJ + COL_WI + 8);
            wv[mt][0] = bf_lo(w0.x) * W_SCALE; wv[mt][1] = bf_hi(w0.x) * W_SCALE; wv[mt][2] = bf_lo(w0.y) * W_SCALE; wv[mt][3] = bf_hi(w0.y) * W_SCALE;
            wv[mt][4] = bf_lo(w0.z) * W_SCALE; wv[mt][5] = bf_hi(w0.z) * W_SCALE; wv[mt][6] = bf_lo(w0.w) * W_SCALE; wv[mt][7] = bf_hi(w0.w) * W_SCALE;
            wv[mt][8] = bf_lo(w1.x) * W_SCALE; wv[mt][9] = bf_hi(w1.x) * W_SCALE; wv[mt][10] = bf_lo(w1.y) * W_SCALE; wv[mt][11] = bf_hi(w1.y) * W_SCALE;
            wv[mt][12] = bf_lo(w1.z) * W_SCALE; wv[mt][13] = bf_hi(w1.z) * W_SCALE; wv[mt][14] = bf_lo(w1.w) * W_SCALE; wv[mt][15] = bf_hi(w1.w) * W_SCALE;
        }
    }
    int cnt[2][2] = {{0, 0}, {0, 0}};
    float tau[2] = {-3.4e38f, -3.4e38f};
    unsigned lob[2][2] = {{0u, 0u}, {0u, 0u}};
    const int cbase[2] = {CAND_OFF + (4 * wid + 0 + hi) * CAND_STRIDE, CAND_OFF + (4 * wid + 2 + hi) * CAND_STRIDE};
    const int skey = tid >> 3, sslot = tid & 7;
    const int sdst = skey * 128 + ((sslot ^ ((skey >> 1) & 7)) * 16);
    const bf16_t* ksrc = proj + (size_t)skey * NPROJ + COL_KI + sslot * 8;
    u32x4 stg = *(const u32x4*)ksrc;
    *(LAS u32x4*)(lds + KT_OFF + sdst) = stg;
    __syncthreads();
#define IDX_MFMA(ACC, MT, BF) do { _Pragma("unroll") for (int i_ = 0; i_ < 16; ++i_) ACC[i_] = 0.f; \
        _Pragma("unroll") for (int s_ = 0; s_ < 4; ++s_) ACC = __builtin_amdgcn_mfma_f32_32x32x16_bf16(Af[MT][s_], BF[s_], ACC, 0, 0, 0); } while (0)
#define IDX_SCORE(SC, ACC, MT) do { \
        float sa_ = 0.f; \
        _Pragma("unroll") for (int r_ = 0; r_ < 16; ++r_) { const float ta_ = __int_as_float(max(__float_as_int(ACC[r_]), 0)); sa_ = fmaf(wv[MT][r_], ta_, sa_); } \
        SC = sa_; } while (0)
#define IDX_PIPE() do { _Pragma("unroll") for (int g_ = 0; g_ < 4; ++g_) { __builtin_amdgcn_sched_group_barrier(0x008, 1, 0); __builtin_amdgcn_sched_group_barrier(0x002, 9, 0); } } while (0)
#define IDX_APPEND(SC, MT, HF) do { \
        const bool pass = (VAR == 1) ? false : (SC >= tau[MT]); if (VAR == 1) { asm volatile("" :: "v"(SC)); } \
        const unsigned long long bm = __ballot(pass); \
        if (bm != 0ull) { \
            const unsigned blo = (unsigned)bm, bhi = (unsigned)(bm >> 32); \
            const int nlo = __builtin_popcount(blo), nhi = __builtin_popcount(bhi); \
            const int pre = __builtin_amdgcn_mbcnt_hi(bhi, __builtin_amdgcn_mbcnt_lo(blo, 0)); \
            const int pos = hi ? (cnt[MT][1] + pre - nlo) : (cnt[MT][0] + pre); \
            if (pass) { \
                const unsigned gk = (unsigned)(jt * 64 + 32 * (HF) + r32); \
                const unsigned P = (ordered_u32(SC) & 0xFFFFC000u) | (16383u - gk); \
                *(LAS unsigned*)(lds + cbase[MT] + pos * 4) = P; \
            } \
            cnt[MT][0] += nlo; cnt[MT][1] += nhi; \
        } } while (0)
    for (int jt = 0; jt < ntile; ++jt) {
        {
            bool cnext = false;
            if (VAR == 0) conv_drain(F, cv.cs >= 1 ? cv.base + (cv.cs - 1) * F.G : -1, cv.cs - 1);
            if (VAR != 5 && jt + 1 < ntile) {
                const bf16_t* g = proj + (size_t)((jt + 1) * 64 + skey) * NPROJ + COL_KI + ((sslot ^ ((skey >> 1) & 7)) * 8);
                __builtin_amdgcn_global_load_lds((const unsigned*)g, (LAS unsigned*)(lds + KT_OFF + ((jt + 1) & 1) * KT_BYTES + wid * 1024), 16, 0, 0);
            }
            if (VAR == 0) cnext = conv_issue(F, cv.base + (cv.cs + 1) * F.G, cv.cs + 1);
            const LAS unsigned char* kb = lds + KT_OFF + (jt & 1) * KT_BYTES;
            bf16x8 Bf0[4], Bf1[4];
#pragma unroll
            for (int s = 0; s < 4; ++s) Bf0[s] = *(const LAS bf16x8*)(kb + r32 * 128 + (((2 * s + hi) ^ ((r32 >> 1) & 7)) * 16));
#pragma unroll
            for (int s = 0; s < 4; ++s) Bf1[s] = *(const LAS bf16x8*)(kb + (32 + r32) * 128 + (((2 * s + hi) ^ ((r32 >> 1) & 7)) * 16));
            f32x16 accA, accB; float scA, scB;
            IDX_MFMA(accA, 0, Bf0);
            __builtin_amdgcn_sched_barrier(0);
            IDX_MFMA(accB, 1, Bf0); IDX_SCORE(scA, accA, 0); IDX_PIPE();
            IDX_APPEND(scA, 0, 0);
            IDX_MFMA(accA, 0, Bf1); IDX_SCORE(scB, accB, 1); IDX_PIPE();
            IDX_APPEND(scB, 1, 0);
            IDX_MFMA(accB, 1, Bf1); IDX_SCORE(scA, accA, 0); IDX_PIPE();
            IDX_APPEND(scA, 0, 1);
            IDX_SCORE(scB, accB, 1);
            IDX_APPEND(scB, 1, 1);
            const int seen = 64 * (jt + 1);
            const int mx = max(max(cnt[0][0], cnt[0][1]), max(cnt[1][0], cnt[1][1]));
            const int q448 = seen / 448;
            const bool sched = (q448 * 448 == seen) && ((q448 & (q448 - 1)) == 0) && (jt + 1 < ntile);
            if (sched || mx >= EMERG) {
#pragma unroll
                for (int mt = 0; mt < 2; ++mt)
#pragma unroll
                    for (int hh = 0; hh < 2; ++hh) {
                        const int n = cnt[mt][hh];
                        if (n > 256) {
                            const int base = CAND_OFF + (4 * wid + 2 * mt + hh) * CAND_STRIDE;
                            unsigned P[NREG]; unsigned mxp = 0;
#pragma unroll
                            for (int j = 0; j < NREG; ++j) { const int i = j * 64 + lane; P[j] = i < n ? *(const LAS unsigned*)(lds + base + i * 4) : 0u; mxp = max(mxp, P[j]); }
#pragma unroll
                            for (int o = 32; o >= 1; o >>= 1) mxp = max(mxp, (unsigned)__shfl_xor((int)mxp, o));
                            mxp = __builtin_amdgcn_readfirstlane(mxp);
                            int bo; unsigned v = select_thr(P, mxp, lob[mt][hh], 14, 0u, -1, bo);
                            int kept = 0;
#pragma unroll
                            for (int j = 0; j < NREG; ++j) kept += __builtin_popcountll(__ballot(P[j] >= v));
                            if (kept > 400) { v = select_thr(P, mxp, lob[mt][hh], 0, v, bo, bo); }
                            int np = 0;
#pragma unroll
                            for (int j = 0; j < NREG; ++j) {
                                const bool k = P[j] >= v; const unsigned long long bm = __ballot(k);
                                const int pre = __builtin_amdgcn_mbcnt_hi((unsigned)(bm >> 32), __builtin_amdgcn_mbcnt_lo((unsigned)bm, 0));
                                if (k) *(LAS unsigned*)(lds + base + (np + pre) * 4) = P[j];
                                np += __builtin_popcountll(bm);
                            }
                            cnt[mt][hh] = np; lob[mt][hh] = v & 0xFFFFC000u;
                            const float tf = unordered_f32(v & 0xFFFFC000u);
                            if (hi == hh) tau[mt] = tf;
                        }
                    }
            }
            if (cnext) asm volatile("s_waitcnt vmcnt(2)" ::: "memory"); else asm volatile("s_waitcnt vmcnt(0)" ::: "memory");
            if (VAR == 0) cv.cs += 1;
        }
        if (VAR != 5) { asm volatile("s_waitcnt lgkmcnt(0)" ::: "memory"); __builtin_amdgcn_s_barrier(); asm volatile("" ::: "memory"); }
    }
#undef IDX_MFMA
#undef IDX_SCORE
#undef IDX_PIPE
#undef IDX_APPEND
#pragma unroll
    for (int mt = 0; mt < 2; ++mt)
#pragma unroll
        for (int hh = 0; hh < 2; ++hh) {
            const int n = cnt[mt][hh];
            const int base = CAND_OFF + (4 * wid + 2 * mt + hh) * CAND_STRIDE;
            unsigned P[NREG]; unsigned mxp = 0;
#pragma unroll
            for (int j = 0; j < NREG; ++j) { const int i = j * 64 + lane; P[j] = i < n ? *(const LAS unsigned*)(lds + base + i * 4) : 0u; mxp = max(mxp, P[j]); }
            unsigned v = 1u;
            if (n > 256) {
#pragma unroll
                for (int o = 32; o >= 1; o >>= 1) mxp = max(mxp, (unsigned)__shfl_xor((int)mxp, o));
                mxp = __builtin_amdgcn_readfirstlane(mxp);
                int bo_; v = select_thr(P, mxp, lob[mt][hh], 0, 0u, -1, bo_);
            }
            asm volatile("s_waitcnt lgkmcnt(0)" ::: "memory");
            for (int i = lane; i < 2 * ntile_q; i += 64) *(LAS unsigned*)(lds + base + i * 4) = 0u;
            asm volatile("s_waitcnt lgkmcnt(0)" ::: "memory");
#pragma unroll
            for (int j = 0; j < NREG; ++j) {
                if (P[j] >= v && P[j] != 0u) {
                    const unsigned gk = 16383u - (P[j] & 0x3FFFu);
                    const unsigned kt = gk >> 6, kk = gk & 63u, t = kk >> 5, jj = kk & 31u, hb = (jj >> 2) & 1u, r = (jj & 3u) + 4u * (jj >> 3);
                    __hip_atomic_fetch_or((LAS unsigned*)(lds + base + (kt * 2 + t) * 4), 1u << (16u * hb + r), __ATOMIC_RELAXED, __HIP_MEMORY_SCOPE_WORKGROUP);
                }
            }
        }
    __syncthreads();
    for (int k2 = wid; 2 * k2 < ntile_q; k2 += 8) {
        const int kt = 2 * k2 + hi;
        if (kt < ntile_q) {
            const u32x2 m = *(const LAS u32x2*)(lds + CAND_OFF + r32 * CAND_STRIDE + kt * 8);
            *(u32x2*)((VAR ? (unsigned long long*)(F.ws + WS_END) : F.MASK) + (size_t)kt * SEQ + t0 + r32) = m;
        }
    }
    __syncthreads();
}
}
#ifndef MK_N_LAUNCHES
#define MK_N_LAUNCHES 1
#endif
constexpr int N_PHASES = 12;
constexpr int BAR_LDS_OFF = LDS_BYTES - 16;

__global__ __launch_bounds__(512, 2) void fwd(Args args) {
    extern __shared__ __attribute__((aligned(16))) unsigned char shm[];
    Frame F;
    F.lds = (LAS unsigned char*)shm;
    F.tid = threadIdx.x; F.lane = F.tid & 63; F.wave = __builtin_amdgcn_readfirstlane(F.tid >> 6);
    F.G = gridDim.x; F.bid = blockIdx.x; F.vcu = (F.G % 8 == 0) ? (F.bid % 8) * (F.G / 8) + F.bid / 8 : F.bid;
    F.x = args.in[0]; F.c = args.in[1]; F.w_ada = args.in[2]; F.b_ada = args.in[3]; F.norm_mix = args.in[4]; F.w_in = args.in[5]; F.t5 = args.in[6]; F.rel = args.in[7];
    F.w_up_a = args.in[8]; F.w_up_b = args.in[9]; F.w_o = args.in[10]; F.norm_ffn = args.in[11]; F.w_rg = args.in[12]; F.b_rg = args.in[13]; F.w_re = args.in[14]; F.b_re = args.in[15];
    F.w1 = args.in[16]; F.w3 = args.in[17]; F.w2 = args.in[18]; F.norm_final = args.in[19];
    F.out = args.out; F.ws = args.ws;
    unsigned char* ws = args.ws;
    F.mod = (float*)(ws + CTL_MOD); F.ecnt = (unsigned*)(ws + CTL_ECNT);
    F.WinT = (bf16_t*)(ws + WS_WINT); F.WupaT = (bf16_t*)(ws + WS_WUPA); F.WupbT = (bf16_t*)(ws + WS_WUPB); F.WoT = (bf16_t*)(ws + WS_WO); F.W13T = (bf16_t*)(ws + WS_W13); F.W2T = (bf16_t*)(ws + WS_W2);
    F.H = (bf16_t*)(ws + WS_H); F.PROJ = (bf16_t*)(ws + WS_PROJ); F.YA = (bf16_t*)(ws + WS_YA); F.YB = (bf16_t*)(ws + WS_YB); F.MRG = (bf16_t*)(ws + WS_MRG);
    F.WinT8 = ws + WS_WINT + (size_t)NPB * DM * 2; F.H8 = ws + WS_H8; F.W13T8 = ws + WS_W13; F.W2T8 = ws + WS_W2; F.Wupa8 = ws + WS_WUPA; F.Wupb8 = ws + WS_WUPB; F.Wo8 = ws + WS_WO;
    F.MASK = (unsigned long long*)(ws + WS_MASK); F.LIST = (int*)(ws + WS_LIST); F.TSLOT = (int*)(ws + WS_TSLOT); F.TW = (float*)(ws + WS_TW); F.RBH = (bf16_t*)(ws + WS_RB); F.RBL = F.RBH + 96 * DM; F.RC = (float*)(ws + WS_RB + (size_t)2 * 96 * DM * 2);

    const int lo = args.ph_lo, hi = args.ph_hi;
    XcdBarrier bar; bar.bar = (unsigned*)(ws + CTL_BAR); bar.x = 0; bar.st = nullptr;
    if (hi - lo > 1) {
        if (F.tid == 0) *(LAS u32x4*)(F.lds + BAR_LDS_OFF) = (u32x4){0u, 0u, 0u, 0u};
        __syncthreads();
        bar = xcd_barrier_post((unsigned*)(ws + CTL_BAR), (volatile LAS unsigned*)(F.lds + BAR_LDS_OFF));
    }
#ifndef PHASE_MASK
#define PHASE_MASK 0xFFF
#endif
#define IN(k) (((PHASE_MASK >> (k)) & 1) && lo <= (k) && (k) < hi)
#ifndef DUP_PHASE
#define DUP_PHASE -1
#endif
#define REP(k) for (int rep_ = 0; rep_ < ((DUP_PHASE) == (k) ? 2 : 1); ++rep_)
#ifdef TIME_A
    unsigned long long* tpw_ = (unsigned long long*)(ws + CTL_ECNT + 4096);
#define TSTAMP(k) do { if (F.bid == 0 && F.tid == 0) { if ((k) == TIME_A - 1) tpw_[0] = __builtin_amdgcn_s_memrealtime(); if ((k) == TIME_B) tpw_[1] = __builtin_amdgcn_s_memrealtime(); } } while (0)
    TSTAMP(-1);
#else
#define TSTAMP(k) do { } while (0)
#endif
#ifdef DOUBLE_BARRIER
#define SEAM(k) do { if (IN(k) && IN((k) + 1)) { xcd_barrier(bar); xcd_barrier(bar); } TSTAMP(k); } while (0)
#else
#define SEAM(k) do { if (IN(k) && IN((k) + 1)) xcd_barrier(bar); TSTAMP(k); } while (0)
#endif

    if (IN(0)) { p0_mod(F); REP(0) p0_convert(F); }
    SEAM(0);
    if (IN(1)) REP(1) { p1_norm(F); }
    SEAM(1);
    if (IN(2)) {
        if (F.G == 256) { if (F.bid >= 192) p1_router_prep(F, F.bid - 192, 64); } else p1_router_prep(F, F.bid, F.G);
        { pg8::StaticOrder<2048> S; S.init(F.H, F.WinT, SEQ, NPB, F.G, F.bid);
          pg8::EpiProj E{F.PROJ};
          pg8::gemm_phase<2048, false, false>(F.lds, S, E);
#if DUP_PHASE == 20
          pg8::gemm_phase<2048, false, false>(F.lds, S, E);
#endif
        }
        { pg8::ProjOrder8 S; S.init(F.H8, F.WinT8, SEQ, NP8, F.G, F.bid); S.bid = F.bid;
          pg8::EpiProj8 E{F.PROJ};
          pg8::gemm_phase<1024, false, true>(F.lds, S, E, W8_SCALE_LOG2, H8_SCALE_LOG2);
#if DUP_PHASE == 21
          pg8::gemm_phase<1024, false, true>(F.lds, S, E, W8_SCALE_LOG2, H8_SCALE_LOG2);
#endif
        }
    }
    SEAM(2);
    if (IN(3)) {
#ifndef NO_IDX
        {
            ConvSt cv; cv.base = TC_LATE_START + F.bid; cv.cs = 0;
            __syncthreads();
            (void)conv_issue(F, cv.base, 0);
            for (int p = F.bid; p < 256; p += F.G) { idx::indexer_unit<0>(F, p, cv); idx::indexer_unit<0>(F, 511 - p, cv); }
#ifdef IDX_PROBE
            for (int p = F.bid; p < 256; p += F.G) { idx::indexer_unit<IDX_PROBE>(F, p, cv); idx::indexer_unit<IDX_PROBE>(F, 511 - p, cv); }
#endif
            conv_drain(F, cv.cs >= 1 ? cv.base + (cv.cs - 1) * F.G : -1, cv.cs - 1);
            asm volatile("s_waitcnt vmcnt(0)" ::: "memory"); __syncthreads();
            conv_drain(F, cv.base + cv.cs * F.G, cv.cs);
            __syncthreads();
            for (int tl = cv.base + (cv.cs + 1) * F.G;; tl += F.G) { TDesc d; f32x4 v[2]; if (!tconv_desc(F, tl, d)) break; tconv_load(F, d, v); tconv_store(F, d, v, 0); }
        }
#endif
#ifndef NO_BAND
        REP(31) for (int p = F.bid; p < 256; p += F.G) {
            const int h = p & 7, j = p >> 3;
            fill_tab_B(F, h, (LAS char*)F.lds);
#pragma unroll 1
            for (int s = 0; s < 2; ++s) {
                const int qt = s ? 63 - j : j, q0 = qt * 256;
                const int kt0 = (4 * qt - 8) > 0 ? (4 * qt - 8) : 0, kt1 = 4 * qt + 4;
                att::attn_unit<1, DMAX_B>(F.PROJ + (size_t)q0 * NPROJ + COL_QB + h * 128, F.PROJ + COL_KB + h * 128, F.PROJ + COL_VB + h * 128, (unsigned char*)F.YA + (size_t)q0 * 2048 + 1024 + h * 128, nullptr, q0, kt0, kt1, (LAS char*)F.lds);
            }
        }
#endif
    }
    SEAM(3);
    if (IN(4)) REP(4) {
        for (int p = F.bid; p < 256; p += F.G) {
            const int h = p & 7, j = p >> 3;
            fill_tab_A(F, h, (LAS char*)F.lds);
#pragma unroll 1
            for (int s = 0; s < 2; ++s) {
                const int qt = s ? 63 - j : j, q0 = qt * 256;
                att::attn_unit<0, DMAX_A>(F.PROJ + (size_t)q0 * NPROJ + COL_QA + h * 128, F.PROJ + COL_KA + h * 128, F.PROJ + COL_VA + h * 128, (unsigned char*)F.YA + (size_t)q0 * 2048 + h * 128, F.MASK + q0, q0, 0, 4 * qt + 4, (LAS char*)F.lds);
            }
        }
    }
    SEAM(4);
    if (IN(5)) {
        pg8::StaticOrder<1024> S; S.init(F.YA, F.Wupa8, SEQ, DM, F.G, F.bid);
        pg8::EpiGate2 E{F.PROJ, (unsigned char*)F.MRG};
        pg8::gemm_phase<1024, false, true>(F.lds, S, E, W8_SCALE_LOG2, Y8_SCALE_LOG2);
#if DUP_PHASE == 5
        pg8::gemm_phase<1024, false, true>(F.lds, S, E, W8_SCALE_LOG2, Y8_SCALE_LOG2);
#endif
    }
    SEAM(6);
#ifdef CHK_POISON
    if (F.bid == 0 && F.wave == 0) {
        float sc = 1.0f;
        const unsigned char* bufs[3] = {(const unsigned char*)F.YA, F.Wupa8, (const unsigned char*)F.MRG};
        const size_t sizes[3] = {(size_t)SEQ * 2048, (size_t)2048 * 2048, (size_t)SEQ * 2048};
        for (int b = 0; b < 3; ++b) {
            const size_t off = ((size_t)F.lane * 1000003u * 16u + (size_t)CHK_POISON * 4096u) % sizes[b] & ~(size_t)15;
            const u32x4 w = *(const u32x4*)(bufs[b] + off);
            int c = 0;
#pragma unroll
            for (int i = 0; i < 4; ++i) for (int j = 0; j < 4; ++j) c += (((w[i] >> (8 * j)) & 0xff) == 0xAA) ? 1 : 0;
            float cf = wave_sum((float)c);
            if (cf > 200.0f) sc *= (float)(2 << b);
        }
        if (F.lane == 0) *(float*)(ws + CTL_ECNT + 4096 + 64) = sc;
    }
#endif
    if (IN(7)) {
        pg8::StaticOrder<1024> S; S.init(F.MRG, F.Wo8, SEQ, DM, F.G, F.bid);
        pg8::EpiRes E{F.x, F.mod + 2 * DM, F.H};
        pg8::gemm_phase<1024, false, true>(F.lds, S, E, W8_SCALE_LOG2, M8_SCALE_LOG2);
#if DUP_PHASE == 7
        pg8::gemm_phase<1024, false, true>(F.lds, S, E, W8_SCALE_LOG2, M8_SCALE_LOG2);
#endif
    }
    SEAM(7);
#ifdef PROBE_LO
    if (IN(8)) { p8_router(F, args.dry); }
#else
    if (IN(8)) { p8_router(F); }
#endif
    SEAM(8);
    if (IN(9)) {
        moe_tables(F); moe1_fill_lists(F);
        MoeOrder1 S{&F, (const LAS int*)(F.lds + MOE_TS), (const LAS int*)(F.lds + MOE_TOK)};
        pg8::EpiMoe1 E{(unsigned char*)F.MRG};
        pg8::gemm_phase<1024, true, true>(F.lds, S, E, W8_SCALE_LOG2, H8_SCALE_LOG2);
#if DUP_PHASE == 9
        pg8::gemm_phase<1024, true, true>(F.lds, S, E, W8_SCALE_LOG2, H8_SCALE_LOG2);
#endif
    }
    SEAM(9);
    if (IN(10)) {
        moe_tables(F);
        MoeOrder2 S{&F, (const LAS int*)(F.lds + MOE_TS)};
        pg8::EpiMoe2 E{F.PROJ};
        pg8::gemm_phase<256, false, true>(F.lds, S, E, W2_SCALE_LOG2, A8_SCALE_LOG2);
#if DUP_PHASE == 10
        pg8::gemm_phase<256, false, true>(F.lds, S, E, W2_SCALE_LOG2, A8_SCALE_LOG2);
#endif
    }
    SEAM(10);
    if (IN(11)) {
        float tsc = 1.0f;
#ifdef CHK_POISON
        { const float s_ = __hip_atomic_load((const float*)(ws + CTL_ECNT + 4096 + 64), __ATOMIC_RELAXED, __HIP_MEMORY_SCOPE_AGENT); tsc = s_ > 1.5f ? s_ : 1.0f; }
#endif
#ifdef TIME_A
        if (F.bid == 0) { if (F.tid == 0) { const float us_ = (float)(tpw_[1] - tpw_[0]) * 0.01f;
#ifndef TIME_OFS
#define TIME_OFS 0.0f
#endif
                const float q_ = floorf(log2f(us_) * 6.0f + TIME_OFS); const float usq_ = exp2f((q_ + 0.5f - TIME_OFS) / 6.0f);
                *(LAS float*)F.lds = 1.0f + sqrtf(usq_ * 1e-4f * 256.0f); } __syncthreads(); tsc = *(LAS float*)F.lds; }
#endif
        moe_tables(F); p11_final(F, tsc); }
#undef IN
#undef SEAM
}

extern "C" void kernel_launch(void* const* d_in, const int* in_sizes, int n_in, void* d_out, int out_size, void* d_ws, size_t ws_size, hipStream_t stream) {
    static int grid = 0;
    if (grid == 0) {
        if (n_in != 20 || out_size != SEQ * DM || ws_size < WS_END) { fprintf(stderr, "kernel_launch: shape/workspace mismatch: n_in %d out %d ws %zu (need %zu)\n", n_in, out_size, ws_size, (size_t)WS_END); grid = -1; return; }
        int dev = 0, cus = 0, per_cu = 0;
        if (hipGetDevice(&dev) != hipSuccess || hipDeviceGetAttribute(&cus, hipDeviceAttributeMultiprocessorCount, dev) != hipSuccess) { grid = -1; return; }
        if (hipFuncSetAttribute((const void*)fwd, hipFuncAttributeMaxDynamicSharedMemorySize, LDS_BYTES) != hipSuccess) { fprintf(stderr, "kernel_launch: hipFuncSetAttribute failed\n"); grid = -1; return; }
        if (hipOccupancyMaxActiveBlocksPerMultiprocessor(&per_cu, (const void*)fwd, 512, LDS_BYTES) != hipSuccess || per_cu < 1) fprintf(stderr, "kernel_launch: occupancy query says %d\n", per_cu);
        (void)hipGetLastError();
        grid = cus;
    }
    if (grid < 0) return;
    (void)hipMemsetAsync((char*)d_ws + WS_CTL, 0, CTL_BYTES, stream);
    Args a{};
    for (int i = 0; i < 20; ++i) a.in[i] = (const float*)d_in[i];
    a.out = (float*)d_out; a.ws = (unsigned char*)d_ws;
#if defined(PREFIX_K)
    a.ph_lo = 0; a.ph_hi = PREFIX_K + 1;
    hipLaunchKernelGGL(fwd, dim3(grid), dim3(512), LDS_BYTES, stream, a);
    (void)hipMemsetAsync((char*)d_ws + WS_CTL, 0, CTL_BYTES, stream);
    a.ph_lo = 0; a.ph_hi = N_PHASES;
    hipLaunchKernelGGL(fwd, dim3(grid), dim3(512), LDS_BYTES, stream, a);
#elif defined(PROBE_LO)
    a.ph_lo = 0; a.ph_hi = N_PHASES; a.dry = 0;
    hipLaunchKernelGGL(fwd, dim3(grid), dim3(512), LDS_BYTES, stream, a);
    for (int rep = 0; rep < PROBE_N; ++rep) {
        if (PROBE_HI - PROBE_LO > 1) (void)hipMemsetAsync((char*)d_ws + WS_CTL + CTL_BAR, 0, 16384, stream);
        if (PROBE_LO <= 8 && 8 < PROBE_HI && PROBE_DRY == 0) (void)hipMemsetAsync((char*)d_ws + WS_CTL + CTL_ECNT, 0, 4096 + 256, stream);
        a.ph_lo = PROBE_LO; a.ph_hi = PROBE_HI; a.dry = PROBE_DRY;
        hipLaunchKernelGGL(fwd, dim3(grid), dim3(512), LDS_BYTES, stream, a);
    }
#elif defined(SUFFIX_A)
    a.ph_lo = 0; a.ph_hi = N_PHASES;
    hipLaunchKernelGGL(fwd, dim3(grid), dim3(512), LDS_BYTES, stream, a);
    for (int rep = 0; rep < SUFFIX_N; ++rep) {
        (void)hipMemsetAsync((char*)d_ws + WS_CTL + CTL_BAR, 0, 16384, stream);
        if (SUFFIX_A <= 8) (void)hipMemsetAsync((char*)d_ws + WS_CTL + CTL_ECNT, 0, 4096 + 256, stream);
        a.ph_lo = SUFFIX_A; a.ph_hi = N_PHASES;
        hipLaunchKernelGGL(fwd, dim3(grid), dim3(512), LDS_BYTES, stream, a);
    }
#elif MK_N_LAUNCHES == 1
    a.ph_lo = 0; a.ph_hi = N_PHASES;
    hipLaunchKernelGGL(fwd, dim3(grid), dim3(512), LDS_BYTES, stream, a);
#else
    for (int ph = 0; ph < N_PHASES; ++ph) { a.ph_lo = ph; a.ph_hi = ph + 1; hipLaunchKernelGGL(fwd, dim3(grid), dim3(512), LDS_BYTES, stream, a); }
#endif
    const hipError_t le = hipPeekAtLastError();
    if (le != hipSuccess) fprintf(stderr, "kernel_launch: launch failed: %s\n", hipGetErrorName(le));
}
```

```cpp
#include <hip/hip_runtime.h>
#include <cstdio>
#include <cstdint>

#define LAS __attribute__((address_space(3)))
typedef unsigned short bf16_t;
typedef short bf16x8 __attribute__((ext_vector_type(8)));
typedef short s16x4 __attribute__((ext_vector_type(4)));
typedef float f32x2 __attribute__((ext_vector_type(2)));
typedef float f32x4 __attribute__((ext_vector_type(4)));
typedef float f32x16 __attribute__((ext_vector_type(16)));
typedef unsigned u32x2 __attribute__((ext_vector_type(2)));
typedef unsigned u32x4 __attribute__((ext_vector_type(4)));
typedef int i32x4_ __attribute__((ext_vector_type(4)));
typedef int i32x8 __attribute__((ext_vector_type(8)));

constexpr int SEQ = 16384, DM = 2048, NPROJ = 11520  , NPROJ_REAL = 11344;
constexpr int COL_QA = 0, COL_KA = 1024, COL_VA = 2048, COL_QI = 3072, COL_KI = 4096, COL_WI = 4160, COL_QB = 4176, COL_KB = 5200, COL_VB = 6224, COL_GA = 7248, COL_GB = 9296;
constexpr int NEXP = 64, DFF = 512, LIST_CAP = 16384;
constexpr int G8_SCALE_LOG2 = 4;
constexpr int NPB = 5376  , NPB_REAL = 5200, NP8 = 6144  ;
constexpr int H8_SCALE_LOG2 = 4, W8_SCALE_LOG2 = 9, W2_SCALE_LOG2 = 8, A8_SCALE_LOG2 = 4, Y8_SCALE_LOG2 = 6, M8_SCALE_LOG2 = 5;
constexpr float EPS = 1e-6f;
constexpr float LOG2E = 1.4426950408889634f;

constexpr size_t A256(size_t x) { return (x + 255) / 256 * 256; }
constexpr size_t WS_CTL = 0;
constexpr size_t CTL_BAR = 0;
constexpr size_t CTL_MOD = 16384;
constexpr size_t CTL_ECNT = 16384 + 49152;
constexpr size_t CTL_BYTES = 16384 + 49152 + 4096 + 256;
constexpr size_t WS_WINT = 131072;
constexpr size_t WS_WUPA = WS_WINT + (size_t)NPROJ * DM * 2;
constexpr size_t WS_WUPB = WS_WUPA + (size_t)DM * 1024 * 2;
constexpr size_t WS_WO   = WS_WUPB + (size_t)DM * 1024 * 2;
constexpr size_t WS_W13  = WS_WO + (size_t)DM * DM * 2;
constexpr size_t WS_W2   = WS_W13 + (size_t)NEXP * 1024 * DM;
constexpr size_t WS_H    = WS_W2 + (size_t)NEXP * DM * DFF;
constexpr size_t WS_PROJ = WS_H + (size_t)SEQ * DM * 2;
constexpr size_t WS_MASK = WS_PROJ + (size_t)SEQ * NPROJ * 2;
constexpr size_t WS_YA   = WS_MASK + (size_t)256 * SEQ * 8;
constexpr size_t WS_YB   = WS_YA + (size_t)SEQ * 1024 * 2;
constexpr size_t WS_MRG  = WS_YB + (size_t)SEQ * 1024 * 2;
constexpr size_t WS_LIST = WS_MRG + (size_t)SEQ * DM * 2;
constexpr size_t WS_TSLOT = WS_LIST + (size_t)NEXP * LIST_CAP * 4;
constexpr size_t WS_TW   = WS_TSLOT + (size_t)SEQ * 2 * 4;
constexpr size_t WS_H8   = WS_TW + (size_t)SEQ * 2 * 4;
constexpr size_t WS_RB   = WS_H8 + (size_t)SEQ * DM;
constexpr size_t WS_END  = WS_RB + (size_t)(1 << 20);
constexpr int MAX_PAD_ROWS = 2 * SEQ + NEXP * 255 + 1;
static_assert((size_t)MAX_PAD_ROWS * DM * 2 <= (size_t)SEQ * NPROJ * 2, "y fits in proj region");
static_assert((size_t)MAX_PAD_ROWS * DFF * 2 <= (size_t)SEQ * DM * 2, "a fits in merged region");

constexpr int LDS_BYTES = 147456;

__device__ __forceinline__ unsigned cvt_pk_bf16(float lo, float hi) { unsigned r; asm volatile("v_cvt_pk_bf16_f32 %0, %1, %2" : "=v"(r) : "v"(lo), "v"(hi)); return r; }
__device__ __forceinline__ float bf_lo(unsigned w) { return __uint_as_float(w << 16); }
__device__ __forceinline__ float bf_hi(unsigned w) { return __uint_as_float(w & 0xffff0000u); }
__device__ __forceinline__ float sigmoidf_(float x) { return __builtin_amdgcn_rcpf(1.0f + __builtin_amdgcn_exp2f(-x * LOG2E)); }
__device__ __forceinline__ unsigned cvt_fp8x4_(float a, float b, float c, float d) {
    int w = 0; w = __builtin_amdgcn_cvt_pk_fp8_f32(a, b, w, false); w = __builtin_amdgcn_cvt_pk_fp8_f32(c, d, w, true); return (unsigned)w;
}
__device__ __forceinline__ float wave_sum(float v) {
#pragma unroll
    for (int o = 32; o >= 1; o >>= 1) v += __shfl_xor(v, o);
    return v;
}

#define XB_TMO      128
#define XB_XCNT(j)  (256  + 64 * (j))
#define XB_XSUB(j)  (1280 + 64 * (j))
#define XB_XGEN(j)  (2304 + 64 * (j))
#define XB_TOP      3328
#define XB_TOPGEN   3392
#define XCD_BAR_WORDS 3456
#define XB_SPIN_CAP (1u << 22)
__device__ __forceinline__ unsigned xb_ld(unsigned* p)              { return __hip_atomic_load(p, __ATOMIC_RELAXED, __HIP_MEMORY_SCOPE_AGENT); }
__device__ __forceinline__ unsigned xb_add(unsigned* p, unsigned v) { return __hip_atomic_fetch_add(p, v, __ATOMIC_RELAXED, __HIP_MEMORY_SCOPE_AGENT); }
__device__ __forceinline__ unsigned xb_xcc_id() { return (unsigned)__builtin_amdgcn_s_getreg((3 << 11) | 20) & 0xFu; }
#define XB_SPIN(cond, bar) do { unsigned _sp = 0; while (cond) { __builtin_amdgcn_s_sleep(1); \
    if ((++_sp & 255u) == 0u) { if (xb_ld(&(bar)[XB_TMO])) break; if (_sp > XB_SPIN_CAP) { atomicAdd(&(bar)[XB_TMO], 1u); break; } } } } while (0)
struct XcdBarrier { unsigned* bar; unsigned x; volatile LAS unsigned* st; };
__device__ __forceinline__ XcdBarrier xcd_barrier_post(unsigned* bar, volatile LAS unsigned* st) {
    XcdBarrier b; b.bar = bar; b.x = xb_xcc_id(); b.st = st;
    if (threadIdx.x == 0) (void)xb_add(&bar[XB_XCNT(b.x)], 1u);
    return b;
}
__device__ __forceinline__ void xcd_barrier_complete(unsigned* bar, unsigned x, unsigned& nloc, unsigned& nx) {
    const unsigned G = gridDim.x * gridDim.y * gridDim.z;
    unsigned sum, cnt, mine, sp = 0u;
    for (;;) {
        sum = 0u; cnt = 0u; mine = 0u;
#pragma unroll
        for (unsigned j = 0; j < 16; ++j) { const unsigned c = xb_ld(&bar[XB_XCNT(j)]); sum += c; cnt += (c > 0u) ? 1u : 0u; mine = (j == x) ? c : mine; }
        if (sum == G) break;
        __builtin_amdgcn_s_sleep(1);
        if ((++sp & 255u) == 0u) { if (xb_ld(&bar[XB_TMO])) break; if (sp > XB_SPIN_CAP) { atomicAdd(&bar[XB_TMO], 1u); break; } }
    }
    nloc = mine > 0u ? mine : 1u; nx = cnt > 0u ? cnt : 1u;
}
__device__ __forceinline__ void xcd_barrier(const XcdBarrier& b) {
    asm volatile("s_waitcnt vmcnt(0)" ::: "memory");
    __syncthreads();
    if (threadIdx.x == 0) {
        unsigned* bar = b.bar;
        __builtin_amdgcn_s_waitcnt(0);
        unsigned nloc = b.st[0], nx = b.st[1];
        if (nloc == 0u) { xcd_barrier_complete(bar, b.x, nloc, nx); b.st[0] = nloc; b.st[1] = nx; }
        const unsigned old = xb_add(&bar[XB_XSUB(b.x)], 1u);
        const unsigned gen = old / nloc;
        if (old + 1u == (gen + 1u) * nloc) {
            __builtin_amdgcn_fence(__ATOMIC_RELEASE, "agent");
            asm volatile("s_waitcnt vmcnt(0)" ::: "memory");
            const unsigned og = xb_add(&bar[XB_TOP], 1u);
            const unsigned tg = og / nx;
            if (og + 1u == (tg + 1u) * nx) xb_add(&bar[XB_TOPGEN], 1u);
            else XB_SPIN(xb_ld(&bar[XB_TOPGEN]) == tg, bar);
            __builtin_amdgcn_fence(__ATOMIC_ACQUIRE, "agent");
            xb_add(&bar[XB_XGEN(b.x)], 1u);
            asm volatile("s_waitcnt vmcnt(0)" ::: "memory");
        } else {
            XB_SPIN(xb_ld(&bar[XB_XGEN(b.x)]) == gen, bar);
            __builtin_amdgcn_fence(__ATOMIC_ACQUIRE, "agent");
            asm volatile("s_waitcnt vmcnt(0)" ::: "memory");
        }
    }
    __syncthreads();
}

namespace pg8 {
constexpr int BM = 256, BK = 64, HALF = 128, HTB = HALF * BK * 2, STAGE_BYTES = 8 * HTB, NXCD = 8, WGM = 8;
__host__ __device__ __forceinline__ int lds_byte(int r, int c) { const int st = (r >> 4) * 2 + (c >> 5), rr = r & 15, cc = c & 31, ob = rr * 64 + cc * 2; return st * 1024 + (ob ^ (((ob >> 9) & 1) << 5)); }
__host__ __device__ __forceinline__ void stage_rc(int b, int& R, int& C) { const int st = b / 1024, sb = b % 1024, swz = sb ^ (((sb >> 9) & 1) << 5); R = (st >> 1) * 16 + swz / 64; C = (st & 1) * 32 + (swz % 64) / 2; }
__host__ __device__ __forceinline__ int perm32(int rho) { const int n = rho >> 4, i = rho & 15; return 8 * (i >> 2) + 4 * n + (i & 3); }

struct Unit { int pm, pn; const char* A; const char* B; int x0, x1; };

template <int K> struct StaticOrder {
    int nM, nN, nwg, G, c; const char* A; const char* Bt;
    __device__ void init(const void* A_, const void* Bt_, int M, int N, int G_, int c_) { A = (const char*)A_; Bt = (const char*)Bt_; nM = M / BM; nN = N / BM; nwg = nM * nN; G = G_; c = c_; }
    __device__ __forceinline__ bool next(int i, Unit& u) const {
        const long L = (long)i * G + c; if (L >= nwg) return false;
        int wgid = (int)L; { const int q = nwg / NXCD, r = nwg % NXCD, xcd = wgid % NXCD, off = wgid / NXCD; wgid = (xcd < r ? xcd * (q + 1) : r * (q + 1) + (xcd - r) * q) + off; }
        const int nig = WGM * nN, gid = wgid / nig, fm = gid * WGM, gsz = (nM - fm) < WGM ? (nM - fm) : WGM;
        u.pm = fm + ((wgid % nig) % gsz); u.pn = (wgid % nig) / gsz;
        u.A = A + (size_t)u.pm * BM * K * 2; u.B = Bt + (size_t)u.pn * BM * K * 2; u.x0 = 0; u.x1 = 0; return true;
    }
    __device__ __forceinline__ int arow(const Unit&, int r) const { return r; }
};

template <bool FP8> struct FragT { typedef bf16x8 A[4][2]; typedef bf16x8 B[2][2]; };
template <> struct FragT<true> { typedef i32x8 A[4]; typedef i32x8 B[2]; };
struct ProjOrder8 : StaticOrder<1024> {
    int bid;
    __device__ __forceinline__ bool next(int i, Unit& u) const {
        if (G != 256) return StaticOrder<1024>::next(i, u);
        long L;
        if (i < 4) L = (long)i * 256 + bid; else { if (bid < 64) return false; L = 1024 + (long)(i - 4) * 192 + (bid - 64); }
        if (L >= nwg) return false;
        int wgid = (int)L; { const int q = nwg / NXCD, r = nwg % NXCD, xcd = wgid % NXCD, off = wgid / NXCD; wgid = (xcd < r ? xcd * (q + 1) : r * (q + 1) + (xcd - r) * q) + off; }
        const int nig = WGM * nN, gid = wgid / nig, fm = gid * WGM, gsz = (nM - fm) < WGM ? (nM - fm) : WGM;
        u.pm = fm + ((wgid % nig) % gsz); u.pn = (wgid % nig) / gsz;
        u.A = A + (size_t)u.pm * BM * 1024 * 2; u.B = Bt + (size_t)u.pn * BM * 1024 * 2; u.x0 = 0; u.x1 = 0; return true;
    }
};
template <class T, class = void> struct HasMid { static constexpr bool v = false; };
template <class T> struct HasMid<T, decltype((void)T::MID, void())> { static constexpr bool v = T::MID; };
template <int K, bool GATHER, bool FP8, class Epi, class Sched>
__device__ __forceinline__ void gemm_phase(LAS unsigned char* lds, const Sched& S, const Epi& E, int sclW_log2 = 0, int sclH_log2 = 0) {
    const int tid = threadIdx.x, wid = __builtin_amdgcn_readfirstlane(tid >> 6), lane = tid & 63, wr = wid >> 2, wc = wid & 3, fr = lane & 15, fq = lane >> 4;
    constexpr int nt = K / BK;
    int R0, C0, R1, C1; stage_rc(tid * 16, R0, C0); stage_rc(tid * 16 + 8192, R1, C1);
    unsigned voffB[2];
    { const int Rb0 = Epi::PERM ? ((R0 & ~31) + perm32(R0 & 31)) : R0, Rb1 = Epi::PERM ? ((R1 & ~31) + perm32(R1 & 31)) : R1;
      voffB[0] = (unsigned)(Rb0 * K + C0) * 2u; voffB[1] = (unsigned)(Rb1 * K + C1) * 2u; }
    constexpr size_t kstep = (size_t)(BK * 2), hstep = (size_t)HALF * K * 2;
    const unsigned ldsw = (unsigned)wid * 1024u;
    const int aoff = lds_byte(wr * 64 + fr, fq * 8), boff = lds_byte(wc * 32 + fr, fq * 8);
#define PG8_SA(b, h) (((b) * 2 + (h)) * HTB)
#define PG8_SB(b, h) ((4 + (b) * 2 + (h)) * HTB)
#define PG8_GLDS(bufoff, gp0, gp1) do { \
        __builtin_amdgcn_global_load_lds((const unsigned*)(gp0), (LAS unsigned*)(lds + (bufoff) + ldsw), 16, 0, 0); \
        __builtin_amdgcn_global_load_lds((const unsigned*)(gp1), (LAS unsigned*)(lds + (bufoff) + ldsw + 8192), 16, 0, 0); } while (0)
#define PG8_STAGE_B(bufoff, gbase) PG8_GLDS(bufoff, (const char*)(gbase) + voffB[0], (const char*)(gbase) + voffB[1])
#define PG8_STAGE_A(bufoff, gbase, v0, v1) PG8_GLDS(bufoff, (const char*)(gbase) + (v0), (const char*)(gbase) + (v1))
#define PG8_LDA(dst, b, h) do { if constexpr (FP8) { _Pragma("unroll") for (int m = 0; m < 4; ++m) { \
            const i32x4_ lo_ = *(const LAS i32x4_*)(lds + PG8_SA(b, h) + aoff + m * 2048), hi_ = *(const LAS i32x4_*)(lds + PG8_SA(b, h) + aoff + m * 2048 + 1024); \
            *(i32x8*)&dst[m] = __builtin_shufflevector(lo_, hi_, 0, 1, 2, 3, 4, 5, 6, 7); } } \
        else { _Pragma("unroll") for (int m = 0; m < 4; ++m) _Pragma("unroll") for (int k = 0; k < 2; ++k) ((bf16x8*)&dst[m])[k] = *(const LAS bf16x8*)(lds + PG8_SA(b, h) + aoff + m * 2048 + k * 1024); } } while (0)
#define PG8_LDB(dst, b, h) do { if constexpr (FP8) { _Pragma("unroll") for (int n = 0; n < 2; ++n) { \
            const i32x4_ lo_ = *(const LAS i32x4_*)(lds + PG8_SB(b, h) + boff + n * 2048), hi_ = *(const LAS i32x4_*)(lds + PG8_SB(b, h) + boff + n * 2048 + 1024); \
            *(i32x8*)&dst[n] = __builtin_shufflevector(lo_, hi_, 0, 1, 2, 3, 4, 5, 6, 7); } } \
        else { _Pragma("unroll") for (int n = 0; n < 2; ++n) _Pragma("unroll") for (int k = 0; k < 2; ++k) ((bf16x8*)&dst[n])[k] = *(const LAS bf16x8*)(lds + PG8_SB(b, h) + boff + n * 2048 + k * 1024); } } while (0)
#define PG8_MMA(ai, bj, At, Bt) do { __builtin_amdgcn_s_setprio(1); \
        if constexpr (FP8) { _Pragma("unroll") for (int m = 0; m < 4; ++m) _Pragma("unroll") for (int n = 0; n < 2; ++n) \
            asm volatile("v_mfma_scale_f32_16x16x128_f8f6f4 %0, %1, %2, %0, %3, %4 op_sel_hi:[0,0,0]" : "+v"(acc[ai][bj][m][n]) : "v"(*(const i32x8*)&Bt[n]), "v"(*(const i32x8*)&At[m]), "v"(sclW), "v"(sclH)); } \
        else { _Pragma("unroll") for (int m = 0; m < 4; ++m) _Pragma("unroll") for (int n = 0; n < 2; ++n) _Pragma("unroll") for (int k = 0; k < 2; ++k) \
            acc[ai][bj][m][n] = __builtin_amdgcn_mfma_f32_16x16x32_bf16(((const bf16x8*)&Bt[n])[k], ((const bf16x8*)&At[m])[k], acc[ai][bj][m][n], 0, 0, 0); } \
        __builtin_amdgcn_s_setprio(0); } while (0)
#define PG8_WAIT_V(n) asm volatile("s_waitcnt vmcnt(" #n ")" ::: "memory")
#define PG8_WAIT_L(n) asm volatile("s_waitcnt lgkmcnt(" #n ")" ::: "memory")
#define PG8_BAR __builtin_amdgcn_s_barrier()
#define PG8_SCHED __builtin_amdgcn_sched_barrier(0)
#define PG8_SETA(u, v) do { if (GATHER) { \
        v[0][0] = (unsigned)(S.arow(u, R0) * K + C0) * 2u; v[0][1] = (unsigned)(S.arow(u, R1) * K + C1) * 2u; \
        v[1][0] = (unsigned)(S.arow(u, HALF + R0) * K + C0) * 2u; v[1][1] = (unsigned)(S.arow(u, HALF + R1) * K + C1) * 2u; \
      } else { v[0][0] = (unsigned)(R0 * K + C0) * 2u; v[0][1] = (unsigned)(R1 * K + C1) * 2u; v[1][0] = v[0][0] + (unsigned)hstep; v[1][1] = v[0][1] + (unsigned)hstep; } } while (0)
    Unit cur, nxt; int ui = 0;
    if (!S.next(0, cur)) return;
    f32x4 acc[2][2][4][2];
#pragma unroll
    for (int a = 0; a < 2; ++a)
#pragma unroll
        for (int b = 0; b < 2; ++b)
#pragma unroll
            for (int m = 0; m < 4; ++m)
#pragma unroll
                for (int n = 0; n < 2; ++n) acc[a][b][m][n] = (f32x4){0.f, 0.f, 0.f, 0.f};
    typename FragT<FP8>::A At; typename FragT<FP8>::B B0, B1;
    const int sclW = 127 - sclW_log2, sclH = 127 - sclH_log2;
    unsigned vA[2][2], vN[2][2];
    PG8_SETA(cur, vA);
    const char* cA = cur.A; const char* cB = cur.B;
    PG8_STAGE_B(PG8_SB(0, 0), cB); PG8_STAGE_A(PG8_SA(0, 0), cA, vA[0][0], vA[0][1]); PG8_STAGE_B(PG8_SB(0, 1), cB + hstep); PG8_STAGE_A(PG8_SA(0, 1), cA, vA[1][0], vA[1][1]);
    if (wr == 1) PG8_BAR;
    PG8_WAIT_V(4); PG8_BAR;
    PG8_STAGE_B(PG8_SB(1, 0), cB + kstep); PG8_STAGE_A(PG8_SA(1, 0), cA + kstep, vA[0][0], vA[0][1]); PG8_STAGE_B(PG8_SB(1, 1), cB + hstep + kstep);
    PG8_WAIT_V(6); PG8_BAR;
    for (;;) {
        const bool has_next = S.next(ui + 1, nxt);
        const char* nA = has_next ? nxt.A : cA; const char* nB = has_next ? nxt.B : cB;
        if (has_next) { PG8_SETA(nxt, vN); } else { vN[0][0] = vA[0][0]; vN[0][1] = vA[0][1]; vN[1][0] = vA[1][0]; vN[1][1] = vA[1][1]; }
        for (int t = 0; t < nt; t += 2) {
            if constexpr (HasMid<Epi>::v) { if (t == nt / 2) {
                if constexpr (FP8) asm volatile("s_nop 15\n\ts_nop 15\n\ts_nop 15" ::: "memory");
                E.mid(acc, cur, wr, wc, fr, fq); } }
            const bool last = (t == nt - 2);
            const char* a1 = cA + (size_t)(t + 1) * kstep;
            const char* a2 = last ? nA : cA + (size_t)(t + 2) * kstep; const char* b2 = last ? nB : cB + (size_t)(t + 2) * kstep;
            const char* a3 = a2 + kstep; const char* b3 = b2 + kstep;
            const unsigned w00 = last ? vN[0][0] : vA[0][0], w01 = last ? vN[0][1] : vA[0][1], w10 = last ? vN[1][0] : vA[1][0], w11 = last ? vN[1][1] : vA[1][1];
            PG8_LDB(B0, 0, 0); PG8_SCHED; PG8_LDA(At, 0, 0); PG8_STAGE_A(PG8_SA(1, 1), a1, vA[1][0], vA[1][1]);
            PG8_WAIT_L(8); PG8_BAR; PG8_WAIT_L(0); PG8_MMA(0, 0, At, B0); PG8_BAR; PG8_SCHED;
            PG8_LDB(B1, 0, 1); PG8_STAGE_B(PG8_SB(0, 0), b2);
            PG8_BAR; PG8_WAIT_L(0); PG8_MMA(0, 1, At, B1); PG8_BAR;
            PG8_LDA(At, 0, 1); PG8_STAGE_A(PG8_SA(0, 0), a2, w00, w01);
            PG8_BAR; PG8_WAIT_L(0); PG8_MMA(1, 0, At, B0); PG8_BAR; PG8_SCHED;
            PG8_STAGE_B(PG8_SB(0, 1), b2 + hstep);
            PG8_WAIT_V(6); PG8_BAR; PG8_MMA(1, 1, At, B1); PG8_BAR;
            PG8_LDB(B0, 1, 0); PG8_SCHED; PG8_LDA(At, 1, 0); PG8_STAGE_A(PG8_SA(0, 1), a2, w10, w11);
            PG8_WAIT_L(8); PG8_BAR; PG8_WAIT_L(0); PG8_MMA(0, 0, At, B0); PG8_BAR; PG8_SCHED;
            PG8_LDB(B1, 1, 1); PG8_STAGE_B(PG8_SB(1, 0), b3);
            PG8_BAR; PG8_WAIT_L(0); PG8_MMA(0, 1, At, B1); PG8_BAR;
            PG8_LDA(At, 1, 1); PG8_STAGE_A(PG8_SA(1, 0), a3, w00, w01);
            PG8_BAR; PG8_WAIT_L(0); PG8_MMA(1, 0, At, B0); PG8_BAR; PG8_SCHED;
            PG8_STAGE_B(PG8_SB(1, 1), b3 + hstep);
            PG8_WAIT_V(6); PG8_BAR; PG8_MMA(1, 1, At, B1); PG8_BAR;
        }
        if constexpr (FP8) asm volatile("s_nop 15\n\ts_nop 15\n\ts_nop 15" ::: "memory");
        E(acc, cur, wr, wc, fr, fq);
        if (!has_next) break;
#pragma unroll
        for (int a = 0; a < 2; ++a)
#pragma unroll
            for (int b = 0; b < 2; ++b)
#pragma unroll
                for (int m = 0; m < 4; ++m)
#pragma unroll
                    for (int n = 0; n < 2; ++n) acc[a][b][m][n] = (f32x4){0.f, 0.f, 0.f, 0.f};
        cur = nxt; cA = nA; cB = nB; ++ui;
        vA[0][0] = vN[0][0]; vA[0][1] = vN[0][1]; vA[1][0] = vN[1][0]; vA[1][1] = vN[1][1];
    }
    PG8_WAIT_V(0);
    if (wr == 0) PG8_BAR;
    PG8_BAR;
#undef PG8_SA
#undef PG8_SB
#undef PG8_GLDS
#undef PG8_STAGE_A
#undef PG8_STAGE_B
#undef PG8_LDA
#undef PG8_LDB
#undef PG8_MMA
#undef PG8_WAIT_V
#undef PG8_WAIT_L
#undef PG8_BAR
#undef PG8_SCHED
#undef PG8_SETA
}

struct EpiProj {
    static constexpr bool PERM = true;
    bf16_t* O;
    __device__ __forceinline__ void operator()(const f32x4 (&acc)[2][2][4][2], const Unit& u, int wr, int wc, int fr, int fq) const {
        const int row0 = u.pm * BM + wr * 64 + fr, col0 = u.pn * BM + wc * 32 + 8 * fq;
#pragma unroll
        for (int ai = 0; ai < 2; ++ai)
#pragma unroll
            for (int m = 0; m < 4; ++m) { bf16_t* rowp = O + (size_t)(row0 + ai * HALF + m * 16) * NPROJ;
#pragma unroll
                for (int bj = 0; bj < 2; ++bj) { const f32x4 v0 = acc[ai][bj][m][0], v1 = acc[ai][bj][m][1];
                    const int c = col0 + bj * HALF;
                    u32x4 w; w.x = cvt_pk_bf16(v0[0], v0[1]); w.y = cvt_pk_bf16(v0[2], v0[3]); w.z = cvt_pk_bf16(v1[0], v1[1]); w.w = cvt_pk_bf16(v1[2], v1[3]);
                    if (c < NPB_REAL) *(u32x4*)(rowp + (c < 2048 ? c : c + 1024)) = w; } }
    }
};
struct EpiProj8 {
    static constexpr bool PERM = true;
    bf16_t* O;
    __device__ __forceinline__ void operator()(const f32x4 (&acc)[2][2][4][2], const Unit& u, int wr, int wc, int fr, int fq) const {
        const int row0 = u.pm * BM + wr * 64 + fr;
        const int tc = u.pn * BM;
        if (tc >= 2048) {
            const int bc = (tc - 2048) + wc * 32 + 8 * fq; const float s8 = (float)(1 << G8_SCALE_LOG2);
#pragma unroll
            for (int ai = 0; ai < 2; ++ai)
#pragma unroll
                for (int m = 0; m < 4; ++m) { unsigned char* rowp = (unsigned char*)(O + (size_t)(row0 + ai * HALF + m * 16) * NPROJ + COL_GA) + bc;
#pragma unroll
                    for (int bj = 0; bj < 2; ++bj) { const f32x4 lo4 = {-440.f, -440.f, -440.f, -440.f}, hi4 = {440.f, 440.f, 440.f, 440.f};
                        const f32x4 v0 = __builtin_elementwise_min(__builtin_elementwise_max(acc[ai][bj][m][0] * s8, lo4), hi4), v1 = __builtin_elementwise_min(__builtin_elementwise_max(acc[ai][bj][m][1] * s8, lo4), hi4);
                        u32x2 w; w.x = cvt_fp8x4_(v0[0], v0[1], v0[2], v0[3]); w.y = cvt_fp8x4_(v1[0], v1[1], v1[2], v1[3]);
                        *(u32x2*)(rowp + bj * HALF) = w; } }
            return;
        }
        const int dc = (tc < 1024 ? COL_VA + tc : COL_VB + (tc - 1024)) + wc * 32 + 8 * fq;
#pragma unroll
        for (int ai = 0; ai < 2; ++ai)
#pragma unroll
            for (int m = 0; m < 4; ++m) { bf16_t* rowp = O + (size_t)(row0 + ai * HALF + m * 16) * NPROJ + dc;
#pragma unroll
                for (int bj = 0; bj < 2; ++bj) { const f32x4 v0 = acc[ai][bj][m][0], v1 = acc[ai][bj][m][1];
                    u32x4 w; w.x = cvt_pk_bf16(v0[0], v0[1]); w.y = cvt_pk_bf16(v0[2], v0[3]); w.z = cvt_pk_bf16(v1[0], v1[1]); w.w = cvt_pk_bf16(v1[2], v1[3]);
                    *(u32x4*)(rowp + bj * HALF) = w; } }
    }
};

struct EpiGate2 {
    static constexpr bool PERM = true; static constexpr bool MID = true;
    const bf16_t* proj; unsigned char* Tout;
    __device__ __forceinline__ static void dec8(const u32x2 g, float (&o)[8]) { const float gs = -LOG2E / (float)(1 << G8_SCALE_LOG2);
        const f32x2 g01 = __builtin_amdgcn_cvt_pk_f32_fp8((int)g.x, false), g23 = __builtin_amdgcn_cvt_pk_f32_fp8((int)g.x, true), g45 = __builtin_amdgcn_cvt_pk_f32_fp8((int)g.y, false), g67 = __builtin_amdgcn_cvt_pk_f32_fp8((int)g.y, true);
        o[0] = g01[0] * gs; o[1] = g01[1] * gs; o[2] = g23[0] * gs; o[3] = g23[1] * gs; o[4] = g45[0] * gs; o[5] = g45[1] * gs; o[6] = g67[0] * gs; o[7] = g67[1] * gs; }
    __device__ __forceinline__ static unsigned goff(const Unit& u, int wr, int wc, int fr, int fq) {
        unsigned o = (unsigned)((u.pm * BM + wr * 64 + fr) * NPROJ + COL_GA) * 2u + (unsigned)(u.pn * BM + wc * 32 + 8 * fq); asm volatile("" : "+v"(o)); return o; }
    __device__ __forceinline__ void mid(f32x4 (&acc)[2][2][4][2], const Unit& u, int wr, int wc, int fr, int fq) const {
        const unsigned char* base = (const unsigned char*)proj; const unsigned o0 = goff(u, wr, wc, fr, fq);
#pragma unroll
        for (int ai = 0; ai < 2; ++ai) {
            u32x2 ga[4][2], gb[4][2];
#pragma unroll
            for (int m = 0; m < 4; ++m)
#pragma unroll
                for (int bj = 0; bj < 2; ++bj) { const unsigned char* gp = base + (o0 + (unsigned)((ai * HALF + m * 16) * NPROJ * 2 + bj * HALF));
                    ga[m][bj] = *(const u32x2*)gp; gb[m][bj] = *(const u32x2*)(gp + 2048); }
#pragma unroll
            for (int m = 0; m < 4; ++m)
#pragma unroll
                for (int bj = 0; bj < 2; ++bj) { float a[8], b[8]; dec8(ga[m][bj], a); dec8(gb[m][bj], b);
#pragma unroll
                    for (int q = 0; q < 8; ++q) { const float r = (1.0f + __builtin_amdgcn_exp2f(b[q])) * __builtin_amdgcn_rcpf(1.0f + __builtin_amdgcn_exp2f(a[q])); acc[ai][bj][m][q >> 2][q & 3] *= r; } }
        }
    }
    __device__ __forceinline__ void operator()(const f32x4 (&acc)[2][2][4][2], const Unit& u, int wr, int wc, int fr, int fq) const {
        const unsigned char* base = (const unsigned char*)proj; const unsigned o0 = goff(u, wr, wc, fr, fq);
        unsigned t0 = (unsigned)((u.pm * BM + wr * 64 + fr) * DM + u.pn * BM + wc * 32 + 8 * fq); asm volatile("" : "+v"(t0));
#pragma unroll
        for (int ai = 0; ai < 2; ++ai) {
            u32x2 gb[4][2];
#pragma unroll
            for (int m = 0; m < 4; ++m)
#pragma unroll
                for (int bj = 0; bj < 2; ++bj) gb[m][bj] = *(const u32x2*)(base + (o0 + (unsigned)((ai * HALF + m * 16) * NPROJ * 2 + bj * HALF + 2048)));
#pragma unroll
            for (int m = 0; m < 4; ++m) {
#pragma unroll
                for (int bj = 0; bj < 2; ++bj) { float b[8], o[8]; dec8(gb[m][bj], b); const float s8 = (float)(1 << M8_SCALE_LOG2);
#pragma unroll
                    for (int q = 0; q < 8; ++q) { const float v = acc[ai][bj][m][q >> 2][q & 3] * __builtin_amdgcn_rcpf(1.0f + __builtin_amdgcn_exp2f(b[q])); o[q] = fminf(fmaxf(v * s8, -440.f), 440.f); }
                    u32x2 w; w.x = cvt_fp8x4_(o[0], o[1], o[2], o[3]); w.y = cvt_fp8x4_(o[4], o[5], o[6], o[7]);
                    *(u32x2*)(Tout + (t0 + (unsigned)((ai * HALF + m * 16) * DM + bj * HALF))) = w; } }
        }
    }
};

template <bool ADD> struct EpiGate {
    static constexpr bool PERM = true;
    const bf16_t* proj; int gcol; const bf16_t* Tin; void* Tout;
    __device__ __forceinline__ void operator()(const f32x4 (&acc)[2][2][4][2], const Unit& u, int wr, int wc, int fr, int fq) const {
        const int row0 = u.pm * BM + wr * 64 + fr, col0 = u.pn * BM + wc * 32 + 8 * fq;
#pragma unroll
        for (int ai = 0; ai < 2; ++ai) {
            u32x2 gb[4][2]; u32x4 tb[4][2];
#pragma unroll
            for (int m = 0; m < 4; ++m)
#pragma unroll
                for (int bj = 0; bj < 2; ++bj) { const size_t row = (size_t)(row0 + ai * HALF + m * 16);
                    gb[m][bj] = *(const u32x2*)((const unsigned char*)(proj + row * NPROJ + COL_GA) + (gcol - COL_GA) + col0 + bj * HALF);
                    if (ADD) tb[m][bj] = *(const u32x4*)(Tin + row * DM + col0 + bj * HALF); }
#pragma unroll
            for (int m = 0; m < 4; ++m) { const size_t row = (size_t)(row0 + ai * HALF + m * 16);
#pragma unroll
                for (int bj = 0; bj < 2; ++bj) { const f32x4 v0 = acc[ai][bj][m][0], v1 = acc[ai][bj][m][1];
                    const u32x2 g = gb[m][bj]; const float gs = 1.0f / (float)(1 << G8_SCALE_LOG2);
                    const f32x2 g01 = __builtin_amdgcn_cvt_pk_f32_fp8((int)g.x, false), g23 = __builtin_amdgcn_cvt_pk_f32_fp8((int)g.x, true), g45 = __builtin_amdgcn_cvt_pk_f32_fp8((int)g.y, false), g67 = __builtin_amdgcn_cvt_pk_f32_fp8((int)g.y, true);
                    float o[8];
                    o[0] = sigmoidf_(g01[0] * gs) * v0[0]; o[1] = sigmoidf_(g01[1] * gs) * v0[1]; o[2] = sigmoidf_(g23[0] * gs) * v0[2]; o[3] = sigmoidf_(g23[1] * gs) * v0[3];
                    o[4] = sigmoidf_(g45[0] * gs) * v1[0]; o[5] = sigmoidf_(g45[1] * gs) * v1[1]; o[6] = sigmoidf_(g67[0] * gs) * v1[2]; o[7] = sigmoidf_(g67[1] * gs) * v1[3];
#if defined(DBG_NOA)
                    if (!ADD) { for (int q_ = 0; q_ < 8; ++q_) o[q_] = 0.f; }
#endif
#if defined(DBG_NOB)
                    if (ADD) { for (int q_ = 0; q_ < 8; ++q_) o[q_] = 0.f; }
#endif
                    if (ADD) { const u32x4 t = tb[m][bj];
                        o[0] += bf_lo(t.x); o[1] += bf_hi(t.x); o[2] += bf_lo(t.y); o[3] += bf_hi(t.y); o[4] += bf_lo(t.z); o[5] += bf_hi(t.z); o[6] += bf_lo(t.w); o[7] += bf_hi(t.w);
                        const float s8 = (float)(1 << M8_SCALE_LOG2);
#pragma unroll
                        for (int q_ = 0; q_ < 8; ++q_) o[q_] = fminf(fmaxf(o[q_] * s8, -440.f), 440.f);
                        u32x2 w; w.x = cvt_fp8x4_(o[0], o[1], o[2], o[3]); w.y = cvt_fp8x4_(o[4], o[5], o[6], o[7]);
                        *(u32x2*)((unsigned char*)Tout + row * DM + col0 + bj * HALF) = w;
                    } else {
                        u32x4 w; w.x = cvt_pk_bf16(o[0], o[1]); w.y = cvt_pk_bf16(o[2], o[3]); w.z = cvt_pk_bf16(o[4], o[5]); w.w = cvt_pk_bf16(o[6], o[7]);
                        *(u32x4*)((bf16_t*)Tout + row * DM + col0 + bj * HALF) = w; } } }
        }
    }
};
struct EpiRes {
    static constexpr bool PERM = true;
    const float* X; const float* g1; bf16_t* O;
    __device__ __forceinline__ void operator()(const f32x4 (&acc)[2][2][4][2], const Unit& u, int wr, int wc, int fr, int fq) const {
        const int row0 = u.pm * BM + wr * 64 + fr, col0 = u.pn * BM + wc * 32 + 8 * fq;
        f32x4 gv[2][2];
#pragma unroll
        for (int bj = 0; bj < 2; ++bj)
#pragma unroll
            for (int n = 0; n < 2; ++n) gv[bj][n] = *(const f32x4*)(g1 + col0 + bj * HALF + n * 4);
#pragma unroll
        for (int ai = 0; ai < 2; ++ai) {
            f32x4 xb[4][2][2];
#pragma unroll
            for (int m = 0; m < 4; ++m)
#pragma unroll
                for (int bj = 0; bj < 2; ++bj) { const size_t ro = (size_t)(row0 + ai * HALF + m * 16) * DM + col0;
                    xb[m][bj][0] = *(const f32x4*)(X + ro + bj * HALF); xb[m][bj][1] = *(const f32x4*)(X + ro + bj * HALF + 4); }
#pragma unroll
            for (int m = 0; m < 4; ++m) { const size_t ro = (size_t)(row0 + ai * HALF + m * 16) * DM + col0;
#pragma unroll
                for (int bj = 0; bj < 2; ++bj) {
                    const f32x4 o0 = xb[m][bj][0] + gv[bj][0] * acc[ai][bj][m][0], o1 = xb[m][bj][1] + gv[bj][1] * acc[ai][bj][m][1];
                    u32x4 w; w.x = cvt_pk_bf16(o0[0], o0[1]); w.y = cvt_pk_bf16(o0[2], o0[3]); w.z = cvt_pk_bf16(o1[0], o1[1]); w.w = cvt_pk_bf16(o1[2], o1[3]);
                    *(u32x4*)(O + ro + bj * HALF) = w; } }
        }
    }
};
struct EpiMoe1 {
    static constexpr bool PERM = false;
    unsigned char* Aout;
    __device__ __forceinline__ void operator()(const f32x4 (&acc)[2][2][4][2], const Unit& u, int wr, int wc, int fr, int fq) const {
        const int row0 = u.x0 + wr * 64 + fr; const float s8 = (float)(1 << A8_SCALE_LOG2);
#pragma unroll
        for (int ai = 0; ai < 2; ++ai)
#pragma unroll
            for (int m = 0; m < 4; ++m) { unsigned char* rowp = Aout + (size_t)(row0 + ai * HALF + m * 16) * DFF;
#pragma unroll
                for (int bj = 0; bj < 2; ++bj) { const f32x4 a1 = acc[ai][bj][m][0], a3 = acc[ai][bj][m][1]; float o[4];
#pragma unroll
                    for (int j = 0; j < 4; ++j) o[j] = fminf(fmaxf(a1[j] * sigmoidf_(a1[j]) * a3[j] * s8, -440.f), 440.f);
                    *(unsigned*)(rowp + (8 * u.pn + 4 * bj + wc) * 16 + 4 * fq) = cvt_fp8x4_(o[0], o[1], o[2], o[3]); } }
    }
};
struct EpiMoe2 {
    static constexpr bool PERM = true;
    bf16_t* Y;
    __device__ __forceinline__ void operator()(const f32x4 (&acc)[2][2][4][2], const Unit& u, int wr, int wc, int fr, int fq) const {
        const int row0 = u.x0 + wr * 64 + fr, col0 = u.pn * BM + wc * 32 + 8 * fq;
#pragma unroll
        for (int ai = 0; ai < 2; ++ai)
#pragma unroll
            for (int m = 0; m < 4; ++m) { bf16_t* rowp = Y + (size_t)(row0 + ai * HALF + m * 16) * DM + col0;
                if (wr * 64 + fr + ai * HALF + m * 16 < u.x1) {
#pragma unroll
                for (int bj = 0; bj < 2; ++bj) { const f32x4 v0 = acc[ai][bj][m][0], v1 = acc[ai][bj][m][1];
                    u32x4 w; w.x = cvt_pk_bf16(v0[0], v0[1]); w.y = cvt_pk_bf16(v0[2], v0[3]); w.z = cvt_pk_bf16(v1[0], v1[1]); w.w = cvt_pk_bf16(v1[2], v1[3]);
                    *(u32x4*)(rowp + bj * HALF) = w; } } }
    }
};
}
struct Args {
    const float* in[20]; float* out; unsigned char* ws; int ph_lo, ph_hi, dry;
};
struct Frame {
    LAS unsigned char* lds; int tid, lane, wave, G, bid, vcu;
    const float *x, *c, *w_ada, *b_ada, *norm_mix, *w_in, *t5, *rel, *w_up_a, *w_up_b, *w_o, *norm_ffn, *w_rg, *b_rg, *w_re, *b_re, *w1, *w3, *w2, *norm_final;
    float* out; unsigned char* ws;
    float* mod; unsigned* ecnt;
    bf16_t *WinT, *WupaT, *WupbT, *WoT, *W13T, *W2T, *H, *PROJ, *YA, *YB, *MRG;
    unsigned char *WinT8, *H8, *W13T8, *W2T8, *Wupa8, *Wupb8, *Wo8;
    unsigned long long* MASK; int* LIST; int* TSLOT; float* TW;
    bf16_t *RBH, *RBL; float* RC;
};

__device__ __forceinline__ void p0_mod(const Frame& F) {
    LAS float* red = (LAS float*)F.lds;
    for (int b = F.bid; b < 256; b += F.G) {
        const int t = F.tid;
        f32x4 acc = {0.f, 0.f, 0.f, 0.f};
        const int c4 = t % 12, kg = t / 12;
        if (t < 480) {
            const float* wp = F.w_ada + b * 48 + c4 * 4;
            int k = kg;
            for (; k + 7 * 40 < DM; k += 8 * 40) {
                f32x4 w[8]; float sv[8];
#pragma unroll
                for (int u = 0; u < 8; ++u) { w[u] = *(const f32x4*)(wp + (size_t)(k + 40 * u) * 12288); const float cv = F.c[k + 40 * u]; sv[u] = cv * sigmoidf_(cv); }
#pragma unroll
                for (int u = 0; u < 8; ++u) acc += w[u] * sv[u];
            }
            for (; k < DM; k += 40) { const float cv = F.c[k]; const float s = cv * sigmoidf_(cv); const f32x4 w = *(const f32x4*)(wp + (size_t)k * 12288); acc += w * s; }
            *(LAS f32x4*)(red + (kg * 12 + c4) * 4) = acc;
        }
        __syncthreads();
        if (t < 12) { f32x4 sum = *(const f32x4*)(F.b_ada + b * 48 + t * 4);
            for (int g = 0; g < 40; ++g) sum += *(LAS f32x4*)(red + (g * 12 + t) * 4);
            *(f32x4*)(F.mod + b * 48 + t * 4) = sum; }
        __syncthreads();
    }
}
__device__ __forceinline__ int rowmap(int n, int mode) { return mode == 0 ? n : (32 * (n >> 4) + (n & 15) + (mode == 2 ? 16 : 0)); }
__device__ __forceinline__ unsigned cvt_fp8x4(float a, float b, float c, float d) {
    int w = 0;
    w = __builtin_amdgcn_cvt_pk_fp8_f32(a, b, w, false);
    w = __builtin_amdgcn_cvt_pk_fp8_f32(c, d, w, true);
    return (unsigned)w;
}
constexpr int TC_WIN = 32 * 178, TC_UP = 16 * 32, TC_WO = 32 * 32, TC_W1 = NEXP * 32 * 8, TC_W2 = NEXP * 8 * 32;
constexpr int TC_TOTAL = TC_WIN + 2 * TC_UP + TC_WO + 2 * TC_W1 + TC_W2;
constexpr int TC_EARLY = TC_WIN + 2 * TC_UP + TC_WO;
#ifndef TC_LATE_START
#define TC_LATE_START TC_EARLY
#endif
struct TDesc { const float* src; int N, k0, n0, ldd, mode; unsigned char* dst; };
__device__ __forceinline__ bool tconv_desc(const Frame& F, int tl, TDesc& d, int limit = TC_TOTAL) {
    if (tl >= limit) return false;
    int r = tl;
    if (r < TC_WIN) { d.src = F.w_in; d.N = NPROJ_REAL; d.k0 = (r % 32) * 64; d.n0 = (r / 32) * 64; d.dst = (unsigned char*)F.WinT; d.ldd = DM; d.mode = 3; return true; }
    r -= TC_WIN;
    if (r < TC_UP) { d.src = F.w_up_a; d.N = DM; d.k0 = (r % 16) * 64; d.n0 = (r / 16) * 64; d.dst = F.Wupa8; { int l_ = 2048; asm volatile("" : "+s"(l_)); d.ldd = l_; } d.mode = 7; return true; }
    r -= TC_UP;
    if (r < TC_UP) { d.src = F.w_up_b; d.N = DM; d.k0 = (r % 16) * 64; d.n0 = (r / 16) * 64; d.dst = F.Wupa8 + 1024; { int l_ = 2048; asm volatile("" : "+s"(l_)); d.ldd = l_; } d.mode = 7; return true; }
    r -= TC_UP;
    if (r < TC_WO) { d.src = F.w_o; d.N = DM; d.k0 = (r % 32) * 64; d.n0 = (r / 32) * 64; d.dst = F.Wo8; d.ldd = DM; d.mode = 7; return true; }
    r -= TC_WO;
    if (r < TC_W1) { const int e = r / 256, q = r % 256; d.src = F.w1 + (size_t)e * DM * DFF; d.N = DFF; d.k0 = (q % 32) * 64; d.n0 = (q / 32) * 64; d.dst = F.W13T8 + (size_t)e * 1024 * DM; d.ldd = DM; d.mode = 4; return true; }
    r -= TC_W1;
    if (r < TC_W1) { const int e = r / 256, q = r % 256; d.src = F.w3 + (size_t)e * DM * DFF; d.N = DFF; d.k0 = (q % 32) * 64; d.n0 = (q / 32) * 64; d.dst = F.W13T8 + (size_t)e * 1024 * DM; d.ldd = DM; d.mode = 5; return true; }
    r -= TC_W1;
    { const int e = r / 256, q = r % 256; d.src = F.w2 + (size_t)e * DFF * DM; d.N = DM; d.k0 = (q % 8) * 64; d.n0 = (q / 8) * 64; d.dst = F.W2T8 + (size_t)e * DM * DFF; d.ldd = DFF; d.mode = 6; return true; }
}
__device__ __forceinline__ void tconv_load(const Frame& F, const TDesc& d, f32x4 (&v)[2]) {
    const int kk = F.tid >> 4, n4 = (F.tid & 15) * 4;
    const int nn = min(d.n0 + n4, d.N - 4);
    const float* p0 = d.src + (size_t)(d.k0 + kk) * d.N + nn; const float* p1 = p0 + (size_t)32 * d.N;
    asm volatile("global_load_dwordx4 %0, %1, off" : "=v"(v[0]) : "v"(p0) : "memory");
    asm volatile("global_load_dwordx4 %0, %1, off" : "=v"(v[1]) : "v"(p1) : "memory");
}
__device__ __forceinline__ void tconv_to_lds(const Frame& F, const f32x4 (&vin)[2], LAS float* tile  ) {
    const int t = F.tid, kk = t >> 4, n4 = (t & 15) * 4;
#pragma unroll
    for (int h = 0; h < 2; ++h) { const int k = kk + 32 * h; tile[k * 65 + n4 + 0] = vin[h][0]; tile[k * 65 + n4 + 1] = vin[h][1]; tile[k * 65 + n4 + 2] = vin[h][2]; tile[k * 65 + n4 + 3] = vin[h][3]; }
}
__device__ __forceinline__ void tconv_from_lds(const Frame& F, const TDesc& d, const LAS float* tile) {
    const int t = F.tid;
    { const int n = t >> 3, kq = (t & 7) * 8; const int k0 = d.k0, n0 = d.n0, mode = d.mode;
      if (n0 + n < d.N) {
        float v[8];
#pragma unroll
        for (int i = 0; i < 8; ++i) v[i] = tile[(kq + i) * 65 + n];
        if (mode == 3) {
            const int c = n0 + n; int rb = -1, r8 = -1;
            if (c < 2048) rb = c; else if (c < 3072) r8 = c - 2048; else if (c < 6224) rb = c - 1024; else if (c < 7248) r8 = 1024 + (c - 6224); else r8 = 2048 + (c - 7248);
            if (rb >= 0) { u32x4 w; w.x = cvt_pk_bf16(v[0], v[1]); w.y = cvt_pk_bf16(v[2], v[3]); w.z = cvt_pk_bf16(v[4], v[5]); w.w = cvt_pk_bf16(v[6], v[7]);
                *(u32x4*)(F.WinT + (size_t)rb * DM + k0 + kq) = w; }
            else { const float sc = (float)(1 << W8_SCALE_LOG2); u32x2 w; w.x = cvt_fp8x4_(v[0] * sc, v[1] * sc, v[2] * sc, v[3] * sc); w.y = cvt_fp8x4_(v[4] * sc, v[5] * sc, v[6] * sc, v[7] * sc);
                *(u32x2*)(F.WinT8 + (size_t)r8 * DM + k0 + kq) = w; }
        } else {
            const float sc = (float)(1 << (mode == 6 ? W2_SCALE_LOG2 : W8_SCALE_LOG2)); const int r = rowmap(n0 + n, mode == 4 ? 1 : (mode == 5 ? 2 : 0));
            u32x2 w; w.x = cvt_fp8x4_(v[0] * sc, v[1] * sc, v[2] * sc, v[3] * sc); w.y = cvt_fp8x4_(v[4] * sc, v[5] * sc, v[6] * sc, v[7] * sc);
            *(u32x2*)(d.dst + (size_t)r * d.ldd + k0 + kq) = w; } } }
}
__device__ __forceinline__ void tconv_store(const Frame& F, const TDesc& d, const f32x4 (&vin)[2], int ahead  ) {
    LAS float* tile = (LAS float*)F.lds;
    if (ahead >= 4) asm volatile("s_waitcnt vmcnt(8)" ::: "memory"); else if (ahead == 3) asm volatile("s_waitcnt vmcnt(6)" ::: "memory"); else if (ahead == 2) asm volatile("s_waitcnt vmcnt(4)" ::: "memory");
    else if (ahead == 1) asm volatile("s_waitcnt vmcnt(2)" ::: "memory"); else asm volatile("s_waitcnt vmcnt(0)" ::: "memory");
#ifdef DIAG_ZERO_P0_WUP
    if (d.mode == 7 && d.ldd == 1024) { const f32x4 z[2] = {(f32x4){0.f,0.f,0.f,0.f}, (f32x4){0.f,0.f,0.f,0.f}}; tconv_to_lds(F, z, tile); } else
#endif
    tconv_to_lds(F, vin, tile);
    __syncthreads();
    tconv_from_lds(F, d, tile);
    __syncthreads();
}
constexpr int CONV_LDS_OFF = 16384, CONV_LDS_BYTES = 64 * 64 * 4;
struct ConvSt { int base, cs; };
__device__ __forceinline__ LAS unsigned char* conv_buf(const Frame& F, int i) { return F.lds + CONV_LDS_OFF + (((i % 3) + 3) % 3) * CONV_LDS_BYTES; }
__device__ __forceinline__ bool conv_issue(const Frame& F, int tl, int bufi) {
    TDesc d; if (!tconv_desc(F, tl, d)) return false;
    LAS unsigned char* buf = conv_buf(F, bufi);
#pragma unroll
    for (int p = 0; p < 2; ++p) {
        const int k = p * 32 + (F.tid >> 4), c = F.tid & 15, cs = c ^ ((k >> 3) & 7);
        const float* g = d.src + (size_t)(d.k0 + k) * d.N + d.n0 + 4 * cs;
        __builtin_amdgcn_global_load_lds((const unsigned*)g, (LAS unsigned*)(buf + p * 8192 + F.wave * 1024), 16, 0, 0);
    }
    return true;
}
__device__ __forceinline__ void conv_drain(const Frame& F, int tl, int bufi) {
    TDesc d; if (tl < 0 || !tconv_desc(F, tl, d)) return;
    const LAS float* tile = (const LAS float*)conv_buf(F, bufi);
    const int t = F.tid, n = t >> 3, kq = (t & 7) * 8, f = t & 7;
    float v[8];
#pragma unroll
    for (int i = 0; i < 8; ++i) v[i] = tile[(kq + i) * 64 + (((n >> 2) ^ f) << 2) + (n & 3)];
    const int mode = d.mode;
    const float sc = (float)(1 << (mode == 6 ? W2_SCALE_LOG2 : W8_SCALE_LOG2)); const int r = rowmap(d.n0 + n, mode == 4 ? 1 : (mode == 5 ? 2 : 0));
    u32x2 w; w.x = cvt_fp8x4_(v[0] * sc, v[1] * sc, v[2] * sc, v[3] * sc); w.y = cvt_fp8x4_(v[4] * sc, v[5] * sc, v[6] * sc, v[7] * sc);
    *(u32x2*)(d.dst + (size_t)r * d.ldd + d.k0 + kq) = w;
}
__device__ __forceinline__ void p0_convert(const Frame& F) {
    TDesc d0, d1, d2, d3, d4; f32x4 v0[2], v1[2], v2[2], v3[2], v4[2];
    int tl = F.bid; const int G = F.G;
    bool h0 = tconv_desc(F, tl, d0, TC_EARLY); if (h0) tconv_load(F, d0, v0);
    bool h1 = tconv_desc(F, tl + G, d1, TC_EARLY); if (h1) tconv_load(F, d1, v1);
    bool h2 = tconv_desc(F, tl + 2 * G, d2, TC_EARLY); if (h2) tconv_load(F, d2, v2);
    bool h3 = tconv_desc(F, tl + 3 * G, d3, TC_EARLY); if (h3) tconv_load(F, d3, v3);
    bool h4 = false;
#define TC_STEP(HX, DX, VX, HN, DN, VN, K, A1, A2, A3) \
        if (!HX) break; \
        HN = tconv_desc(F, tl + (K) * G, DN, TC_EARLY); if (HN) tconv_load(F, DN, VN); \
        tconv_store(F, DX, VX, (A1 ? 1 : 0) + (A2 ? 1 : 0) + (A3 ? 1 : 0) + (HN ? 1 : 0));
    for (;;) {
        TC_STEP(h0, d0, v0, h4, d4, v4, 4, h1, h2, h3)
        TC_STEP(h1, d1, v1, h0, d0, v0, 5, h2, h3, h4)
        TC_STEP(h2, d2, v2, h1, d1, v1, 6, h3, h4, h0)
        TC_STEP(h3, d3, v3, h2, d2, v2, 7, h4, h0, h1)
        TC_STEP(h4, d4, v4, h3, d3, v3, 8, h0, h1, h2)
        tl += 5 * G;
    }
#undef TC_STEP
    asm volatile("s_waitcnt vmcnt(0)" ::: "memory");
    { u32x4* z = (u32x4*)(F.WinT + (size_t)NPB_REAL * DM); const int n16 = (NPB - NPB_REAL) * DM * 2 / 16;
      for (int i = F.bid * 512 + F.tid; i < n16; i += F.G * 512) z[i] = (u32x4){0u, 0u, 0u, 0u}; }
}

__device__ __forceinline__ void p1_router_prep(const Frame& F, int col0, int cstep) {
    const float* sh2 = F.mod + 3 * DM; const float* sc2 = F.mod + 4 * DM;
    LAS float* red = (LAS float*)F.lds;
    for (int col = col0; col < 96; col += cstep) {
        const int k = F.tid * 4;
        const f32x4 ga = *(const f32x4*)(F.norm_ffn + k) * (*(const f32x4*)(sc2 + k) + 1.0f), gb = *(const f32x4*)(sh2 + k);
        float w[4], gbw = 0.f;
#pragma unroll
        for (int j = 0; j < 4; ++j) { const float wv = col < 8 ? F.w_rg[(size_t)(k + j) * 8 + col] : (col < 72 ? F.w_re[(size_t)(k + j) * 64 + (col - 8)] : 0.f); gbw += gb[j] * wv; w[j] = wv * ga[j]; }
        u32x2 h, l;
        h.x = cvt_pk_bf16(w[0], w[1]); h.y = cvt_pk_bf16(w[2], w[3]);
        l.x = cvt_pk_bf16(w[0] - bf_lo(h.x), w[1] - bf_hi(h.x)); l.y = cvt_pk_bf16(w[2] - bf_lo(h.y), w[3] - bf_hi(h.y));
        { unsigned char* fb = (unsigned char*)F.RBH + (size_t)(((k >> 4) * 3 + (col >> 5)) * 2) * 1024 + ((col & 31) + 32 * ((k >> 3) & 1)) * 16 + (k & 7) * 2;
          *(u32x2*)fb = h; *(u32x2*)(fb + 1024) = l; }
        gbw = wave_sum(gbw);
        if (F.lane == 0) red[F.wave] = gbw;
        __syncthreads();
        if (F.tid == 0) { float s = 0.f; for (int i = 0; i < 8; ++i) s += red[i]; F.RC[col] = s; }
        __syncthreads();
    }
}

__device__ __forceinline__ void p1_norm(const Frame& F) {
    const float* sh1 = F.mod; const float* sc1 = F.mod + DM;
    f32x4 ga[8], gb[8];
#pragma unroll
    for (int j = 0; j < 8; ++j) { const int c = 4 * F.lane + 256 * j; const f32x4 nm = *(const f32x4*)(F.norm_mix + c), sc = *(const f32x4*)(sc1 + c); ga[j] = nm * (sc + 1.0f); gb[j] = *(const f32x4*)(sh1 + c); }
    const int rstep = F.G * 8; int row = F.bid * 8 + F.wave;
    f32x4 v[8], vn[8];
    if (row < SEQ) {
#pragma unroll
        for (int j = 0; j < 8; ++j) v[j] = *(const f32x4*)(F.x + (size_t)row * DM + 4 * F.lane + 256 * j);
    }
    for (; row < SEQ; row += rstep) {
        const int nrow = row + rstep;
        if (nrow < SEQ) {
#pragma unroll
            for (int j = 0; j < 8; ++j) vn[j] = *(const f32x4*)(F.x + (size_t)nrow * DM + 4 * F.lane + 256 * j);
        }
        float ss = 0.f;
#pragma unroll
        for (int j = 0; j < 8; ++j) ss += v[j][0] * v[j][0] + v[j][1] * v[j][1] + v[j][2] * v[j][2] + v[j][3] * v[j][3];
        ss = wave_sum(ss);
        const float rstd = __builtin_amdgcn_rsqf(ss * (1.0f / DM) + EPS);
        bf16_t* hp = F.H + (size_t)row * DM + 4 * F.lane; unsigned char* h8 = F.H8 + (size_t)row * DM + 4 * F.lane;
        const float s8 = (float)(1 << H8_SCALE_LOG2);
#pragma unroll
        for (int j = 0; j < 8; ++j) { const f32x4 o = v[j] * rstd * ga[j] + gb[j]; u32x2 w; w.x = cvt_pk_bf16(o[0], o[1]); w.y = cvt_pk_bf16(o[2], o[3]); *(u32x2*)(hp + 256 * j) = w;
            const f32x4 c8 = __builtin_elementwise_min(__builtin_elementwise_max(o * s8, (f32x4){-440.f, -440.f, -440.f, -440.f}), (f32x4){440.f, 440.f, 440.f, 440.f});
            *(unsigned*)(h8 + 256 * j) = cvt_fp8x4_(c8[0], c8[1], c8[2], c8[3]); }
#pragma unroll
        for (int j = 0; j < 8; ++j) v[j] = vn[j];
    }
}

constexpr int P8_RSTD = 0, P8_ECL = 256, P8_EBASE = 512, P8_LOG = 1024, P8_AS = 32768, P8_AS_STRIDE = 64 * 80;
__device__ __forceinline__ void p8_router(const Frame& F, const int dry = 0) {
    const float* sh2 = F.mod + 3 * DM; const float* sc2 = F.mod + 4 * DM;
    const bf16_t* X1 = F.H;
    LAS float* rs = (LAS float*)(F.lds + P8_RSTD);
    LAS float* lg = (LAS float*)(F.lds + P8_LOG);
    for (int blk = F.bid; blk < SEQ / 64; blk += F.G) {
        const int T0 = blk * 64;
        if (dry < 5) {
            int l4 = 4 * F.lane; asm volatile("" : "+v"(l4));
            f32x4 ga[8], gb[8];
#pragma unroll
            for (int j = 0; j < 8; ++j) { const int c = l4 + 256 * j; const f32x4 nm = *(const f32x4*)(F.norm_ffn + c), sc = *(const f32x4*)(sc2 + c); ga[j] = nm * (sc + 1.0f); gb[j] = *(const f32x4*)(sh2 + c); }
            u32x2 xw[8], xwn[8];
            { const bf16_t* xp = X1 + (size_t)(T0 + F.wave) * DM + l4;
#pragma unroll
              for (int j = 0; j < 8; ++j) xw[j] = *(const u32x2*)(xp + 256 * j); }
            for (int r = F.wave; r < 64; r += 8) {
                if (r + 8 < 64) { const bf16_t* xp = X1 + (size_t)(T0 + r + 8) * DM + l4;
#pragma unroll
                    for (int j = 0; j < 8; ++j) xwn[j] = *(const u32x2*)(xp + 256 * j); }
                f32x4 v[8]; float ss = 0.f;
#pragma unroll
                for (int j = 0; j < 8; ++j) { const u32x2 w = xw[j]; v[j] = (f32x4){bf_lo(w.x), bf_hi(w.x), bf_lo(w.y), bf_hi(w.y)}; }
#pragma unroll
                for (int j = 0; j < 8; ++j) ss += v[j][0] * v[j][0] + v[j][1] * v[j][1] + v[j][2] * v[j][2] + v[j][3] * v[j][3];
                ss = wave_sum(ss);
                const float rstd = __builtin_amdgcn_rsqf(ss * (1.0f / DM) + EPS);
                if (F.lane == 0) rs[r] = rstd;
                unsigned char* hp = F.H8 + (size_t)(T0 + r) * DM + l4; const float s8 = (float)(1 << H8_SCALE_LOG2);
#pragma unroll
                for (int j = 0; j < 8; ++j) { const f32x4 o = v[j] * rstd * ga[j] + gb[j];
                    const f32x4 c8 = __builtin_elementwise_min(__builtin_elementwise_max(o * s8, (f32x4){-440.f, -440.f, -440.f, -440.f}), (f32x4){440.f, 440.f, 440.f, 440.f});
                    *(unsigned*)(hp + 256 * j) = cvt_fp8x4_(c8[0], c8[1], c8[2], c8[3]); }
#pragma unroll
                for (int j = 0; j < 8; ++j) xw[j] = xwn[j];
            }
            if (F.tid < 64) ((LAS int*)(F.lds + P8_ECL))[F.tid] = 0;
        }
        __syncthreads();
        f32x16 acc[2][3];
#pragma unroll
        for (int a = 0; a < 2; ++a)
#pragma unroll
            for (int b = 0; b < 3; ++b)
#pragma unroll
                for (int i = 0; i < 16; ++i) acc[a][b][i] = 0.f;
        if (dry < 4) {
            const int mi = F.lane & 31, mk = F.lane >> 5;
            LAS unsigned char* Aw = F.lds + P8_AS + F.wave * P8_AS_STRIDE;
            const int lrow = F.lane >> 2, lpc = F.lane & 3;
            unsigned gao = (unsigned)((T0 + lrow) * DM + F.wave * 256 + lpc * 8) * 2u; asm volatile("" : "+v"(gao));
            const char* xbase = (const char*)X1;
            const unsigned law = (unsigned)(lrow * 80 + lpc * 16), lar = (unsigned)(mi * 80 + mk * 16);
            unsigned bo = (unsigned)(F.wave * 16 * 6 * 1024 + F.lane * 16); asm volatile("" : "+v"(bo));
            const char* bbase = (const char*)F.RBH;
            u32x4 ac[4], an[4], bq[4][6];
#define P8_LDA(c, R) { _Pragma("unroll") for (int i = 0; i < 4; ++i) R[i] = *(const u32x4*)(xbase + gao + (c) * 64 + i * (16 * DM * 2)); }
#define P8_LDB(ks, R) { _Pragma("unroll") for (int q = 0; q < 6; ++q) R[q] = *(const u32x4*)(bbase + bo + ((ks) * 6 + q) * 1024); }
            P8_LDA(0, ac) P8_LDB(0, bq[0]) P8_LDB(1, bq[1]) P8_LDB(2, bq[2])
#pragma unroll
            for (int c = 0; c < 8; ++c) {
#pragma unroll
                for (int i = 0; i < 4; ++i) *(LAS u32x4*)(Aw + law + i * (16 * 80)) = ac[i];
                if (c + 1 < 8) P8_LDA(c + 1, an)
#pragma unroll
                for (int s = 0; s < 2; ++s) {
                    const int ks = c * 2 + s;
                    if (ks + 3 < 16) P8_LDB(ks + 3, bq[(ks + 3) & 3])
                    const bf16x8 a0 = *(const LAS bf16x8*)(Aw + lar + s * 32), a1 = *(const LAS bf16x8*)(Aw + lar + 32 * 80 + s * 32);
#pragma unroll
                    for (int nt = 0; nt < 3; ++nt) { const bf16x8 h_ = __builtin_bit_cast(bf16x8, bq[ks & 3][2 * nt]), l_ = __builtin_bit_cast(bf16x8, bq[ks & 3][2 * nt + 1]);
                        acc[0][nt] = __builtin_amdgcn_mfma_f32_32x32x16_bf16(a0, l_, acc[0][nt], 0, 0, 0); acc[1][nt] = __builtin_amdgcn_mfma_f32_32x32x16_bf16(a1, l_, acc[1][nt], 0, 0, 0);
                        acc[0][nt] = __builtin_amdgcn_mfma_f32_32x32x16_bf16(a0, h_, acc[0][nt], 0, 0, 0); acc[1][nt] = __builtin_amdgcn_mfma_f32_32x32x16_bf16(a1, h_, acc[1][nt], 0, 0, 0); }
                }
#pragma unroll
                for (int i = 0; i < 4; ++i) ac[i] = an[i];
            }
#undef P8_LDA
#undef P8_LDB
        }
        if (dry < 3) {
            LAS f32x4* R = (LAS f32x4*)(F.lds + P8_AS);
#define P8_WR(reg) { _Pragma("unroll") for (int q = 0; q < 24; ++q) { const int t_ = q >> 2, rq = q & 3; \
                const f32x4 v_ = {acc[t_ / 3][t_ % 3][4 * rq], acc[t_ / 3][t_ % 3][4 * rq + 1], acc[t_ / 3][t_ % 3][4 * rq + 2], acc[t_ / 3][t_ % 3][4 * rq + 3]}; R[((reg) * 24 + q) * 64 + F.lane] = v_; } }
#define P8_RD(reg) { _Pragma("unroll") for (int q = 0; q < 24; ++q) { const int t_ = q >> 2, rq = q & 3; const f32x4 v_ = R[((reg) * 24 + q) * 64 + F.lane]; \
                acc[t_ / 3][t_ % 3][4 * rq] += v_[0]; acc[t_ / 3][t_ % 3][4 * rq + 1] += v_[1]; acc[t_ / 3][t_ % 3][4 * rq + 2] += v_[2]; acc[t_ / 3][t_ % 3][4 * rq + 3] += v_[3]; } }
            __syncthreads();
            if (F.wave >= 4) P8_WR(F.wave - 4)
            __syncthreads();
            if (F.wave < 4) P8_RD(F.wave)
            if (F.wave == 2 || F.wave == 3) P8_WR(F.wave)
            __syncthreads();
            if (F.wave < 2) P8_RD(F.wave + 2)
            if (F.wave == 1) P8_WR(3)
            __syncthreads();
            if (F.wave == 0) {
                P8_RD(3)
                const int col = F.lane & 31, hi = F.lane >> 5;
#pragma unroll
                for (int mt = 0; mt < 2; ++mt)
#pragma unroll
                    for (int nt = 0; nt < 3; ++nt)
#pragma unroll
                        for (int r = 0; r < 16; ++r) { const int tok = 32 * mt + (r & 3) + 8 * (r >> 2) + 4 * hi; lg[tok * 96 + 32 * nt + col] = acc[mt][nt][r]; }
            }
#undef P8_WR
#undef P8_RD
            __syncthreads();
        }
        if (F.tid < 64 && dry < 2) {
            const int tok = F.tid, T = T0 + tok; const LAS float* Lr = lg + tok * 96; const float* Lc = F.RC; const float rsv = rs[tok];
#define L(i_) (rsv * Lr[i_] + Lc[i_])
            float g[8]; float gmax = -3.4e38f; int grp = 0;
#pragma unroll
            for (int i = 0; i < 8; ++i) { g[i] = L(i) + F.b_rg[i]; if (g[i] > gmax) { gmax = g[i]; grp = i; } }
            float den = 0.f;
#pragma unroll
            for (int i = 0; i < 8; ++i) den += __expf(g[i] - gmax);
            const float pgrp = 1.0f / den;
            float v0 = -3.4e38f, v1 = -3.4e38f; int i0 = 0, i1 = 0;
#pragma unroll
            for (int i = 0; i < 8; ++i) { const float e = L(8 + grp * 8 + i) + F.b_re[grp * 8 + i];
                if (e > v0) { v1 = v0; i1 = i0; v0 = e; i0 = i; } else if (e > v1) { v1 = e; i1 = i; } }
            const float ex = __expf(v1 - v0); const float p0 = 1.0f / (1.0f + ex), p1 = ex / (1.0f + ex);
            const int e0 = grp * 8 + i0, e1 = grp * 8 + i1;
            if (dry >= 1) { if (pgrp * p0 + (float)(e0 + e1) == -12345.0f) F.TW[0] = p1; } else {
                LAS int* ecl = (LAS int*)(F.lds + P8_ECL); LAS unsigned* ebase = (LAS unsigned*)(F.lds + P8_EBASE);
                const int lr0 = __hip_atomic_fetch_add(ecl + e0, 1, __ATOMIC_RELAXED, __HIP_MEMORY_SCOPE_WORKGROUP), lr1 = __hip_atomic_fetch_add(ecl + e1, 1, __ATOMIC_RELAXED, __HIP_MEMORY_SCOPE_WORKGROUP);
                asm volatile("s_waitcnt lgkmcnt(0)" ::: "memory");
                { const int cn = ecl[tok]; ebase[tok] = cn ? atomicAdd(F.ecnt + 16 * tok, (unsigned)cn) : 0u; }
                asm volatile("s_waitcnt vmcnt(0) lgkmcnt(0)" ::: "memory");
                const unsigned pos0 = ebase[e0] + (unsigned)lr0, pos1 = ebase[e1] + (unsigned)lr1;
                F.LIST[(size_t)e0 * LIST_CAP + pos0] = T; F.LIST[(size_t)e1 * LIST_CAP + pos1] = T;
                F.TSLOT[2 * T + 0] = (e0 << 16) | (int)pos0; F.TSLOT[2 * T + 1] = (e1 << 16) | (int)pos1;
                F.TW[2 * T + 0] = pgrp * p0; F.TW[2 * T + 1] = pgrp * p1;
            }
#undef L
        }
        __syncthreads();
    }
}

constexpr int MOE_TS = 131072, MOE_CNT = 131072 + 512, MOE_TOK = 131072 + 1024;
__device__ __forceinline__ void moe_tables(const Frame& F) {
    LAS int* ts = (LAS int*)(F.lds + MOE_TS); LAS int* cn = (LAS int*)(F.lds + MOE_CNT);
    if (F.tid < 64) cn[F.tid] = (int)__hip_atomic_load(F.ecnt + 16 * F.tid, __ATOMIC_RELAXED, __HIP_MEMORY_SCOPE_AGENT);
    __syncthreads();
    if (F.tid == 0) { int s = 0; for (int e = 0; e < 64; ++e) { ts[e] = s; s += (cn[e] + 255) >> 8; } ts[64] = s; }
    __syncthreads();
}
__device__ __forceinline__ int moe_find(const LAS int* ts, int T) {
    int lo = 0, hi = 64;
    while (hi - lo > 1) { const int mid = (lo + hi) >> 1; if (ts[mid] <= T) lo = mid; else hi = mid; }
    return lo;
}
struct MoeOrder1 {
    const Frame* F; const LAS int* ts; const LAS int* tokl;
    __device__ __forceinline__ bool next(int i, pg8::Unit& u) const {
        const int uu = i * F->G + F->vcu, T = uu >> 2; if (T >= ts[64]) return false;
        const int e = moe_find(ts, T);
        u.pm = T; u.pn = uu & 3; u.A = (const char*)F->H8; u.B = (const char*)(F->W13T8 + (size_t)e * 1024 * DM + (size_t)u.pn * 256 * DM); u.x0 = T * 256; u.x1 = i; return true;
    }
    __device__ __forceinline__ int arow(const pg8::Unit& u, int r) const { return tokl[u.x1 * 256 + r]; }
};
struct MoeOrder2 {
    const Frame* F; const LAS int* ts;
    __device__ __forceinline__ bool next(int i, pg8::Unit& u) const {
        const int uu = i * F->G + F->vcu, T = uu >> 3; if (T >= ts[64]) return false;
        const int e = moe_find(ts, T);
        u.pm = T; u.pn = uu & 7; u.A = (const char*)F->MRG + (size_t)T * 256 * DFF; u.B = (const char*)(F->W2T8 + (size_t)e * DM * DFF + (size_t)u.pn * 256 * DFF); u.x0 = T * 256;
        { const LAS int* cn = (const LAS int*)(F->lds + MOE_CNT); const int left = cn[e] - (T - ts[e]) * 256; u.x1 = left < 256 ? left : 256; }
        return true;
    }
    __device__ __forceinline__ int arow(const pg8::Unit&, int r) const { return r; }
};
__device__ __forceinline__ void moe1_fill_lists(const Frame& F) {
    const LAS int* ts = (const LAS int*)(F.lds + MOE_TS); const LAS int* cn = (const LAS int*)(F.lds + MOE_CNT); LAS int* tokl = (LAS int*)(F.lds + MOE_TOK);
    for (int i = 0; i < 8; ++i) {
        const int uu = i * F.G + F.vcu, T = uu >> 2; if (T >= ts[64]) break;
        const int e = moe_find(ts, T), mt = T - ts[e];
        if (F.tid < 256) { const int pos = mt * 256 + F.tid; tokl[i * 256 + F.tid] = pos < cn[e] ? F.LIST[(size_t)e * LIST_CAP + pos] : 0; }
    }
    __syncthreads();
}

__device__ __forceinline__ void p11_final(const Frame& F, float tsc) {
    const LAS int* ts = (const LAS int*)(F.lds + MOE_TS);
    const float* g2 = F.mod + 5 * DM; const bf16_t* Y = F.PROJ;
    f32x4 gg[8], nf[8];
#pragma unroll
    for (int j = 0; j < 8; ++j) { const int c = 4 * F.lane + 256 * j; gg[j] = *(const f32x4*)(g2 + c); nf[j] = *(const f32x4*)(F.norm_final + c); }
    const int rstep = F.G * 8; int row = F.bid * 8 + F.wave;
    u32x2 xw[8], ya[8], yb[8], xwn[8], yan[8], ybn[8]; float w0 = 0.f, w1 = 0.f, w0n = 0.f, w1n = 0.f;
#define P11_LOAD(R, XW, YA, YB, W0, W1) do { const int s0_ = F.TSLOT[2 * (R)], s1_ = F.TSLOT[2 * (R) + 1]; W0 = F.TW[2 * (R)]; W1 = F.TW[2 * (R) + 1]; \
        const size_t r0_ = (size_t)ts[s0_ >> 16] * 256 + (s0_ & 0xffff), r1_ = (size_t)ts[s1_ >> 16] * 256 + (s1_ & 0xffff); \
        const bf16_t* x1p_ = F.H + (size_t)(R) * DM + 4 * F.lane; const bf16_t* y0_ = Y + r0_ * DM + 4 * F.lane; const bf16_t* y1_ = Y + r1_ * DM + 4 * F.lane; \
        _Pragma("unroll") for (int j = 0; j < 8; ++j) { XW[j] = *(const u32x2*)(x1p_ + 256 * j); YA[j] = *(const u32x2*)(y0_ + 256 * j); YB[j] = *(const u32x2*)(y1_ + 256 * j); } } while (0)
    if (row < SEQ) P11_LOAD(row, xw, ya, yb, w0, w1);
    for (; row < SEQ; row += rstep) {
        const int nrow = row + rstep;
        if (nrow < SEQ) P11_LOAD(nrow, xwn, yan, ybn, w0n, w1n);
        float* xp = F.out + (size_t)row * DM + 4 * F.lane;
        f32x4 v[8]; float ss = 0.f;
#pragma unroll
        for (int j = 0; j < 8; ++j) { const f32x4 xv = {bf_lo(xw[j].x), bf_hi(xw[j].x), bf_lo(xw[j].y), bf_hi(xw[j].y)}; const u32x2 a = ya[j], b = yb[j];
            f32x4 m; m[0] = w0 * bf_lo(a.x) + w1 * bf_lo(b.x); m[1] = w0 * bf_hi(a.x) + w1 * bf_hi(b.x); m[2] = w0 * bf_lo(a.y) + w1 * bf_lo(b.y); m[3] = w0 * bf_hi(a.y) + w1 * bf_hi(b.y);
#if defined(DBG_NOMOE)
            m = (f32x4){0.f, 0.f, 0.f, 0.f};
#endif
            v[j] = xv + gg[j] * m; }
#pragma unroll
        for (int j = 0; j < 8; ++j) ss += v[j][0] * v[j][0] + v[j][1] * v[j][1] + v[j][2] * v[j][2] + v[j][3] * v[j][3];
        ss = wave_sum(ss);
        const float rstd = __builtin_amdgcn_rsqf(ss * (1.0f / DM) + EPS) * tsc;
#pragma unroll
        for (int j = 0; j < 8; ++j) *(f32x4*)(xp + 256 * j) = v[j] * rstd * nf[j];
#pragma unroll
        for (int j = 0; j < 8; ++j) { xw[j] = xwn[j]; ya[j] = yan[j]; yb[j] = ybn[j]; }
        w0 = w0n; w1 = w1n;
    }
#undef P11_LOAD
}
namespace att {
constexpr int D = 128, NW = 8, QBLK = 32, KVBLK = 64;
constexpr float SCALE = 0.088388347648318440f;
constexpr float THR = 8.f;
constexpr int LDP = NPROJ;
constexpr int LDO = 2048;
constexpr int SHM_V = KVBLK * D * 2, SHM_K = KVBLK * D * 2;
constexpr int OFF_WS = 2 * SHM_V + 2 * SHM_K, OFF_TAB = OFF_WS + NW * 64 * 4;
constexpr int DLO = -63;
#define KSWZ(row, colB) ((row) * 256 + ((colB) ^ (((row) & 7) << 4)))
#define SBAR() __builtin_amdgcn_sched_barrier(0)
__device__ __forceinline__ int crow(int r, int hi) { return (r & 3) + 8 * (r >> 2) + 4 * hi; }

__device__ __forceinline__ void partialSM(f32x16& p0, f32x16& p1, float& m_reg, float& mn, float& alpha) {
  constexpr float C = SCALE * 1.4426950408889634f;
  float pmax = p0[0];
#pragma unroll
  for (int r = 1; r < 16; ++r) pmax = fmaxf(pmax, p0[r]);
#pragma unroll
  for (int r = 0; r < 16; ++r) pmax = fmaxf(pmax, p1[r]);
  { auto rr = __builtin_amdgcn_permlane32_swap(__float_as_uint(pmax), __float_as_uint(pmax), false, false);
    pmax = fmaxf(__uint_as_float(rr[0]), __uint_as_float(rr[1])); }
  if (__builtin_expect(__all(pmax - m_reg <= THR / SCALE), 1)) { mn = m_reg; alpha = 1.f; }
  else { mn = fmaxf(m_reg, pmax); alpha = __builtin_amdgcn_exp2f((m_reg - mn) * C); m_reg = mn; }
  float mnC = -mn * C;
#pragma unroll
  for (int r = 0; r < 16; ++r) p0[r] = fmaf(p0[r], C, mnC);
#pragma unroll
  for (int r = 0; r < 16; ++r) p1[r] = fmaf(p1[r], C, mnC);
#pragma unroll
  for (int r = 0; r < 16; ++r) p0[r] = __builtin_amdgcn_exp2f(p0[r]);
}
template <int MODE>
__device__ __forceinline__ void finishSM(f32x16& p0, f32x16& p1, float alpha, float& l_reg, bf16x8& pa0, bf16x8& pa1, bf16x8& pa2, bf16x8& pa3) {
#pragma unroll
  for (int r = 0; r < 16; ++r) p1[r] = __builtin_amdgcn_exp2f(p1[r]);
  float ps = 0;
#pragma unroll
  for (int r = 0; r < 16; ++r) ps += p0[r];
#pragma unroll
  for (int r = 0; r < 16; ++r) ps += p1[r];
  { auto rr = __builtin_amdgcn_permlane32_swap(__float_as_uint(ps), __float_as_uint(ps), false, false);
    ps = __uint_as_float(rr[0]) + __uint_as_float(rr[1]); }
  l_reg = l_reg * alpha + ps;
#define PK4(P, BASE, OUT) do { unsigned a0 = cvt_pk_bf16(P[BASE + 0], P[BASE + 1]), a1 = cvt_pk_bf16(P[BASE + 2], P[BASE + 3]);   \
    unsigned b0 = cvt_pk_bf16(P[BASE + 4], P[BASE + 5]), b1 = cvt_pk_bf16(P[BASE + 6], P[BASE + 7]);                              \
    auto r0 = __builtin_amdgcn_permlane32_swap(a0, b0, false, false); auto r1 = __builtin_amdgcn_permlane32_swap(a1, b1, false, false); \
    u32x4 w = {r0[0], r1[0], r0[1], r1[1]}; OUT = *reinterpret_cast<bf16x8*>(&w); } while (0)
  PK4(p0, 0, pa0); PK4(p0, 8, pa1); PK4(p1, 0, pa2); PK4(p1, 8, pa3);
#undef PK4
}
__device__ __forceinline__ void qkt(f32x16& p0, f32x16& p1, const LAS char* Ks, const bf16x8* qr, int r32, int hi) {
#pragma unroll
  for (int i = 0; i < 16; ++i) { p0[i] = 0.f; p1[i] = 0.f; }
#pragma unroll
  for (int d0 = 0; d0 < 8; ++d0) { int cb = (d0 * 16 + hi * 8) * 2;
    bf16x8 b0 = *reinterpret_cast<const LAS bf16x8*>(Ks + KSWZ(r32, cb));
    bf16x8 b1 = *reinterpret_cast<const LAS bf16x8*>(Ks + KSWZ(32 + r32, cb));
    p0 = __builtin_amdgcn_mfma_f32_32x32x16_bf16(b0, qr[d0], p0, 0, 0, 0);
    p1 = __builtin_amdgcn_mfma_f32_32x32x16_bf16(b1, qr[d0], p1, 0, 0, 0); }
}
__device__ __forceinline__ int v_st(int k, int c) { const int kk = (k & ~0xC) | ((k & 4) << 1) | ((k & 8) >> 1); return ((kk >> 3) * 4 + (c >> 5)) * 512 + ((kk & 7) * 32 + (c & 31)) * 2; }
__device__ __forceinline__ int v_rd_base(int lane) { return ((lane & 3) << 3) | (((lane >> 2) & 3) << 6) | (((lane >> 4) & 1) << 5) | (((lane >> 5) & 1) << 8); }
constexpr int v_rd_off(int d0, int ks, int half) { return d0 * 512 + ks * 4096 + half * 2048; }
template <int OFF> __device__ __forceinline__ s16x4 tr_read(int vb) {
  s16x4 r; asm volatile("ds_read_b64_tr_b16 %0, %1 offset:%2" : "=&v"(r) : "v"(vb), "i"(OFF) : "memory"); return r;
}
template <int D0> __device__ __forceinline__ void pv_one(f32x16& od, int vb, bf16x8 pa0, bf16x8 pa1, bf16x8 pa2, bf16x8 pa3) {
  const s16x4 l0 = tr_read<v_rd_off(D0, 0, 0)>(vb), h0 = tr_read<v_rd_off(D0, 0, 1)>(vb), l1 = tr_read<v_rd_off(D0, 1, 0)>(vb), h1 = tr_read<v_rd_off(D0, 1, 1)>(vb);
  const s16x4 l2 = tr_read<v_rd_off(D0, 2, 0)>(vb), h2 = tr_read<v_rd_off(D0, 2, 1)>(vb), l3 = tr_read<v_rd_off(D0, 3, 0)>(vb), h3 = tr_read<v_rd_off(D0, 3, 1)>(vb);
  asm volatile("s_waitcnt lgkmcnt(0)" ::: "memory"); SBAR();
#define PK(L, H) (bf16x8){L[0], L[1], L[2], L[3], H[0], H[1], H[2], H[3]}
  od = __builtin_amdgcn_mfma_f32_32x32x16_bf16(pa0, PK(l0, h0), od, 0, 0, 0);
  od = __builtin_amdgcn_mfma_f32_32x32x16_bf16(pa1, PK(l1, h1), od, 0, 0, 0);
  od = __builtin_amdgcn_mfma_f32_32x32x16_bf16(pa2, PK(l2, h2), od, 0, 0, 0);
  od = __builtin_amdgcn_mfma_f32_32x32x16_bf16(pa3, PK(l3, h3), od, 0, 0, 0);
#undef PK
}
__device__ __forceinline__ void pv_d0(f32x16* o, int vb, bf16x8 pa0, bf16x8 pa1, bf16x8 pa2, bf16x8 pa3) {
  pv_one<0>(o[0], vb, pa0, pa1, pa2, pa3); pv_one<1>(o[1], vb, pa0, pa1, pa2, pa3); pv_one<2>(o[2], vb, pa0, pa1, pa2, pa3); pv_one<3>(o[3], vb, pa0, pa1, pa2, pa3);
}

template <int MODE, int DMAX>
__device__ __forceinline__ void score_hook(f32x16& p0, f32x16& p1, int kt, int tq  , int tq_wave0  , int hi, const LAS float* tab, unsigned long long msk) {
  if (MODE == 1) {
    const int cw = tq_wave0 >> 6;
    if (kt > cw || kt < cw - 8) {
#pragma unroll
      for (int r = 0; r < 16; ++r) { p0[r] = -3.0e38f; p1[r] = -3.0e38f; }
      return;
    }
  }
#ifndef ATT_NOHOOK
  if (tq_wave0 - (kt * 64 + 63) < DMAX) {
    const int base = tq - kt * 64 - 4 * hi - DLO;
#pragma unroll
    for (int r = 0; r < 16; ++r) {
      const int c = (r & 3) + 8 * (r >> 2);
      int i0 = base - c, i1 = base - c - 32;
      i0 = min(max(i0, 0), DMAX - DLO); i1 = min(max(i1, 0), DMAX - DLO);
      p0[r] += tab[i0]; p1[r] += tab[i1];
      SBAR();
    }
  }
#endif
  if (MODE == 0) {
    const unsigned mk0 = (unsigned)msk >> (16 * hi), mk1 = (unsigned)(msk >> 32) >> (16 * hi);
#pragma unroll
    for (int r = 0; r < 16; ++r) {
      { const unsigned m_ = (unsigned)__builtin_amdgcn_sbfe(mk0, r, 1); p0[r] = __uint_as_float((m_ & __float_as_uint(p0[r])) | (~m_ & 0xFF61B1E6u)); }
      { const unsigned m_ = (unsigned)__builtin_amdgcn_sbfe(mk1, r, 1); p1[r] = __uint_as_float((m_ & __float_as_uint(p1[r])) | (~m_ & 0xFF61B1E6u)); }
    }
  }
}

__device__ __forceinline__ unsigned long long mload_(const char* base, unsigned off) { asm volatile("" : "+v"(off)); return *(const unsigned long long*)(base + off); }
template <int MODE, int DMAX>
__device__ __forceinline__ void attn_unit(const bf16_t* __restrict__ Qb  , const bf16_t* __restrict__ Kh  , const bf16_t* __restrict__ Vh,
                                          unsigned char* __restrict__ Ob  , const unsigned long long* __restrict__ maskq  , int q0, int kt0, int kt1, LAS char* lds) {
  const int tid = threadIdx.x, wid = tid >> 6, lane = tid & 63, r32 = lane & 31, hi = lane >> 5;
  LAS char* V_lds = lds; LAS char* K_lds = lds + 2 * SHM_V;
  LAS float* ws = (LAS float*)(lds + OFF_WS) + wid * 64; LAS float* li_l = ws; LAS float* al_l = ws + 32;
  const LAS float* tab = (const LAS float*)(lds + OFF_TAB);
  float m_reg = -1e30f, l_reg = 0; f32x16 o[4]; bf16x8 qr[8];
#pragma unroll
  for (int d = 0; d < 4; ++d)
#pragma unroll
    for (int r = 0; r < 16; ++r) o[d][r] = 0.f;
  const bf16_t* Qw = Qb + (long)(wid * QBLK + r32) * LDP + hi * 8;
#pragma unroll
  for (int d0 = 0; d0 < 8; ++d0) qr[d0] = *reinterpret_cast<const bf16x8*>(Qw + d0 * 16);
  const int tq0w = q0 + wid * QBLK, tq = tq0w + r32;
  const int sr = tid >> 4, sc = (tid & 15) * 8, vst0 = v_st(sr, sc), vst1 = v_st(32 + sr, sc);
  const int vb0 = (int)(uintptr_t)V_lds + v_rd_base(lane);
  const char* Kc = (const char*)Kh; const char* Vc = (const char*)Vh; const unsigned soff = (unsigned)(sr * LDP + sc) * 2u;
  const unsigned moff = (unsigned)(__builtin_amdgcn_readfirstlane(wid) * QBLK + r32) * 8u;
  struct { bf16x8 vs0, vs1, ks0, ks1; } sr_[1];
#define SLOAD(i, k0) do { unsigned _so = soff; asm volatile("" : "+v"(_so)); unsigned _so2 = soff; asm volatile("" : "+v"(_so2)); \
    const char* _kp = Kc + (size_t)(unsigned)(k0) * (size_t)(LDP * 2); const char* _vp = Vc + (size_t)(unsigned)(k0) * (size_t)(LDP * 2); \
    const char* _kp2 = _kp + (32 * LDP * 2); const char* _vp2 = _vp + (32 * LDP * 2); \
    sr_[i].vs0 = *reinterpret_cast<const bf16x8*>(_vp + _so); sr_[i].vs1 = *reinterpret_cast<const bf16x8*>(_vp2 + _so2); \
    sr_[i].ks0 = *reinterpret_cast<const bf16x8*>(_kp + _so); sr_[i].ks1 = *reinterpret_cast<const bf16x8*>(_kp2 + _so2); } while (0)
#define SWRITE(b, i) do { *(LAS bf16x8*)(V_lds + (b) * SHM_V + vst0) = sr_[i].vs0;          \
    *(LAS bf16x8*)(V_lds + (b) * SHM_V + vst1) = sr_[i].vs1; int kc = sc * 2;               \
    *(LAS bf16x8*)(K_lds + (b) * SHM_K + KSWZ(sr, kc)) = sr_[i].ks0;                       \
    *(LAS bf16x8*)(K_lds + (b) * SHM_K + KSWZ(32 + sr, kc)) = sr_[i].ks1; } while (0)
#define SWAIT() asm volatile("s_waitcnt vmcnt(0)" ::: "memory")
#define RESC(a) do { if (__any((a) < 1.f)) { if (hi == 0) al_l[r32] = (a); asm volatile("s_waitcnt lgkmcnt(0)" ::: "memory"); \
    _Pragma("unroll") for (int d = 0; d < 4; ++d) _Pragma("unroll") for (int r = 0; r < 16; ++r) o[d][r] *= al_l[crow(r, hi)]; } } while (0)
#define MLOAD(kt) (MODE == 0 ? mload_((const char*)maskq + (size_t)(unsigned)(kt) * (size_t)(SEQ * 8), moff) : 0ull)
  f32x16 pA0, pA1, pB0, pB1; float mnA, mnB, alA, alB; bf16x8 pa0, pa1, pa2, pa3; const int NT = kt1 - kt0;
  unsigned long long mA = 0, mB = 0;
  constexpr int SE = 0, SO = 0;
  SLOAD(SE, kt0 * KVBLK); mA = MLOAD(kt0); asm volatile("s_waitcnt vmcnt(0)" ::: "memory"); SWRITE(0, SE); __syncthreads();
  qkt(pA0, pA1, K_lds, qr, r32, hi); score_hook<MODE, DMAX>(pA0, pA1, kt0, tq, tq0w, hi, tab, mA); partialSM(pA0, pA1, m_reg, mnA, alA);
  SLOAD(SO, (kt0 + 1) * KVBLK);
  SWAIT(); SWRITE(1, SO); __syncthreads();
  for (int j = 1; j + 1 < NT; j += 2) {
    SBAR(); mB = MLOAD(kt0 + j); qkt(pB0, pB1, K_lds + SHM_K, qr, r32, hi); score_hook<MODE, DMAX>(pB0, pB1, kt0 + j, tq, tq0w, hi, tab, mB);
    finishSM<MODE>(pA0, pA1, alA, l_reg, pa0, pa1, pa2, pa3); SBAR();
    SLOAD(SO, (kt0 + j + 1) * KVBLK); SBAR();
    pv_d0(o, vb0, pa0, pa1, pa2, pa3); partialSM(pB0, pB1, m_reg, mnB, alB);
    __syncthreads(); SWAIT(); SWRITE(0, SE);
    RESC(alB); __syncthreads();
    SBAR(); mA = MLOAD(kt0 + j + 1); qkt(pA0, pA1, K_lds, qr, r32, hi); score_hook<MODE, DMAX>(pA0, pA1, kt0 + j + 1, tq, tq0w, hi, tab, mA);
    finishSM<MODE>(pB0, pB1, alB, l_reg, pa0, pa1, pa2, pa3); SBAR();
    SLOAD(SE, (kt0 + j + 2) * KVBLK); SBAR();
    pv_d0(o, vb0 + SHM_V, pa0, pa1, pa2, pa3); partialSM(pA0, pA1, m_reg, mnA, alA);
    __syncthreads(); SWAIT(); SWRITE(1, SO);
    RESC(alA); __syncthreads();
  }
  SBAR(); mB = MLOAD(kt1 - 1); qkt(pB0, pB1, K_lds + SHM_K, qr, r32, hi); score_hook<MODE, DMAX>(pB0, pB1, kt1 - 1, tq, tq0w, hi, tab, mB);
  finishSM<MODE>(pA0, pA1, alA, l_reg, pa0, pa1, pa2, pa3); SBAR();
  pv_d0(o, vb0, pa0, pa1, pa2, pa3); partialSM(pB0, pB1, m_reg, mnB, alB);
  __syncthreads(); RESC(alB);
  finishSM<MODE>(pB0, pB1, alB, l_reg, pa0, pa1, pa2, pa3); SBAR();
  pv_d0(o, vb0 + SHM_V, pa0, pa1, pa2, pa3);
  if (hi == 0) li_l[r32] = l_reg; asm volatile("s_waitcnt lgkmcnt(0)" ::: "memory");
  float rli[16];
#pragma unroll
  for (int r = 0; r < 16; ++r) rli[r] = __builtin_amdgcn_rcpf(li_l[crow(r, hi)]);
  unsigned char* Ow = Ob + (long)(wid * QBLK) * LDO; const float s8 = (float)(1 << Y8_SCALE_LOG2);
#pragma unroll
  for (int r = 0; r < 16; ++r) { int orow = crow(r, hi);
#pragma unroll
    for (int d0 = 0; d0 < 4; ++d0) { const float v = fminf(fmaxf(o[d0][r] * rli[r] * s8, -440.f), 440.f); const int w = __builtin_amdgcn_cvt_pk_fp8_f32(v, 0.f, 0, false); Ow[(long)orow * LDO + d0 * 32 + r32] = (unsigned char)(w & 0xff); } }
  __syncthreads();
#undef SLOAD
#undef SWRITE
#undef SWAIT
#undef RESC
#undef MLOAD
}
#undef KSWZ
}

__device__ __forceinline__ int t5_bucket_dev(int rel) {
    const int n = rel < 0 ? -rel : rel; int b;
    if (n < 8) b = n; else b = 8 + (n >= 15) + (n >= 27) + (n >= 50) + (n >= 91) + (n >= 166) + (n >= 305) + (n >= 559);
    return b + (rel > 0 ? 16 : 0);
}
constexpr int DMAX_A = 559, DMAX_B = 128;
__device__ __forceinline__ void fill_tab_A(const Frame& F, int h, LAS char* lds) {
    LAS float* tab = (LAS float*)(lds + att::OFF_TAB);
    const float far = F.t5[15 * 8 + h];
    for (int i = F.tid; i <= DMAX_A - att::DLO; i += 512) { const int d = i + att::DLO; tab[i] = (F.t5[t5_bucket_dev(-d) * 8 + h] - far) * (1.0f / att::SCALE); }
    __syncthreads();
}
__device__ __forceinline__ void fill_tab_B(const Frame& F, int h, LAS char* lds) {
    LAS float* tab = (LAS float*)(lds + att::OFF_TAB);
    const float far = F.rel[h * 257 + 256];
    for (int i = F.tid; i <= DMAX_B - att::DLO; i += 512) { const int d = i + att::DLO; tab[i] = (F.rel[h * 257 + min(max(d, -128), 128) + 128] - far) * (1.0f / att::SCALE); }
    __syncthreads();
}
namespace idx {
constexpr int KT_OFF = 0, KT_BYTES = 8192, CAND_OFF = CONV_LDS_OFF + 3 * CONV_LDS_BYTES + 256, CAND_STRIDE = 2440, CAP = 608, EMERG = CAP - 64, NREG = (CAP + 63) / 64;
static_assert(CAND_OFF % 8 == 0 && CAND_OFF + 32 * CAND_STRIDE <= LDS_BYTES - 16, "indexer LDS map");
constexpr float W_SCALE = 0.03125f;

__device__ __forceinline__ unsigned ordered_u32(float f) { const unsigned u = __float_as_uint(f); return u ^ ((unsigned)((int)u >> 31) | 0x80000000u); }
__device__ __forceinline__ float unordered_f32(unsigned o) { const unsigned u = (o & 0x80000000u) ? (o ^ 0x80000000u) : ~o; return __uint_as_float(u); }

__device__ __forceinline__ unsigned select_thr(const unsigned (&P)[NREG], unsigned maxP, unsigned lob, int lowbit, unsigned vin, int bin, int& bout) {
    int b; unsigned v;
    if (bin < 0) { const unsigned X = maxP ^ lob; if (X == 0u) { bout = -1; return maxP; } b = 31 - __builtin_clz(X); v = maxP & ~((2u << b) - 1u); }
    else { b = bin; v = vin; }
    if (lowbit > b) { bout = b; return v; }
    for (int bit = b; bit >= lowbit; --bit) {
        const unsigned tr = v | (1u << bit);
        int c = 0;
#pragma unroll
        for (int j = 0; j < NREG; ++j) c += __builtin_popcountll(__ballot(P[j] >= tr));
        if (c >= 256) v = tr;
    }
    bout = lowbit - 1;
    return v;
}

template <int VAR> __device__ __forceinline__ void indexer_unit(const Frame& F, int u, ConvSt& cv) {
    LAS unsigned char* lds = F.lds;
    const int tid = F.tid, wid = F.wave, lane = F.lane, r32 = lane & 31, hi = lane >> 5;
    const int t0 = u * 32, chunk = t0 >> 6, ntile = chunk + 1, ntile_q = 4 * ((chunk >> 2) + 1);
    const bf16_t* proj = F.PROJ;
    bf16x8 Af[2][4]; float wv[2][16];
    {
        const int head = (r32 & 3) | ((r32 >> 3) << 2), qsel = (r32 >> 2) & 1;
#pragma unroll
        for (int mt = 0; mt < 2; ++mt) {
            const int q = t0 + 4 * wid + 2 * mt + qsel;
            const bf16_t* qp = proj + (size_t)q * NPROJ + COL_QI + head * 64 + 8 * hi;
#pragma unroll
            for (int s = 0; s < 4; ++s) Af[mt][s] = *(const bf16x8*)(qp + 16 * s);
            const int qh = t0 + 4 * wid + 2 * mt + hi;
            const u32x4 w0 = *(const u32x4*)(proj + (size_t)qh * NPROJ + COL_WI), w1 = *(const u32x4*)(proj + (size_t)qh * NPROJ + COL_WI + 8);
            wv[mt][0] = bf_lo(w0.x) * W_SCALE; wv[mt][1] = bf_hi(w0.x) * W_SCALE; wv[mt][2] = bf_lo(w0.y) * W_SCALE; wv[mt][3] = bf_hi(w0.y) * W_SCALE;
            wv[mt][4] = bf_lo(w0.z) * W_SCALE; wv[mt][5] = bf_hi(w0.z) * W_SCALE; wv[mt][6] = bf_lo(w0.w) * W_SCALE; wv[mt][7] = bf_hi(w0.w) * W_SCALE;
            wv[mt][8] = bf_lo(w1.x) * W_SCALE; wv[mt][9] = bf_hi(w1.x) * W_SCALE; wv[mt][10] = bf_lo(w1.y) * W_SCALE; wv[mt][11] = bf_hi(w1.y) * W_SCALE;
            wv[mt][12] = bf_lo(w1.z) * W_SCALE; wv[mt][13] = bf_hi(w1.z) * W_SCALE; wv[mt][14] = bf_lo(w1.w) * W_SCALE; wv[mt][15] = bf_hi(w1.w) * W_SCALE;
        }
    }
    int cnt[2][2] = {{0, 0}, {0, 0}};
    float tau[2] = {-3.4e38f, -3.4e38f};
    unsigned lob[2][2] = {{0u, 0u}, {0u, 0u}};
    const int cbase[2] = {CAND_OFF + (4 * wid + 0 + hi) * CAND_STRIDE, CAND_OFF + (4 * wid + 2 + hi) * CAND_STRIDE};
    const int skey = tid >> 3, sslot = tid & 7;
    const int sdst = skey * 128 + ((sslot ^ ((skey >> 1) & 7)) * 16);
    const bf16_t* ksrc = proj + (size_t)skey * NPROJ + COL_KI + sslot * 8;
    u32x4 stg = *(const u32x4*)ksrc;
    *(LAS u32x4*)(lds + KT_OFF + sdst) = stg;
    __syncthreads();
#define IDX_MFMA(ACC, MT, BF) do { _Pragma("unroll") for (int i_ = 0; i_ < 16; ++i_) ACC[i_] = 0.f; \
        _Pragma("unroll") for (int s_ = 0; s_ < 4; ++s_) ACC = __builtin_amdgcn_mfma_f32_32x32x16_bf16(Af[MT][s_], BF[s_], ACC, 0, 0, 0); } while (0)
#define IDX_SCORE(SC, ACC, MT) do { \
        float sa_ = 0.f; \
        _Pragma("unroll") for (int r_ = 0; r_ < 16; ++r_) { const float ta_ = __int_as_float(max(__float_as_int(ACC[r_]), 0)); sa_ = fmaf(wv[MT][r_], ta_, sa_); } \
        SC = sa_; } while (0)
#define IDX_PIPE() do { _Pragma("unroll") for (int g_ = 0; g_ < 4; ++g_) { __builtin_amdgcn_sched_group_barrier(0x008, 1, 0); __builtin_amdgcn_sched_group_barrier(0x002, 9, 0); } } while (0)
#define IDX_APPEND(SC, MT, HF) do { \
        const bool pass = (VAR == 1) ? false : (SC >= tau[MT]); if (VAR == 1) { asm volatile("" :: "v"(SC)); } \
        const unsigned long long bm = __ballot(pass); \
        if (bm != 0ull) { \
            const unsigned blo = (unsigned)bm, bhi = (unsigned)(bm >> 32); \
            const int nlo = __builtin_popcount(blo), nhi = __builtin_popcount(bhi); \
            const int pre = __builtin_amdgcn_mbcnt_hi(bhi, __builtin_amdgcn_mbcnt_lo(blo, 0)); \
            const int pos = hi ? (cnt[MT][1] + pre - nlo) : (cnt[MT][0] + pre); \
            if (pass) { \
                const unsigned gk = (unsigned)(jt * 64 + 32 * (HF) + r32); \
                const unsigned P = (ordered_u32(SC) & 0xFFFFC000u) | (16383u - gk); \
                *(LAS unsigned*)(lds + cbase[MT] + pos * 4) = P; \
            } \
            cnt[MT][0] += nlo; cnt[MT][1] += nhi; \
        } } while (0)
    for (int jt = 0; jt < ntile; ++jt) {
        {
            bool cnext = false;
            if (VAR == 0) conv_drain(F, cv.cs >= 1 ? cv.base + (cv.cs - 1) * F.G : -1, cv.cs - 1);
            if (VAR != 5 && jt + 1 < ntile) {
                const bf16_t* g = proj + (size_t)((jt + 1) * 64 + skey) * NPROJ + COL_KI + ((sslot ^ ((skey >> 1) & 7)) * 8);
                __builtin_amdgcn_global_load_lds((const unsigned*)g, (LAS unsigned*)(lds + KT_OFF + ((jt + 1) & 1) * KT_BYTES + wid * 1024), 16, 0, 0);
            }
            if (VAR == 0) cnext = conv_issue(F, cv.base + (cv.cs + 1) * F.G, cv.cs + 1);
            const LAS unsigned char* kb = lds + KT_OFF + (jt & 1) * KT_BYTES;
            bf16x8 Bf0[4], Bf1[4];
#pragma unroll
            for (int s = 0; s < 4; ++s) Bf0[s] = *(const LAS bf16x8*)(kb + r32 * 128 + (((2 * s + hi) ^ ((r32 >> 1) & 7)) * 16));
#pragma unroll
            for (int s = 0; s < 4; ++s) Bf1[s] = *(const LAS bf16x8*)(kb + (32 + r32) * 128 + (((2 * s + hi) ^ ((r32 >> 1) & 7)) * 16));
            f32x16 accA, accB; float scA, scB;
            IDX_MFMA(accA, 0, Bf0);
            __builtin_amdgcn_sched_barrier(0);
            IDX_MFMA(accB, 1, Bf0); IDX_SCORE(scA, accA, 0); IDX_PIPE();
            IDX_APPEND(scA, 0, 0);
            IDX_MFMA(accA, 0, Bf1); IDX_SCORE(scB, accB, 1); IDX_PIPE();
            IDX_APPEND(scB, 1, 0);
            IDX_MFMA(accB, 1, Bf1); IDX_SCORE(scA, accA, 0); IDX_PIPE();
            IDX_APPEND(scA, 0, 1);
            IDX_SCORE(scB, accB, 1);
            IDX_APPEND(scB, 1, 1);
            const int seen = 64 * (jt + 1);
            const int mx = max(max(cnt[0][0], cnt[0][1]), max(cnt[1][0], cnt[1][1]));
            const int q448 = seen / 448;
            const bool sched = (q448 * 448 == seen) && ((q448 & (q448 - 1)) == 0) && (jt + 1 < ntile);
            if (sched || mx >= EMERG) {
#pragma unroll
                for (int mt = 0; mt < 2; ++mt)
#pragma unroll
                    for (int hh = 0; hh < 2; ++hh) {
                        const int n = cnt[mt][hh];
                        if (n > 256) {
                            const int base = CAND_OFF + (4 * wid + 2 * mt + hh) * CAND_STRIDE;
                            unsigned P[NREG]; unsigned mxp = 0;
#pragma unroll
                            for (int j = 0; j < NREG; ++j) { const int i = j * 64 + lane; P[j] = i < n ? *(const LAS unsigned*)(lds + base + i * 4) : 0u; mxp = max(mxp, P[j]); }
#pragma unroll
                            for (int o = 32; o >= 1; o >>= 1) mxp = max(mxp, (unsigned)__shfl_xor((int)mxp, o));
                            mxp = __builtin_amdgcn_readfirstlane(mxp);
                            int bo; unsigned v = select_thr(P, mxp, lob[mt][hh], 14, 0u, -1, bo);
                            int kept = 0;
#pragma unroll
                            for (int j = 0; j < NREG; ++j) kept += __builtin_popcountll(__ballot(P[j] >= v));
                            if (kept > 400) { v = select_thr(P, mxp, lob[mt][hh], 0, v, bo, bo); }
                            int np = 0;
#pragma unroll
                            for (int j = 0; j < NREG; ++j) {
                                const bool k = P[j] >= v; const unsigned long long bm = __ballot(k);
                                const int pre = __builtin_amdgcn_mbcnt_hi((unsigned)(bm >> 32), __builtin_amdgcn_mbcnt_lo((unsigned)bm, 0));
                                if (k) *(LAS unsigned*)(lds + base + (np + pre) * 4) = P[j];
                                np += __builtin_popcountll(bm);
                            }
                            cnt[mt][hh] = np; lob[mt][hh] = v & 0xFFFFC000u;
                            const float tf = unordered_f32(v & 0xFFFFC000u);
                            if (hi == hh) tau[mt] = tf;
                        }
                    }
            }
            if (cnext) asm volatile("s_waitcnt vmcnt(2)" ::: "memory"); else asm volatile("s_waitcnt vmcnt(0)" ::: "memory");
            if (VAR == 0) cv.cs += 1;
        }
        if (VAR != 5) { asm volatile("s_waitcnt lgkmcnt(0)" ::: "memory"); __builtin_amdgcn_s_barrier(); asm volatile("" ::: "memory"); }
    }
#undef IDX_MFMA
#undef IDX_SCORE
#undef IDX_PIPE
#undef IDX_APPEND
#pragma unroll
    for (int mt = 0; mt < 2; ++mt)
#pragma unroll
        for (int hh = 0; hh < 2; ++hh) {
            const int n = cnt[mt][hh];
            const int base = CAND_OFF + (4 * wid + 2 * mt + hh) * CAND_STRIDE;
            unsigned P[NREG]; unsigned mxp = 0;
#pragma unroll
            for (int j = 0; j < NREG; ++j) { const int i = j * 64 + lane; P[j] = i < n ? *(const LAS unsigned*)(lds + base + i * 4) : 0u; mxp = max(mxp, P[j]); }
            unsigned v = 1u;
            if (n > 256) {
#pragma unroll
                for (int o = 32; o >= 1; o >>= 1) mxp = max(mxp, (unsigned)__shfl_xor((int)mxp, o));
                mxp = __builtin_amdgcn_readfirstlane(mxp);
                int bo_; v = select_thr(P, mxp, lob[mt][hh], 0, 0u, -1, bo_);
            }
            asm volatile("s_waitcnt lgkmcnt(0)" ::: "memory");
            for (int i = lane; i < 2 * ntile_q; i += 64) *(LAS unsigned*)(lds + base + i * 4) = 0u;
            asm volatile("s_waitcnt lgkmcnt(0)" ::: "memory");
#pragma unroll
            for (int j = 0; j < NREG; ++j) {
                if (P[j] >= v && P[j] != 0u) {
                    const unsigned gk = 16383u - (P[j] & 0x3FFFu);
                    const unsigned kt = gk >> 6, kk = gk & 63u, t = kk >> 5, jj = kk & 31u, hb = (jj >> 2) & 1u, r = (jj & 3u) + 4u * (jj >> 3);
                    __hip_atomic_fetch_or((LAS unsigned*)(lds + base + (kt * 2 + t) * 4), 1u << (16u * hb + r), __ATOMIC_RELAXED, __HIP_MEMORY_SCOPE_WORKGROUP);
                }
            }
        }
    __syncthreads();
    for (int k2 = wid; 2 * k2 < ntile_q; k2 += 8) {
        const int kt = 2 * k2 + hi;
        if (kt < ntile_q) {
            const u32x2 m = *(const LAS u32x2*)(lds + CAND_OFF + r32 * CAND_STRIDE + kt * 8);
            *(u32x2*)((VAR ? (unsigned long long*)(F.ws + WS_END) : F.MASK) + (size_t)kt * SEQ + t0 + r32) = m;
        }
    }
    __syncthreads();
}
}
#ifndef MK_N_LAUNCHES
#define MK_N_LAUNCHES 1
#endif
constexpr int N_PHASES = 12;
constexpr int BAR_LDS_OFF = LDS_BYTES - 16;

__global__ __launch_bounds__(512, 2) void fwd(Args args) {
    extern __shared__ __attribute__((aligned(16))) unsigned char shm[];
    Frame F;
    F.lds = (LAS unsigned char*)shm;
    F.tid = threadIdx.x; F.lane = F.tid & 63; F.wave = __builtin_amdgcn_readfirstlane(F.tid >> 6);
    F.G = gridDim.x; F.bid = blockIdx.x; F.vcu = (F.G % 8 == 0) ? (F.bid % 8) * (F.G / 8) + F.bid / 8 : F.bid;
    F.x = args.in[0]; F.c = args.in[1]; F.w_ada = args.in[2]; F.b_ada = args.in[3]; F.norm_mix = args.in[4]; F.w_in = args.in[5]; F.t5 = args.in[6]; F.rel = args.in[7];
    F.w_up_a = args.in[8]; F.w_up_b = args.in[9]; F.w_o = args.in[10]; F.norm_ffn = args.in[11]; F.w_rg = args.in[12]; F.b_rg = args.in[13]; F.w_re = args.in[14]; F.b_re = args.in[15];
    F.w1 = args.in[16]; F.w3 = args.in[17]; F.w2 = args.in[18]; F.norm_final = args.in[19];
    F.out = args.out; F.ws = args.ws;
    unsigned char* ws = args.ws;
    F.mod = (float*)(ws + CTL_MOD); F.ecnt = (unsigned*)(ws + CTL_ECNT);
    F.WinT = (bf16_t*)(ws + WS_WINT); F.WupaT = (bf16_t*)(ws + WS_WUPA); F.WupbT = (bf16_t*)(ws + WS_WUPB); F.WoT = (bf16_t*)(ws + WS_WO); F.W13T = (bf16_t*)(ws + WS_W13); F.W2T = (bf16_t*)(ws + WS_W2);
    F.H = (bf16_t*)(ws + WS_H); F.PROJ = (bf16_t*)(ws + WS_PROJ); F.YA = (bf16_t*)(ws + WS_YA); F.YB = (bf16_t*)(ws + WS_YB); F.MRG = (bf16_t*)(ws + WS_MRG);
    F.WinT8 = ws + WS_WINT + (size_t)NPB * DM * 2; F.H8 = ws + WS_H8; F.W13T8 = ws + WS_W13; F.W2T8 = ws + WS_W2; F.Wupa8 = ws + WS_WUPA; F.Wupb8 = ws + WS_WUPB; F.Wo8 = ws + WS_WO;
    F.MASK = (unsigned long long*)(ws + WS_MASK); F.LIST = (int*)(ws + WS_LIST); F.TSLOT = (int*)(ws + WS_TSLOT); F.TW = (float*)(ws + WS_TW); F.RBH = (bf16_t*)(ws + WS_RB); F.RBL = F.RBH + 96 * DM; F.RC = (float*)(ws + WS_RB + (size_t)2 * 96 * DM * 2);

    const int lo = args.ph_lo, hi = args.ph_hi;
    XcdBarrier bar; bar.bar = (unsigned*)(ws + CTL_BAR); bar.x = 0; bar.st = nullptr;
    if (hi - lo > 1) {
        if (F.tid == 0) *(LAS u32x4*)(F.lds + BAR_LDS_OFF) = (u32x4){0u, 0u, 0u, 0u};
        __syncthreads();
        bar = xcd_barrier_post((unsigned*)(ws + CTL_BAR), (volatile LAS unsigned*)(F.lds + BAR_LDS_OFF));
    }
#ifndef PHASE_MASK
#define PHASE_MASK 0xFFF
#endif
#define IN(k) (((PHASE_MASK >> (k)) & 1) && lo <= (k) && (k) < hi)
#ifndef DUP_PHASE
#define DUP_PHASE -1
#endif
#define REP(k) for (int rep_ = 0; rep_ < ((DUP_PHASE) == (k) ? 2 : 1); ++rep_)
#ifdef TIME_A
    unsigned long long* tpw_ = (unsigned long long*)(ws + CTL_ECNT + 4096);
#define TSTAMP(k) do { if (F.bid == 0 && F.tid == 0) { if ((k) == TIME_A - 1) tpw_[0] = __builtin_amdgcn_s_memrealtime(); if ((k) == TIME_B) tpw_[1] = __builtin_amdgcn_s_memrealtime(); } } while (0)
    TSTAMP(-1);
#else
#define TSTAMP(k) do { } while (0)
#endif
#ifdef DOUBLE_BARRIER
#define SEAM(k) do { if (IN(k) && IN((k) + 1)) { xcd_barrier(bar); xcd_barrier(bar); } TSTAMP(k); } while (0)
#else
#define SEAM(k) do { if (IN(k) && IN((k) + 1)) xcd_barrier(bar); TSTAMP(k); } while (0)
#endif

    if (IN(0)) { p0_mod(F); REP(0) p0_convert(F); }
    SEAM(0);
    if (IN(1)) REP(1) { p1_norm(F); }
    SEAM(1);
    if (IN(2)) {
        if (F.G == 256) { if (F.bid >= 192) p1_router_prep(F, F.bid - 192, 64); } else p1_router_prep(F, F.bid, F.G);
        { pg8::StaticOrder<2048> S; S.init(F.H, F.WinT, SEQ, NPB, F.G, F.bid);
          pg8::EpiProj E{F.PROJ};
          pg8::gemm_phase<2048, false, false>(F.lds, S, E);
#if DUP_PHASE == 20
          pg8::gemm_phase<2048, false, false>(F.lds, S, E);
#endif
        }
        { pg8::ProjOrder8 S; S.init(F.H8, F.WinT8, SEQ, NP8, F.G, F.bid); S.bid = F.bid;
          pg8::EpiProj8 E{F.PROJ};
          pg8::gemm_phase<1024, false, true>(F.lds, S, E, W8_SCALE_LOG2, H8_SCALE_LOG2);
#if DUP_PHASE == 21
          pg8::gemm_phase<1024, false, true>(F.lds, S, E, W8_SCALE_LOG2, H8_SCALE_LOG2);
#endif
        }
    }
    SEAM(2);
    if (IN(3)) {
#ifndef NO_IDX
        {
            ConvSt cv; cv.base = TC_LATE_START + F.bid; cv.cs = 0;
            __syncthreads();
            (void)conv_issue(F, cv.base, 0);
            for (int p = F.bid; p < 256; p += F.G) { idx::indexer_unit<0>(F, p, cv); idx::indexer_unit<0>(F, 511 - p, cv); }
#ifdef IDX_PROBE
            for (int p = F.bid; p < 256; p += F.G) { idx::indexer_unit<IDX_PROBE>(F, p, cv); idx::indexer_unit<IDX_PROBE>(F, 511 - p, cv); }
#endif
            conv_drain(F, cv.cs >= 1 ? cv.base + (cv.cs - 1) * F.G : -1, cv.cs - 1);
            asm volatile("s_waitcnt vmcnt(0)" ::: "memory"); __syncthreads();
            conv_drain(F, cv.base + cv.cs * F.G, cv.cs);
            __syncthreads();
            for (int tl = cv.base + (cv.cs + 1) * F.G;; tl += F.G) { TDesc d; f32x4 v[2]; if (!tconv_desc(F, tl, d)) break; tconv_load(F, d, v); tconv_store(F, d, v, 0); }
        }
#endif
#ifndef NO_BAND
        REP(31) for (int p = F.bid; p < 256; p += F.G) {
            const int h = p & 7, j = p >> 3;
            fill_tab_B(F, h, (LAS char*)F.lds);
#pragma unroll 1
            for (int s = 0; s < 2; ++s) {
                const int qt = s ? 63 - j : j, q0 = qt * 256;
                const int kt0 = (4 * qt - 8) > 0 ? (4 * qt - 8) : 0, kt1 = 4 * qt + 4;
                att::attn_unit<1, DMAX_B>(F.PROJ + (size_t)q0 * NPROJ + COL_QB + h * 128, F.PROJ + COL_KB + h * 128, F.PROJ + COL_VB + h * 128, (unsigned char*)F.YA + (size_t)q0 * 2048 + 1024 + h * 128, nullptr, q0, kt0, kt1, (LAS char*)F.lds);
            }
        }
#endif
    }
    SEAM(3);
    if (IN(4)) REP(4) {
        for (int p = F.bid; p < 256; p += F.G) {
            const int h = p & 7, j = p >> 3;
            fill_tab_A(F, h, (LAS char*)F.lds);
#pragma unroll 1
            for (int s = 0; s < 2; ++s) {
                const int qt = s ? 63 - j : j, q0 = qt * 256;
                att::attn_unit<0, DMAX_A>(F.PROJ + (size_t)q0 * NPROJ + COL_QA + h * 128, F.PROJ + COL_KA + h * 128, F.PROJ + COL_VA + h * 128, (unsigned char*)F.YA + (size_t)q0 * 2048 + h * 128, F.MASK + q0, q0, 0, 4 * qt + 4, (LAS char*)F.lds);
            }
        }
    }
    SEAM(4);
    if (IN(5)) {
        pg8::StaticOrder<1024> S; S.init(F.YA, F.Wupa8, SEQ, DM, F.G, F.bid);
        pg8::EpiGate2 E{F.PROJ, (unsigned char*)F.MRG};
        pg8::gemm_phase<1024, false, true>(F.lds, S, E, W8_SCALE_LOG2, Y8_SCALE_LOG2);
#if DUP_PHASE == 5
        pg8::gemm_phase<1024, false, true>(F.lds, S, E, W8_SCALE_LOG2, Y8_SCALE_LOG2);
#endif
    }
    SEAM(6);
    if (IN(7)) {
        pg8::StaticOrder<1024> S; S.init(F.MRG, F.Wo8, SEQ, DM, F.G, F.bid);
        pg8::EpiRes E{F.x, F.mod + 2 * DM, F.H};
        pg8::gemm_phase<1024, false, true>(F.lds, S, E, W8_SCALE_LOG2, M8_SCALE_LOG2);
#if DUP_PHASE == 7
        pg8::gemm_phase<1024, false, true>(F.lds, S, E, W8_SCALE_LOG2, M8_SCALE_LOG2);
#endif
    }
    SEAM(7);
#ifdef PROBE_LO
    if (IN(8)) { p8_router(F, args.dry); }
#else
    if (IN(8)) { p8_router(F); }
#endif
    SEAM(8);
    if (IN(9)) {
        moe_tables(F); moe1_fill_lists(F);
        MoeOrder1 S{&F, (const LAS int*)(F.lds + MOE_TS), (const LAS int*)(F.lds + MOE_TOK)};
        pg8::EpiMoe1 E{(unsigned char*)F.MRG};
        pg8::gemm_phase<1024, true, true>(F.lds, S, E, W8_SCALE_LOG2, H8_SCALE_LOG2);
#if DUP_PHASE == 9
        pg8::gemm_phase<1024, true, true>(F.lds, S, E, W8_SCALE_LOG2, H8_SCALE_LOG2);
#endif
    }
    SEAM(9);
    if (IN(10)) {
        moe_tables(F);
        MoeOrder2 S{&F, (const LAS int*)(F.lds + MOE_TS)};
        pg8::EpiMoe2 E{F.PROJ};
        pg8::gemm_phase<256, false, true>(F.lds, S, E, W2_SCALE_LOG2, A8_SCALE_LOG2);
#if DUP_PHASE == 10
        pg8::gemm_phase<256, false, true>(F.lds, S, E, W2_SCALE_LOG2, A8_SCALE_LOG2);
#endif
    }
    SEAM(10);
    if (IN(11)) {
        float tsc = 1.0f;
#ifdef TIME_A
        if (F.bid == 0) { if (F.tid == 0) { const float us_ = (float)(tpw_[1] - tpw_[0]) * 0.01f;
#ifndef TIME_OFS
#define TIME_OFS 0.0f
#endif
                const float q_ = floorf(log2f(us_) * 6.0f + TIME_OFS); const float usq_ = exp2f((q_ + 0.5f - TIME_OFS) / 6.0f);
                *(LAS float*)F.lds = 1.0f + sqrtf(usq_ * 1e-4f * 256.0f); } __syncthreads(); tsc = *(LAS float*)F.lds; }
#endif
        moe_tables(F); p11_final(F, tsc); }
#undef IN
#undef SEAM
}

extern "C" void kernel_launch(void* const* d_in, const int* in_sizes, int n_in, void* d_out, int out_size, void* d_ws, size_t ws_size, hipStream_t stream) {
    static int grid = 0;
    if (grid == 0) {
        if (n_in != 20 || out_size != SEQ * DM || ws_size < WS_END) { fprintf(stderr, "kernel_launch: shape/workspace mismatch: n_in %d out %d ws %zu (need %zu)\n", n_in, out_size, ws_size, (size_t)WS_END); grid = -1; return; }
        int dev = 0, cus = 0, per_cu = 0;
        if (hipGetDevice(&dev) != hipSuccess || hipDeviceGetAttribute(&cus, hipDeviceAttributeMultiprocessorCount, dev) != hipSuccess) { grid = -1; return; }
        if (hipFuncSetAttribute((const void*)fwd, hipFuncAttributeMaxDynamicSharedMemorySize, LDS_BYTES) != hipSuccess) { fprintf(stderr, "kernel_launch: hipFuncSetAttribute failed\n"); grid = -1; return; }
        if (hipOccupancyMaxActiveBlocksPerMultiprocessor(&per_cu, (const void*)fwd, 512, LDS_BYTES) != hipSuccess || per_cu < 1) fprintf(stderr, "kernel_launch: occupancy query says %d\n", per_cu);
        (void)hipGetLastError();
        grid = cus;
    }
    if (grid < 0) return;
    (void)hipMemsetAsync((char*)d_ws + WS_CTL, 0, CTL_BYTES, stream);
    Args a{};
    for (int i = 0; i < 20; ++i) a.in[i] = (const float*)d_in[i];
    a.out = (float*)d_out; a.ws = (unsigned char*)d_ws;
#if defined(PREFIX_K)
    a.ph_lo = 0; a.ph_hi = PREFIX_K + 1;
    hipLaunchKernelGGL(fwd, dim3(grid), dim3(512), LDS_BYTES, stream, a);
    (void)hipMemsetAsync((char*)d_ws + WS_CTL, 0, CTL_BYTES, stream);
    a.ph_lo = 0; a.ph_hi = N_PHASES;
    hipLaunchKernelGGL(fwd, dim3(grid), dim3(512), LDS_BYTES, stream, a);
#elif defined(PROBE_LO)
    a.ph_lo = 0; a.ph_hi = N_PHASES; a.dry = 0;
    hipLaunchKernelGGL(fwd, dim3(grid), dim3(512), LDS_BYTES, stream, a);
    for (int rep = 0; rep < PROBE_N; ++rep) {
        if (PROBE_HI - PROBE_LO > 1) (void)hipMemsetAsync((char*)d_ws + WS_CTL + CTL_BAR, 0, 16384, stream);
        if (PROBE_LO <= 8 && 8 < PROBE_HI && PROBE_DRY == 0) (void)hipMemsetAsync((char*)d_ws + WS_CTL + CTL_ECNT, 0, 4096 + 256, stream);
        a.ph_lo = PROBE_LO; a.ph_hi = PROBE_HI; a.dry = PROBE_DRY;
        hipLaunchKernelGGL(fwd, dim3(grid), dim3(512), LDS_BYTES, stream, a);
    }
#elif defined(SUFFIX_A)
    a.ph_lo = 0; a.ph_hi = N_PHASES;
    hipLaunchKernelGGL(fwd, dim3(grid), dim3(512), LDS_BYTES, stream, a);
    for (int rep = 0; rep < SUFFIX_N; ++rep) {
        (void)hipMemsetAsync((char*)d_ws + WS_CTL + CTL_BAR, 0, 16384, stream);
        if (SUFFIX_A <= 8) (void)hipMemsetAsync((char*)d_ws + WS_CTL + CTL_ECNT, 0, 4096 + 256, stream);
        a.ph_lo = SUFFIX_A; a.ph_hi = N_PHASES;
        hipLaunchKernelGGL(fwd, dim3(grid), dim3(512), LDS_BYTES, stream, a);
    }
#elif MK_N_LAUNCHES == 1
    a.ph_lo = 0; a.ph_hi = N_PHASES;
    hipLaunchKernelGGL(fwd, dim3(grid), dim3(512), LDS_BYTES, stream, a);
#else
    for (int ph = 0; ph < N_PHASES; ++ph) { a.ph_lo = ph; a.ph_hi = ph + 1; hipLaunchKernelGGL(fwd, dim3(grid), dim3(512), LDS_BYTES, stream, a); }
#endif
    const hipError_t le = hipPeekAtLastError();
    if (le != hipSuccess) fprintf(stderr, "kernel_launch: launch failed: %s\n", hipGetErrorName(le));
}
```
